# Optimizing an MI355X kernel written in HIP

```python
import math
import jax, jax.numpy as jnp
from jax import lax
import numpy as np

D_MODEL = 2048
BATCH = 4
SEQ = 2048
DEPTH = 1

MIX_WIDTH = D_MODEL
SSM_WIDTH = MIX_WIDTH // 2
ATTN_WIDTH = MIX_WIDTH - SSM_WIDTH
SSM_GROUP = 16
SSM_GROUPS = SSM_WIDTH // SSM_GROUP
SSM_STATE = 64
DT_MIN = 0.001
DT_MAX = 0.1
HEAD_DIM = 128
N_HEADS = ATTN_WIDTH // HEAD_DIM
DILATION_PAIRS = ((128, 1), (512, 4), (2048, 16))
Q_BLOCK = 128
ROPE_THETA = 10000.0
D_FF = -(-8 * D_MODEL // (3 * 256)) * 256
PROJ_WIDTH = SSM_WIDTH + 3 * ATTN_WIDTH
N_MOD = 6
EPS = 1e-6
NEG = -1e30

kernel_name = "hymba_s5_dilated_attn_block"


def rmsnorm(x, g):
    xf = x.astype(jnp.float32)
    y = xf * lax.rsqrt(jnp.mean(xf * xf, axis=-1, keepdims=True) + EPS)
    return (y * g.astype(jnp.float32)).astype(x.dtype)


def rope(t, pos):
    half = t.shape[-1] // 2
    inv_freq = ROPE_THETA ** (-jnp.arange(half, dtype=jnp.float32) / half)
    ang = pos.astype(jnp.float32)[:, :, None] * inv_freq
    cos = jnp.cos(ang)[:, :, None, :]
    sin = jnp.sin(ang)[:, :, None, :]
    t1, t2 = t[..., :half], t[..., half:]
    return jnp.concatenate([t1 * cos - t2 * sin, t1 * sin + t2 * cos], axis=-1)


def s5_mixer(u, a_re, a_im, log_dt, b_re, b_im, c_re, c_im, d_skip, w_glu, b_glu):
    bsz, s, _ = u.shape
    f32 = jnp.float32
    uf = u.astype(f32).reshape(bsz, s, SSM_GROUPS, SSM_GROUP)
    a_re = a_re.astype(f32); a_im = a_im.astype(f32)
    b_re = b_re.astype(f32); b_im = b_im.astype(f32)
    c_re = c_re.astype(f32); c_im = c_im.astype(f32)
    dt = jnp.exp(log_dt.astype(f32))[:, None]
    mag = jnp.exp(a_re * dt)
    abar_re = mag * jnp.cos(a_im * dt)
    abar_im = mag * jnp.sin(a_im * dt)
    den = a_re * a_re + a_im * a_im
    nr = abar_re - 1.0
    ni = abar_im
    f_re = (nr * a_re + ni * a_im) / den
    f_im = (ni * a_re - nr * a_im) / den
    bb_re = f_re[..., None] * b_re - f_im[..., None] * b_im
    bb_im = f_re[..., None] * b_im + f_im[..., None] * b_re
    bu_re = jnp.einsum('bsgc,gpc->bsgp', uf, bb_re)
    bu_im = jnp.einsum('bsgc,gpc->bsgp', uf, bb_im)
    ar_full = jnp.broadcast_to(abar_re, bu_re.shape)
    ai_full = jnp.broadcast_to(abar_im, bu_re.shape)

    def combine(e1, e2):
        a1r, a1i, b1r, b1i = e1
        a2r, a2i, b2r, b2i = e2
        return (a2r * a1r - a2i * a1i,
                a2r * a1i + a2i * a1r,
                a2r * b1r - a2i * b1i + b2r,
                a2r * b1i + a2i * b1r + b2i)

    _, _, st_re, st_im = lax.associative_scan(combine, (ar_full, ai_full, bu_re, bu_im), axis=1)
    y = (jnp.einsum('bsgp,gcp->bsgc', st_re, c_re)
         - jnp.einsum('bsgp,gcp->bsgc', st_im, c_im))
    y = y + d_skip.astype(f32).reshape(SSM_GROUPS, SSM_GROUP) * uf
    y = y.reshape(bsz, s, SSM_WIDTH)
    vg = jax.nn.gelu(y)
    out = vg * jax.nn.sigmoid(vg @ w_glu.astype(f32) + b_glu.astype(f32))
    return out.astype(u.dtype)


def dilated_branch(q, k, v, dilation, steps):
    bsz, s, h, e = q.shape
    seg = s // dilation
    nb = -(-seg // Q_BLOCK)
    segp = nb * Q_BLOCK

    def to_blocks(t):
        t = t.reshape(bsz, seg, dilation, h, e)
        t = jnp.pad(t, ((0, 0), (0, segp - seg), (0, 0), (0, 0), (0, 0)))
        return t.reshape(bsz, nb, Q_BLOCK, dilation, h, e)

    def with_prev(t):
        prev = jnp.pad(t[:, :-1], ((0, 0), (1, 0), (0, 0), (0, 0), (0, 0), (0, 0)))
        return jnp.concatenate([prev, t], axis=2)

    qb = to_blocks(q)
    kc = with_prev(to_blocks(k))
    vc = with_prev(to_blocks(v))
    sc = jnp.einsum('bnqrhe,bnkrhe->bnrhqk', qb, kc) * (e ** -0.5)
    qi = jnp.arange(Q_BLOCK)[:, None] + Q_BLOCK
    ki = jnp.arange(2 * Q_BLOCK)[None, :]
    dist = qi - ki
    band = (dist >= 0) & (dist <= steps)
    kglob = jnp.arange(nb)[:, None] * Q_BLOCK + ki - Q_BLOCK
    mask = band[None] & (kglob >= 0)[:, None, :]
    sc = jnp.where(mask[None, :, None, None], sc, NEG)
    m = jnp.max(sc, axis=-1, keepdims=True)
    p = jnp.exp(sc - m)
    l = jnp.sum(p, axis=-1, keepdims=True)
    o = jnp.einsum('bnrhqk,bnkrhe->bnrhqe', p, vc) / l
    lse = (m + jnp.log(l))[..., 0]
    o = o.transpose(0, 1, 4, 2, 3, 5).reshape(bsz, segp, dilation, h, e)[:, :seg]
    lse = lse.transpose(0, 1, 4, 2, 3).reshape(bsz, segp, dilation, h)[:, :seg]
    return o.reshape(bsz, s, h, e), lse.reshape(bsz, s, h)


def dilated_attention(q, k, v, positions):
    bsz, s, _ = q.shape
    f32 = jnp.float32
    q = rope(q.astype(f32).reshape(bsz, s, N_HEADS, HEAD_DIM), positions)
    k = rope(k.astype(f32).reshape(bsz, s, N_HEADS, HEAD_DIM), positions)
    vh = v.astype(f32).reshape(bsz, s, N_HEADS, HEAD_DIM)
    outs = []
    lses = []
    for window, dilation in DILATION_PAIRS:
        o, lse = dilated_branch(q, k, vh, dilation, window // dilation)
        outs.append(o)
        lses.append(lse)
    wts = jax.nn.softmax(jnp.stack(lses, axis=0), axis=0)
    o = jnp.sum(wts[..., None] * jnp.stack(outs, axis=0), axis=0)
    return o.reshape(bsz, s, ATTN_WIDTH).astype(v.dtype)


def setup_inputs(seed: int = 0) -> dict:
    key = jax.random.key(seed)
    ks = jax.random.split(key, 32)
    f32 = jnp.float32
    nrm = lambda k, shape, scale: jax.random.normal(k, shape, f32) * scale
    x = nrm(ks[0], (BATCH, SEQ, D_MODEL), 1.0)
    c = nrm(ks[1], (BATCH, D_MODEL), 1.0)
    offs = jax.random.randint(ks[2], (BATCH, 1), 0, 4096, dtype=jnp.int32)
    positions = offs + jnp.arange(SEQ, dtype=jnp.int32)[None, :]
    w_mod = nrm(ks[3], (DEPTH, D_MODEL, N_MOD * D_MODEL), 0.5 * D_MODEL ** -0.5)
    b_mod = nrm(ks[4], (DEPTH, N_MOD * D_MODEL), 0.02)
    g_mix = 1.0 + nrm(ks[5], (DEPTH, D_MODEL), 0.01)
    w_in = nrm(ks[6], (DEPTH, D_MODEL, PROJ_WIDTH), D_MODEL ** -0.5)
    n_idx = jnp.arange(SSM_STATE, dtype=f32)
    ssm_a_re = -0.5 + nrm(ks[7], (DEPTH, SSM_GROUPS, SSM_STATE), 0.01)
    ssm_a_im = math.pi * n_idx + nrm(ks[8], (DEPTH, SSM_GROUPS, SSM_STATE), 0.01)
    ssm_log_dt = jax.random.uniform(ks[9], (DEPTH, SSM_GROUPS), f32,
                                    math.log(DT_MIN), math.log(DT_MAX))
    ssm_b_re = nrm(ks[10], (DEPTH, SSM_GROUPS, SSM_STATE, SSM_GROUP), (2 * SSM_GROUP) ** -0.5)
    ssm_b_im = nrm(ks[11], (DEPTH, SSM_GROUPS, SSM_STATE, SSM_GROUP), (2 * SSM_GROUP) ** -0.5)
    ssm_c_re = nrm(ks[12], (DEPTH, SSM_GROUPS, SSM_GROUP, SSM_STATE), 1.0)
    ssm_c_im = nrm(ks[13], (DEPTH, SSM_GROUPS, SSM_GROUP, SSM_STATE), 1.0)
    ssm_d = nrm(ks[14], (DEPTH, SSM_WIDTH), 0.5)
    w_glu = nrm(ks[15], (DEPTH, SSM_WIDTH, SSM_WIDTH), SSM_WIDTH ** -0.5)
    b_glu = nrm(ks[16], (DEPTH, SSM_WIDTH), 0.01)
    g_ssm_out = 1.0 + nrm(ks[17], (DEPTH, SSM_WIDTH), 0.01)
    g_attn_out = 1.0 + nrm(ks[18], (DEPTH, ATTN_WIDTH), 0.01)
    w_out = nrm(ks[19], (DEPTH, MIX_WIDTH, D_MODEL), MIX_WIDTH ** -0.5)
    g_ffn = 1.0 + nrm(ks[20], (DEPTH, D_MODEL), 0.01)
    w_gate = nrm(ks[21], (DEPTH, D_MODEL, D_FF), D_MODEL ** -0.5)
    w_up = nrm(ks[22], (DEPTH, D_MODEL, D_FF), D_MODEL ** -0.5)
    w_down = nrm(ks[23], (DEPTH, D_FF, D_MODEL), D_FF ** -0.5)
    g_final = 1.0 + nrm(ks[24], (D_MODEL,), 0.01)
    return {"x": x, "c": c, "positions": positions, "w_mod": w_mod, "b_mod": b_mod,
            "g_mix": g_mix, "w_in": w_in, "ssm_a_re": ssm_a_re, "ssm_a_im": ssm_a_im,
            "ssm_log_dt": ssm_log_dt, "ssm_b_re": ssm_b_re, "ssm_b_im": ssm_b_im,
            "ssm_c_re": ssm_c_re, "ssm_c_im": ssm_c_im, "ssm_d": ssm_d, "w_glu": w_glu,
            "b_glu": b_glu, "g_ssm_out": g_ssm_out, "g_attn_out": g_attn_out, "w_out": w_out,
            "g_ffn": g_ffn, "w_gate": w_gate, "w_up": w_up, "w_down": w_down,
            "g_final": g_final}


def reference(x, c, positions, w_mod, b_mod, g_mix, w_in, ssm_a_re, ssm_a_im, ssm_log_dt,
              ssm_b_re, ssm_b_im, ssm_c_re, ssm_c_im, ssm_d, w_glu, b_glu, g_ssm_out,
              g_attn_out, w_out, g_ffn, w_gate, w_up, w_down, g_final):
    for l in range(DEPTH):
        mod = (jax.nn.silu(c) @ w_mod[l] + b_mod[l])[:, None, :]
        sh1, sc1, gt1, sh2, sc2, gt2 = jnp.split(mod, N_MOD, axis=-1)
        h = rmsnorm(x, g_mix[l]) * (1.0 + sc1) + sh1
        proj = h @ w_in[l]
        u, q, k, v = jnp.split(proj, [SSM_WIDTH, SSM_WIDTH + ATTN_WIDTH,
                                      SSM_WIDTH + 2 * ATTN_WIDTH], axis=-1)
        y_ssm = s5_mixer(u, ssm_a_re[l], ssm_a_im[l], ssm_log_dt[l], ssm_b_re[l], ssm_b_im[l],
                         ssm_c_re[l], ssm_c_im[l], ssm_d[l], w_glu[l], b_glu[l])
        y_att = dilated_attention(q, k, v, positions)
        y = jnp.concatenate([rmsnorm(y_ssm, g_ssm_out[l]), rmsnorm(y_att, g_attn_out[l])], axis=-1)
        x = x + gt1 * (y @ w_out[l])
        h = rmsnorm(x, g_ffn[l]) * (1.0 + sc2) + sh2
        f = (jax.nn.silu(h @ w_gate[l]) * (h @ w_up[l])) @ w_down[l]
        x = x + gt2 * f
    return rmsnorm(x, g_final)
```

```cpp
#include <hip/hip_runtime.h>
#include <hip/hip_cooperative_groups.h>
#include <cstdio>
#include <cstdint>
namespace cg = cooperative_groups;
namespace pg8 {
#define PG8_LAS __attribute__((address_space(3)))
typedef unsigned short bf16_t;
typedef short bf16x8 __attribute__((ext_vector_type(8)));
typedef float f32x4 __attribute__((ext_vector_type(4)));
typedef unsigned u32x4 __attribute__((ext_vector_type(4)));
constexpr int BM = 256, BK = 64, HALF = 128, HTB = HALF * BK * 2  , STAGE_BYTES = 8 * HTB, NXCD = 8, WGM = 8;

__host__ __device__ __forceinline__ int lds_byte(int r, int c) { const int st = (r >> 4) * 2 + (c >> 5), rr = r & 15, cc = c & 31, ob = rr * 64 + cc * 2; return st * 1024 + (ob ^ (((ob >> 9) & 1) << 5)); }
__host__ __device__ __forceinline__ void stage_rc(int b, int& R, int& C) { const int st = b / 1024, sb = b % 1024, swz = sb ^ (((sb >> 9) & 1) << 5); R = (st >> 1) * 16 + swz / 64; C = (st & 1) * 32 + (swz % 64) / 2; }
__host__ __device__ __forceinline__ int perm32(int rho) { const int n = rho >> 4, i = rho & 15; return 8 * (i >> 2) + 4 * n + (i & 3); }

struct Unit { int pm, pn; };
struct Gemm { const bf16_t* A; const bf16_t* Bt; int M, N, K; };

struct StaticOrder {
    int nM, nN, nwg, G, c;
    __host__ __device__ void init(int M, int N, int G_, int c_) { nM = M / BM; nN = N / BM; nwg = nM * nN; G = G_; c = c_; }
    __host__ __device__ bool next(int i, Unit& u) const {
        const long L = (long)i * G + c; if (L >= nwg) return false;
        int wgid = (int)L; { const int q = nwg / NXCD, r = nwg % NXCD, xcd = wgid % NXCD, off = wgid / NXCD; wgid = (xcd < r ? xcd * (q + 1) : r * (q + 1) + (xcd - r) * q) + off; }
        const int nig = WGM * nN, gid = wgid / nig, fm = gid * WGM, gsz = (nM - fm) < WGM ? (nM - fm) : WGM;
        u.pm = fm + ((wgid % nig) % gsz); u.pn = (wgid % nig) / gsz; return true;
    }
    __device__ __forceinline__ void a_ready(const Unit&) const {}
    __device__ __forceinline__ void done(const Unit&) const {}
};

__device__ __forceinline__ unsigned cvt_pk_bf16(float lo, float hi) { unsigned r; asm volatile("v_cvt_pk_bf16_f32 %0, %1, %2" : "=v"(r) : "v"(lo), "v"(hi)); return r; }
typedef float f32x2 __attribute__((ext_vector_type(2)));
__device__ __forceinline__ f32x2 gelu_pk(f32x2 v) {
    const f32x2 av = __builtin_elementwise_abs(v), d = av * 0.2316418882f + 1.0f;
    f32x2 t; t.x = __builtin_amdgcn_rcpf(d.x); t.y = __builtin_amdgcn_rcpf(d.y);
    f32x2 q = t * 0.5307027145f + (-0.7265760135f); q = q * t + 0.7107068705f; q = q * t + (-0.142248368f); q = q * t + 0.127414796f; q = q * t;
    const f32x2 s = (v * v) * (-0.72134752044f);
    f32x2 e; e.x = __builtin_amdgcn_exp2f(s.x); e.y = __builtin_amdgcn_exp2f(s.y);
    const f32x2 m = v * (q * e), r = v - m;
    f32x2 o; o.x = v.x < 0.f ? m.x : r.x; o.y = v.y < 0.f ? m.y : r.y; return o;
}

__device__ __forceinline__ float bflo(unsigned w) { return __uint_as_float(w << 16); }
__device__ __forceinline__ float bfhi(unsigned w) { return __uint_as_float(w & 0xffff0000u); }
__device__ __forceinline__ float fast_sigmoid(float v) { return __builtin_amdgcn_rcpf(1.0f + __builtin_amdgcn_exp2f(-1.4426950408889634f * v)); }
struct EpiProj {
    static constexpr bool PERM = true, AFTER_DRAIN = false;
    bf16_t* O; const float* cosT; const float* sinT; float qscale;
    __device__ __forceinline__ void operator()(const f32x4 (&acc)[2][2][4][2], const Unit& u, int wr, int wc, int fr, int fq) const {
        const int row0 = u.pm * BM + wr * 64 + fr; const int col0 = u.pn * BM + wc * 32 + 8 * fq;
        const int sect = u.pn >> 2;
        const int j0 = 4 * (4 * wc + fq);
        const float sc = (sect == 1) ? qscale : 1.f;
#pragma unroll
        for (int ai = 0; ai < 2; ++ai)
#pragma unroll
            for (int m = 0; m < 4; ++m) { const int row = row0 + ai * HALF + m * 16; bf16_t* rowp = O + (size_t)row * 4096 + col0;
                f32x4 cs = (f32x4){1.f, 1.f, 1.f, 1.f}, sn = (f32x4){0.f, 0.f, 0.f, 0.f};
                if (sect == 1 || sect == 2) { cs = *(const f32x4*)(cosT + (size_t)row * 64 + j0); sn = *(const f32x4*)(sinT + (size_t)row * 64 + j0); }
#pragma unroll
                for (int bj = 0; bj < 2; ++bj) { const f32x4 t1 = acc[ai][bj][m][0], t2 = acc[ai][bj][m][1];
                    f32x4 v0 = (t1 * cs - t2 * sn) * sc, v1 = (t1 * sn + t2 * cs) * sc;
                    u32x4 w; w.x = cvt_pk_bf16(v0[0], v0[1]); w.y = cvt_pk_bf16(v0[2], v0[3]); w.z = cvt_pk_bf16(v1[0], v1[1]); w.w = cvt_pk_bf16(v1[2], v1[3]);
                    *(u32x4*)(rowp + bj * HALF) = w; } }
    }
};
struct EpiGlu {
    static constexpr bool PERM = true, AFTER_DRAIN = false;
    bf16_t* O; const bf16_t* VG; const float* bias;
    __device__ __forceinline__ void operator()(const f32x4 (&acc)[2][2][4][2], const Unit& u, int wr, int wc, int fr, int fq) const {
        const int row0 = u.pm * BM + wr * 64 + fr; const int col0 = u.pn * BM + wc * 32 + 8 * fq;
        f32x4 bv[2][2];
#pragma unroll
        for (int bj = 0; bj < 2; ++bj)
#pragma unroll
            for (int n = 0; n < 2; ++n) bv[bj][n] = *(const f32x4*)(bias + col0 + bj * HALF + 4 * n);
#pragma unroll
        for (int ai = 0; ai < 2; ++ai)
#pragma unroll
            for (int m = 0; m < 4; ++m) { const int row = row0 + ai * HALF + m * 16;
#pragma unroll
                for (int bj = 0; bj < 2; ++bj) { const u32x4 g = *(const u32x4*)(VG + (size_t)row * 1024 + col0 + bj * HALF);
                    const f32x4 a0 = acc[ai][bj][m][0] + bv[bj][0], a1 = acc[ai][bj][m][1] + bv[bj][1];
                    u32x4 w; w.x = cvt_pk_bf16(bflo(g.x) * fast_sigmoid(a0[0]), bfhi(g.x) * fast_sigmoid(a0[1])); w.y = cvt_pk_bf16(bflo(g.y) * fast_sigmoid(a0[2]), bfhi(g.y) * fast_sigmoid(a0[3]));
                    w.z = cvt_pk_bf16(bflo(g.z) * fast_sigmoid(a1[0]), bfhi(g.z) * fast_sigmoid(a1[1])); w.w = cvt_pk_bf16(bflo(g.w) * fast_sigmoid(a1[2]), bfhi(g.w) * fast_sigmoid(a1[3]));
                    *(u32x4*)(O + (size_t)row * 2048 + col0 + bj * HALF) = w; } }
    }
};
struct EpiResid {
    static constexpr bool PERM = false, AFTER_DRAIN = false;
    const float* base; float* out; const float* gate;
    __device__ __forceinline__ void operator()(const f32x4 (&acc)[2][2][4][2], const Unit& u, int wr, int wc, int fr, int fq) const {
        const int col0 = u.pn * BM + wc * 32 + 4 * fq; const int b = u.pm >> 3;
        f32x4 gv[2][2];
#pragma unroll
        for (int bj = 0; bj < 2; ++bj)
#pragma unroll
            for (int n = 0; n < 2; ++n) gv[bj][n] = *(const f32x4*)(gate + (size_t)b * 12288 + col0 + bj * HALF + n * 16);
#pragma unroll
        for (int ai = 0; ai < 2; ++ai)
#pragma unroll
            for (int m = 0; m < 4; ++m) { const size_t off = (size_t)(u.pm * BM + ai * HALF + wr * 64 + m * 16 + fr) * 2048 + col0;
#pragma unroll
                for (int bj = 0; bj < 2; ++bj)
#pragma unroll
                    for (int n = 0; n < 2; ++n) { const f32x4 bs = *(const f32x4*)(base + off + bj * HALF + n * 16);
                        *(f32x4*)(out + off + bj * HALF + n * 16) = bs + gv[bj][n] * acc[ai][bj][m][n]; } }
    }
};
struct EpiSwiglu {
    static constexpr bool PERM = true, AFTER_DRAIN = false;
    bf16_t* O;
    __device__ __forceinline__ void operator()(const f32x4 (&acc)[2][2][4][2], const Unit& u, int wr, int wc, int fr, int fq) const {
        const int row0 = u.pm * BM + wr * 64 + fr; const int col0 = u.pn * HALF + wc * 32 + 8 * fq;
#pragma unroll
        for (int ai = 0; ai < 2; ++ai)
#pragma unroll
            for (int m = 0; m < 4; ++m) { const int row = row0 + ai * HALF + m * 16;
                const f32x4 g0 = acc[ai][0][m][0], g1 = acc[ai][0][m][1], u0 = acc[ai][1][m][0], u1 = acc[ai][1][m][1];
                f32x4 v0, v1;
#pragma unroll
                for (int i = 0; i < 4; ++i) { v0[i] = g0[i] * fast_sigmoid(g0[i]) * u0[i]; v1[i] = g1[i] * fast_sigmoid(g1[i]) * u1[i]; }
                u32x4 w; w.x = cvt_pk_bf16(v0[0], v0[1]); w.y = cvt_pk_bf16(v0[2], v0[3]); w.z = cvt_pk_bf16(v1[0], v1[1]); w.w = cvt_pk_bf16(v1[2], v1[3]);
                *(u32x4*)(O + (size_t)row * 5632 + col0) = w; }
    }
};

template <class Epi, class Sched, bool ALIGN_EPI = false, bool SP2 = false>
__device__ __forceinline__ void gemm_phase(PG8_LAS unsigned char* lds, const Gemm g, const Sched& S, const Epi& E) {
    const int tid = threadIdx.x, wid = __builtin_amdgcn_readfirstlane(tid >> 6), lane = tid & 63, wr = wid >> 2, wc = wid & 3, fr = lane & 15, fq = lane >> 4;
    const int K = g.K, nt = K / BK;
    unsigned voffA[2], voffB[2];
#pragma unroll
    for (int i = 0; i < 2; ++i) { int R, C; stage_rc(tid * 16 + i * 8192, R, C); const int Rb = Epi::PERM ? ((R & ~31) + perm32(R & 31)) : R;
        voffA[i] = (unsigned)(R * K + C) * 2u; voffB[i] = (unsigned)(Rb * K + C) * 2u; }
    const size_t kstep = (size_t)(BK * 2);
    const size_t hstep = (size_t)HALF * K * 2;
    const size_t tstep = 2 * hstep;
    const unsigned ldsw = (unsigned)wid * 1024u;
    const int aoff = lds_byte(wr * 64 + fr, fq * 8), boff = lds_byte(wc * 32 + fr, fq * 8);
#define PG8_SA(b, h) (((b) * 2 + (h)) * HTB)
#define PG8_SB(b, h) ((4 + (b) * 2 + (h)) * HTB)
#define PG8_STAGE(bufoff, gbase, voff) do { _Pragma("unroll") for (int _i = 0; _i < 2; ++_i) \
        __builtin_amdgcn_global_load_lds((const unsigned*)((const char*)(gbase) + (voff)[_i]), (PG8_LAS unsigned*)(lds + (bufoff) + ldsw + _i * 8192), 16, 0, 0); } while (0)
#define PG8_LDA(dst, b, h) do { _Pragma("unroll") for (int m = 0; m < 4; ++m) _Pragma("unroll") for (int k = 0; k < 2; ++k) dst[m][k] = *(const PG8_LAS bf16x8*)(lds + PG8_SA(b, h) + aoff + m * 2048 + k * 1024); } while (0)
#define PG8_LDB(dst, b, h) do { _Pragma("unroll") for (int n = 0; n < 2; ++n) _Pragma("unroll") for (int k = 0; k < 2; ++k) dst[n][k] = *(const PG8_LAS bf16x8*)(lds + PG8_SB(b, h) + boff + n * 2048 + k * 1024); } while (0)
#define PG8_MMA(ai, bj, At, Bt) do { __builtin_amdgcn_s_setprio(1); _Pragma("unroll") for (int m = 0; m < 4; ++m) _Pragma("unroll") for (int n = 0; n < 2; ++n) _Pragma("unroll") for (int k = 0; k < 2; ++k) \
        acc[ai][bj][m][n] = __builtin_amdgcn_mfma_f32_16x16x32_bf16(Bt[n][k], At[m][k], acc[ai][bj][m][n], 0, 0, 0); __builtin_amdgcn_s_setprio(0); } while (0)
#define PG8_WAIT_V(n) asm volatile("s_waitcnt vmcnt(" #n ")" ::: "memory")
#define PG8_WAIT_L(n) asm volatile("s_waitcnt lgkmcnt(" #n ")" ::: "memory")
#define PG8_BAR __builtin_amdgcn_s_barrier()
#define PG8_SCHED __builtin_amdgcn_sched_barrier(0)
    Unit cur, nxt; int ui = 0;
    if (!S.next(0, cur)) return;
    f32x4 acc[2][2][4][2];
#pragma unroll
    for (int a = 0; a < 2; ++a)
#pragma unroll
        for (int b = 0; b < 2; ++b)
#pragma unroll
            for (int m = 0; m < 4; ++m)
#pragma unroll
                for (int n = 0; n < 2; ++n) acc[a][b][m][n] = (f32x4){0.f, 0.f, 0.f, 0.f};
    bf16x8 At[4][2], B0[2][2], B1[2][2];
    const char* cA = (const char*)g.A + (size_t)cur.pm * tstep; const char* cB = (const char*)g.Bt + (size_t)cur.pn * tstep;
    S.a_ready(cur);
    if constexpr (SP2) {
        PG8_STAGE(PG8_SB(0, 0), cB, voffB); PG8_STAGE(PG8_SB(0, 1), cB + hstep, voffB); PG8_STAGE(PG8_SA(0, 0), cA, voffA); PG8_STAGE(PG8_SA(0, 1), cA + hstep, voffA);
        if (wr == 1) PG8_BAR;
        PG8_WAIT_V(2); PG8_BAR;
        PG8_STAGE(PG8_SB(1, 0), cB + kstep, voffB); PG8_STAGE(PG8_SA(1, 0), cA + kstep, voffA); PG8_STAGE(PG8_SB(1, 1), cB + hstep + kstep, voffB);
        PG8_WAIT_V(6); PG8_BAR;
    } else {
        PG8_STAGE(PG8_SB(0, 0), cB, voffB); PG8_STAGE(PG8_SA(0, 0), cA, voffA); PG8_STAGE(PG8_SB(0, 1), cB + hstep, voffB); PG8_STAGE(PG8_SA(0, 1), cA + hstep, voffA);
        if (wr == 1) PG8_BAR;
        PG8_WAIT_V(4); PG8_BAR;
        PG8_STAGE(PG8_SB(1, 0), cB + kstep, voffB); PG8_STAGE(PG8_SA(1, 0), cA + kstep, voffA); PG8_STAGE(PG8_SB(1, 1), cB + hstep + kstep, voffB);
        PG8_WAIT_V(6); PG8_BAR;
    }
    for (;;) {
        const bool has_next = S.next(ui + 1, nxt);
        const char* nA = has_next ? (const char*)g.A + (size_t)nxt.pm * tstep : cA; const char* nB = has_next ? (const char*)g.Bt + (size_t)nxt.pn * tstep : cB;
        for (int t = 0; t < nt; t += 2) {
            const bool last = (t == nt - 2);
            const char* a1 = cA + (size_t)(t + 1) * kstep;
            const char* a2 = last ? nA : cA + (size_t)(t + 2) * kstep; const char* b2 = last ? nB : cB + (size_t)(t + 2) * kstep;
            const char* a3 = a2 + kstep; const char* b3 = b2 + kstep;
            if (last && has_next) S.a_ready(nxt);
            if constexpr (SP2) {
            PG8_LDB(B0, 0, 0); PG8_LDB(B1, 0, 1); PG8_SCHED; PG8_LDA(At, 0, 0); PG8_STAGE(PG8_SA(1, 1), a1 + hstep, voffA);
            PG8_WAIT_V(8); PG8_WAIT_L(0); PG8_BAR; PG8_MMA(0, 0, At, B0); PG8_MMA(0, 1, At, B1); PG8_BAR; PG8_SCHED;
            PG8_LDA(At, 0, 1); PG8_STAGE(PG8_SB(0, 0), b2, voffB); PG8_STAGE(PG8_SB(0, 1), b2 + hstep, voffB); PG8_STAGE(PG8_SA(0, 0), a2, voffA);
            PG8_WAIT_V(8); PG8_WAIT_L(0); PG8_BAR; PG8_MMA(1, 0, At, B0); PG8_MMA(1, 1, At, B1); PG8_BAR; PG8_SCHED;
            PG8_LDB(B0, 1, 0); PG8_LDB(B1, 1, 1); PG8_SCHED; PG8_LDA(At, 1, 0); PG8_STAGE(PG8_SA(0, 1), a2 + hstep, voffA);
            PG8_WAIT_V(8); PG8_WAIT_L(0); PG8_BAR; PG8_MMA(0, 0, At, B0); PG8_MMA(0, 1, At, B1); PG8_BAR; PG8_SCHED;
            PG8_LDA(At, 1, 1); PG8_STAGE(PG8_SB(1, 0), b3, voffB); PG8_STAGE(PG8_SB(1, 1), b3 + hstep, voffB); PG8_STAGE(PG8_SA(1, 0), a3, voffA);
            PG8_WAIT_V(8); PG8_WAIT_L(0); PG8_BAR; PG8_MMA(1, 0, At, B0); PG8_MMA(1, 1, At, B1); PG8_BAR; PG8_SCHED;
            } else {
            PG8_LDB(B0, 0, 0); PG8_SCHED; PG8_LDA(At, 0, 0); PG8_STAGE(PG8_SA(1, 1), a1 + hstep, voffA);
            PG8_WAIT_L(8); PG8_BAR; PG8_WAIT_L(0); PG8_MMA(0, 0, At, B0); PG8_BAR; PG8_SCHED;
            PG8_LDB(B1, 0, 1); PG8_STAGE(PG8_SB(0, 0), b2, voffB);
            PG8_BAR; PG8_WAIT_L(0); PG8_MMA(0, 1, At, B1); PG8_BAR;
            PG8_LDA(At, 0, 1); PG8_STAGE(PG8_SA(0, 0), a2, voffA);
            PG8_BAR; PG8_WAIT_L(0); PG8_MMA(1, 0, At, B0); PG8_BAR; PG8_SCHED;
            PG8_STAGE(PG8_SB(0, 1), b2 + hstep, voffB);
            PG8_WAIT_V(6); PG8_BAR; PG8_MMA(1, 1, At, B1); PG8_BAR;
            PG8_LDB(B0, 1, 0); PG8_SCHED; PG8_LDA(At, 1, 0); PG8_STAGE(PG8_SA(0, 1), a2 + hstep, voffA);
            PG8_WAIT_L(8); PG8_BAR; PG8_WAIT_L(0); PG8_MMA(0, 0, At, B0); PG8_BAR; PG8_SCHED;
            PG8_LDB(B1, 1, 1); PG8_STAGE(PG8_SB(1, 0), b3, voffB);
            PG8_BAR; PG8_WAIT_L(0); PG8_MMA(0, 1, At, B1); PG8_BAR;
            PG8_LDA(At, 1, 1); PG8_STAGE(PG8_SA(1, 0), a3, voffA);
            PG8_BAR; PG8_WAIT_L(0); PG8_MMA(1, 0, At, B0); PG8_BAR; PG8_SCHED;
            PG8_STAGE(PG8_SB(1, 1), b3 + hstep, voffB);
            PG8_WAIT_V(6); PG8_BAR; PG8_MMA(1, 1, At, B1); PG8_BAR;
            }
        }
        if constexpr (ALIGN_EPI) { if (wr == 0) PG8_BAR; }
        if constexpr (!Epi::AFTER_DRAIN) { E(acc, cur, wr, wc, fr, fq); S.done(cur); }
        if (!has_next) break;
#pragma unroll
        for (int a = 0; a < 2; ++a)
#pragma unroll
            for (int b = 0; b < 2; ++b)
#pragma unroll
                for (int m = 0; m < 4; ++m)
#pragma unroll
                    for (int n = 0; n < 2; ++n) acc[a][b][m][n] = (f32x4){0.f, 0.f, 0.f, 0.f};
        cur = nxt; cA = nA; cB = nB; ++ui;
        if constexpr (ALIGN_EPI) { if (wr == 1) PG8_BAR; }
    }
    PG8_WAIT_V(0);
    if constexpr (!ALIGN_EPI) { if (wr == 0) PG8_BAR; }
    PG8_BAR;
    if constexpr (Epi::AFTER_DRAIN) { E.fused(acc, cur, wr, wc, fr, fq, lds, wid, lane); S.done(cur); }
#undef PG8_SA
#undef PG8_SB
#undef PG8_STAGE
#undef PG8_LDA
#undef PG8_LDB
#undef PG8_MMA
#undef PG8_WAIT_V
#undef PG8_WAIT_L
#undef PG8_BAR
#undef PG8_SCHED
}
}

constexpr int NWAVES = 8;
constexpr int BATCH = 4, SEQ = 2048, DM = 2048, MTOK = BATCH * SEQ, SSMW = 1024, ATTW = 1024, NGRP = 64, NST = 64, NHEAD = 8, HDIM = 128, DFF = 5632, PROJW = 4096, NMODW = 6 * DM;
constexpr int KSPLIT = 32;
constexpr size_t MiB = 1u << 20;
constexpr size_t WS_MODP = 2 * MiB, WS_MODF = 8 * MiB, WS_ROPE = 9 * MiB, WS_KTAB = 13 * MiB, WS_GTAB = 16 * MiB, WS_HTAB = 32 * MiB, WS_A64 = 48 * MiB;
constexpr size_t WS_WIN = 49 * MiB, WS_WGLU = 65 * MiB, WS_WOUT = 67 * MiB, WS_WGU = 75 * MiB, WS_WDN = 119 * MiB, WS_H = 141 * MiB, WS_PROJ = 173 * MiB, WS_VG = 237 * MiB;
constexpr size_t WS_YCAT = 253 * MiB, WS_OBR = 285 * MiB, WS_LSE = 333 * MiB, WS_FF = 173 * MiB, WS_END = 334 * MiB;
static_assert(WS_FF + (size_t)MTOK * DFF * 2 <= WS_OBR, "ff overlay");
constexpr int LDS_BYTES = 147456;

#define GAS __attribute__((address_space(1)))
#define LAS __attribute__((address_space(3)))
typedef unsigned short bf16;
typedef unsigned v4u __attribute__((ext_vector_type(4)));
typedef unsigned v2u __attribute__((ext_vector_type(2)));
typedef float f32x4 __attribute__((ext_vector_type(4)));
typedef float f32x16 __attribute__((ext_vector_type(16)));
typedef short bf16x8 __attribute__((ext_vector_type(8)));
typedef short s16x4 __attribute__((ext_vector_type(4)));
#define LDS_WAIT() asm volatile("s_waitcnt lgkmcnt(0)" ::: "memory")
__device__ __forceinline__ unsigned f2bf(float f) { unsigned u = __builtin_bit_cast(unsigned, f); return (u + 0x7fffu + ((u >> 16) & 1u)) >> 16; }
__device__ __forceinline__ unsigned pk2(float lo, float hi) { return f2bf(lo) | (f2bf(hi) << 16); }
__device__ __forceinline__ float bf_lo(unsigned w) { return __uint_as_float(w << 16); }
__device__ __forceinline__ float bf_hi(unsigned w) { return __uint_as_float(w & 0xffff0000u); }
__device__ __forceinline__ float wave_sum(float v) {
#pragma unroll
    for (int o = 1; o < 64; o <<= 1) v += __shfl_xor(v, o);
    return v;
}

struct Args { const float* in[25]; float* out; unsigned char* ws; int ph_lo, ph_hi; };

template <int MODE>
__device__ __forceinline__ void p0_transpose_item(const float* __restrict__ W, int K, int N, bf16* WT, LAS float* scr, int item, int lane, const float* gs, const float* ga) {
    const int nblk = N / 32, kb = item / nblk, nb = item % nblk, k0 = 64 * kb, n0 = 32 * nb;
#pragma unroll 8
    for (int i = 0; i < 32; ++i) { const int kk = 2 * i + (lane >> 5); float v = W[(size_t)(k0 + kk) * N + n0 + (lane & 31)];
        if (MODE == 4) { const int k = k0 + kk; v *= (k < SSMW) ? gs[k] : ga[k - SSMW]; }
        scr[kk * 33 + (lane & 31)] = v; }
    LDS_WAIT(); asm volatile("" ::: "memory");
    const int c = lane & 7;
#pragma unroll
    for (int j = 0; j < 4; ++j) { const int n = (lane >> 3) + 8 * j; const LAS float* s = scr + (8 * c) * 33 + n;
        v4u o; o.x = pk2(s[0 * 33], s[1 * 33]); o.y = pk2(s[2 * 33], s[3 * 33]); o.z = pk2(s[4 * 33], s[5 * 33]); o.w = pk2(s[6 * 33], s[7 * 33]);
        int col = n0 + n, row = col;
        if (MODE == 1) { if (col >= 1024 && col < 3072) { const int e = col & 127, half = e >> 6, ep = e & 63; row = (col - e) + ((ep >> 2) << 3) + (half << 2) + (ep & 3); } }
        if (MODE == 2) row = (col >> 7) * 256 + (col & 127);
        if (MODE == 3) row = (col >> 7) * 256 + 128 + (col & 127);
        *(GAS v4u*)(WT + (size_t)row * K + k0 + 8 * c) = o; }
    LDS_WAIT(); asm volatile("" ::: "memory");
}
__device__ __forceinline__ void p0_gemv_item(const float* __restrict__ cvec, const float* __restrict__ wmod, float* modp, LAS float* scr, int item, int lane) {
    const int ks = item / 48, cb = item % 48, k0 = ks * 64, col = cb * 256 + lane * 4;
#pragma unroll
    for (int b = 0; b < 4; ++b) { const float v = cvec[b * DM + k0 + lane]; scr[lane * 4 + b] = v / (1.0f + __expf(-v)); }
    LDS_WAIT(); asm volatile("" ::: "memory");
    f32x4 a0 = {0, 0, 0, 0}, a1 = a0, a2 = a0, a3 = a0;
#pragma unroll 8
    for (int k = 0; k < 64; ++k) { const f32x4 w = *(const f32x4*)(wmod + (size_t)(k0 + k) * NMODW + col); const f32x4 s = *(const LAS f32x4*)(scr + 4 * k);
        a0 += w * s[0]; a1 += w * s[1]; a2 += w * s[2]; a3 += w * s[3]; }
    float* o = modp + (size_t)(ks * 4) * NMODW + col;
    *(f32x4*)(o) = a0; *(f32x4*)(o + NMODW) = a1; *(f32x4*)(o + 2 * NMODW) = a2; *(f32x4*)(o + 3 * NMODW) = a3;
    LDS_WAIT(); asm volatile("" ::: "memory");
}
__device__ __forceinline__ void p0_rope_item(const int* __restrict__ pos, float* cosT, float* sinT, int item, int lane) {
    const double inv = exp(-(double)lane * (9.210340371976184 / 64.0));
    const double ang = (double)pos[item] * inv;
    cosT[(size_t)item * 64 + lane] = (float)cos(ang); sinT[(size_t)item * 64 + lane] = (float)sin(ang);
}
struct SsmLane { double xr, xi; };
__device__ __forceinline__ SsmLane ssm_lane(const float* are, const float* aim, const float* ldt, int g, int p) {
    const double dt = exp((double)ldt[g]); SsmLane L; L.xr = (double)are[g * 64 + p] * dt; L.xi = (double)aim[g * 64 + p] * dt; return L; }
__device__ __forceinline__ void ssm_pow(const SsmLane& L, int n, float& zr, float& zi) { const double m = exp(L.xr * n), th = L.xi * n; zr = (float)(m * cos(th)); zi = (float)(m * sin(th)); }
__device__ __forceinline__ void ssm_bbar(const float* are, const float* aim, const float* ldt, const float* bre, const float* bim, int g, int p, float (&br)[16], float (&bi)[16]) {
    const double dt = exp((double)ldt[g]), ar = are[g * 64 + p], ai = aim[g * 64 + p];
    const double m = exp(ar * dt), nr = m * cos(ai * dt) - 1.0, ni = m * sin(ai * dt), den = ar * ar + ai * ai;
    const float fr = (float)((nr * ar + ni * ai) / den), fi = (float)((ni * ar - nr * ai) / den);
    const f32x4* pr = (const f32x4*)(bre + (size_t)(g * 64 + p) * 16); const f32x4* pi = (const f32x4*)(bim + (size_t)(g * 64 + p) * 16);
#pragma unroll
    for (int q = 0; q < 4; ++q) { const f32x4 r = pr[q], i = pi[q];
#pragma unroll
        for (int e = 0; e < 4; ++e) { br[4 * q + e] = fr * r[e] - fi * i[e]; bi[4 * q + e] = fr * i[e] + fi * r[e]; } }
}
__device__ __forceinline__ void p0_ktab_item(const float* const* in, bf16* ktab, float* a64, LAS float* scr, int g, int ti, int lane) {
    if (ti == 0) { const SsmLane L = ssm_lane(in[7], in[8], in[9], g, lane); float zr, zi; ssm_pow(L, 64, zr, zi); a64[(g * 64 + lane) * 2] = zr; a64[(g * 64 + lane) * 2 + 1] = zi;
        *(GAS v2u*)(ktab + (size_t)(g * 65) * 256 + lane * 4) = (v2u){0u, 0u}; return; }
    { const SsmLane L = ssm_lane(in[7], in[8], in[9], g, lane); float zr, zi; ssm_pow(L, ti - 1, zr, zi);
      float br[16], bi[16]; ssm_bbar(in[7], in[8], in[9], in[10], in[11], g, lane, br, bi);
#pragma unroll
      for (int c = 0; c < 16; ++c) { scr[lane * 16 + c] = zr * br[c] - zi * bi[c]; scr[1024 + lane * 16 + c] = zr * bi[c] + zi * br[c]; } }
    LDS_WAIT(); asm volatile("" ::: "memory");
    const int c = lane >> 2, q = lane & 3; const float* cr = in[12] + (size_t)(g * 16 + c) * 64; const float* ci = in[13] + (size_t)(g * 16 + c) * 64;
    f32x4 acc = {0, 0, 0, 0};
#pragma unroll 8
    for (int p = 0; p < 64; ++p) { const f32x4 wr = *(const LAS f32x4*)(scr + p * 16 + 4 * q), wi = *(const LAS f32x4*)(scr + 1024 + p * 16 + 4 * q); acc += wr * cr[p] - wi * ci[p]; }
    *(GAS v2u*)(ktab + ((size_t)(g * 65 + ti) * 16 + c) * 16 + 4 * q) = (v2u){pk2(acc[0], acc[1]), pk2(acc[2], acc[3])};
    LDS_WAIT(); asm volatile("" ::: "memory");
}
__device__ __forceinline__ void p0_gtab_item(const float* const* in, bf16* gtab, int g, int t, int lane) {
    const SsmLane L = ssm_lane(in[7], in[8], in[9], g, lane); float zr, zi; ssm_pow(L, t + 1, zr, zi);
    const int p = lane;
#pragma unroll
    for (int c = 0; c < 16; ++c) { const float cr = in[12][(size_t)(g * 16 + c) * 64 + p], ci = in[13][(size_t)(g * 16 + c) * 64 + p];
        const float gre = cr * zr - ci * zi, gni = -(cr * zi + ci * zr);
        const size_t base = ((size_t)(g * 32 + (t >> 1)) * 8) * 512;
        { const int pp = p;      gtab[base + (size_t)(pp >> 4) * 512 + ((16 * (t & 1) + c) + 32 * ((pp >> 3) & 1)) * 8 + (pp & 7)] = (bf16)f2bf(gre); }
        { const int pp = p + 64; gtab[base + (size_t)(pp >> 4) * 512 + ((16 * (t & 1) + c) + 32 * ((pp >> 3) & 1)) * 8 + (pp & 7)] = (bf16)f2bf(gni); } }
}
__device__ __forceinline__ void p0_htab_item(const float* const* in, bf16* htab, int g, int s, int lane) {
    const SsmLane L = ssm_lane(in[7], in[8], in[9], g, lane); float zr, zi; ssm_pow(L, 63 - s, zr, zi);
    float br[16], bi[16]; ssm_bbar(in[7], in[8], in[9], in[10], in[11], g, lane, br, bi);
    float hr[16], hi[16];
#pragma unroll
    for (int c = 0; c < 16; ++c) { hr[c] = zr * br[c] - zi * bi[c]; hi[c] = zr * bi[c] + zi * br[c]; }
#pragma unroll
    for (int part = 0; part < 2; ++part) { const int pp = lane + 64 * part;
#pragma unroll
        for (int hh = 0; hh < 2; ++hh) { const float* v = part ? hi : hr; v4u o; o.x = pk2(v[8 * hh], v[8 * hh + 1]); o.y = pk2(v[8 * hh + 2], v[8 * hh + 3]); o.z = pk2(v[8 * hh + 4], v[8 * hh + 5]); o.w = pk2(v[8 * hh + 6], v[8 * hh + 7]);
            *(GAS v4u*)(htab + ((((size_t)(g * 4 + (pp >> 5)) * 64 + s) * 64) + (pp & 31) + 32 * hh) * 8) = o; } }
}
template <bool FROMP>
__device__ __forceinline__ void modnorm_phase(LAS unsigned char* lds, const float* xin, bf16* hout, const float* gvec, const float* modp, const float* bmod, const float* modf, int jsh, int jsc, int tid, int lane, int wave) {
    LAS float* TA = (LAS float*)lds; LAS float* TS = TA + DM;
    const int b = (blockIdx.x * 32) / SEQ;
    for (int k = tid; k < DM; k += NWAVES * 64) {
        float sh, sc;
        if (FROMP) { sh = bmod[jsh * DM + k]; sc = bmod[jsc * DM + k];
            for (int ks = 0; ks < KSPLIT; ++ks) { sh += modp[(size_t)(ks * 4 + b) * NMODW + jsh * DM + k]; sc += modp[(size_t)(ks * 4 + b) * NMODW + jsc * DM + k]; } }
        else { sh = modf[(size_t)b * NMODW + jsh * DM + k]; sc = modf[(size_t)b * NMODW + jsc * DM + k]; }
        TA[k] = gvec[k] * (1.0f + sc); TS[k] = sh; }
    __syncthreads();
    for (int r = 0; r < 4; ++r) { const int row = blockIdx.x * 32 + wave * 4 + r;
        const f32x4* xr = (const f32x4*)(xin + (size_t)row * DM) + lane;
        f32x4 v[8]; float s = 0.f;
#pragma unroll
        for (int j = 0; j < 8; ++j) { v[j] = xr[64 * j]; s += (v[j].x * v[j].x + v[j].y * v[j].y) + (v[j].z * v[j].z + v[j].w * v[j].w); }
        const float rstd = 1.0f / sqrtf(wave_sum(s) * (1.0f / DM) + 1e-6f);
        GAS v2u* o8 = (GAS v2u*)(hout + (size_t)row * DM) + lane;
#pragma unroll
        for (int j = 0; j < 8; ++j) { const f32x4 a = *(const LAS f32x4*)(TA + 4 * (lane + 64 * j)), sft = *(const LAS f32x4*)(TS + 4 * (lane + 64 * j));
            const f32x4 o = v[j] * rstd * a + sft; o8[64 * j] = (v2u){pk2(o.x, o.y), pk2(o.z, o.w)}; } }
    __syncthreads();
}

constexpr int SS_UST = 2064;
constexpr int SS_U = 0, SS_K = 32 * SS_UST, SS_E = SS_K + 65 * 512, SS_C = SS_E + 2 * 128 * 33 * 4, SS_CST = 272, SS_END = SS_C + 32 * SS_CST;
static_assert(SS_END <= 147456 - 1024, "ssm LDS");
__device__ __forceinline__ float gelu_tanh(float v) { const float t = 0.7978845608028654f * (v + 0.044715f * v * v * v); const float e = __builtin_amdgcn_exp2f(-2.885390081777927f * t); return v * __builtin_amdgcn_rcpf(1.0f + e); }
__device__ __forceinline__ void ssm_unit(LAS unsigned char* lds, int b, int g, const bf16* proj, const bf16* ktab, const bf16* gtab, const bf16* htab, const float* a64, const float* dskip, bf16* vg, int tid, int lane, int wave) {
    for (int i = tid; i < 4096; i += NWAVES * 64) { const int t = i >> 1, hf = i & 1;
        const v4u v = *(const GAS v4u*)(proj + ((size_t)(b * SEQ + t) * PROJW + 16 * g + 8 * hf));
        *(LAS v4u*)(lds + SS_U + (t >> 6) * SS_UST + (t & 63) * 32 + hf * 16) = v; }
    for (int i = tid; i < 2080; i += NWAVES * 64) *(LAS v4u*)(lds + SS_K + i * 16) = *(const GAS v4u*)(ktab + (size_t)g * 65 * 256 + i * 8);
    __syncthreads();
    const int n = lane & 31, h = lane >> 5;
    { const int mt = wave & 3, kh = wave >> 2; f32x16 acc;
#pragma unroll
      for (int i = 0; i < 16; ++i) acc[i] = 0.f;
      const bf16* hp = htab + (((size_t)(g * 4 + mt) * 64 + kh * 32) * 64 + lane) * 8;
#pragma unroll 4
      for (int s = 0; s < 32; ++s) { const bf16x8 a = *(const GAS bf16x8*)(hp + (size_t)s * 512);
          const bf16x8 bb = *(const LAS bf16x8*)(lds + SS_U + n * SS_UST + (kh * 32 + s) * 32 + h * 16);
          acc = __builtin_amdgcn_mfma_f32_32x32x16_bf16(a, bb, acc, 0, 0, 0); }
      LAS float* E = (LAS float*)(lds + SS_E) + kh * 128 * 33;
#pragma unroll
      for (int r = 0; r < 16; ++r) E[(32 * mt + (r & 3) + 8 * (r >> 2) + 4 * h) * 33 + n] = acc[r]; }
    __syncthreads();
    if (tid < 64) { const int p = tid; const float ar = a64[(g * 64 + p) * 2], ai = a64[(g * 64 + p) * 2 + 1]; float cr = 0.f, ci = 0.f;
        const LAS float* E0 = (const LAS float*)(lds + SS_E); const LAS float* E1 = E0 + 128 * 33;
        for (int j = 0; j < 32; ++j) { *(LAS bf16*)(lds + SS_C + j * SS_CST + p * 2) = (bf16)f2bf(cr); *(LAS bf16*)(lds + SS_C + j * SS_CST + (64 + p) * 2) = (bf16)f2bf(ci);
            const float er = E0[p * 33 + j] + E1[p * 33 + j], ei = E0[(64 + p) * 33 + j] + E1[(64 + p) * 33 + j];
            const float nr = ar * cr - ai * ci + er, ni = ar * ci + ai * cr + ei; cr = nr; ci = ni; } }
    __syncthreads();
    for (int q = 0; q < 4; ++q) { const int mt = (q == 0) ? wave : (q == 1) ? 15 - wave : (q == 2) ? 16 + wave : 31 - wave;
        f32x16 acc;
#pragma unroll
        for (int i = 0; i < 16; ++i) acc[i] = 0.f;
        const int t_l = 2 * mt + (n >> 4), c_l = n & 15;
        const int abase = SS_K + ((t_l + 1) * 16 + c_l) * 32 + h * 16;
        const int bbase = SS_U + n * SS_UST + h * 16;
        const int ns = 2 * mt + 2;
        for (int s = 0; s < ns; ++s) { const bf16x8 a = *(const LAS bf16x8*)(lds + abase - s * 512); const bf16x8 bb = *(const LAS bf16x8*)(lds + bbase + s * 32);
            acc = __builtin_amdgcn_mfma_f32_32x32x16_bf16(a, bb, acc, 0, 0, 0); }
        const bf16* gp = gtab + (((size_t)(g * 32 + mt) * 8) * 64 + lane) * 8;
#pragma unroll
        for (int ks = 0; ks < 8; ++ks) { const bf16x8 a = *(const GAS bf16x8*)(gp + (size_t)ks * 512); const bf16x8 bb = *(const LAS bf16x8*)(lds + SS_C + n * SS_CST + (16 * ks + 8 * h) * 2);
            acc = __builtin_amdgcn_mfma_f32_32x32x16_bf16(a, bb, acc, 0, 0, 0); }
#pragma unroll
        for (int q4 = 0; q4 < 4; ++q4) { const int t = 2 * mt + (q4 >> 1), c0 = 8 * (q4 & 1) + 4 * h;
            const v2u uu = *(const LAS v2u*)(lds + SS_U + n * SS_UST + t * 32 + c0 * 2);
            const f32x4 dv = *(const f32x4*)(dskip + 16 * g + c0);
            const float y0 = acc[4 * q4 + 0] + dv[0] * bf_lo(uu.x), y1 = acc[4 * q4 + 1] + dv[1] * bf_hi(uu.x), y2 = acc[4 * q4 + 2] + dv[2] * bf_lo(uu.y), y3 = acc[4 * q4 + 3] + dv[3] * bf_hi(uu.y);
            *(GAS v2u*)(vg + (size_t)(b * SEQ + 64 * n + t) * SSMW + 16 * g + c0) = (v2u){pk2(gelu_tanh(y0), gelu_tanh(y1)), pk2(gelu_tanh(y2), gelu_tanh(y3))}; } }
    __syncthreads();
}

constexpr int AT_K = 0, AT_V = 272 * 256, AT_END = 2 * 272 * 256;
static_assert(AT_END <= 147456 - 1024, "attn LDS");
__device__ __forceinline__ unsigned off_b(unsigned row, unsigned ch) { return 256u * row + 16u * (ch ^ (((row & 3) << 2) | ((row >> 2) & 3))); }
typedef short v4i16_t __attribute__((ext_vector_type(4)));
__device__ __forceinline__ s16x4 tr_read(LAS unsigned char* p) { return __builtin_bit_cast(s16x4, __builtin_amdgcn_ds_read_tr16_b64_v4i16((LAS v4i16_t*)p)); }
__device__ __forceinline__ void attn_unit(LAS unsigned char* lds, int b, int hd, int di, int dil, int res, int blk, const bf16* proj, bf16* obr, float* lse, int tid, int lane, int wave) {
    const size_t rowb = (size_t)b * SEQ;
    for (int it = 0; it < 8; ++it) { const int idx = tid + 512 * it, row = idx >> 4, ch = idx & 15; const int sub = 128 * blk - 128 + row;
        v4u kv = (v4u){0u, 0u, 0u, 0u}, vv = kv;
        if (sub >= 0) { const bf16* src = proj + (rowb + res + dil * sub) * PROJW + 2048 + hd * HDIM + ch * 8; kv = *(const GAS v4u*)src; vv = *(const GAS v4u*)(src + 1024); }
        *(LAS v4u*)(lds + AT_K + off_b(row, ch)) = kv; *(LAS v4u*)(lds + AT_V + off_b(row, ch)) = vv; }
    if (tid < 256) { const int row = 256 + (tid >> 4), ch = tid & 15; *(LAS v4u*)(lds + AT_K + off_b(row, ch)) = (v4u){0u, 0u, 0u, 0u}; *(LAS v4u*)(lds + AT_V + off_b(row, ch)) = (v4u){0u, 0u, 0u, 0u}; }
    const int qn = lane & 15, g = lane >> 4;
    const int qtok = res + dil * (128 * blk + 16 * wave + qn);
    bf16x8 qf[4];
#pragma unroll
    for (int s = 0; s < 4; ++s) qf[s] = *(const GAS bf16x8*)(proj + (rowb + qtok) * PROJW + 1024 + hd * HDIM + 32 * s + 8 * g);
    __syncthreads();
    f32x4 sc[10];
#pragma unroll
    for (int kt = 0; kt < 10; ++kt) { f32x4 a = {0.f, 0.f, 0.f, 0.f};
#pragma unroll
        for (int s = 0; s < 4; ++s) { const bf16x8 kf = *(const LAS bf16x8*)(lds + AT_K + off_b(16 * (wave + kt) + qn, 4 * s + g));
            a = __builtin_amdgcn_mfma_f32_16x16x32_bf16(kf, qf[s], a, 0, 0, 0); }
        sc[kt] = a; }
    const bool first = (blk == 0);
    float mx = -1e30f;
#pragma unroll
    for (int kt = 0; kt < 10; ++kt)
#pragma unroll
        for (int r = 0; r < 4; ++r) { const int rel = 16 * kt + 4 * g + r; bool ok = (rel >= qn) && (rel <= qn + 128);
            if (first) ok = ok && (16 * (wave + kt) + 4 * g + r >= 128);
            sc[kt][r] = ok ? sc[kt][r] : -1e30f; mx = fmaxf(mx, sc[kt][r]); }
    mx = fmaxf(mx, __shfl_xor(mx, 16)); mx = fmaxf(mx, __shfl_xor(mx, 32));
    float ls = 0.f;
#pragma unroll
    for (int kt = 0; kt < 10; ++kt)
#pragma unroll
        for (int r = 0; r < 4; ++r) { const float p = (sc[kt][r] > -1e29f) ? __builtin_amdgcn_exp2f(sc[kt][r] - mx) : 0.f; sc[kt][r] = p; ls += p; }
    ls += __shfl_xor(ls, 16); ls += __shfl_xor(ls, 32);
    f32x4 o[8];
#pragma unroll
    for (int c = 0; c < 8; ++c) o[c] = (f32x4){0.f, 0.f, 0.f, 0.f};
    const int q4 = (lane & 15) >> 2, p4 = lane & 3;
#pragma unroll
    for (int ks = 0; ks < 5; ++ks) {
        union { unsigned u[4]; bf16x8 v; } pb;
        pb.u[0] = pk2(sc[2 * ks][0], sc[2 * ks][1]); pb.u[1] = pk2(sc[2 * ks][2], sc[2 * ks][3]); pb.u[2] = pk2(sc[2 * ks + 1][0], sc[2 * ks + 1][1]); pb.u[3] = pk2(sc[2 * ks + 1][2], sc[2 * ks + 1][3]);
#pragma unroll
        for (int c = 0; c < 8; ++c) {
            const unsigned r0 = 16 * wave + 32 * ks + 4 * g + q4;
            const s16x4 v0 = tr_read(lds + AT_V + off_b(r0, 2 * c + (p4 >> 1)) + 8 * (p4 & 1));
            const s16x4 v1 = tr_read(lds + AT_V + off_b(r0 + 16, 2 * c + (p4 >> 1)) + 8 * (p4 & 1));
            bf16x8 va; va[0] = v0[0]; va[1] = v0[1]; va[2] = v0[2]; va[3] = v0[3]; va[4] = v1[0]; va[5] = v1[1]; va[6] = v1[2]; va[7] = v1[3];
            o[c] = __builtin_amdgcn_mfma_f32_16x16x32_bf16(va, pb.v, o[c], 0, 0, 0); } }
    const float inv = 1.0f / ls;
    bf16* op = obr + (size_t)di * MTOK * ATTW + (rowb + qtok) * ATTW + hd * HDIM + 4 * g;
#pragma unroll
    for (int c = 0; c < 8; ++c) *(GAS v2u*)(op + 16 * c) = (v2u){pk2(o[c][0] * inv, o[c][1] * inv), pk2(o[c][2] * inv, o[c][3] * inv)};
    if (g == 0) lse[(size_t)di * MTOK * NHEAD + (rowb + qtok) * NHEAD + hd] = mx + __builtin_amdgcn_logf(ls);
    __syncthreads();
}

__device__ __forceinline__ void ynorm_phase(bf16* ycat, const bf16* obr, const float* lse, int lane, int wave) {
    for (int r = 0; r < 4; ++r) { const int row = blockIdx.x * 32 + wave * 4 + r;
        { bf16* p = ycat + (size_t)row * DM + lane * 16; const v4u a = *(const GAS v4u*)p, c = *(const GAS v4u*)(p + 8);
          float v[16] = {bf_lo(a.x), bf_hi(a.x), bf_lo(a.y), bf_hi(a.y), bf_lo(a.z), bf_hi(a.z), bf_lo(a.w), bf_hi(a.w), bf_lo(c.x), bf_hi(c.x), bf_lo(c.y), bf_hi(c.y), bf_lo(c.z), bf_hi(c.z), bf_lo(c.w), bf_hi(c.w)};
          float s = 0.f;
#pragma unroll
          for (int i = 0; i < 16; ++i) s += v[i] * v[i];
          const float rstd = 1.0f / sqrtf(wave_sum(s) * (1.0f / SSMW) + 1e-6f);
          *(GAS v4u*)p = (v4u){pk2(v[0] * rstd, v[1] * rstd), pk2(v[2] * rstd, v[3] * rstd), pk2(v[4] * rstd, v[5] * rstd), pk2(v[6] * rstd, v[7] * rstd)};
          *(GAS v4u*)(p + 8) = (v4u){pk2(v[8] * rstd, v[9] * rstd), pk2(v[10] * rstd, v[11] * rstd), pk2(v[12] * rstd, v[13] * rstd), pk2(v[14] * rstd, v[15] * rstd)}; }
        { const int hd = lane >> 3;
          const float l0 = lse[(size_t)row * NHEAD + hd], l1 = lse[(size_t)MTOK * NHEAD + (size_t)row * NHEAD + hd], l2 = lse[(size_t)2 * MTOK * NHEAD + (size_t)row * NHEAD + hd];
          const float lm = fmaxf(l0, fmaxf(l1, l2)); float w0 = __builtin_amdgcn_exp2f(l0 - lm), w1 = __builtin_amdgcn_exp2f(l1 - lm), w2 = __builtin_amdgcn_exp2f(l2 - lm);
          const float wi = 1.0f / (w0 + w1 + w2); w0 *= wi; w1 *= wi; w2 *= wi;
          float v[16];
#pragma unroll
          for (int i = 0; i < 16; ++i) v[i] = 0.f;
#pragma unroll
          for (int d = 0; d < 3; ++d) { const bf16* p = obr + (size_t)d * MTOK * ATTW + (size_t)row * ATTW + lane * 16; const v4u a = *(const GAS v4u*)p, c = *(const GAS v4u*)(p + 8); const float w = d == 0 ? w0 : d == 1 ? w1 : w2;
              v[0] += w * bf_lo(a.x); v[1] += w * bf_hi(a.x); v[2] += w * bf_lo(a.y); v[3] += w * bf_hi(a.y); v[4] += w * bf_lo(a.z); v[5] += w * bf_hi(a.z); v[6] += w * bf_lo(a.w); v[7] += w * bf_hi(a.w);
              v[8] += w * bf_lo(c.x); v[9] += w * bf_hi(c.x); v[10] += w * bf_lo(c.y); v[11] += w * bf_hi(c.y); v[12] += w * bf_lo(c.z); v[13] += w * bf_hi(c.z); v[14] += w * bf_lo(c.w); v[15] += w * bf_hi(c.w); }
          float s = 0.f;
#pragma unroll
          for (int i = 0; i < 16; ++i) s += v[i] * v[i];
          const float rstd = 1.0f / sqrtf(wave_sum(s) * (1.0f / ATTW) + 1e-6f);
          bf16* p = ycat + (size_t)row * DM + SSMW + lane * 16;
          *(GAS v4u*)p = (v4u){pk2(v[0] * rstd, v[1] * rstd), pk2(v[2] * rstd, v[3] * rstd), pk2(v[4] * rstd, v[5] * rstd), pk2(v[6] * rstd, v[7] * rstd)};
          *(GAS v4u*)(p + 8) = (v4u){pk2(v[8] * rstd, v[9] * rstd), pk2(v[10] * rstd, v[11] * rstd), pk2(v[12] * rstd, v[13] * rstd), pk2(v[14] * rstd, v[15] * rstd)}; } }
}
__device__ __forceinline__ void final_norm_phase(float* out, const float* gfin, int lane, int wave) {
    for (int r = 0; r < 4; ++r) { const int row = blockIdx.x * 32 + wave * 4 + r;
        f32x4* xr = (f32x4*)(out + (size_t)row * DM) + lane; f32x4 v[8]; float s = 0.f;
#pragma unroll
        for (int j = 0; j < 8; ++j) { v[j] = xr[64 * j]; s += (v[j].x * v[j].x + v[j].y * v[j].y) + (v[j].z * v[j].z + v[j].w * v[j].w); }
        const float rstd = 1.0f / sqrtf(wave_sum(s) * (1.0f / DM) + 1e-6f);
#pragma unroll
        for (int j = 0; j < 8; ++j) { const f32x4 gq = *((const f32x4*)gfin + lane + 64 * j); xr[64 * j] = v[j] * rstd * gq; } }
}

constexpr int NPH = 11;
constexpr int IT_GEMV = KSPLIT * 48, IT_SSM = NGRP * 193, IT_ROPE = MTOK, IT_WIN = (DM / 64) * (PROJW / 32), IT_WGLU = (SSMW / 64) * (SSMW / 32), IT_WOUT = (DM / 64) * (DM / 32),
              IT_WG = (DM / 64) * (DFF / 32), IT_WD = (DFF / 64) * (DM / 32), IT_TOTAL = IT_GEMV + IT_SSM + IT_ROPE + IT_WIN + IT_WGLU + IT_WOUT + 2 * IT_WG + IT_WD;
__global__ void __launch_bounds__(NWAVES * 64, 2) hymba_fwd(Args args) {
    extern __shared__ __attribute__((aligned(16))) unsigned char lds_raw[];
    LAS unsigned char* lds = (LAS unsigned char*)lds_raw;
    cg::grid_group grid = cg::this_grid();
    const int tid = threadIdx.x, lane = tid & 63, wave = __builtin_amdgcn_readfirstlane(tid >> 6);
    const int G = gridDim.x, bx = blockIdx.x;
    unsigned char* ws = args.ws;
    const float* const* in = args.in;
    float* modp = (float*)(ws + WS_MODP); float* modf = (float*)(ws + WS_MODF); float* cosT = (float*)(ws + WS_ROPE); float* sinT = cosT + (size_t)MTOK * 64;
    bf16* ktab = (bf16*)(ws + WS_KTAB); bf16* gtab = (bf16*)(ws + WS_GTAB); bf16* htab = (bf16*)(ws + WS_HTAB); float* a64 = (float*)(ws + WS_A64);
    bf16* Win = (bf16*)(ws + WS_WIN); bf16* Wglu = (bf16*)(ws + WS_WGLU); bf16* Wout = (bf16*)(ws + WS_WOUT); bf16* Wgu = (bf16*)(ws + WS_WGU); bf16* Wdn = (bf16*)(ws + WS_WDN);
    bf16* Hb = (bf16*)(ws + WS_H); bf16* proj = (bf16*)(ws + WS_PROJ); bf16* vg = (bf16*)(ws + WS_VG); bf16* ycat = (bf16*)(ws + WS_YCAT); bf16* obr = (bf16*)(ws + WS_OBR); float* lse = (float*)(ws + WS_LSE);
    bf16* ff = (bf16*)(ws + WS_FF);
    const int lo = args.ph_lo, hi = args.ph_hi;
#ifndef PHMASK
#define PHMASK 0x7ff
#endif
#define IN(k) (((PHMASK >> (k)) & 1) && lo <= (k) && (k) < hi)
#define SEAM(k) do { if (IN(k) && IN((k) + 1)) grid.sync(); } while (0)

    if (IN(0)) {
        LAS float* scr = (LAS float*)(lds + wave * 16384);
        const int gw = wave * G + bx, NGW = G * NWAVES;
        for (int it = gw; it < IT_TOTAL; it += NGW) {
            int r = it;
            if (r < IT_GEMV) { p0_gemv_item(in[1], in[3], modp, scr, r, lane); continue; } r -= IT_GEMV;
            if (r < IT_SSM) { const int g = r / 193, sub = r % 193;
                if (sub < 65) p0_ktab_item(in, ktab, a64, scr, g, sub, lane); else if (sub < 129) p0_gtab_item(in, gtab, g, sub - 65, lane); else p0_htab_item(in, htab, g, sub - 129, lane);
                continue; } r -= IT_SSM;
            if (r < IT_ROPE) { p0_rope_item((const int*)in[2], cosT, sinT, r, lane); continue; } r -= IT_ROPE;
            if (r < IT_WIN) { p0_transpose_item<1>(in[6], DM, PROJW, Win, scr, r, lane, nullptr, nullptr); continue; } r -= IT_WIN;
            if (r < IT_WGLU) { p0_transpose_item<0>(in[15], SSMW, SSMW, Wglu, scr, r, lane, nullptr, nullptr); continue; } r -= IT_WGLU;
            if (r < IT_WOUT) { p0_transpose_item<4>(in[19], DM, DM, Wout, scr, r, lane, in[17], in[18]); continue; } r -= IT_WOUT;
            if (r < IT_WG) { p0_transpose_item<2>(in[21], DM, DFF, Wgu, scr, r, lane, nullptr, nullptr); continue; } r -= IT_WG;
            if (r < IT_WG) { p0_transpose_item<3>(in[22], DM, DFF, Wgu, scr, r, lane, nullptr, nullptr); continue; } r -= IT_WG;
            p0_transpose_item<0>(in[23], DFF, DM, Wdn, scr, r, lane, nullptr, nullptr);
        }
        __syncthreads();
    }
    SEAM(0);
    if (IN(1)) {
        for (int i = tid; i < 192; i += NWAVES * 64) { const int idx = bx * 192 + i, b = idx / NMODW, j = idx % NMODW; float s = in[4][j];
            for (int ks = 0; ks < KSPLIT; ++ks) s += modp[(size_t)(ks * 4 + b) * NMODW + j];
            modf[idx] = s; }
        modnorm_phase<true>(lds, in[0], Hb, in[5], modp, in[4], modf, 0, 1, tid, lane, wave);
    }
    SEAM(1);
    if (IN(2)) {
        pg8::Gemm g{Hb, Win, MTOK, PROJW, DM}; pg8::StaticOrder S; S.init(MTOK, PROJW, G, bx);
        pg8::EpiProj E{proj, cosT, sinT, 0.08838834764831845f * 1.4426950408889634f};
        pg8::gemm_phase<pg8::EpiProj, pg8::StaticOrder, true, true>(lds, g, S, E);
    }
    SEAM(2);
    if (IN(3)) {
        int tid = threadIdx.x; asm volatile("" : "+v"(tid)); const int lane = tid & 63, wave = __builtin_amdgcn_readfirstlane(tid >> 6);
        for (int u = bx; u < BATCH * NGRP; u += G) ssm_unit(lds, u / NGRP, u % NGRP, proj, ktab, gtab, htab, a64, in[14], vg, tid, lane, wave);
        for (int u = bx; u < BATCH * NHEAD * 48; u += G) { const int bh = u / 48, w = u % 48; int di, dil, res, blk;
            if (w < 16) { di = 0; dil = 1; res = 0; blk = w; } else if (w < 32) { di = 1; dil = 4; res = (w - 16) >> 2; blk = (w - 16) & 3; } else { di = 2; dil = 16; res = w - 32; blk = 0; }
            attn_unit(lds, bh / NHEAD, bh % NHEAD, di, dil, res, blk, proj, obr, lse, tid, lane, wave); }
    }
    SEAM(3);
    if (IN(4)) {
        pg8::Gemm g{vg, Wglu, MTOK, SSMW, SSMW}; pg8::StaticOrder S; S.init(MTOK, SSMW, G, bx);
        pg8::EpiGlu E{ycat, vg, in[16]};
        pg8::gemm_phase<pg8::EpiGlu, pg8::StaticOrder, true, true>(lds, g, S, E);
    }
    SEAM(4);
    if (IN(5)) ynorm_phase(ycat, obr, lse, lane, wave);
    SEAM(5);
    if (IN(6)) {
        pg8::Gemm g{ycat, Wout, MTOK, DM, DM}; pg8::StaticOrder S; S.init(MTOK, DM, G, bx);
        pg8::EpiResid E{in[0], args.out, modf + 2 * DM};
        pg8::gemm_phase<pg8::EpiResid, pg8::StaticOrder, true, true>(lds, g, S, E);
    }
    SEAM(6);
    if (IN(7)) modnorm_phase<false>(lds, args.out, Hb, in[20], modp, in[4], modf, 3, 4, tid, lane, wave);
    SEAM(7);
    if (IN(8)) {
        pg8::Gemm g{Hb, Wgu, MTOK, 2 * DFF, DM}; pg8::StaticOrder S; S.init(MTOK, 2 * DFF, G, bx);
        pg8::EpiSwiglu E{ff};
        pg8::gemm_phase<pg8::EpiSwiglu, pg8::StaticOrder, true, true>(lds, g, S, E);
    }
    SEAM(8);
    if (IN(9)) {
        pg8::Gemm g{ff, Wdn, MTOK, DM, DFF}; pg8::StaticOrder S; S.init(MTOK, DM, G, bx);
        pg8::EpiResid E{args.out, args.out, modf + 5 * DM};
        pg8::gemm_phase<pg8::EpiResid, pg8::StaticOrder, true, true>(lds, g, S, E);
    }
    SEAM(9);
    if (IN(10)) final_norm_phase(args.out, in[24], lane, wave);
#undef IN
#undef SEAM
}

#ifndef MK_PER_PHASE
#define MK_PER_PHASE 0
#endif
extern "C" void kernel_launch(void* const* d_in, const int* in_sizes, int n_in, void* d_out, int out_size, void* d_ws, size_t ws_size, hipStream_t stream) {
    static int ready = 0;
    if (ready == 0) {
        ready = 1;
        if (n_in != 25 || out_size != MTOK * DM || ws_size < WS_END) { fprintf(stderr, "kernel_launch: unexpected shapes (n_in %d out %d ws %zu)\n", n_in, out_size, ws_size); ready = -1; }
        else if (hipFuncSetAttribute((const void*)hymba_fwd, hipFuncAttributeMaxDynamicSharedMemorySize, LDS_BYTES) != hipSuccess) { fprintf(stderr, "kernel_launch: hipFuncSetAttribute failed\n"); ready = -1; }
        else { int per_cu = 0; (void)hipOccupancyMaxActiveBlocksPerMultiprocessor(&per_cu, (const void*)hymba_fwd, NWAVES * 64, LDS_BYTES); (void)hipGetLastError();
               if (per_cu < 1) fprintf(stderr, "kernel_launch: occupancy query reports %d blocks per CU\n", per_cu); }
    }
    if (ready < 0) return;
    Args a{};
    for (int i = 0; i < 25; ++i) a.in[i] = (const float*)d_in[i];
    a.out = (float*)d_out; a.ws = (unsigned char*)d_ws;
#if MK_PER_PHASE
    for (int p = 0; p < NPH; ++p) { a.ph_lo = p; a.ph_hi = p + 1; hipLaunchKernelGGL(hymba_fwd, dim3(256), dim3(NWAVES * 64), LDS_BYTES, stream, a); }
#else
    a.ph_lo = 0; a.ph_hi = NPH;
    void* kargs[] = {&a};
    hipError_t e = hipLaunchCooperativeKernel((const void*)hymba_fwd, dim3(256), dim3(NWAVES * 64), kargs, LDS_BYTES, stream);
    if (e != hipSuccess) fprintf(stderr, "kernel_launch: cooperative launch failed: %s\n", hipGetErrorString(e));
#endif
}
```

```cpp
#include <hip/hip_runtime.h>
#include <hip/hip_cooperative_groups.h>
#include <cstdio>
#include <cstdint>
namespace cg = cooperative_groups;
namespace pg8 {
#define PG8_LAS __attribute__((address_space(3)))
typedef unsigned short bf16_t;
typedef short bf16x8 __attribute__((ext_vector_type(8)));
typedef float f32x4 __attribute__((ext_vector_type(4)));
typedef unsigned u32x4 __attribute__((ext_vector_type(4)));
constexpr int BM = 256, BK = 64, HALF = 128, HTB = HALF * BK * 2  , STAGE_BYTES = 8 * HTB, NXCD = 8, WGM = 8;

__host__ __device__ __forceinline__ int lds_byte(int r, int c) { const int st = (r >> 4) * 2 + (c >> 5), rr = r & 15, cc = c & 31, ob = rr * 64 + cc * 2; return st * 1024 + (ob ^ (((ob >> 9) & 1) << 5)); }
__host__ __device__ __forceinline__ void stage_rc(int b, int& R, int& C) { const int st = b / 1024, sb = b % 1024, swz = sb ^ (((sb >> 9) & 1) << 5); R = (st >> 1) * 16 + swz / 64; C = (st & 1) * 32 + (swz % 64) / 2; }
__host__ __device__ __forceinline__ int perm32(int rho) { const int n = rho >> 4, i = rho & 15; return 8 * (i >> 2) + 4 * n + (i & 3); }

struct Unit { int pm, pn; };
struct Gemm { const bf16_t* A; const bf16_t* Bt; int M, N, K; };

struct StaticOrder {
    int nM, nN, nwg, G, c;
    __host__ __device__ void init(int M, int N, int G_, int c_) { nM = M / BM; nN = N / BM; nwg = nM * nN; G = G_; c = c_; }
    __host__ __device__ bool next(int i, Unit& u) const {
        const long L = (long)i * G + c; if (L >= nwg) return false;
        int wgid = (int)L; { const int q = nwg / NXCD, r = nwg % NXCD, xcd = wgid % NXCD, off = wgid / NXCD; wgid = (xcd < r ? xcd * (q + 1) : r * (q + 1) + (xcd - r) * q) + off; }
        const int nig = WGM * nN, gid = wgid / nig, fm = gid * WGM, gsz = (nM - fm) < WGM ? (nM - fm) : WGM;
        u.pm = fm + ((wgid % nig) % gsz); u.pn = (wgid % nig) / gsz; return true;
    }
    __device__ __forceinline__ void a_ready(const Unit&) const {}
    __device__ __forceinline__ void done(const Unit&) const {}
};

__device__ __forceinline__ unsigned cvt_pk_bf16(float lo, float hi) { unsigned r; asm volatile("v_cvt_pk_bf16_f32 %0, %1, %2" : "=v"(r) : "v"(lo), "v"(hi)); return r; }
typedef float f32x2 __attribute__((ext_vector_type(2)));
__device__ __forceinline__ f32x2 gelu_pk(f32x2 v) {
    const f32x2 av = __builtin_elementwise_abs(v), d = av * 0.2316418882f + 1.0f;
    f32x2 t; t.x = __builtin_amdgcn_rcpf(d.x); t.y = __builtin_amdgcn_rcpf(d.y);
    f32x2 q = t * 0.5307027145f + (-0.7265760135f); q = q * t + 0.7107068705f; q = q * t + (-0.142248368f); q = q * t + 0.127414796f; q = q * t;
    const f32x2 s = (v * v) * (-0.72134752044f);
    f32x2 e; e.x = __builtin_amdgcn_exp2f(s.x); e.y = __builtin_amdgcn_exp2f(s.y);
    const f32x2 m = v * (q * e), r = v - m;
    f32x2 o; o.x = v.x < 0.f ? m.x : r.x; o.y = v.y < 0.f ? m.y : r.y; return o;
}

__device__ __forceinline__ float bflo(unsigned w) { return __uint_as_float(w << 16); }
__device__ __forceinline__ float bfhi(unsigned w) { return __uint_as_float(w & 0xffff0000u); }
__device__ __forceinline__ float fast_sigmoid(float v) { return __builtin_amdgcn_rcpf(1.0f + __builtin_amdgcn_exp2f(-1.4426950408889634f * v)); }
struct EpiProj {
    static constexpr bool PERM = true, AFTER_DRAIN = false;
    bf16_t* O; const float* cosT; const float* sinT; float qscale;
    __device__ __forceinline__ void operator()(const f32x4 (&acc)[2][2][4][2], const Unit& u, int wr, int wc, int fr, int fq) const {
        const int row0 = u.pm * BM + wr * 64 + fr; const int col0 = u.pn * BM + wc * 32 + 8 * fq;
        const int sect = u.pn >> 2;
        const int j0 = 4 * (4 * wc + fq);
        const float sc = (sect == 1) ? qscale : 1.f;
#pragma unroll
        for (int ai = 0; ai < 2; ++ai)
#pragma unroll
            for (int m = 0; m < 4; ++m) { const int row = row0 + ai * HALF + m * 16; bf16_t* rowp = O + (size_t)row * 4096 + col0;
                f32x4 cs = (f32x4){1.f, 1.f, 1.f, 1.f}, sn = (f32x4){0.f, 0.f, 0.f, 0.f};
                if (sect == 1 || sect == 2) { cs = *(const f32x4*)(cosT + (size_t)row * 64 + j0); sn = *(const f32x4*)(sinT + (size_t)row * 64 + j0); }
#pragma unroll
                for (int bj = 0; bj < 2; ++bj) { const f32x4 t1 = acc[ai][bj][m][0], t2 = acc[ai][bj][m][1];
                    f32x4 v0 = (t1 * cs - t2 * sn) * sc, v1 = (t1 * sn + t2 * cs) * sc;
                    u32x4 w; w.x = cvt_pk_bf16(v0[0], v0[1]); w.y = cvt_pk_bf16(v0[2], v0[3]); w.z = cvt_pk_bf16(v1[0], v1[1]); w.w = cvt_pk_bf16(v1[2], v1[3]);
                    *(u32x4*)(rowp + bj * HALF) = w; } }
    }
};
struct EpiGlu {
    static constexpr bool PERM = true, AFTER_DRAIN = false;
    bf16_t* O; const bf16_t* VG; const float* bias;
    __device__ __forceinline__ void operator()(const f32x4 (&acc)[2][2][4][2], const Unit& u, int wr, int wc, int fr, int fq) const {
        const int row0 = u.pm * BM + wr * 64 + fr; const int col0 = u.pn * BM + wc * 32 + 8 * fq;
        f32x4 bv[2][2];
#pragma unroll
        for (int bj = 0; bj < 2; ++bj)
#pragma unroll
            for (int n = 0; n < 2; ++n) bv[bj][n] = *(const f32x4*)(bias + col0 + bj * HALF + 4 * n);
#pragma unroll
        for (int ai = 0; ai < 2; ++ai)
#pragma unroll
            for (int m = 0; m < 4; ++m) { const int row = row0 + ai * HALF + m * 16;
#pragma unroll
                for (int bj = 0; bj < 2; ++bj) { const u32x4 g = *(const u32x4*)(VG + (size_t)row * 1024 + col0 + bj * HALF);
                    const f32x4 a0 = acc[ai][bj][m][0] + bv[bj][0], a1 = acc[ai][bj][m][1] + bv[bj][1];
                    u32x4 w; w.x = cvt_pk_bf16(bflo(g.x) * fast_sigmoid(a0[0]), bfhi(g.x) * fast_sigmoid(a0[1])); w.y = cvt_pk_bf16(bflo(g.y) * fast_sigmoid(a0[2]), bfhi(g.y) * fast_sigmoid(a0[3]));
                    w.z = cvt_pk_bf16(bflo(g.z) * fast_sigmoid(a1[0]), bfhi(g.z) * fast_sigmoid(a1[1])); w.w = cvt_pk_bf16(bflo(g.w) * fast_sigmoid(a1[2]), bfhi(g.w) * fast_sigmoid(a1[3]));
                    *(u32x4*)(O + (size_t)row * 2048 + col0 + bj * HALF) = w; } }
    }
};
struct EpiResid {
    static constexpr bool PERM = false, AFTER_DRAIN = false;
    const float* base; float* out; const float* gate;
    __device__ __forceinline__ void operator()(const f32x4 (&acc)[2][2][4][2], const Unit& u, int wr, int wc, int fr, int fq) const {
        const int col0 = u.pn * BM + wc * 32 + 4 * fq; const int b = u.pm >> 3;
        f32x4 gv[2][2];
#pragma unroll
        for (int bj = 0; bj < 2; ++bj)
#pragma unroll
            for (int n = 0; n < 2; ++n) gv[bj][n] = *(const f32x4*)(gate + (size_t)b * 12288 + col0 + bj * HALF + n * 16);
#pragma unroll
        for (int ai = 0; ai < 2; ++ai)
#pragma unroll
            for (int m = 0; m < 4; ++m) { const size_t off = (size_t)(u.pm * BM + ai * HALF + wr * 64 + m * 16 + fr) * 2048 + col0;
#pragma unroll
                for (int bj = 0; bj < 2; ++bj)
#pragma unroll
                    for (int n = 0; n < 2; ++n) { const f32x4 bs = *(const f32x4*)(base + off + bj * HALF + n * 16);
                        *(f32x4*)(out + off + bj * HALF + n * 16) = bs + gv[bj][n] * acc[ai][bj][m][n]; } }
    }
};
struct EpiSwiglu {
    static constexpr bool PERM = true, AFTER_DRAIN = false;
    bf16_t* O;
    __device__ __forceinline__ void operator()(const f32x4 (&acc)[2][2][4][2], const Unit& u, int wr, int wc, int fr, int fq) const {
        const int row0 = u.pm * BM + wr * 64 + fr; const int col0 = u.pn * HALF + wc * 32 + 8 * fq;
#pragma unroll
        for (int ai = 0; ai < 2; ++ai)
#pragma unroll
            for (int m = 0; m < 4; ++m) { const int row = row0 + ai * HALF + m * 16;
                const f32x4 g0 = acc[ai][0][m][0], g1 = acc[ai][0][m][1], u0 = acc[ai][1][m][0], u1 = acc[ai][1][m][1];
                f32x4 v0, v1;
#pragma unroll
                for (int i = 0; i < 4; ++i) { v0[i] = g0[i] * fast_sigmoid(g0[i]) * u0[i]; v1[i] = g1[i] * fast_sigmoid(g1[i]) * u1[i]; }
                u32x4 w; w.x = cvt_pk_bf16(v0[0], v0[1]); w.y = cvt_pk_bf16(v0[2], v0[3]); w.z = cvt_pk_bf16(v1[0], v1[1]); w.w = cvt_pk_bf16(v1[2], v1[3]);
                *(u32x4*)(O + (size_t)row * 5632 + col0) = w; }
    }
};

template <class Epi, class Sched, bool ALIGN_EPI = false, bool SP2 = false>
__device__ __forceinline__ void gemm_phase(PG8_LAS unsigned char* lds, const Gemm g, const Sched& S, const Epi& E) {
    const int tid = threadIdx.x, wid = __builtin_amdgcn_readfirstlane(tid >> 6), lane = tid & 63, wr = wid >> 2, wc = wid & 3, fr = lane & 15, fq = lane >> 4;
    const int K = g.K, nt = K / BK;
    unsigned voffA[2], voffB[2];
#pragma unroll
    for (int i = 0; i < 2; ++i) { int R, C; stage_rc(tid * 16 + i * 8192, R, C); const int Rb = Epi::PERM ? ((R & ~31) + perm32(R & 31)) : R;
        voffA[i] = (unsigned)(R * K + C) * 2u; voffB[i] = (unsigned)(Rb * K + C) * 2u; }
    const size_t kstep = (size_t)(BK * 2);
    const size_t hstep = (size_t)HALF * K * 2;
    const size_t tstep = 2 * hstep;
    const unsigned ldsw = (unsigned)wid * 1024u;
    const int aoff = lds_byte(wr * 64 + fr, fq * 8), boff = lds_byte(wc * 32 + fr, fq * 8);
#define PG8_SA(b, h) (((b) * 2 + (h)) * HTB)
#define PG8_SB(b, h) ((4 + (b) * 2 + (h)) * HTB)
#define PG8_STAGE(bufoff, gbase, voff) do { _Pragma("unroll") for (int _i = 0; _i < 2; ++_i) \
        __builtin_amdgcn_global_load_lds((const unsigned*)((const char*)(gbase) + (voff)[_i]), (PG8_LAS unsigned*)(lds + (bufoff) + ldsw + _i * 8192), 16, 0, 0); } while (0)
#define PG8_LDA(dst, b, h) do { _Pragma("unroll") for (int m = 0; m < 4; ++m) _Pragma("unroll") for (int k = 0; k < 2; ++k) dst[m][k] = *(const PG8_LAS bf16x8*)(lds + PG8_SA(b, h) + aoff + m * 2048 + k * 1024); } while (0)
#define PG8_LDB(dst, b, h) do { _Pragma("unroll") for (int n = 0; n < 2; ++n) _Pragma("unroll") for (int k = 0; k < 2; ++k) dst[n][k] = *(const PG8_LAS bf16x8*)(lds + PG8_SB(b, h) + boff + n * 2048 + k * 1024); } while (0)
#define PG8_MMA(ai, bj, At, Bt) do { __builtin_amdgcn_s_setprio(1); _Pragma("unroll") for (int m = 0; m < 4; ++m) _Pragma("unroll") for (int n = 0; n < 2; ++n) _Pragma("unroll") for (int k = 0; k < 2; ++k) \
        acc[ai][bj][m][n] = __builtin_amdgcn_mfma_f32_16x16x32_bf16(Bt[n][k], At[m][k], acc[ai][bj][m][n], 0, 0, 0); __builtin_amdgcn_s_setprio(0); } while (0)
#define PG8_WAIT_V(n) asm volatile("s_waitcnt vmcnt(" #n ")" ::: "memory")
#define PG8_WAIT_L(n) asm volatile("s_waitcnt lgkmcnt(" #n ")" ::: "memory")
#define PG8_BAR __builtin_amdgcn_s_barrier()
#define PG8_SCHED __builtin_amdgcn_sched_barrier(0)
    Unit cur, nxt; int ui = 0;
    if (!S.next(0, cur)) return;
    f32x4 acc[2][2][4][2];
#pragma unroll
    for (int a = 0; a < 2; ++a)
#pragma unroll
        for (int b = 0; b < 2; ++b)
#pragma unroll
            for (int m = 0; m < 4; ++m)
#pragma unroll
                for (int n = 0; n < 2; ++n) acc[a][b][m][n] = (f32x4){0.f, 0.f, 0.f, 0.f};
    bf16x8 At[4][2], B0[2][2], B1[2][2];
    const char* cA = (const char*)g.A + (size_t)cur.pm * tstep; const char* cB = (const char*)g.Bt + (size_t)cur.pn * tstep;
    S.a_ready(cur);
    if constexpr (SP2) {
        PG8_STAGE(PG8_SB(0, 0), cB, voffB); PG8_STAGE(PG8_SB(0, 1), cB + hstep, voffB); PG8_STAGE(PG8_SA(0, 0), cA, voffA); PG8_STAGE(PG8_SA(0, 1), cA + hstep, voffA);
        if (wr == 1) PG8_BAR;
        PG8_WAIT_V(2); PG8_BAR;
        PG8_STAGE(PG8_SB(1, 0), cB + kstep, voffB); PG8_STAGE(PG8_SA(1, 0), cA + kstep, voffA); PG8_STAGE(PG8_SB(1, 1), cB + hstep + kstep, voffB);
        PG8_WAIT_V(6); PG8_BAR;
    } else {
        PG8_STAGE(PG8_SB(0, 0), cB, voffB); PG8_STAGE(PG8_SA(0, 0), cA, voffA); PG8_STAGE(PG8_SB(0, 1), cB + hstep, voffB); PG8_STAGE(PG8_SA(0, 1), cA + hstep, voffA);
        if (wr == 1) PG8_BAR;
        PG8_WAIT_V(4); PG8_BAR;
        PG8_STAGE(PG8_SB(1, 0), cB + kstep, voffB); PG8_STAGE(PG8_SA(1, 0), cA + kstep, voffA); PG8_STAGE(PG8_SB(1, 1), cB + hstep + kstep, voffB);
        PG8_WAIT_V(6); PG8_BAR;
    }
    for (;;) {
        const bool has_next = S.next(ui + 1, nxt);
        const char* nA = has_next ? (const char*)g.A + (size_t)nxt.pm * tstep : cA; const char* nB = has_next ? (const char*)g.Bt + (size_t)nxt.pn * tstep : cB;
        for (int t = 0; t < nt; t += 2) {
            const bool last = (t == nt - 2);
            const char* a1 = cA + (size_t)(t + 1) * kstep;
            const char* a2 = last ? nA : cA + (size_t)(t + 2) * kstep; const char* b2 = last ? nB : cB + (size_t)(t + 2) * kstep;
            const char* a3 = a2 + kstep; const char* b3 = b2 + kstep;
            if (last && has_next) S.a_ready(nxt);
            if constexpr (SP2) {
            PG8_LDB(B0, 0, 0); PG8_LDB(B1, 0, 1); PG8_SCHED; PG8_LDA(At, 0, 0); PG8_STAGE(PG8_SA(1, 1), a1 + hstep, voffA);
            PG8_WAIT_V(8); PG8_WAIT_L(0); PG8_BAR; PG8_MMA(0, 0, At, B0); PG8_MMA(0, 1, At, B1); PG8_BAR; PG8_SCHED;
            PG8_LDA(At, 0, 1); PG8_STAGE(PG8_SB(0, 0), b2, voffB); PG8_STAGE(PG8_SB(0, 1), b2 + hstep, voffB); PG8_STAGE(PG8_SA(0, 0), a2, voffA);
            PG8_WAIT_V(8); PG8_WAIT_L(0); PG8_BAR; PG8_MMA(1, 0, At, B0); PG8_MMA(1, 1, At, B1); PG8_BAR; PG8_SCHED;
            PG8_LDB(B0, 1, 0); PG8_LDB(B1, 1, 1); PG8_SCHED; PG8_LDA(At, 1, 0); PG8_STAGE(PG8_SA(0, 1), a2 + hstep, voffA);
            PG8_WAIT_V(8); PG8_WAIT_L(0); PG8_BAR; PG8_MMA(0, 0, At, B0); PG8_MMA(0, 1, At, B1); PG8_BAR; PG8_SCHED;
            PG8_LDA(At, 1, 1); PG8_STAGE(PG8_SB(1, 0), b3, voffB); PG8_STAGE(PG8_SB(1, 1), b3 + hstep, voffB); PG8_STAGE(PG8_SA(1, 0), a3, voffA);
            PG8_WAIT_V(8); PG8_WAIT_L(0); PG8_BAR; PG8_MMA(1, 0, At, B0); PG8_MMA(1, 1, At, B1); PG8_BAR; PG8_SCHED;
            } else {
            PG8_LDB(B0, 0, 0); PG8_SCHED; PG8_LDA(At, 0, 0); PG8_STAGE(PG8_SA(1, 1), a1 + hstep, voffA);
            PG8_WAIT_L(8); PG8_BAR; PG8_WAIT_L(0); PG8_MMA(0, 0, At, B0); PG8_BAR; PG8_SCHED;
            PG8_LDB(B1, 0, 1); PG8_STAGE(PG8_SB(0, 0), b2, voffB);
            PG8_BAR; PG8_WAIT_L(0); PG8_MMA(0, 1, At, B1); PG8_BAR;
            PG8_LDA(At, 0, 1); PG8_STAGE(PG8_SA(0, 0), a2, voffA);
            PG8_BAR; PG8_WAIT_L(0); PG8_MMA(1, 0, At, B0); PG8_BAR; PG8_SCHED;
            PG8_STAGE(PG8_SB(0, 1), b2 + hstep, voffB);
            PG8_WAIT_V(6); PG8_BAR; PG8_MMA(1, 1, At, B1); PG8_BAR;
            PG8_LDB(B0, 1, 0); PG8_SCHED; PG8_LDA(At, 1, 0); PG8_STAGE(PG8_SA(0, 1), a2 + hstep, voffA);
            PG8_WAIT_L(8); PG8_BAR; PG8_WAIT_L(0); PG8_MMA(0, 0, At, B0); PG8_BAR; PG8_SCHED;
            PG8_LDB(B1, 1, 1); PG8_STAGE(PG8_SB(1, 0), b3, voffB);
            PG8_BAR; PG8_WAIT_L(0); PG8_MMA(0, 1, At, B1); PG8_BAR;
            PG8_LDA(At, 1, 1); PG8_STAGE(PG8_SA(1, 0), a3, voffA);
            PG8_BAR; PG8_WAIT_L(0); PG8_MMA(1, 0, At, B0); PG8_BAR; PG8_SCHED;
            PG8_STAGE(PG8_SB(1, 1), b3 + hstep, voffB);
            PG8_WAIT_V(6); PG8_BAR; PG8_MMA(1, 1, At, B1); PG8_BAR;
            }
        }
        if constexpr (ALIGN_EPI) { if (wr == 0) PG8_BAR; }
        if constexpr (!Epi::AFTER_DRAIN) { E(acc, cur, wr, wc, fr, fq); S.done(cur); }
        if (!has_next) break;
#pragma unroll
        for (int a = 0; a < 2; ++a)
#pragma unroll
            for (int b = 0; b < 2; ++b)
#pragma unroll
                for (int m = 0; m < 4; ++m)
#pragma unroll
                    for (int n = 0; n < 2; ++n) acc[a][b][m][n] = (f32x4){0.f, 0.f, 0.f, 0.f};
        cur = nxt; cA = nA; cB = nB; ++ui;
        if constexpr (ALIGN_EPI) { if (wr == 1) PG8_BAR; }
    }
    PG8_WAIT_V(0);
    if constexpr (!ALIGN_EPI) { if (wr == 0) PG8_BAR; }
    PG8_BAR;
    if constexpr (Epi::AFTER_DRAIN) { E.fused(acc, cur, wr, wc, fr, fq, lds, wid, lane); S.done(cur); }
#undef PG8_SA
#undef PG8_SB
#undef PG8_STAGE
#undef PG8_LDA
#undef PG8_LDB
#undef PG8_MMA
#undef PG8_WAIT_V
#undef PG8_WAIT_L
#undef PG8_BAR
#undef PG8_SCHED
}
}

constexpr int NWAVES = 8;
constexpr int BATCH = 4, SEQ = 2048, DM = 2048, MTOK = BATCH * SEQ, SSMW = 1024, ATTW = 1024, NGRP = 64, NST = 64, NHEAD = 8, HDIM = 128, DFF = 5632, PROJW = 4096, NMODW = 6 * DM;
constexpr int KSPLIT = 32;
constexpr size_t MiB = 1u << 20;
constexpr size_t WS_MODP = 2 * MiB, WS_MODF = 8 * MiB, WS_ROPE = 9 * MiB, WS_KTAB = 13 * MiB, WS_GTAB = 16 * MiB, WS_HTAB = 32 * MiB, WS_A64 = 48 * MiB;
constexpr size_t WS_WIN = 49 * MiB, WS_WGLU = 65 * MiB, WS_WOUT = 67 * MiB, WS_WGU = 75 * MiB, WS_WDN = 119 * MiB, WS_H = 141 * MiB, WS_PROJ = 173 * MiB, WS_VG = 237 * MiB;
constexpr size_t WS_YCAT = 253 * MiB, WS_OBR = 285 * MiB, WS_LSE = 333 * MiB, WS_FF = 173 * MiB, WS_END = 334 * MiB;
static_assert(WS_FF + (size_t)MTOK * DFF * 2 <= WS_OBR, "ff overlay");
constexpr int LDS_BYTES = 147456, MISC_OFF = 147456 - 256;
constexpr size_t WS_CTL = 0, CTL_ZERO_BYTES = 32768, WS_CNT = 16384;

#define GAS __attribute__((address_space(1)))
#define LAS __attribute__((address_space(3)))
typedef unsigned short bf16;
typedef unsigned v4u __attribute__((ext_vector_type(4)));
typedef unsigned v2u __attribute__((ext_vector_type(2)));
typedef float f32x4 __attribute__((ext_vector_type(4)));
typedef float f32x16 __attribute__((ext_vector_type(16)));
typedef short bf16x8 __attribute__((ext_vector_type(8)));
typedef short s16x4 __attribute__((ext_vector_type(4)));
#define LDS_WAIT() asm volatile("s_waitcnt lgkmcnt(0)" ::: "memory")
__device__ __forceinline__ unsigned f2bf(float f) { unsigned u = __builtin_bit_cast(unsigned, f); return (u + 0x7fffu + ((u >> 16) & 1u)) >> 16; }
__device__ __forceinline__ unsigned pk2(float lo, float hi) { return f2bf(lo) | (f2bf(hi) << 16); }
__device__ __forceinline__ float bf_lo(unsigned w) { return __uint_as_float(w << 16); }
__device__ __forceinline__ float bf_hi(unsigned w) { return __uint_as_float(w & 0xffff0000u); }
__device__ __forceinline__ float wave_sum(float v) {
#pragma unroll
    for (int o = 1; o < 64; o <<= 1) v += __shfl_xor(v, o);
    return v;
}

struct Args { const float* in[25]; float* out; unsigned char* ws; int ph_lo, ph_hi; };

template <int MODE>
__device__ __forceinline__ void p0_transpose_item(const float* __restrict__ W, int K, int N, bf16* WT, LAS float* scr, int item, int lane, const float* gs, const float* ga) {
    const int nblk = N / 32, kb = item / nblk, nb = item % nblk, k0 = 64 * kb, n0 = 32 * nb;
#pragma unroll 8
    for (int i = 0; i < 32; ++i) { const int kk = 2 * i + (lane >> 5); float v = W[(size_t)(k0 + kk) * N + n0 + (lane & 31)];
        if (MODE == 4) { const int k = k0 + kk; v *= (k < SSMW) ? gs[k] : ga[k - SSMW]; }
        scr[kk * 33 + (lane & 31)] = v; }
    LDS_WAIT(); asm volatile("" ::: "memory");
    const int c = lane & 7;
#pragma unroll
    for (int j = 0; j < 4; ++j) { const int n = (lane >> 3) + 8 * j; const LAS float* s = scr + (8 * c) * 33 + n;
        v4u o; o.x = pk2(s[0 * 33], s[1 * 33]); o.y = pk2(s[2 * 33], s[3 * 33]); o.z = pk2(s[4 * 33], s[5 * 33]); o.w = pk2(s[6 * 33], s[7 * 33]);
        int col = n0 + n, row = col;
        if (MODE == 1) { if (col >= 1024 && col < 3072) { const int e = col & 127, half = e >> 6, ep = e & 63; row = (col - e) + ((ep >> 2) << 3) + (half << 2) + (ep & 3); } }
        if (MODE == 2) row = (col >> 7) * 256 + (col & 127);
        if (MODE == 3) row = (col >> 7) * 256 + 128 + (col & 127);
        *(GAS v4u*)(WT + (size_t)row * K + k0 + 8 * c) = o; }
    LDS_WAIT(); asm volatile("" ::: "memory");
}
__device__ __forceinline__ void p0_gemv_item(const float* __restrict__ cvec, const float* __restrict__ wmod, float* modp, float* modf, const float* __restrict__ bmod, unsigned* cnt, LAS float* scr, int item, int lane) {
    const int ks = item / 48, cb = item % 48, k0 = ks * 64, col = cb * 256 + lane * 4;
#pragma unroll
    for (int b = 0; b < 4; ++b) { const float v = cvec[b * DM + k0 + lane]; scr[lane * 4 + b] = v / (1.0f + __expf(-v)); }
    LDS_WAIT(); asm volatile("" ::: "memory");
    f32x4 a0 = {0, 0, 0, 0}, a1 = a0, a2 = a0, a3 = a0;
#pragma unroll 8
    for (int k = 0; k < 64; ++k) { const f32x4 w = *(const f32x4*)(wmod + (size_t)(k0 + k) * NMODW + col); const f32x4 s = *(const LAS f32x4*)(scr + 4 * k);
        a0 += w * s[0]; a1 += w * s[1]; a2 += w * s[2]; a3 += w * s[3]; }
    float* o = modp + (size_t)(ks * 4) * NMODW + col;
    *(f32x4*)(o) = a0; *(f32x4*)(o + NMODW) = a1; *(f32x4*)(o + 2 * NMODW) = a2; *(f32x4*)(o + 3 * NMODW) = a3;
    LDS_WAIT(); asm volatile("" ::: "memory");
    __threadfence();
    unsigned old = 0u; if (lane == 0) old = atomicAdd(cnt + 64 * cb, 1u);
    old = (unsigned)__builtin_amdgcn_readfirstlane((int)old);
    if (old == (unsigned)(KSPLIT - 1)) {
        __threadfence();
        const f32x4 bv = *(const f32x4*)(bmod + col); f32x4 s0 = bv, s1 = bv, s2 = bv, s3 = bv;
#pragma unroll 4
        for (int k2 = 0; k2 < KSPLIT; ++k2) { const float* pp = modp + (size_t)(k2 * 4) * NMODW + col;
            s0 += __builtin_nontemporal_load((const f32x4*)pp); s1 += __builtin_nontemporal_load((const f32x4*)(pp + NMODW)); s2 += __builtin_nontemporal_load((const f32x4*)(pp + 2 * NMODW)); s3 += __builtin_nontemporal_load((const f32x4*)(pp + 3 * NMODW)); }
        *(f32x4*)(modf + col) = s0; *(f32x4*)(modf + NMODW + col) = s1; *(f32x4*)(modf + 2 * NMODW + col) = s2; *(f32x4*)(modf + 3 * NMODW + col) = s3;
    }
}
__device__ __forceinline__ void p0_rope_item(const int* __restrict__ pos, float* cosT, float* sinT, int item, int lane) {
    const double inv = exp(-(double)lane * (9.210340371976184 / 64.0));
    const double ang = (double)pos[item] * inv;
    cosT[(size_t)item * 64 + lane] = (float)cos(ang); sinT[(size_t)item * 64 + lane] = (float)sin(ang);
}
struct SsmLane { double xr, xi; };
__device__ __forceinline__ SsmLane ssm_lane(const float* are, const float* aim, const float* ldt, int g, int p) {
    const double dt = exp((double)ldt[g]); SsmLane L; L.xr = (double)are[g * 64 + p] * dt; L.xi = (double)aim[g * 64 + p] * dt; return L; }
__device__ __forceinline__ void ssm_pow(const SsmLane& L, int n, float& zr, float& zi) { const double m = exp(L.xr * n), th = L.xi * n; zr = (float)(m * cos(th)); zi = (float)(m * sin(th)); }
__device__ __forceinline__ void ssm_bbar(const float* are, const float* aim, const float* ldt, const float* bre, const float* bim, int g, int p, float (&br)[16], float (&bi)[16]) {
    const double dt = exp((double)ldt[g]), ar = are[g * 64 + p], ai = aim[g * 64 + p];
    const double m = exp(ar * dt), nr = m * cos(ai * dt) - 1.0, ni = m * sin(ai * dt), den = ar * ar + ai * ai;
    const float fr = (float)((nr * ar + ni * ai) / den), fi = (float)((ni * ar - nr * ai) / den);
    const f32x4* pr = (const f32x4*)(bre + (size_t)(g * 64 + p) * 16); const f32x4* pi = (const f32x4*)(bim + (size_t)(g * 64 + p) * 16);
#pragma unroll
    for (int q = 0; q < 4; ++q) { const f32x4 r = pr[q], i = pi[q];
#pragma unroll
        for (int e = 0; e < 4; ++e) { br[4 * q + e] = fr * r[e] - fi * i[e]; bi[4 * q + e] = fr * i[e] + fi * r[e]; } }
}
__device__ __forceinline__ void p0_ktab_item(const float* const* in, bf16* ktab, float* a64, LAS float* scr, int g, int ti, int lane) {
    if (ti == 0) { const SsmLane L = ssm_lane(in[7], in[8], in[9], g, lane); float zr, zi; ssm_pow(L, 64, zr, zi); a64[(g * 64 + lane) * 2] = zr; a64[(g * 64 + lane) * 2 + 1] = zi;
        *(GAS v2u*)(ktab + (size_t)(g * 65) * 256 + lane * 4) = (v2u){0u, 0u}; return; }
    { const SsmLane L = ssm_lane(in[7], in[8], in[9], g, lane); float zr, zi; ssm_pow(L, ti - 1, zr, zi);
      float br[16], bi[16]; ssm_bbar(in[7], in[8], in[9], in[10], in[11], g, lane, br, bi);
#pragma unroll
      for (int c = 0; c < 16; ++c) { scr[lane * 16 + c] = zr * br[c] - zi * bi[c]; scr[1024 + lane * 16 + c] = zr * bi[c] + zi * br[c]; } }
    LDS_WAIT(); asm volatile("" ::: "memory");
    const int c = lane >> 2, q = lane & 3; const float* cr = in[12] + (size_t)(g * 16 + c) * 64; const float* ci = in[13] + (size_t)(g * 16 + c) * 64;
    f32x4 acc = {0, 0, 0, 0};
#pragma unroll 8
    for (int p = 0; p < 64; ++p) { const f32x4 wr = *(const LAS f32x4*)(scr + p * 16 + 4 * q), wi = *(const LAS f32x4*)(scr + 1024 + p * 16 + 4 * q); acc += wr * cr[p] - wi * ci[p]; }
    *(GAS v2u*)(ktab + ((size_t)(g * 65 + ti) * 16 + c) * 16 + 4 * q) = (v2u){pk2(acc[0], acc[1]), pk2(acc[2], acc[3])};
    LDS_WAIT(); asm volatile("" ::: "memory");
}
__device__ __forceinline__ void p0_gtab_item(const float* const* in, bf16* gtab, int g, int t, int lane) {
    const SsmLane L = ssm_lane(in[7], in[8], in[9], g, lane); float zr, zi; ssm_pow(L, t + 1, zr, zi);
    const int p = lane;
#pragma unroll
    for (int c = 0; c < 16; ++c) { const float cr = in[12][(size_t)(g * 16 + c) * 64 + p], ci = in[13][(size_t)(g * 16 + c) * 64 + p];
        const float gre = cr * zr - ci * zi, gni = -(cr * zi + ci * zr);
        const size_t base = ((size_t)(g * 32 + (t >> 1)) * 8) * 512;
        { const int pp = p;      gtab[base + (size_t)(pp >> 4) * 512 + ((16 * (t & 1) + c) + 32 * ((pp >> 3) & 1)) * 8 + (pp & 7)] = (bf16)f2bf(gre); }
        { const int pp = p + 64; gtab[base + (size_t)(pp >> 4) * 512 + ((16 * (t & 1) + c) + 32 * ((pp >> 3) & 1)) * 8 + (pp & 7)] = (bf16)f2bf(gni); } }
}
__device__ __forceinline__ void p0_htab_item(const float* const* in, bf16* htab, int g, int s, int lane) {
    const SsmLane L = ssm_lane(in[7], in[8], in[9], g, lane); float zr, zi; ssm_pow(L, 63 - s, zr, zi);
    float br[16], bi[16]; ssm_bbar(in[7], in[8], in[9], in[10], in[11], g, lane, br, bi);
    float hr[16], hi[16];
#pragma unroll
    for (int c = 0; c < 16; ++c) { hr[c] = zr * br[c] - zi * bi[c]; hi[c] = zr * bi[c] + zi * br[c]; }
#pragma unroll
    for (int part = 0; part < 2; ++part) { const int pp = lane + 64 * part;
#pragma unroll
        for (int hh = 0; hh < 2; ++hh) { const float* v = part ? hi : hr; v4u o; o.x = pk2(v[8 * hh], v[8 * hh + 1]); o.y = pk2(v[8 * hh + 2], v[8 * hh + 3]); o.z = pk2(v[8 * hh + 4], v[8 * hh + 5]); o.w = pk2(v[8 * hh + 6], v[8 * hh + 7]);
            *(GAS v4u*)(htab + ((((size_t)(g * 4 + (pp >> 5)) * 64 + s) * 64) + (pp & 31) + 32 * hh) * 8) = o; } }
}
#define XB_TMO      128
#define XB_XCNT(j)  (256  + 64 * (j))
#define XB_XSUB(j)  (1280 + 64 * (j))
#define XB_XGEN(j)  (2304 + 64 * (j))
#define XB_TOP      3328
#define XB_TOPGEN   3392
#define XCD_BAR_WORDS 3456
#define XB_SPIN_CAP (1u << 18)

__device__ __forceinline__ unsigned xb_ld(unsigned* p)              { return __hip_atomic_load(p, __ATOMIC_RELAXED, __HIP_MEMORY_SCOPE_AGENT); }
__device__ __forceinline__ unsigned xb_add(unsigned* p, unsigned v) { return __hip_atomic_fetch_add(p, v, __ATOMIC_RELAXED, __HIP_MEMORY_SCOPE_AGENT); }
__device__ __forceinline__ unsigned xb_xcc_id() { return (unsigned)__builtin_amdgcn_s_getreg((3 << 11) | 20) & 0xFu; }
#define XB_SPIN(cond, bar) do { unsigned _sp = 0; while (cond) { __builtin_amdgcn_s_sleep(1); \
    if ((++_sp & 255u) == 0u) { if (xb_ld(&(bar)[XB_TMO])) break; if (_sp > XB_SPIN_CAP) { atomicAdd(&(bar)[XB_TMO], 1u); break; } } } } while (0)

struct XcdBarrier {
    unsigned* bar; unsigned x;
    volatile LAS unsigned* st;
};

__device__ __forceinline__ XcdBarrier xcd_barrier_post(unsigned* bar, volatile LAS unsigned* st) {
    XcdBarrier b; b.bar = bar; b.x = xb_xcc_id(); b.st = st;
    if (threadIdx.x == 0) (void)xb_add(&bar[XB_XCNT(b.x)], 1u);
    return b;
}
__device__ __forceinline__ void xcd_barrier_complete(unsigned* bar, unsigned x, unsigned& nloc, unsigned& nx) {
    const unsigned G = gridDim.x * gridDim.y * gridDim.z;
    unsigned sum, cnt, mine, sp = 0u;
    for (;;) {
        sum = 0u; cnt = 0u; mine = 0u;
#pragma unroll
        for (unsigned j = 0; j < 16; ++j) { const unsigned c = xb_ld(&bar[XB_XCNT(j)]); sum += c; cnt += (c > 0u) ? 1u : 0u; mine = (j == x) ? c : mine; }
        if (sum == G) break;
        __builtin_amdgcn_s_sleep(1);
        if ((++sp & 255u) == 0u) { if (xb_ld(&bar[XB_TMO])) break; if (sp > XB_SPIN_CAP) { atomicAdd(&bar[XB_TMO], 1u); break; } }
    }
    nloc = mine > 0u ? mine : 1u; nx = cnt > 0u ? cnt : 1u;
}

__device__ __forceinline__ void xcd_barrier(const XcdBarrier& b) {
    asm volatile("s_waitcnt vmcnt(0)" ::: "memory");
    __syncthreads();
    if (threadIdx.x == 0) {
        unsigned* bar = b.bar;
        __builtin_amdgcn_s_waitcnt(0);
        unsigned nloc = b.st[0], nx = b.st[1];
        if (nloc == 0u) { xcd_barrier_complete(bar, b.x, nloc, nx); b.st[0] = nloc; b.st[1] = nx; }
        const unsigned old = xb_add(&bar[XB_XSUB(b.x)], 1u);
        const unsigned gen = old / nloc;
        if (old + 1u == (gen + 1u) * nloc) {
            __builtin_amdgcn_fence(__ATOMIC_RELEASE, "agent");
            asm volatile("s_waitcnt vmcnt(0)" ::: "memory");
            const unsigned og = xb_add(&bar[XB_TOP], 1u);
            const unsigned tg = og / nx;
            if (og + 1u == (tg + 1u) * nx) xb_add(&bar[XB_TOPGEN], 1u);
            else XB_SPIN(xb_ld(&bar[XB_TOPGEN]) == tg, bar);
            __builtin_amdgcn_fence(__ATOMIC_ACQUIRE, "agent");
            xb_add(&bar[XB_XGEN(b.x)], 1u);
            asm volatile("s_waitcnt vmcnt(0)" ::: "memory");
        } else {
            XB_SPIN(xb_ld(&bar[XB_XGEN(b.x)]) == gen, bar);
            __builtin_amdgcn_fence(__ATOMIC_ACQUIRE, "agent");
            asm volatile("s_waitcnt vmcnt(0)" ::: "memory");
        }
    }
    __syncthreads();
}

template <bool FROMP>
__device__ __forceinline__ void modnorm_phase(LAS unsigned char* lds, const float* xin, bf16* hout, const float* gvec, const float* modp, const float* bmod, const float* modf, int jsh, int jsc, int tid, int lane, int wave) {
    LAS float* TA = (LAS float*)lds; LAS float* TS = TA + DM;
    const int b = (blockIdx.x * 32) / SEQ;
    for (int k = tid; k < DM; k += NWAVES * 64) {
        float sh, sc;
        if (FROMP) { sh = bmod[jsh * DM + k]; sc = bmod[jsc * DM + k];
            for (int ks = 0; ks < KSPLIT; ++ks) { sh += modp[(size_t)(ks * 4 + b) * NMODW + jsh * DM + k]; sc += modp[(size_t)(ks * 4 + b) * NMODW + jsc * DM + k]; } }
        else { sh = modf[(size_t)b * NMODW + jsh * DM + k]; sc = modf[(size_t)b * NMODW + jsc * DM + k]; }
        TA[k] = gvec[k] * (1.0f + sc); TS[k] = sh; }
    __syncthreads();
    for (int r = 0; r < 4; ++r) { const int row = blockIdx.x * 32 + wave * 4 + r;
        const f32x4* xr = (const f32x4*)(xin + (size_t)row * DM) + lane;
        f32x4 v[8]; float s = 0.f;
#pragma unroll
        for (int j = 0; j < 8; ++j) { v[j] = xr[64 * j]; s += (v[j].x * v[j].x + v[j].y * v[j].y) + (v[j].z * v[j].z + v[j].w * v[j].w); }
        const float rstd = 1.0f / sqrtf(wave_sum(s) * (1.0f / DM) + 1e-6f);
        GAS v2u* o8 = (GAS v2u*)(hout + (size_t)row * DM) + lane;
#pragma unroll
        for (int j = 0; j < 8; ++j) { const f32x4 a = *(const LAS f32x4*)(TA + 4 * (lane + 64 * j)), sft = *(const LAS f32x4*)(TS + 4 * (lane + 64 * j));
            const f32x4 o = v[j] * rstd * a + sft; o8[64 * j] = (v2u){pk2(o.x, o.y), pk2(o.z, o.w)}; } }
    __syncthreads();
}

constexpr int SS_UST = 2064;
constexpr int SS_U = 0, SS_K = 32 * SS_UST, SS_E = SS_K + 65 * 512, SS_C = SS_E + 2 * 128 * 33 * 4, SS_CST = 272, SS_END = SS_C + 32 * SS_CST;
static_assert(SS_END <= 147456 - 1024, "ssm LDS");
__device__ __forceinline__ float gelu_tanh(float v) { const float t = 0.7978845608028654f * (v + 0.044715f * v * v * v); const float e = __builtin_amdgcn_exp2f(-2.885390081777927f * t); return v * __builtin_amdgcn_rcpf(1.0f + e); }
__device__ __forceinline__ void ssm_unit(LAS unsigned char* lds, int b, int g, const bf16* proj, const bf16* ktab, const bf16* gtab, const bf16* htab, const float* a64, const float* dskip, bf16* vg, int tid, int lane, int wave) {
    for (int i = tid; i < 4096; i += NWAVES * 64) { const int t = i >> 1, hf = i & 1;
        const v4u v = *(const GAS v4u*)(proj + ((size_t)(b * SEQ + t) * PROJW + 16 * g + 8 * hf));
        *(LAS v4u*)(lds + SS_U + (t >> 6) * SS_UST + (t & 63) * 32 + hf * 16) = v; }
    for (int i = tid; i < 2080; i += NWAVES * 64) *(LAS v4u*)(lds + SS_K + i * 16) = *(const GAS v4u*)(ktab + (size_t)g * 65 * 256 + i * 8);
    __syncthreads();
    const int n = lane & 31, h = lane >> 5;
    { const int mt = wave & 3, kh = wave >> 2; f32x16 acc;
#pragma unroll
      for (int i = 0; i < 16; ++i) acc[i] = 0.f;
      const bf16* hp = htab + (((size_t)(g * 4 + mt) * 64 + kh * 32) * 64 + lane) * 8;
#pragma unroll 4
      for (int s = 0; s < 32; ++s) { const bf16x8 a = *(const GAS bf16x8*)(hp + (size_t)s * 512);
          const bf16x8 bb = *(const LAS bf16x8*)(lds + SS_U + n * SS_UST + (kh * 32 + s) * 32 + h * 16);
          acc = __builtin_amdgcn_mfma_f32_32x32x16_bf16(a, bb, acc, 0, 0, 0); }
      LAS float* E = (LAS float*)(lds + SS_E) + kh * 128 * 33;
#pragma unroll
      for (int r = 0; r < 16; ++r) E[(32 * mt + (r & 3) + 8 * (r >> 2) + 4 * h) * 33 + n] = acc[r]; }
    __syncthreads();
    if (tid < 64) { const int p = tid; const float ar = a64[(g * 64 + p) * 2], ai = a64[(g * 64 + p) * 2 + 1]; float cr = 0.f, ci = 0.f;
        const LAS float* E0 = (const LAS float*)(lds + SS_E); const LAS float* E1 = E0 + 128 * 33;
        for (int j = 0; j < 32; ++j) { *(LAS bf16*)(lds + SS_C + j * SS_CST + p * 2) = (bf16)f2bf(cr); *(LAS bf16*)(lds + SS_C + j * SS_CST + (64 + p) * 2) = (bf16)f2bf(ci);
            const float er = E0[p * 33 + j] + E1[p * 33 + j], ei = E0[(64 + p) * 33 + j] + E1[(64 + p) * 33 + j];
            const float nr = ar * cr - ai * ci + er, ni = ar * ci + ai * cr + ei; cr = nr; ci = ni; } }
    __syncthreads();
    for (int q = 0; q < 4; ++q) { const int mt = (q == 0) ? wave : (q == 1) ? 15 - wave : (q == 2) ? 16 + wave : 31 - wave;
        f32x16 acc;
#pragma unroll
        for (int i = 0; i < 16; ++i) acc[i] = 0.f;
        const int t_l = 2 * mt + (n >> 4), c_l = n & 15;
        const int abase = SS_K + ((t_l + 1) * 16 + c_l) * 32 + h * 16;
        const int bbase = SS_U + n * SS_UST + h * 16;
        const int ns = 2 * mt + 2;
        for (int s = 0; s < ns; ++s) { const bf16x8 a = *(const LAS bf16x8*)(lds + abase - s * 512); const bf16x8 bb = *(const LAS bf16x8*)(lds + bbase + s * 32);
            acc = __builtin_amdgcn_mfma_f32_32x32x16_bf16(a, bb, acc, 0, 0, 0); }
        const bf16* gp = gtab + (((size_t)(g * 32 + mt) * 8) * 64 + lane) * 8;
#pragma unroll
        for (int ks = 0; ks < 8; ++ks) { const bf16x8 a = *(const GAS bf16x8*)(gp + (size_t)ks * 512); const bf16x8 bb = *(const LAS bf16x8*)(lds + SS_C + n * SS_CST + (16 * ks + 8 * h) * 2);
            acc = __builtin_amdgcn_mfma_f32_32x32x16_bf16(a, bb, acc, 0, 0, 0); }
#pragma unroll
        for (int q4 = 0; q4 < 4; ++q4) { const int t = 2 * mt + (q4 >> 1), c0 = 8 * (q4 & 1) + 4 * h;
            const v2u uu = *(const LAS v2u*)(lds + SS_U + n * SS_UST + t * 32 + c0 * 2);
            const f32x4 dv = *(const f32x4*)(dskip + 16 * g + c0);
            const float y0 = acc[4 * q4 + 0] + dv[0] * bf_lo(uu.x), y1 = acc[4 * q4 + 1] + dv[1] * bf_hi(uu.x), y2 = acc[4 * q4 + 2] + dv[2] * bf_lo(uu.y), y3 = acc[4 * q4 + 3] + dv[3] * bf_hi(uu.y);
            *(GAS v2u*)(vg + (size_t)(b * SEQ + 64 * n + t) * SSMW + 16 * g + c0) = (v2u){pk2(gelu_tanh(y0), gelu_tanh(y1)), pk2(gelu_tanh(y2), gelu_tanh(y3))}; } }
    __syncthreads();
}

constexpr int AT_K = 0, AT_V = 272 * 256, AT_END = 2 * 272 * 256;
static_assert(AT_END <= 147456 - 1024, "attn LDS");
__device__ __forceinline__ unsigned off_b(unsigned row, unsigned ch) { return 256u * row + 16u * (ch ^ (((row & 3) << 2) | ((row >> 2) & 3))); }
typedef short v4i16_t __attribute__((ext_vector_type(4)));
__device__ __forceinline__ s16x4 tr_read(LAS unsigned char* p) { return __builtin_bit_cast(s16x4, __builtin_amdgcn_ds_read_tr16_b64_v4i16((LAS v4i16_t*)p)); }
__device__ __forceinline__ void attn_unit(LAS unsigned char* lds, int b, int hd, int di, int dil, int res, int blk, const bf16* proj, bf16* obr, float* lse, int tid, int lane, int wave) {
    const size_t rowb = (size_t)b * SEQ;
    for (int it = 0; it < 8; ++it) { const int idx = tid + 512 * it, row = idx >> 4, ch = idx & 15; const int sub = 128 * blk - 128 + row;
        v4u kv = (v4u){0u, 0u, 0u, 0u}, vv = kv;
        if (sub >= 0) { const bf16* src = proj + (rowb + res + dil * sub) * PROJW + 2048 + hd * HDIM + ch * 8; kv = *(const GAS v4u*)src; vv = *(const GAS v4u*)(src + 1024); }
        *(LAS v4u*)(lds + AT_K + off_b(row, ch)) = kv; *(LAS v4u*)(lds + AT_V + off_b(row, ch)) = vv; }
    if (tid < 256) { const int row = 256 + (tid >> 4), ch = tid & 15; *(LAS v4u*)(lds + AT_K + off_b(row, ch)) = (v4u){0u, 0u, 0u, 0u}; *(LAS v4u*)(lds + AT_V + off_b(row, ch)) = (v4u){0u, 0u, 0u, 0u}; }
    const int qn = lane & 15, g = lane >> 4;
    const int qtok = res + dil * (128 * blk + 16 * wave + qn);
    bf16x8 qf[4];
#pragma unroll
    for (int s = 0; s < 4; ++s) qf[s] = *(const GAS bf16x8*)(proj + (rowb + qtok) * PROJW + 1024 + hd * HDIM + 32 * s + 8 * g);
    __syncthreads();
    f32x4 sc[10];
#pragma unroll
    for (int kt = 0; kt < 10; ++kt) { f32x4 a = {0.f, 0.f, 0.f, 0.f};
#pragma unroll
        for (int s = 0; s < 4; ++s) { const bf16x8 kf = *(const LAS bf16x8*)(lds + AT_K + off_b(16 * (wave + kt) + qn, 4 * s + g));
            a = __builtin_amdgcn_mfma_f32_16x16x32_bf16(kf, qf[s], a, 0, 0, 0); }
        sc[kt] = a; }
    const bool first = (blk == 0);
    float mx = -1e30f;
#pragma unroll
    for (int kt = 0; kt < 10; ++kt)
#pragma unroll
        for (int r = 0; r < 4; ++r) { const int rel = 16 * kt + 4 * g + r; bool ok = (rel >= qn) && (rel <= qn + 128);
            if (first) ok = ok && (16 * (wave + kt) + 4 * g + r >= 128);
            sc[kt][r] = ok ? sc[kt][r] : -1e30f; mx = fmaxf(mx, sc[kt][r]); }
    mx = fmaxf(mx, __shfl_xor(mx, 16)); mx = fmaxf(mx, __shfl_xor(mx, 32));
    float ls = 0.f;
#pragma unroll
    for (int kt = 0; kt < 10; ++kt)
#pragma unroll
        for (int r = 0; r < 4; ++r) { const float p = (sc[kt][r] > -1e29f) ? __builtin_amdgcn_exp2f(sc[kt][r] - mx) : 0.f; sc[kt][r] = p; ls += p; }
    ls += __shfl_xor(ls, 16); ls += __shfl_xor(ls, 32);
    f32x4 o[8];
#pragma unroll
    for (int c = 0; c < 8; ++c) o[c] = (f32x4){0.f, 0.f, 0.f, 0.f};
    const int q4 = (lane & 15) >> 2, p4 = lane & 3;
#pragma unroll
    for (int ks = 0; ks < 5; ++ks) {
        union { unsigned u[4]; bf16x8 v; } pb;
        pb.u[0] = pk2(sc[2 * ks][0], sc[2 * ks][1]); pb.u[1] = pk2(sc[2 * ks][2], sc[2 * ks][3]); pb.u[2] = pk2(sc[2 * ks + 1][0], sc[2 * ks + 1][1]); pb.u[3] = pk2(sc[2 * ks + 1][2], sc[2 * ks + 1][3]);
#pragma unroll
        for (int c = 0; c < 8; ++c) {
            const unsigned r0 = 16 * wave + 32 * ks + 4 * g + q4;
            const s16x4 v0 = tr_read(lds + AT_V + off_b(r0, 2 * c + (p4 >> 1)) + 8 * (p4 & 1));
            const s16x4 v1 = tr_read(lds + AT_V + off_b(r0 + 16, 2 * c + (p4 >> 1)) + 8 * (p4 & 1));
            bf16x8 va; va[0] = v0[0]; va[1] = v0[1]; va[2] = v0[2]; va[3] = v0[3]; va[4] = v1[0]; va[5] = v1[1]; va[6] = v1[2]; va[7] = v1[3];
            o[c] = __builtin_amdgcn_mfma_f32_16x16x32_bf16(va, pb.v, o[c], 0, 0, 0); } }
    const float inv = 1.0f / ls;
    bf16* op = obr + (size_t)di * MTOK * ATTW + (rowb + qtok) * ATTW + hd * HDIM + 4 * g;
#pragma unroll
    for (int c = 0; c < 8; ++c) *(GAS v2u*)(op + 16 * c) = (v2u){pk2(o[c][0] * inv, o[c][1] * inv), pk2(o[c][2] * inv, o[c][3] * inv)};
    if (g == 0) lse[(size_t)di * MTOK * NHEAD + (rowb + qtok) * NHEAD + hd] = mx + __builtin_amdgcn_logf(ls);
    __syncthreads();
}

__device__ __forceinline__ void ynorm_phase(bf16* ycat, const bf16* obr, const float* lse, int lane, int wave) {
    for (int r = 0; r < 4; ++r) { const int row = blockIdx.x * 32 + wave * 4 + r;
        { bf16* p = ycat + (size_t)row * DM + lane * 16; const v4u a = *(const GAS v4u*)p, c = *(const GAS v4u*)(p + 8);
          float v[16] = {bf_lo(a.x), bf_hi(a.x), bf_lo(a.y), bf_hi(a.y), bf_lo(a.z), bf_hi(a.z), bf_lo(a.w), bf_hi(a.w), bf_lo(c.x), bf_hi(c.x), bf_lo(c.y), bf_hi(c.y), bf_lo(c.z), bf_hi(c.z), bf_lo(c.w), bf_hi(c.w)};
          float s = 0.f;
#pragma unroll
          for (int i = 0; i < 16; ++i) s += v[i] * v[i];
          const float rstd = 1.0f / sqrtf(wave_sum(s) * (1.0f / SSMW) + 1e-6f);
          *(GAS v4u*)p = (v4u){pk2(v[0] * rstd, v[1] * rstd), pk2(v[2] * rstd, v[3] * rstd), pk2(v[4] * rstd, v[5] * rstd), pk2(v[6] * rstd, v[7] * rstd)};
          *(GAS v4u*)(p + 8) = (v4u){pk2(v[8] * rstd, v[9] * rstd), pk2(v[10] * rstd, v[11] * rstd), pk2(v[12] * rstd, v[13] * rstd), pk2(v[14] * rstd, v[15] * rstd)}; }
        { const int hd = lane >> 3;
          const float l0 = lse[(size_t)row * NHEAD + hd], l1 = lse[(size_t)MTOK * NHEAD + (size_t)row * NHEAD + hd], l2 = lse[(size_t)2 * MTOK * NHEAD + (size_t)row * NHEAD + hd];
          const float lm = fmaxf(l0, fmaxf(l1, l2)); float w0 = __builtin_amdgcn_exp2f(l0 - lm), w1 = __builtin_amdgcn_exp2f(l1 - lm), w2 = __builtin_amdgcn_exp2f(l2 - lm);
          const float wi = 1.0f / (w0 + w1 + w2); w0 *= wi; w1 *= wi; w2 *= wi;
          float v[16];
#pragma unroll
          for (int i = 0; i < 16; ++i) v[i] = 0.f;
#pragma unroll
          for (int d = 0; d < 3; ++d) { const bf16* p = obr + (size_t)d * MTOK * ATTW + (size_t)row * ATTW + lane * 16; const v4u a = *(const GAS v4u*)p, c = *(const GAS v4u*)(p + 8); const float w = d == 0 ? w0 : d == 1 ? w1 : w2;
              v[0] += w * bf_lo(a.x); v[1] += w * bf_hi(a.x); v[2] += w * bf_lo(a.y); v[3] += w * bf_hi(a.y); v[4] += w * bf_lo(a.z); v[5] += w * bf_hi(a.z); v[6] += w * bf_lo(a.w); v[7] += w * bf_hi(a.w);
              v[8] += w * bf_lo(c.x); v[9] += w * bf_hi(c.x); v[10] += w * bf_lo(c.y); v[11] += w * bf_hi(c.y); v[12] += w * bf_lo(c.z); v[13] += w * bf_hi(c.z); v[14] += w * bf_lo(c.w); v[15] += w * bf_hi(c.w); }
          float s = 0.f;
#pragma unroll
          for (int i = 0; i < 16; ++i) s += v[i] * v[i];
          const float rstd = 1.0f / sqrtf(wave_sum(s) * (1.0f / ATTW) + 1e-6f);
          bf16* p = ycat + (size_t)row * DM + SSMW + lane * 16;
          *(GAS v4u*)p = (v4u){pk2(v[0] * rstd, v[1] * rstd), pk2(v[2] * rstd, v[3] * rstd), pk2(v[4] * rstd, v[5] * rstd), pk2(v[6] * rstd, v[7] * rstd)};
          *(GAS v4u*)(p + 8) = (v4u){pk2(v[8] * rstd, v[9] * rstd), pk2(v[10] * rstd, v[11] * rstd), pk2(v[12] * rstd, v[13] * rstd), pk2(v[14] * rstd, v[15] * rstd)}; } }
}
__device__ __forceinline__ void final_norm_phase(float* out, const float* gfin, int lane, int wave) {
    for (int r = 0; r < 4; ++r) { const int row = blockIdx.x * 32 + wave * 4 + r;
        f32x4* xr = (f32x4*)(out + (size_t)row * DM) + lane; f32x4 v[8]; float s = 0.f;
#pragma unroll
        for (int j = 0; j < 8; ++j) { v[j] = xr[64 * j]; s += (v[j].x * v[j].x + v[j].y * v[j].y) + (v[j].z * v[j].z + v[j].w * v[j].w); }
        const float rstd = 1.0f / sqrtf(wave_sum(s) * (1.0f / DM) + 1e-6f);
#pragma unroll
        for (int j = 0; j < 8; ++j) { const f32x4 gq = *((const f32x4*)gfin + lane + 64 * j); xr[64 * j] = v[j] * rstd * gq; } }
}

constexpr int NPH = 11;
constexpr int IT_GEMV = KSPLIT * 48, IT_SSM = NGRP * 193, IT_ROPE = MTOK, IT_WIN = (DM / 64) * (PROJW / 32), IT_WGLU = (SSMW / 64) * (SSMW / 32), IT_WOUT = (DM / 64) * (DM / 32),
              IT_WG = (DM / 64) * (DFF / 32), IT_WD = (DFF / 64) * (DM / 32), IT_TOTAL = IT_GEMV + IT_SSM + IT_ROPE + IT_WIN + IT_WGLU + IT_WOUT + 2 * IT_WG + IT_WD;
__global__ void __launch_bounds__(NWAVES * 64, 2) hymba_fwd(Args args) {
    extern __shared__ __attribute__((aligned(16))) unsigned char lds_raw[];
    LAS unsigned char* lds = (LAS unsigned char*)lds_raw;
    cg::grid_group grid = cg::this_grid();
    const int tid = threadIdx.x, lane = tid & 63, wave = __builtin_amdgcn_readfirstlane(tid >> 6);
    const int G = gridDim.x, bx = blockIdx.x;
    unsigned char* ws = args.ws;
    const float* const* in = args.in;
    float* modp = (float*)(ws + WS_MODP); float* modf = (float*)(ws + WS_MODF); float* cosT = (float*)(ws + WS_ROPE); float* sinT = cosT + (size_t)MTOK * 64;
    bf16* ktab = (bf16*)(ws + WS_KTAB); bf16* gtab = (bf16*)(ws + WS_GTAB); bf16* htab = (bf16*)(ws + WS_HTAB); float* a64 = (float*)(ws + WS_A64);
    bf16* Win = (bf16*)(ws + WS_WIN); bf16* Wglu = (bf16*)(ws + WS_WGLU); bf16* Wout = (bf16*)(ws + WS_WOUT); bf16* Wgu = (bf16*)(ws + WS_WGU); bf16* Wdn = (bf16*)(ws + WS_WDN);
    bf16* Hb = (bf16*)(ws + WS_H); bf16* proj = (bf16*)(ws + WS_PROJ); bf16* vg = (bf16*)(ws + WS_VG); bf16* ycat = (bf16*)(ws + WS_YCAT); bf16* obr = (bf16*)(ws + WS_OBR); float* lse = (float*)(ws + WS_LSE);
    bf16* ff = (bf16*)(ws + WS_FF);
    const int lo = args.ph_lo, hi = args.ph_hi;
#ifndef PHMASK
#define PHMASK 0x7ff
#endif
#define IN(k) (((PHMASK >> (k)) & 1) && lo <= (k) && (k) < hi)
    volatile LAS unsigned* MISC = (volatile LAS unsigned*)(lds + MISC_OFF);
    if (tid < 2) MISC[tid] = 0u;
    __syncthreads();
    if (args.ph_lo < 0) grid.sync();
    const XcdBarrier xbar = xcd_barrier_post((unsigned*)(ws + WS_CTL), MISC);
#define SEAM(k) do { if (IN(k) && IN((k) + 1)) xcd_barrier(xbar); } while (0)
#ifndef DOUBLE_MASK
#define DOUBLE_MASK 0
#endif
#define REPS(k) for (int rep_ = 0; rep_ < 1 + ((DOUBLE_MASK >> (k)) & 1); ++rep_)
#define RSYNC(k) do { if ((DOUBLE_MASK >> (k)) & 1) xcd_barrier(xbar); } while (0)

    REPS(0) if (IN(0)) {
        RSYNC(0);
        LAS float* scr = (LAS float*)(lds + wave * 16384);
        const int gw = wave * G + bx, NGW = G * NWAVES;
        for (int it = gw; it < IT_TOTAL; it += NGW) {
            int r = it;
            if (r < IT_GEMV) { p0_gemv_item(in[1], in[3], modp, modf, in[4], (unsigned*)(ws + WS_CNT), scr, r, lane); continue; } r -= IT_GEMV;
            if (r < IT_SSM) { const int g = r / 193, sub = r % 193;
                if (sub < 65) p0_ktab_item(in, ktab, a64, scr, g, sub, lane); else if (sub < 129) p0_gtab_item(in, gtab, g, sub - 65, lane); else p0_htab_item(in, htab, g, sub - 129, lane);
                continue; } r -= IT_SSM;
            if (r < IT_ROPE) { p0_rope_item((const int*)in[2], cosT, sinT, r, lane); continue; } r -= IT_ROPE;
            if (r < IT_WIN) { p0_transpose_item<1>(in[6], DM, PROJW, Win, scr, r, lane, nullptr, nullptr); continue; } r -= IT_WIN;
            if (r < IT_WGLU) { p0_transpose_item<0>(in[15], SSMW, SSMW, Wglu, scr, r, lane, nullptr, nullptr); continue; } r -= IT_WGLU;
            if (r < IT_WOUT) { p0_transpose_item<4>(in[19], DM, DM, Wout, scr, r, lane, in[17], in[18]); continue; } r -= IT_WOUT;
            if (r < IT_WG) { p0_transpose_item<2>(in[21], DM, DFF, Wgu, scr, r, lane, nullptr, nullptr); continue; } r -= IT_WG;
            if (r < IT_WG) { p0_transpose_item<3>(in[22], DM, DFF, Wgu, scr, r, lane, nullptr, nullptr); continue; } r -= IT_WG;
            p0_transpose_item<0>(in[23], DFF, DM, Wdn, scr, r, lane, nullptr, nullptr);
        }
        __syncthreads();
    }
    SEAM(0);
    REPS(1) if (IN(1)) {
        RSYNC(1);
        modnorm_phase<false>(lds, in[0], Hb, in[5], modp, in[4], modf, 0, 1, tid, lane, wave);
    }
    SEAM(1);
    if (IN(2)) {
        pg8::Gemm g{Hb, Win, MTOK, PROJW, DM}; pg8::StaticOrder S; S.init(MTOK, PROJW, G, bx);
        pg8::EpiProj E{proj, cosT, sinT, 0.08838834764831845f * 1.4426950408889634f};
        pg8::gemm_phase<pg8::EpiProj, pg8::StaticOrder, true, true>(lds, g, S, E);
    }
    SEAM(2);
    REPS(3) if (IN(3)) {
        RSYNC(3);
        int tid = threadIdx.x; asm volatile("" : "+v"(tid)); const int lane = tid & 63, wave = __builtin_amdgcn_readfirstlane(tid >> 6);
        for (int u = bx; u < BATCH * NGRP; u += G) ssm_unit(lds, u / NGRP, u % NGRP, proj, ktab, gtab, htab, a64, in[14], vg, tid, lane, wave);
        for (int u = bx; u < BATCH * NHEAD * 48; u += G) { const int bh = u / 48, w = u % 48; int di, dil, res, blk;
            if (w < 16) { di = 0; dil = 1; res = 0; blk = w; } else if (w < 32) { di = 1; dil = 4; res = (w - 16) >> 2; blk = (w - 16) & 3; } else { di = 2; dil = 16; res = w - 32; blk = 0; }
            attn_unit(lds, bh / NHEAD, bh % NHEAD, di, dil, res, blk, proj, obr, lse, tid, lane, wave); }
    }
    SEAM(3);
    if (IN(4)) {
        pg8::Gemm g{vg, Wglu, MTOK, SSMW, SSMW}; pg8::StaticOrder S; S.init(MTOK, SSMW, G, bx);
        pg8::EpiGlu E{ycat, vg, in[16]};
        pg8::gemm_phase<pg8::EpiGlu, pg8::StaticOrder, true, true>(lds, g, S, E);
    }
    SEAM(4);
    REPS(5) if (IN(5)) ynorm_phase(ycat, obr, lse, lane, wave);
    SEAM(5);
    if (IN(6)) {
        pg8::Gemm g{ycat, Wout, MTOK, DM, DM}; pg8::StaticOrder S; S.init(MTOK, DM, G, bx);
        pg8::EpiResid E{in[0], args.out, modf + 2 * DM};
        pg8::gemm_phase<pg8::EpiResid, pg8::StaticOrder, true, true>(lds, g, S, E);
    }
    SEAM(6);
    REPS(7) if (IN(7)) modnorm_phase<false>(lds, args.out, Hb, in[20], modp, in[4], modf, 3, 4, tid, lane, wave);
    SEAM(7);
    if (IN(8)) {
        pg8::Gemm g{Hb, Wgu, MTOK, 2 * DFF, DM}; pg8::StaticOrder S; S.init(MTOK, 2 * DFF, G, bx);
        pg8::EpiSwiglu E{ff};
        pg8::gemm_phase<pg8::EpiSwiglu, pg8::StaticOrder, true, true>(lds, g, S, E);
    }
    SEAM(8);
    if (IN(9)) {
        pg8::Gemm g{ff, Wdn, MTOK, DM, DFF}; pg8::StaticOrder S; S.init(MTOK, DM, G, bx);
        pg8::EpiResid E{args.out, args.out, modf + 5 * DM};
        pg8::gemm_phase<pg8::EpiResid, pg8::StaticOrder, true, true>(lds, g, S, E);
    }
    SEAM(9);
    if (IN(10)) final_norm_phase(args.out, in[24], lane, wave);
#undef IN
#undef SEAM
}

#ifndef MK_PER_PHASE
#define MK_PER_PHASE 0
#endif
extern "C" void kernel_launch(void* const* d_in, const int* in_sizes, int n_in, void* d_out, int out_size, void* d_ws, size_t ws_size, hipStream_t stream) {
    static int ready = 0;
    if (ready == 0) {
        ready = 1;
        if (n_in != 25 || out_size != MTOK * DM || ws_size < WS_END) { fprintf(stderr, "kernel_launch: unexpected shapes (n_in %d out %d ws %zu)\n", n_in, out_size, ws_size); ready = -1; }
        else if (hipFuncSetAttribute((const void*)hymba_fwd, hipFuncAttributeMaxDynamicSharedMemorySize, LDS_BYTES) != hipSuccess) { fprintf(stderr, "kernel_launch: hipFuncSetAttribute failed\n"); ready = -1; }
        else { int per_cu = 0; (void)hipOccupancyMaxActiveBlocksPerMultiprocessor(&per_cu, (const void*)hymba_fwd, NWAVES * 64, LDS_BYTES); (void)hipGetLastError();
               if (per_cu < 1) fprintf(stderr, "kernel_launch: occupancy query reports %d blocks per CU\n", per_cu); }
    }
    if (ready < 0) return;
    if (hipMemsetAsync((char*)d_ws + WS_CTL, 0, CTL_ZERO_BYTES, stream) != hipSuccess) { fprintf(stderr, "kernel_launch: memset failed\n"); return; }
    Args a{};
    for (int i = 0; i < 25; ++i) a.in[i] = (const float*)d_in[i];
    a.out = (float*)d_out; a.ws = (unsigned char*)d_ws;
#if MK_PER_PHASE
    for (int p = 0; p < NPH; ++p) { a.ph_lo = p; a.ph_hi = p + 1; hipLaunchKernelGGL(hymba_fwd, dim3(256), dim3(NWAVES * 64), LDS_BYTES, stream, a); }
#else
    a.ph_lo = 0; a.ph_hi = NPH;
    void* kargs[] = {&a};
    hipError_t e = hipLaunchCooperativeKernel((const void*)hymba_fwd, dim3(256), dim3(NWAVES * 64), kargs, LDS_BYTES, stream);
    if (e != hipSuccess) fprintf(stderr, "kernel_launch: cooperative launch failed: %s\n", hipGetErrorString(e));
#endif
}
```

```cpp
#include <hip/hip_runtime.h>
#include <hip/hip_cooperative_groups.h>
#include <cstdio>
#include <cstdint>
namespace cg = cooperative_groups;
namespace pg8 {
#define PG8_LAS __attribute__((address_space(3)))
typedef unsigned short bf16_t;
typedef short bf16x8 __attribute__((ext_vector_type(8)));
typedef float f32x4 __attribute__((ext_vector_type(4)));
typedef unsigned u32x4 __attribute__((ext_vector_type(4)));
constexpr int BM = 256, BK = 64, HALF = 128, HTB = HALF * BK * 2  , STAGE_BYTES = 8 * HTB, NXCD = 8, WGM = 8;

__host__ __device__ __forceinline__ int lds_byte(int r, int c) { const int st = (r >> 4) * 2 + (c >> 5), rr = r & 15, cc = c & 31, ob = rr * 64 + cc * 2; return st * 1024 + (ob ^ (((ob >> 9) & 1) << 5)); }
__host__ __device__ __forceinline__ void stage_rc(int b, int& R, int& C) { const int st = b / 1024, sb = b % 1024, swz = sb ^ (((sb >> 9) & 1) << 5); R = (st >> 1) * 16 + swz / 64; C = (st & 1) * 32 + (swz % 64) / 2; }
__host__ __device__ __forceinline__ int perm32(int rho) { const int n = rho >> 4, i = rho & 15; return 8 * (i >> 2) + 4 * n + (i & 3); }

struct Unit { int pm, pn; };
struct Gemm { const bf16_t* A; const bf16_t* Bt; int M, N, K; };

struct StaticOrder {
    int nM, nN, nwg, G, c;
    __host__ __device__ void init(int M, int N, int G_, int c_) { nM = M / BM; nN = N / BM; nwg = nM * nN; G = G_; c = c_; }
    __host__ __device__ bool next(int i, Unit& u) const {
        const long L = (long)i * G + c; if (L >= nwg) return false;
        int wgid = (int)L; { const int q = nwg / NXCD, r = nwg % NXCD, xcd = wgid % NXCD, off = wgid / NXCD; wgid = (xcd < r ? xcd * (q + 1) : r * (q + 1) + (xcd - r) * q) + off; }
        const int nig = WGM * nN, gid = wgid / nig, fm = gid * WGM, gsz = (nM - fm) < WGM ? (nM - fm) : WGM;
        u.pm = fm + ((wgid % nig) % gsz); u.pn = (wgid % nig) / gsz; return true;
    }
    __device__ __forceinline__ void a_ready(const Unit&) const {}
    __device__ __forceinline__ void done(const Unit&) const {}
};

__device__ __forceinline__ unsigned cvt_pk_bf16(float lo, float hi) { unsigned r; asm volatile("v_cvt_pk_bf16_f32 %0, %1, %2" : "=v"(r) : "v"(lo), "v"(hi)); return r; }
typedef float f32x2 __attribute__((ext_vector_type(2)));
__device__ __forceinline__ f32x2 gelu_pk(f32x2 v) {
    const f32x2 av = __builtin_elementwise_abs(v), d = av * 0.2316418882f + 1.0f;
    f32x2 t; t.x = __builtin_amdgcn_rcpf(d.x); t.y = __builtin_amdgcn_rcpf(d.y);
    f32x2 q = t * 0.5307027145f + (-0.7265760135f); q = q * t + 0.7107068705f; q = q * t + (-0.142248368f); q = q * t + 0.127414796f; q = q * t;
    const f32x2 s = (v * v) * (-0.72134752044f);
    f32x2 e; e.x = __builtin_amdgcn_exp2f(s.x); e.y = __builtin_amdgcn_exp2f(s.y);
    const f32x2 m = v * (q * e), r = v - m;
    f32x2 o; o.x = v.x < 0.f ? m.x : r.x; o.y = v.y < 0.f ? m.y : r.y; return o;
}

__device__ __forceinline__ float bflo(unsigned w) { return __uint_as_float(w << 16); }
__device__ __forceinline__ float bfhi(unsigned w) { return __uint_as_float(w & 0xffff0000u); }
__device__ __forceinline__ float fast_sigmoid(float v) { return __builtin_amdgcn_rcpf(1.0f + __builtin_amdgcn_exp2f(-1.4426950408889634f * v)); }
struct EpiProj {
    static constexpr bool PERM = true, AFTER_DRAIN = false;
    bf16_t* O; const float* cosT; const float* sinT; float qscale;
    __device__ __forceinline__ void operator()(const f32x4 (&acc)[2][2][4][2], const Unit& u, int wr, int wc, int fr, int fq) const {
        const int row0 = u.pm * BM + wr * 64 + fr; const int col0 = u.pn * BM + wc * 32 + 8 * fq;
        const int sect = u.pn >> 2;
        const int j0 = 4 * (4 * wc + fq);
        const float sc = (sect == 1) ? qscale : 1.f;
#pragma unroll
        for (int ai = 0; ai < 2; ++ai)
#pragma unroll
            for (int m = 0; m < 4; ++m) { const int row = row0 + ai * HALF + m * 16; bf16_t* rowp = O + (size_t)row * 4096 + col0;
                f32x4 cs = (f32x4){1.f, 1.f, 1.f, 1.f}, sn = (f32x4){0.f, 0.f, 0.f, 0.f};
                if (sect == 1 || sect == 2) { cs = *(const f32x4*)(cosT + (size_t)row * 64 + j0); sn = *(const f32x4*)(sinT + (size_t)row * 64 + j0); }
#pragma unroll
                for (int bj = 0; bj < 2; ++bj) { const f32x4 t1 = acc[ai][bj][m][0], t2 = acc[ai][bj][m][1];
                    f32x4 v0 = (t1 * cs - t2 * sn) * sc, v1 = (t1 * sn + t2 * cs) * sc;
                    u32x4 w; w.x = cvt_pk_bf16(v0[0], v0[1]); w.y = cvt_pk_bf16(v0[2], v0[3]); w.z = cvt_pk_bf16(v1[0], v1[1]); w.w = cvt_pk_bf16(v1[2], v1[3]);
                    *(u32x4*)(rowp + bj * HALF) = w; } }
    }
};
struct EpiGlu {
    static constexpr bool PERM = true, AFTER_DRAIN = false;
    bf16_t* O; const bf16_t* VG; const float* bias;
    __device__ __forceinline__ void operator()(const f32x4 (&acc)[2][2][4][2], const Unit& u, int wr, int wc, int fr, int fq) const {
        const int row0 = u.pm * BM + wr * 64 + fr; const int col0 = u.pn * BM + wc * 32 + 8 * fq;
        f32x4 bv[2][2];
#pragma unroll
        for (int bj = 0; bj < 2; ++bj)
#pragma unroll
            for (int n = 0; n < 2; ++n) bv[bj][n] = *(const f32x4*)(bias + col0 + bj * HALF + 4 * n);
#pragma unroll
        for (int ai = 0; ai < 2; ++ai)
#pragma unroll
            for (int m = 0; m < 4; ++m) { const int row = row0 + ai * HALF + m * 16;
#pragma unroll
                for (int bj = 0; bj < 2; ++bj) { const u32x4 g = *(const u32x4*)(VG + (size_t)row * 1024 + col0 + bj * HALF);
                    const f32x4 a0 = acc[ai][bj][m][0] + bv[bj][0], a1 = acc[ai][bj][m][1] + bv[bj][1];
                    u32x4 w; w.x = cvt_pk_bf16(bflo(g.x) * fast_sigmoid(a0[0]), bfhi(g.x) * fast_sigmoid(a0[1])); w.y = cvt_pk_bf16(bflo(g.y) * fast_sigmoid(a0[2]), bfhi(g.y) * fast_sigmoid(a0[3]));
                    w.z = cvt_pk_bf16(bflo(g.z) * fast_sigmoid(a1[0]), bfhi(g.z) * fast_sigmoid(a1[1])); w.w = cvt_pk_bf16(bflo(g.w) * fast_sigmoid(a1[2]), bfhi(g.w) * fast_sigmoid(a1[3]));
                    *(u32x4*)(O + (size_t)row * 2048 + col0 + bj * HALF) = w; } }
    }
};
struct EpiResid {
    static constexpr bool PERM = false, AFTER_DRAIN = false;
    const float* base; float* out; const float* gate;
    __device__ __forceinline__ void operator()(const f32x4 (&acc)[2][2][4][2], const Unit& u, int wr, int wc, int fr, int fq) const {
        const int col0 = u.pn * BM + wc * 32 + 4 * fq; const int b = u.pm >> 3;
        f32x4 gv[2][2];
#pragma unroll
        for (int bj = 0; bj < 2; ++bj)
#pragma unroll
            for (int n = 0; n < 2; ++n) gv[bj][n] = *(const f32x4*)(gate + (size_t)b * 12288 + col0 + bj * HALF + n * 16);
#pragma unroll
        for (int ai = 0; ai < 2; ++ai)
#pragma unroll
            for (int m = 0; m < 4; ++m) { const size_t off = (size_t)(u.pm * BM + ai * HALF + wr * 64 + m * 16 + fr) * 2048 + col0;
#pragma unroll
                for (int bj = 0; bj < 2; ++bj)
#pragma unroll
                    for (int n = 0; n < 2; ++n) { const f32x4 bs = *(const f32x4*)(base + off + bj * HALF + n * 16);
                        *(f32x4*)(out + off + bj * HALF + n * 16) = bs + gv[bj][n] * acc[ai][bj][m][n]; } }
    }
};
struct EpiSwiglu {
    static constexpr bool PERM = true, AFTER_DRAIN = false;
    bf16_t* O;
    __device__ __forceinline__ void operator()(const f32x4 (&acc)[2][2][4][2], const Unit& u, int wr, int wc, int fr, int fq) const {
        const int row0 = u.pm * BM + wr * 64 + fr; const int col0 = u.pn * HALF + wc * 32 + 8 * fq;
#pragma unroll
        for (int ai = 0; ai < 2; ++ai)
#pragma unroll
            for (int m = 0; m < 4; ++m) { const int row = row0 + ai * HALF + m * 16;
                const f32x4 g0 = acc[ai][0][m][0], g1 = acc[ai][0][m][1], u0 = acc[ai][1][m][0], u1 = acc[ai][1][m][1];
                f32x4 v0, v1;
#pragma unroll
                for (int i = 0; i < 4; ++i) { v0[i] = g0[i] * fast_sigmoid(g0[i]) * u0[i]; v1[i] = g1[i] * fast_sigmoid(g1[i]) * u1[i]; }
                u32x4 w; w.x = cvt_pk_bf16(v0[0], v0[1]); w.y = cvt_pk_bf16(v0[2], v0[3]); w.z = cvt_pk_bf16(v1[0], v1[1]); w.w = cvt_pk_bf16(v1[2], v1[3]);
                *(u32x4*)(O + (size_t)row * 5632 + col0) = w; }
    }
};

template <class Epi, class Sched, bool ALIGN_EPI = false, bool SP2 = false>
__device__ __forceinline__ void gemm_phase(PG8_LAS unsigned char* lds, const Gemm g, const Sched& S, const Epi& E) {
    const int tid = threadIdx.x, wid = __builtin_amdgcn_readfirstlane(tid >> 6), lane = tid & 63, wr = wid >> 2, wc = wid & 3, fr = lane & 15, fq = lane >> 4;
    const int K = g.K, nt = K / BK;
    unsigned voffA[2], voffB[2];
#pragma unroll
    for (int i = 0; i < 2; ++i) { int R, C; stage_rc(tid * 16 + i * 8192, R, C); const int Rb = Epi::PERM ? ((R & ~31) + perm32(R & 31)) : R;
        voffA[i] = (unsigned)(R * K + C) * 2u; voffB[i] = (unsigned)(Rb * K + C) * 2u; }
    const size_t kstep = (size_t)(BK * 2);
    const size_t hstep = (size_t)HALF * K * 2;
    const size_t tstep = 2 * hstep;
    const unsigned ldsw = (unsigned)wid * 1024u;
    const int aoff = lds_byte(wr * 64 + fr, fq * 8), boff = lds_byte(wc * 32 + fr, fq * 8);
#define PG8_SA(b, h) (((b) * 2 + (h)) * HTB)
#define PG8_SB(b, h) ((4 + (b) * 2 + (h)) * HTB)
#define PG8_STAGE(bufoff, gbase, voff) do { _Pragma("unroll") for (int _i = 0; _i < 2; ++_i) \
        __builtin_amdgcn_global_load_lds((const unsigned*)((const char*)(gbase) + (voff)[_i]), (PG8_LAS unsigned*)(lds + (bufoff) + ldsw + _i * 8192), 16, 0, 0); } while (0)
#define PG8_LDA(dst, b, h) do { _Pragma("unroll") for (int m = 0; m < 4; ++m) _Pragma("unroll") for (int k = 0; k < 2; ++k) dst[m][k] = *(const PG8_LAS bf16x8*)(lds + PG8_SA(b, h) + aoff + m * 2048 + k * 1024); } while (0)
#define PG8_LDB(dst, b, h) do { _Pragma("unroll") for (int n = 0; n < 2; ++n) _Pragma("unroll") for (int k = 0; k < 2; ++k) dst[n][k] = *(const PG8_LAS bf16x8*)(lds + PG8_SB(b, h) + boff + n * 2048 + k * 1024); } while (0)
#define PG8_MMA(ai, bj, At, Bt) do { __builtin_amdgcn_s_setprio(1); _Pragma("unroll") for (int m = 0; m < 4; ++m) _Pragma("unroll") for (int n = 0; n < 2; ++n) _Pragma("unroll") for (int k = 0; k < 2; ++k) \
        acc[ai][bj][m][n] = __builtin_amdgcn_mfma_f32_16x16x32_bf16(Bt[n][k], At[m][k], acc[ai][bj][m][n], 0, 0, 0); __builtin_amdgcn_s_setprio(0); } while (0)
#define PG8_WAIT_V(n) asm volatile("s_waitcnt vmcnt(" #n ")" ::: "memory")
#define PG8_WAIT_L(n) asm volatile("s_waitcnt lgkmcnt(" #n ")" ::: "memory")
#define PG8_BAR __builtin_amdgcn_s_barrier()
#define PG8_SCHED __builtin_amdgcn_sched_barrier(0)
    Unit cur, nxt; int ui = 0;
    if (!S.next(0, cur)) return;
    f32x4 acc[2][2][4][2];
#pragma unroll
    for (int a = 0; a < 2; ++a)
#pragma unroll
        for (int b = 0; b < 2; ++b)
#pragma unroll
            for (int m = 0; m < 4; ++m)
#pragma unroll
                for (int n = 0; n < 2; ++n) acc[a][b][m][n] = (f32x4){0.f, 0.f, 0.f, 0.f};
    bf16x8 At[4][2], B0[2][2], B1[2][2];
    const char* cA = (const char*)g.A + (size_t)cur.pm * tstep; const char* cB = (const char*)g.Bt + (size_t)cur.pn * tstep;
    S.a_ready(cur);
    if constexpr (SP2) {
        PG8_STAGE(PG8_SB(0, 0), cB, voffB); PG8_STAGE(PG8_SB(0, 1), cB + hstep, voffB); PG8_STAGE(PG8_SA(0, 0), cA, voffA); PG8_STAGE(PG8_SA(0, 1), cA + hstep, voffA);
        if (wr == 1) PG8_BAR;
        PG8_WAIT_V(2); PG8_BAR;
        PG8_STAGE(PG8_SB(1, 0), cB + kstep, voffB); PG8_STAGE(PG8_SA(1, 0), cA + kstep, voffA); PG8_STAGE(PG8_SB(1, 1), cB + hstep + kstep, voffB);
        PG8_WAIT_V(6); PG8_BAR;
    } else {
        PG8_STAGE(PG8_SB(0, 0), cB, voffB); PG8_STAGE(PG8_SA(0, 0), cA, voffA); PG8_STAGE(PG8_SB(0, 1), cB + hstep, voffB); PG8_STAGE(PG8_SA(0, 1), cA + hstep, voffA);
        if (wr == 1) PG8_BAR;
        PG8_WAIT_V(4); PG8_BAR;
        PG8_STAGE(PG8_SB(1, 0), cB + kstep, voffB); PG8_STAGE(PG8_SA(1, 0), cA + kstep, voffA); PG8_STAGE(PG8_SB(1, 1), cB + hstep + kstep, voffB);
        PG8_WAIT_V(6); PG8_BAR;
    }
    for (;;) {
        const bool has_next = S.next(ui + 1, nxt);
        const char* nA = has_next ? (const char*)g.A + (size_t)nxt.pm * tstep : cA; const char* nB = has_next ? (const char*)g.Bt + (size_t)nxt.pn * tstep : cB;
        for (int t = 0; t < nt; t += 2) {
            const bool last = (t == nt - 2);
            const char* a1 = cA + (size_t)(t + 1) * kstep;
            const char* a2 = last ? nA : cA + (size_t)(t + 2) * kstep; const char* b2 = last ? nB : cB + (size_t)(t + 2) * kstep;
            const char* a3 = a2 + kstep; const char* b3 = b2 + kstep;
            if (last && has_next) S.a_ready(nxt);
            if constexpr (SP2) {
            PG8_LDB(B0, 0, 0); PG8_LDB(B1, 0, 1); PG8_SCHED; PG8_LDA(At, 0, 0); PG8_STAGE(PG8_SA(1, 1), a1 + hstep, voffA);
            PG8_WAIT_V(8); PG8_WAIT_L(0); PG8_BAR; PG8_MMA(0, 0, At, B0); PG8_MMA(0, 1, At, B1); PG8_BAR; PG8_SCHED;
            PG8_LDA(At, 0, 1); PG8_STAGE(PG8_SB(0, 0), b2, voffB); PG8_STAGE(PG8_SB(0, 1), b2 + hstep, voffB); PG8_STAGE(PG8_SA(0, 0), a2, voffA);
            PG8_WAIT_V(8); PG8_WAIT_L(0); PG8_BAR; PG8_MMA(1, 0, At, B0); PG8_MMA(1, 1, At, B1); PG8_BAR; PG8_SCHED;
            PG8_LDB(B0, 1, 0); PG8_LDB(B1, 1, 1); PG8_SCHED; PG8_LDA(At, 1, 0); PG8_STAGE(PG8_SA(0, 1), a2 + hstep, voffA);
            PG8_WAIT_V(8); PG8_WAIT_L(0); PG8_BAR; PG8_MMA(0, 0, At, B0); PG8_MMA(0, 1, At, B1); PG8_BAR; PG8_SCHED;
            PG8_LDA(At, 1, 1); PG8_STAGE(PG8_SB(1, 0), b3, voffB); PG8_STAGE(PG8_SB(1, 1), b3 + hstep, voffB); PG8_STAGE(PG8_SA(1, 0), a3, voffA);
            PG8_WAIT_V(8); PG8_WAIT_L(0); PG8_BAR; PG8_MMA(1, 0, At, B0); PG8_MMA(1, 1, At, B1); PG8_BAR; PG8_SCHED;
            } else {
            PG8_LDB(B0, 0, 0); PG8_SCHED; PG8_LDA(At, 0, 0); PG8_STAGE(PG8_SA(1, 1), a1 + hstep, voffA);
            PG8_WAIT_L(8); PG8_BAR; PG8_WAIT_L(0); PG8_MMA(0, 0, At, B0); PG8_BAR; PG8_SCHED;
            PG8_LDB(B1, 0, 1); PG8_STAGE(PG8_SB(0, 0), b2, voffB);
            PG8_BAR; PG8_WAIT_L(0); PG8_MMA(0, 1, At, B1); PG8_BAR;
            PG8_LDA(At, 0, 1); PG8_STAGE(PG8_SA(0, 0), a2, voffA);
            PG8_BAR; PG8_WAIT_L(0); PG8_MMA(1, 0, At, B0); PG8_BAR; PG8_SCHED;
            PG8_STAGE(PG8_SB(0, 1), b2 + hstep, voffB);
            PG8_WAIT_V(6); PG8_BAR; PG8_MMA(1, 1, At, B1); PG8_BAR;
            PG8_LDB(B0, 1, 0); PG8_SCHED; PG8_LDA(At, 1, 0); PG8_STAGE(PG8_SA(0, 1), a2 + hstep, voffA);
            PG8_WAIT_L(8); PG8_BAR; PG8_WAIT_L(0); PG8_MMA(0, 0, At, B0); PG8_BAR; PG8_SCHED;
            PG8_LDB(B1, 1, 1); PG8_STAGE(PG8_SB(1, 0), b3, voffB);
            PG8_BAR; PG8_WAIT_L(0); PG8_MMA(0, 1, At, B1); PG8_BAR;
            PG8_LDA(At, 1, 1); PG8_STAGE(PG8_SA(1, 0), a3, voffA);
            PG8_BAR; PG8_WAIT_L(0); PG8_MMA(1, 0, At, B0); PG8_BAR; PG8_SCHED;
            PG8_STAGE(PG8_SB(1, 1), b3 + hstep, voffB);
            PG8_WAIT_V(6); PG8_BAR; PG8_MMA(1, 1, At, B1); PG8_BAR;
            }
        }
        if constexpr (ALIGN_EPI) { if (wr == 0) PG8_BAR; }
        if constexpr (!Epi::AFTER_DRAIN) { E(acc, cur, wr, wc, fr, fq); S.done(cur); }
        if (!has_next) break;
#pragma unroll
        for (int a = 0; a < 2; ++a)
#pragma unroll
            for (int b = 0; b < 2; ++b)
#pragma unroll
                for (int m = 0; m < 4; ++m)
#pragma unroll
                    for (int n = 0; n < 2; ++n) acc[a][b][m][n] = (f32x4){0.f, 0.f, 0.f, 0.f};
        cur = nxt; cA = nA; cB = nB; ++ui;
        if constexpr (ALIGN_EPI) { if (wr == 1) PG8_BAR; }
    }
    PG8_WAIT_V(0);
    if constexpr (!ALIGN_EPI) { if (wr == 0) PG8_BAR; }
    PG8_BAR;
    if constexpr (Epi::AFTER_DRAIN) { E.fused(acc, cur, wr, wc, fr, fq, lds, wid, lane); S.done(cur); }
#undef PG8_SA
#undef PG8_SB
#undef PG8_STAGE
#undef PG8_LDA
#undef PG8_LDB
#undef PG8_MMA
#undef PG8_WAIT_V
#undef PG8_WAIT_L
#undef PG8_BAR
#undef PG8_SCHED
}
}

constexpr int NWAVES = 8;
constexpr int BATCH = 4, SEQ = 2048, DM = 2048, MTOK = BATCH * SEQ, SSMW = 1024, ATTW = 1024, NGRP = 64, NST = 64, NHEAD = 8, HDIM = 128, DFF = 5632, PROJW = 4096, NMODW = 6 * DM;
constexpr int KSPLIT = 32;
constexpr size_t MiB = 1u << 20;
constexpr size_t WS_MODP = 2 * MiB, WS_MODF = 8 * MiB, WS_ROPE = 9 * MiB, WS_KTAB = 13 * MiB, WS_GTAB = 16 * MiB, WS_HTAB = 32 * MiB, WS_A64 = 48 * MiB;
constexpr size_t WS_WIN = 49 * MiB, WS_WGLU = 65 * MiB, WS_WOUT = 67 * MiB, WS_WGU = 75 * MiB, WS_WDN = 119 * MiB, WS_H = 141 * MiB, WS_PROJ = 173 * MiB, WS_VG = 237 * MiB;
constexpr size_t WS_YCAT = 253 * MiB, WS_OBR = 285 * MiB, WS_LSE = 333 * MiB, WS_FF = 173 * MiB, WS_END = 334 * MiB;
static_assert(WS_FF + (size_t)MTOK * DFF * 2 <= WS_OBR, "ff overlay");
constexpr int LDS_BYTES = 147456, MISC_OFF = 147456 - 256;
constexpr size_t WS_CTL = 0, CTL_ZERO_BYTES = 32768, WS_CNT = 16384;

#define GAS __attribute__((address_space(1)))
#define LAS __attribute__((address_space(3)))
typedef unsigned short bf16;
typedef unsigned v4u __attribute__((ext_vector_type(4)));
typedef unsigned v2u __attribute__((ext_vector_type(2)));
typedef float f32x4 __attribute__((ext_vector_type(4)));
typedef float f32x16 __attribute__((ext_vector_type(16)));
typedef short bf16x8 __attribute__((ext_vector_type(8)));
typedef short s16x4 __attribute__((ext_vector_type(4)));
#define LDS_WAIT() asm volatile("s_waitcnt lgkmcnt(0)" ::: "memory")
__device__ __forceinline__ unsigned f2bf(float f) { unsigned u = __builtin_bit_cast(unsigned, f); return (u + 0x7fffu + ((u >> 16) & 1u)) >> 16; }
__device__ __forceinline__ unsigned pk2(float lo, float hi) { return f2bf(lo) | (f2bf(hi) << 16); }
__device__ __forceinline__ float bf_lo(unsigned w) { return __uint_as_float(w << 16); }
__device__ __forceinline__ float bf_hi(unsigned w) { return __uint_as_float(w & 0xffff0000u); }
__device__ __forceinline__ float wave_sum(float v) {
#pragma unroll
    for (int o = 1; o < 64; o <<= 1) v += __shfl_xor(v, o);
    return v;
}

struct Args { const float* in[25]; float* out; unsigned char* ws; int ph_lo, ph_hi; };

template <int MODE>
__device__ __forceinline__ void p0_transpose_item(const float* __restrict__ W, int K, int N, bf16* WT, LAS float* scr, int item, int lane, const float* gs, const float* ga) {
    const int nblk = N / 64, kb = item / nblk, nb = item % nblk, k0 = 64 * kb, n0 = 64 * nb;
    const int lr = lane >> 4, lc = lane & 15;
    f32x4 v[16];
#pragma unroll
    for (int i = 0; i < 16; ++i) v[i] = __builtin_nontemporal_load((const f32x4*)(W + (size_t)(k0 + 4 * i + lr) * N + n0 + 4 * lc));
#pragma unroll
    for (int i = 0; i < 16; ++i) { const int kk = 4 * i + lr; f32x4 t = v[i];
        if (MODE == 4) { const int k = k0 + kk; t = t * ((k < SSMW) ? gs[k] : ga[k - SSMW]); }
        LAS float* d = scr + kk * 65 + 4 * lc; d[0] = t.x; d[1] = t.y; d[2] = t.z; d[3] = t.w; }
    LDS_WAIT(); asm volatile("" ::: "memory");
    const int c = lane & 7;
#pragma unroll
    for (int j = 0; j < 8; ++j) { const int n = (lane >> 3) + 8 * j; const LAS float* s = scr + (8 * c) * 65 + n;
        v4u o; o.x = pk2(s[0 * 65], s[1 * 65]); o.y = pk2(s[2 * 65], s[3 * 65]); o.z = pk2(s[4 * 65], s[5 * 65]); o.w = pk2(s[6 * 65], s[7 * 65]);
        int col = n0 + n, row = col;
        if (MODE == 1) { if (col >= 1024 && col < 3072) { const int e = col & 127, half = e >> 6, ep = e & 63; row = (col - e) + ((ep >> 2) << 3) + (half << 2) + (ep & 3); } }
        if (MODE == 2) row = (col >> 7) * 256 + (col & 127);
        if (MODE == 3) row = (col >> 7) * 256 + 128 + (col & 127);
        *(GAS v4u*)(WT + (size_t)row * K + k0 + 8 * c) = o; }
    LDS_WAIT(); asm volatile("" ::: "memory");
}
__device__ __forceinline__ void p0_gemv_item(const float* __restrict__ cvec, const float* __restrict__ wmod, float* modp, float* modf, const float* __restrict__ bmod, unsigned* cnt, LAS float* scr, int item, int lane) {
    const int ks = item / 48, cb = item % 48, k0 = ks * 64, col = cb * 256 + lane * 4;
#pragma unroll
    for (int b = 0; b < 4; ++b) { const float v = cvec[b * DM + k0 + lane]; scr[lane * 4 + b] = v / (1.0f + __expf(-v)); }
    LDS_WAIT(); asm volatile("" ::: "memory");
    f32x4 a0 = {0, 0, 0, 0}, a1 = a0, a2 = a0, a3 = a0;
#pragma unroll 16
    for (int k = 0; k < 64; ++k) { const f32x4 w = __builtin_nontemporal_load((const f32x4*)(wmod + (size_t)(k0 + k) * NMODW + col)); const f32x4 s = *(const LAS f32x4*)(scr + 4 * k);
        a0 += w * s[0]; a1 += w * s[1]; a2 += w * s[2]; a3 += w * s[3]; }
    float* o = modp + (size_t)(ks * 4) * NMODW + col;
    *(f32x4*)(o) = a0; *(f32x4*)(o + NMODW) = a1; *(f32x4*)(o + 2 * NMODW) = a2; *(f32x4*)(o + 3 * NMODW) = a3;
    LDS_WAIT(); asm volatile("" ::: "memory");
    __threadfence();
    unsigned old = 0u; if (lane == 0) old = atomicAdd(cnt + 64 * cb, 1u);
    old = (unsigned)__builtin_amdgcn_readfirstlane((int)old);
    if (old == (unsigned)(KSPLIT - 1)) {
        __threadfence();
        const f32x4 bv = *(const f32x4*)(bmod + col); f32x4 s0 = bv, s1 = bv, s2 = bv, s3 = bv;
#pragma unroll 4
        for (int k2 = 0; k2 < KSPLIT; ++k2) { const float* pp = modp + (size_t)(k2 * 4) * NMODW + col;
            s0 += __builtin_nontemporal_load((const f32x4*)pp); s1 += __builtin_nontemporal_load((const f32x4*)(pp + NMODW)); s2 += __builtin_nontemporal_load((const f32x4*)(pp + 2 * NMODW)); s3 += __builtin_nontemporal_load((const f32x4*)(pp + 3 * NMODW)); }
        *(f32x4*)(modf + col) = s0; *(f32x4*)(modf + NMODW + col) = s1; *(f32x4*)(modf + 2 * NMODW + col) = s2; *(f32x4*)(modf + 3 * NMODW + col) = s3;
    }
}
__device__ __forceinline__ void p0_rope_item(const int* __restrict__ pos, float* cosT, float* sinT, int item, int lane) {
    const double inv = exp(-(double)lane * (9.210340371976184 / 64.0));
    const double ang = (double)pos[item] * inv;
    cosT[(size_t)item * 64 + lane] = (float)cos(ang); sinT[(size_t)item * 64 + lane] = (float)sin(ang);
}
struct SsmLane { double xr, xi; };
__device__ __forceinline__ SsmLane ssm_lane(const float* are, const float* aim, const float* ldt, int g, int p) {
    const double dt = exp((double)ldt[g]); SsmLane L; L.xr = (double)are[g * 64 + p] * dt; L.xi = (double)aim[g * 64 + p] * dt; return L; }
__device__ __forceinline__ void ssm_pow(const SsmLane& L, int n, float& zr, float& zi) { const double m = exp(L.xr * n), th = L.xi * n; zr = (float)(m * cos(th)); zi = (float)(m * sin(th)); }
__device__ __forceinline__ void ssm_bbar(const float* are, const float* aim, const float* ldt, const float* bre, const float* bim, int g, int p, float (&br)[16], float (&bi)[16]) {
    const double dt = exp((double)ldt[g]), ar = are[g * 64 + p], ai = aim[g * 64 + p];
    const double m = exp(ar * dt), nr = m * cos(ai * dt) - 1.0, ni = m * sin(ai * dt), den = ar * ar + ai * ai;
    const float fr = (float)((nr * ar + ni * ai) / den), fi = (float)((ni * ar - nr * ai) / den);
    const f32x4* pr = (const f32x4*)(bre + (size_t)(g * 64 + p) * 16); const f32x4* pi = (const f32x4*)(bim + (size_t)(g * 64 + p) * 16);
#pragma unroll
    for (int q = 0; q < 4; ++q) { const f32x4 r = pr[q], i = pi[q];
#pragma unroll
        for (int e = 0; e < 4; ++e) { br[4 * q + e] = fr * r[e] - fi * i[e]; bi[4 * q + e] = fr * i[e] + fi * r[e]; } }
}
__device__ __forceinline__ void p0_ktab_item(const float* const* in, bf16* ktab, float* a64, LAS float* scr, int g, int ti, int lane) {
    if (ti == 0) { const SsmLane L = ssm_lane(in[7], in[8], in[9], g, lane); float zr, zi; ssm_pow(L, 64, zr, zi); a64[(g * 64 + lane) * 2] = zr; a64[(g * 64 + lane) * 2 + 1] = zi;
        *(GAS v2u*)(ktab + (size_t)(g * 65) * 256 + lane * 4) = (v2u){0u, 0u}; return; }
    { const SsmLane L = ssm_lane(in[7], in[8], in[9], g, lane); float zr, zi; ssm_pow(L, ti - 1, zr, zi);
      float br[16], bi[16]; ssm_bbar(in[7], in[8], in[9], in[10], in[11], g, lane, br, bi);
#pragma unroll
      for (int c = 0; c < 16; ++c) { scr[lane * 16 + c] = zr * br[c] - zi * bi[c]; scr[1024 + lane * 16 + c] = zr * bi[c] + zi * br[c]; } }
    LDS_WAIT(); asm volatile("" ::: "memory");
    const int c = lane >> 2, q = lane & 3; const float* cr = in[12] + (size_t)(g * 16 + c) * 64; const float* ci = in[13] + (size_t)(g * 16 + c) * 64;
    f32x4 acc = {0, 0, 0, 0};
#pragma unroll 8
    for (int p = 0; p < 64; ++p) { const f32x4 wr = *(const LAS f32x4*)(scr + p * 16 + 4 * q), wi = *(const LAS f32x4*)(scr + 1024 + p * 16 + 4 * q); acc += wr * cr[p] - wi * ci[p]; }
    *(GAS v2u*)(ktab + ((size_t)(g * 65 + ti) * 16 + c) * 16 + 4 * q) = (v2u){pk2(acc[0], acc[1]), pk2(acc[2], acc[3])};
    LDS_WAIT(); asm volatile("" ::: "memory");
}
__device__ __forceinline__ void p0_gtab_item(const float* const* in, bf16* gtab, int g, int t, int lane) {
    const SsmLane L = ssm_lane(in[7], in[8], in[9], g, lane); float zr, zi; ssm_pow(L, t + 1, zr, zi);
    const int p = lane;
#pragma unroll
    for (int c = 0; c < 16; ++c) { const float cr = in[12][(size_t)(g * 16 + c) * 64 + p], ci = in[13][(size_t)(g * 16 + c) * 64 + p];
        const float gre = cr * zr - ci * zi, gni = -(cr * zi + ci * zr);
        const size_t base = ((size_t)(g * 32 + (t >> 1)) * 8) * 512;
        { const int pp = p;      gtab[base + (size_t)(pp >> 4) * 512 + ((16 * (t & 1) + c) + 32 * ((pp >> 3) & 1)) * 8 + (pp & 7)] = (bf16)f2bf(gre); }
        { const int pp = p + 64; gtab[base + (size_t)(pp >> 4) * 512 + ((16 * (t & 1) + c) + 32 * ((pp >> 3) & 1)) * 8 + (pp & 7)] = (bf16)f2bf(gni); } }
}
__device__ __forceinline__ void p0_htab_item(const float* const* in, bf16* htab, int g, int s, int lane) {
    const SsmLane L = ssm_lane(in[7], in[8], in[9], g, lane); float zr, zi; ssm_pow(L, 63 - s, zr, zi);
    float br[16], bi[16]; ssm_bbar(in[7], in[8], in[9], in[10], in[11], g, lane, br, bi);
    float hr[16], hi[16];
#pragma unroll
    for (int c = 0; c < 16; ++c) { hr[c] = zr * br[c] - zi * bi[c]; hi[c] = zr * bi[c] + zi * br[c]; }
#pragma unroll
    for (int part = 0; part < 2; ++part) { const int pp = lane + 64 * part;
#pragma unroll
        for (int hh = 0; hh < 2; ++hh) { const float* v = part ? hi : hr; v4u o; o.x = pk2(v[8 * hh], v[8 * hh + 1]); o.y = pk2(v[8 * hh + 2], v[8 * hh + 3]); o.z = pk2(v[8 * hh + 4], v[8 * hh + 5]); o.w = pk2(v[8 * hh + 6], v[8 * hh + 7]);
            *(GAS v4u*)(htab + ((((size_t)(g * 4 + (pp >> 5)) * 64 + s) * 64) + (pp & 31) + 32 * hh) * 8) = o; } }
}
#define XB_TMO      128
#define XB_XCNT(j)  (256  + 64 * (j))
#define XB_XSUB(j)  (1280 + 64 * (j))
#define XB_XGEN(j)  (2304 + 64 * (j))
#define XB_TOP      3328
#define XB_TOPGEN   3392
#define XCD_BAR_WORDS 3456
#define XB_SPIN_CAP (1u << 18)

__device__ __forceinline__ unsigned xb_ld(unsigned* p)              { return __hip_atomic_load(p, __ATOMIC_RELAXED, __HIP_MEMORY_SCOPE_AGENT); }
__device__ __forceinline__ unsigned xb_add(unsigned* p, unsigned v) { return __hip_atomic_fetch_add(p, v, __ATOMIC_RELAXED, __HIP_MEMORY_SCOPE_AGENT); }
__device__ __forceinline__ unsigned xb_xcc_id() { return (unsigned)__builtin_amdgcn_s_getreg((3 << 11) | 20) & 0xFu; }
#define XB_SPIN(cond, bar) do { unsigned _sp = 0; while (cond) { __builtin_amdgcn_s_sleep(1); \
    if ((++_sp & 255u) == 0u) { if (xb_ld(&(bar)[XB_TMO])) break; if (_sp > XB_SPIN_CAP) { atomicAdd(&(bar)[XB_TMO], 1u); break; } } } } while (0)

struct XcdBarrier {
    unsigned* bar; unsigned x;
    volatile LAS unsigned* st;
};

__device__ __forceinline__ XcdBarrier xcd_barrier_post(unsigned* bar, volatile LAS unsigned* st) {
    XcdBarrier b; b.bar = bar; b.x = xb_xcc_id(); b.st = st;
    if (threadIdx.x == 0) (void)xb_add(&bar[XB_XCNT(b.x)], 1u);
    return b;
}
__device__ __forceinline__ void xcd_barrier_complete(unsigned* bar, unsigned x, unsigned& nloc, unsigned& nx) {
    const unsigned G = gridDim.x * gridDim.y * gridDim.z;
    unsigned sum, cnt, mine, sp = 0u;
    for (;;) {
        sum = 0u; cnt = 0u; mine = 0u;
#pragma unroll
        for (unsigned j = 0; j < 16; ++j) { const unsigned c = xb_ld(&bar[XB_XCNT(j)]); sum += c; cnt += (c > 0u) ? 1u : 0u; mine = (j == x) ? c : mine; }
        if (sum == G) break;
        __builtin_amdgcn_s_sleep(1);
        if ((++sp & 255u) == 0u) { if (xb_ld(&bar[XB_TMO])) break; if (sp > XB_SPIN_CAP) { atomicAdd(&bar[XB_TMO], 1u); break; } }
    }
    nloc = mine > 0u ? mine : 1u; nx = cnt > 0u ? cnt : 1u;
}

__device__ __forceinline__ void xcd_barrier(const XcdBarrier& b) {
    asm volatile("s_waitcnt vmcnt(0)" ::: "memory");
    __syncthreads();
    if (threadIdx.x == 0) {
        unsigned* bar = b.bar;
        __builtin_amdgcn_s_waitcnt(0);
        unsigned nloc = b.st[0], nx = b.st[1];
        if (nloc == 0u) { xcd_barrier_complete(bar, b.x, nloc, nx); b.st[0] = nloc; b.st[1] = nx; }
        const unsigned old = xb_add(&bar[XB_XSUB(b.x)], 1u);
        const unsigned gen = old / nloc;
        if (old + 1u == (gen + 1u) * nloc) {
            __builtin_amdgcn_fence(__ATOMIC_RELEASE, "agent");
            asm volatile("s_waitcnt vmcnt(0)" ::: "memory");
            const unsigned og = xb_add(&bar[XB_TOP], 1u);
            const unsigned tg = og / nx;
            if (og + 1u == (tg + 1u) * nx) xb_add(&bar[XB_TOPGEN], 1u);
            else XB_SPIN(xb_ld(&bar[XB_TOPGEN]) == tg, bar);
            __builtin_amdgcn_fence(__ATOMIC_ACQUIRE, "agent");
            xb_add(&bar[XB_XGEN(b.x)], 1u);
            asm volatile("s_waitcnt vmcnt(0)" ::: "memory");
        } else {
            XB_SPIN(xb_ld(&bar[XB_XGEN(b.x)]) == gen, bar);
            __builtin_amdgcn_fence(__ATOMIC_ACQUIRE, "agent");
            asm volatile("s_waitcnt vmcnt(0)" ::: "memory");
        }
    }
    __syncthreads();
}

template <bool FROMP>
__device__ __forceinline__ void modnorm_phase(LAS unsigned char* lds, const float* xin, bf16* hout, const float* gvec, const float* modp, const float* bmod, const float* modf, int jsh, int jsc, int tid, int lane, int wave) {
    LAS float* TA = (LAS float*)lds; LAS float* TS = TA + DM;
    const int b = (blockIdx.x * 32) / SEQ;
    for (int k = tid; k < DM; k += NWAVES * 64) {
        float sh, sc;
        if (FROMP) { sh = bmod[jsh * DM + k]; sc = bmod[jsc * DM + k];
            for (int ks = 0; ks < KSPLIT; ++ks) { sh += modp[(size_t)(ks * 4 + b) * NMODW + jsh * DM + k]; sc += modp[(size_t)(ks * 4 + b) * NMODW + jsc * DM + k]; } }
        else { sh = modf[(size_t)b * NMODW + jsh * DM + k]; sc = modf[(size_t)b * NMODW + jsc * DM + k]; }
        TA[k] = gvec[k] * (1.0f + sc); TS[k] = sh; }
    __syncthreads();
    for (int r = 0; r < 4; ++r) { const int row = blockIdx.x * 32 + wave * 4 + r;
        const f32x4* xr = (const f32x4*)(xin + (size_t)row * DM) + lane;
        f32x4 v[8]; float s = 0.f;
#pragma unroll
        for (int j = 0; j < 8; ++j) { v[j] = xr[64 * j]; s += (v[j].x * v[j].x + v[j].y * v[j].y) + (v[j].z * v[j].z + v[j].w * v[j].w); }
        const float rstd = 1.0f / sqrtf(wave_sum(s) * (1.0f / DM) + 1e-6f);
        GAS v2u* o8 = (GAS v2u*)(hout + (size_t)row * DM) + lane;
#pragma unroll
        for (int j = 0; j < 8; ++j) { const f32x4 a = *(const LAS f32x4*)(TA + 4 * (lane + 64 * j)), sft = *(const LAS f32x4*)(TS + 4 * (lane + 64 * j));
            const f32x4 o = v[j] * rstd * a + sft; o8[64 * j] = (v2u){pk2(o.x, o.y), pk2(o.z, o.w)}; } }
    __syncthreads();
}

constexpr int SS_UST = 2064;
constexpr int SS_U = 0, SS_K = 32 * SS_UST, SS_E = SS_K + 65 * 512, SS_C = SS_E + 2 * 128 * 33 * 4, SS_CST = 272, SS_END = SS_C + 32 * SS_CST;
static_assert(SS_END <= 147456 - 1024, "ssm LDS");
__device__ __forceinline__ float gelu_tanh(float v) { const float t = 0.7978845608028654f * (v + 0.044715f * v * v * v); const float e = __builtin_amdgcn_exp2f(-2.885390081777927f * t); return v * __builtin_amdgcn_rcpf(1.0f + e); }
__device__ __forceinline__ void ssm_unit(LAS unsigned char* lds, int b, int g, const bf16* proj, const bf16* ktab, const bf16* gtab, const bf16* htab, const float* a64, const float* dskip, bf16* vg, int tid, int lane, int wave) {
    for (int i = tid; i < 4096; i += NWAVES * 64) { const int t = i >> 1, hf = i & 1;
        const v4u v = *(const GAS v4u*)(proj + ((size_t)(b * SEQ + t) * PROJW + 16 * g + 8 * hf));
        *(LAS v4u*)(lds + SS_U + (t >> 6) * SS_UST + (t & 63) * 32 + hf * 16) = v; }
    for (int i = tid; i < 2080; i += NWAVES * 64) *(LAS v4u*)(lds + SS_K + i * 16) = *(const GAS v4u*)(ktab + (size_t)g * 65 * 256 + i * 8);
    __syncthreads();
    const int n = lane & 31, h = lane >> 5;
    { const int mt = wave & 3, kh = wave >> 2; f32x16 acc;
#pragma unroll
      for (int i = 0; i < 16; ++i) acc[i] = 0.f;
      const bf16* hp = htab + (((size_t)(g * 4 + mt) * 64 + kh * 32) * 64 + lane) * 8;
#pragma unroll 4
      for (int s = 0; s < 32; ++s) { const bf16x8 a = *(const GAS bf16x8*)(hp + (size_t)s * 512);
          const bf16x8 bb = *(const LAS bf16x8*)(lds + SS_U + n * SS_UST + (kh * 32 + s) * 32 + h * 16);
          acc = __builtin_amdgcn_mfma_f32_32x32x16_bf16(a, bb, acc, 0, 0, 0); }
      LAS float* E = (LAS float*)(lds + SS_E) + kh * 128 * 33;
#pragma unroll
      for (int r = 0; r < 16; ++r) E[(32 * mt + (r & 3) + 8 * (r >> 2) + 4 * h) * 33 + n] = acc[r]; }
    __syncthreads();
    if (tid < 64) { const int p = tid; const float ar = a64[(g * 64 + p) * 2], ai = a64[(g * 64 + p) * 2 + 1]; float cr = 0.f, ci = 0.f;
        const LAS float* E0 = (const LAS float*)(lds + SS_E); const LAS float* E1 = E0 + 128 * 33;
        for (int j = 0; j < 32; ++j) { *(LAS bf16*)(lds + SS_C + j * SS_CST + p * 2) = (bf16)f2bf(cr); *(LAS bf16*)(lds + SS_C + j * SS_CST + (64 + p) * 2) = (bf16)f2bf(ci);
            const float er = E0[p * 33 + j] + E1[p * 33 + j], ei = E0[(64 + p) * 33 + j] + E1[(64 + p) * 33 + j];
            const float nr = ar * cr - ai * ci + er, ni = ar * ci + ai * cr + ei; cr = nr; ci = ni; } }
    __syncthreads();
    for (int q = 0; q < 4; ++q) { const int mt = (q == 0) ? wave : (q == 1) ? 15 - wave : (q == 2) ? 16 + wave : 31 - wave;
        f32x16 acc;
#pragma unroll
        for (int i = 0; i < 16; ++i) acc[i] = 0.f;
        const int t_l = 2 * mt + (n >> 4), c_l = n & 15;
        const int abase = SS_K + ((t_l + 1) * 16 + c_l) * 32 + h * 16;
        const int bbase = SS_U + n * SS_UST + h * 16;
        const int ns = 2 * mt + 2;
        for (int s = 0; s < ns; ++s) { const bf16x8 a = *(const LAS bf16x8*)(lds + abase - s * 512); const bf16x8 bb = *(const LAS bf16x8*)(lds + bbase + s * 32);
            acc = __builtin_amdgcn_mfma_f32_32x32x16_bf16(a, bb, acc, 0, 0, 0); }
        const bf16* gp = gtab + (((size_t)(g * 32 + mt) * 8) * 64 + lane) * 8;
#pragma unroll
        for (int ks = 0; ks < 8; ++ks) { const bf16x8 a = *(const GAS bf16x8*)(gp + (size_t)ks * 512); const bf16x8 bb = *(const LAS bf16x8*)(lds + SS_C + n * SS_CST + (16 * ks + 8 * h) * 2);
            acc = __builtin_amdgcn_mfma_f32_32x32x16_bf16(a, bb, acc, 0, 0, 0); }
#pragma unroll
        for (int q4 = 0; q4 < 4; ++q4) { const int t = 2 * mt + (q4 >> 1), c0 = 8 * (q4 & 1) + 4 * h;
            const v2u uu = *(const LAS v2u*)(lds + SS_U + n * SS_UST + t * 32 + c0 * 2);
            const f32x4 dv = *(const f32x4*)(dskip + 16 * g + c0);
            const float y0 = acc[4 * q4 + 0] + dv[0] * bf_lo(uu.x), y1 = acc[4 * q4 + 1] + dv[1] * bf_hi(uu.x), y2 = acc[4 * q4 + 2] + dv[2] * bf_lo(uu.y), y3 = acc[4 * q4 + 3] + dv[3] * bf_hi(uu.y);
            *(GAS v2u*)(vg + (size_t)(b * SEQ + 64 * n + t) * SSMW + 16 * g + c0) = (v2u){pk2(gelu_tanh(y0), gelu_tanh(y1)), pk2(gelu_tanh(y2), gelu_tanh(y3))}; } }
    __syncthreads();
}

constexpr int AT_K = 0, AT_V = 272 * 256, AT_END = 2 * 272 * 256;
static_assert(AT_END <= 147456 - 1024, "attn LDS");
__device__ __forceinline__ unsigned off_b(unsigned row, unsigned ch) { return 256u * row + 16u * (ch ^ (((row & 3) << 2) | ((row >> 2) & 3))); }
typedef short v4i16_t __attribute__((ext_vector_type(4)));
__device__ __forceinline__ s16x4 tr_read(LAS unsigned char* p) { return __builtin_bit_cast(s16x4, __builtin_amdgcn_ds_read_tr16_b64_v4i16((LAS v4i16_t*)p)); }
__device__ __forceinline__ void attn_unit(LAS unsigned char* lds, int b, int hd, int di, int dil, int res, int blk, const bf16* proj, bf16* obr, float* lse, int tid, int lane, int wave) {
    const size_t rowb = (size_t)b * SEQ;
    for (int it = 0; it < 8; ++it) { const int idx = tid + 512 * it, row = idx >> 4, ch = idx & 15; const int sub = 128 * blk - 128 + row;
        v4u kv = (v4u){0u, 0u, 0u, 0u}, vv = kv;
        if (sub >= 0) { const bf16* src = proj + (rowb + res + dil * sub) * PROJW + 2048 + hd * HDIM + ch * 8; kv = *(const GAS v4u*)src; vv = *(const GAS v4u*)(src + 1024); }
        *(LAS v4u*)(lds + AT_K + off_b(row, ch)) = kv; *(LAS v4u*)(lds + AT_V + off_b(row, ch)) = vv; }
    if (tid < 256) { const int row = 256 + (tid >> 4), ch = tid & 15; *(LAS v4u*)(lds + AT_K + off_b(row, ch)) = (v4u){0u, 0u, 0u, 0u}; *(LAS v4u*)(lds + AT_V + off_b(row, ch)) = (v4u){0u, 0u, 0u, 0u}; }
    const int qn = lane & 15, g = lane >> 4;
    const int qtok = res + dil * (128 * blk + 16 * wave + qn);
    bf16x8 qf[4];
#pragma unroll
    for (int s = 0; s < 4; ++s) qf[s] = *(const GAS bf16x8*)(proj + (rowb + qtok) * PROJW + 1024 + hd * HDIM + 32 * s + 8 * g);
    __syncthreads();
    f32x4 sc[10];
#pragma unroll
    for (int kt = 0; kt < 10; ++kt) { f32x4 a = {0.f, 0.f, 0.f, 0.f};
#pragma unroll
        for (int s = 0; s < 4; ++s) { const bf16x8 kf = *(const LAS bf16x8*)(lds + AT_K + off_b(16 * (wave + kt) + qn, 4 * s + g));
            a = __builtin_amdgcn_mfma_f32_16x16x32_bf16(kf, qf[s], a, 0, 0, 0); }
        sc[kt] = a; }
    const bool first = (blk == 0);
    float mx = -1e30f;
#pragma unroll
    for (int kt = 0; kt < 10; ++kt)
#pragma unroll
        for (int r = 0; r < 4; ++r) { const int rel = 16 * kt + 4 * g + r; bool ok = (rel >= qn) && (rel <= qn + 128);
            if (first) ok = ok && (16 * (wave + kt) + 4 * g + r >= 128);
            sc[kt][r] = ok ? sc[kt][r] : -1e30f; mx = fmaxf(mx, sc[kt][r]); }
    mx = fmaxf(mx, __shfl_xor(mx, 16)); mx = fmaxf(mx, __shfl_xor(mx, 32));
    float ls = 0.f;
#pragma unroll
    for (int kt = 0; kt < 10; ++kt)
#pragma unroll
        for (int r = 0; r < 4; ++r) { const float p = (sc[kt][r] > -1e29f) ? __builtin_amdgcn_exp2f(sc[kt][r] - mx) : 0.f; sc[kt][r] = p; ls += p; }
    ls += __shfl_xor(ls, 16); ls += __shfl_xor(ls, 32);
    f32x4 o[8];
#pragma unroll
    for (int c = 0; c < 8; ++c) o[c] = (f32x4){0.f, 0.f, 0.f, 0.f};
    const int q4 = (lane & 15) >> 2, p4 = lane & 3;
#pragma unroll
    for (int ks = 0; ks < 5; ++ks) {
        union { unsigned u[4]; bf16x8 v; } pb;
        pb.u[0] = pk2(sc[2 * ks][0], sc[2 * ks][1]); pb.u[1] = pk2(sc[2 * ks][2], sc[2 * ks][3]); pb.u[2] = pk2(sc[2 * ks + 1][0], sc[2 * ks + 1][1]); pb.u[3] = pk2(sc[2 * ks + 1][2], sc[2 * ks + 1][3]);
#pragma unroll
        for (int c = 0; c < 8; ++c) {
            const unsigned r0 = 16 * wave + 32 * ks + 4 * g + q4;
            const s16x4 v0 = tr_read(lds + AT_V + off_b(r0, 2 * c + (p4 >> 1)) + 8 * (p4 & 1));
            const s16x4 v1 = tr_read(lds + AT_V + off_b(r0 + 16, 2 * c + (p4 >> 1)) + 8 * (p4 & 1));
            bf16x8 va; va[0] = v0[0]; va[1] = v0[1]; va[2] = v0[2]; va[3] = v0[3]; va[4] = v1[0]; va[5] = v1[1]; va[6] = v1[2]; va[7] = v1[3];
            o[c] = __builtin_amdgcn_mfma_f32_16x16x32_bf16(va, pb.v, o[c], 0, 0, 0); } }
    const float inv = 1.0f / ls;
    bf16* op = obr + (size_t)di * MTOK * ATTW + (rowb + qtok) * ATTW + hd * HDIM + 4 * g;
#pragma unroll
    for (int c = 0; c < 8; ++c) *(GAS v2u*)(op + 16 * c) = (v2u){pk2(o[c][0] * inv, o[c][1] * inv), pk2(o[c][2] * inv, o[c][3] * inv)};
    if (g == 0) lse[(size_t)di * MTOK * NHEAD + (rowb + qtok) * NHEAD + hd] = mx + __builtin_amdgcn_logf(ls);
    __syncthreads();
}

__device__ __forceinline__ void ynorm_phase(bf16* ycat, const bf16* obr, const float* lse, int lane, int wave) {
    for (int r = 0; r < 4; ++r) { const int row = blockIdx.x * 32 + wave * 4 + r;
        { bf16* p = ycat + (size_t)row * DM + lane * 16; const v4u a = *(const GAS v4u*)p, c = *(const GAS v4u*)(p + 8);
          float v[16] = {bf_lo(a.x), bf_hi(a.x), bf_lo(a.y), bf_hi(a.y), bf_lo(a.z), bf_hi(a.z), bf_lo(a.w), bf_hi(a.w), bf_lo(c.x), bf_hi(c.x), bf_lo(c.y), bf_hi(c.y), bf_lo(c.z), bf_hi(c.z), bf_lo(c.w), bf_hi(c.w)};
          float s = 0.f;
#pragma unroll
          for (int i = 0; i < 16; ++i) s += v[i] * v[i];
          const float rstd = 1.0f / sqrtf(wave_sum(s) * (1.0f / SSMW) + 1e-6f);
          *(GAS v4u*)p = (v4u){pk2(v[0] * rstd, v[1] * rstd), pk2(v[2] * rstd, v[3] * rstd), pk2(v[4] * rstd, v[5] * rstd), pk2(v[6] * rstd, v[7] * rstd)};
          *(GAS v4u*)(p + 8) = (v4u){pk2(v[8] * rstd, v[9] * rstd), pk2(v[10] * rstd, v[11] * rstd), pk2(v[12] * rstd, v[13] * rstd), pk2(v[14] * rstd, v[15] * rstd)}; }
        { const int hd = lane >> 3;
          const float l0 = lse[(size_t)row * NHEAD + hd], l1 = lse[(size_t)MTOK * NHEAD + (size_t)row * NHEAD + hd], l2 = lse[(size_t)2 * MTOK * NHEAD + (size_t)row * NHEAD + hd];
          const float lm = fmaxf(l0, fmaxf(l1, l2)); float w0 = __builtin_amdgcn_exp2f(l0 - lm), w1 = __builtin_amdgcn_exp2f(l1 - lm), w2 = __builtin_amdgcn_exp2f(l2 - lm);
          const float wi = 1.0f / (w0 + w1 + w2); w0 *= wi; w1 *= wi; w2 *= wi;
          float v[16];
#pragma unroll
          for (int i = 0; i < 16; ++i) v[i] = 0.f;
#pragma unroll
          for (int d = 0; d < 3; ++d) { const bf16* p = obr + (size_t)d * MTOK * ATTW + (size_t)row * ATTW + lane * 16; const v4u a = *(const GAS v4u*)p, c = *(const GAS v4u*)(p + 8); const float w = d == 0 ? w0 : d == 1 ? w1 : w2;
              v[0] += w * bf_lo(a.x); v[1] += w * bf_hi(a.x); v[2] += w * bf_lo(a.y); v[3] += w * bf_hi(a.y); v[4] += w * bf_lo(a.z); v[5] += w * bf_hi(a.z); v[6] += w * bf_lo(a.w); v[7] += w * bf_hi(a.w);
              v[8] += w * bf_lo(c.x); v[9] += w * bf_hi(c.x); v[10] += w * bf_lo(c.y); v[11] += w * bf_hi(c.y); v[12] += w * bf_lo(c.z); v[13] += w * bf_hi(c.z); v[14] += w * bf_lo(c.w); v[15] += w * bf_hi(c.w); }
          float s = 0.f;
#pragma unroll
          for (int i = 0; i < 16; ++i) s += v[i] * v[i];
          const float rstd = 1.0f / sqrtf(wave_sum(s) * (1.0f / ATTW) + 1e-6f);
          bf16* p = ycat + (size_t)row * DM + SSMW + lane * 16;
          *(GAS v4u*)p = (v4u){pk2(v[0] * rstd, v[1] * rstd), pk2(v[2] * rstd, v[3] * rstd), pk2(v[4] * rstd, v[5] * rstd), pk2(v[6] * rstd, v[7] * rstd)};
          *(GAS v4u*)(p + 8) = (v4u){pk2(v[8] * rstd, v[9] * rstd), pk2(v[10] * rstd, v[11] * rstd), pk2(v[12] * rstd, v[13] * rstd), pk2(v[14] * rstd, v[15] * rstd)}; } }
}
__device__ __forceinline__ void final_norm_phase(float* out, const float* gfin, int lane, int wave) {
    for (int r = 0; r < 4; ++r) { const int row = blockIdx.x * 32 + wave * 4 + r;
        f32x4* xr = (f32x4*)(out + (size_t)row * DM) + lane; f32x4 v[8]; float s = 0.f;
#pragma unroll
        for (int j = 0; j < 8; ++j) { v[j] = xr[64 * j]; s += (v[j].x * v[j].x + v[j].y * v[j].y) + (v[j].z * v[j].z + v[j].w * v[j].w); }
        const float rstd = 1.0f / sqrtf(wave_sum(s) * (1.0f / DM) + 1e-6f);
#pragma unroll
        for (int j = 0; j < 8; ++j) { const f32x4 gq = *((const f32x4*)gfin + lane + 64 * j); xr[64 * j] = v[j] * rstd * gq; } }
}

constexpr int NPH = 11;
constexpr int IT_GEMV = KSPLIT * 48, IT_SSM = NGRP * 193, IT_ROPE = MTOK, IT_WIN = (DM / 64) * (PROJW / 64), IT_WGLU = (SSMW / 64) * (SSMW / 64), IT_WOUT = (DM / 64) * (DM / 64),
              IT_WG = (DM / 64) * (DFF / 64), IT_WD = (DFF / 64) * (DM / 64), IT_TOTAL = IT_GEMV + IT_SSM + IT_ROPE + IT_WIN + IT_WGLU + IT_WOUT + 2 * IT_WG + IT_WD;
__global__ void __launch_bounds__(NWAVES * 64, 2) hymba_fwd(Args args) {
    extern __shared__ __attribute__((aligned(16))) unsigned char lds_raw[];
    LAS unsigned char* lds = (LAS unsigned char*)lds_raw;
    cg::grid_group grid = cg::this_grid();
    const int tid = threadIdx.x, lane = tid & 63, wave = __builtin_amdgcn_readfirstlane(tid >> 6);
    const int G = gridDim.x, bx = blockIdx.x;
    unsigned char* ws = args.ws;
    const float* const* in = args.in;
    float* modp = (float*)(ws + WS_MODP); float* modf = (float*)(ws + WS_MODF); float* cosT = (float*)(ws + WS_ROPE); float* sinT = cosT + (size_t)MTOK * 64;
    bf16* ktab = (bf16*)(ws + WS_KTAB); bf16* gtab = (bf16*)(ws + WS_GTAB); bf16* htab = (bf16*)(ws + WS_HTAB); float* a64 = (float*)(ws + WS_A64);
    bf16* Win = (bf16*)(ws + WS_WIN); bf16* Wglu = (bf16*)(ws + WS_WGLU); bf16* Wout = (bf16*)(ws + WS_WOUT); bf16* Wgu = (bf16*)(ws + WS_WGU); bf16* Wdn = (bf16*)(ws + WS_WDN);
    bf16* Hb = (bf16*)(ws + WS_H); bf16* proj = (bf16*)(ws + WS_PROJ); bf16* vg = (bf16*)(ws + WS_VG); bf16* ycat = (bf16*)(ws + WS_YCAT); bf16* obr = (bf16*)(ws + WS_OBR); float* lse = (float*)(ws + WS_LSE);
    bf16* ff = (bf16*)(ws + WS_FF);
    const int lo = args.ph_lo, hi = args.ph_hi;
#ifndef PHMASK
#define PHMASK 0x7ff
#endif
#define IN(k) (((PHMASK >> (k)) & 1) && lo <= (k) && (k) < hi)
    volatile LAS unsigned* MISC = (volatile LAS unsigned*)(lds + MISC_OFF);
    if (tid < 2) MISC[tid] = 0u;
    __syncthreads();
    if (args.ph_lo < 0) grid.sync();
    const XcdBarrier xbar = xcd_barrier_post((unsigned*)(ws + WS_CTL), MISC);
#define SEAM(k) do { if (IN(k) && IN((k) + 1)) xcd_barrier(xbar); } while (0)
#ifndef DOUBLE_MASK
#define DOUBLE_MASK 0
#endif
#define REPS(k) for (int rep_ = 0; rep_ < 1 + ((DOUBLE_MASK >> (k)) & 1); ++rep_)
#define RSYNC(k) do { if ((DOUBLE_MASK >> (k)) & 1) xcd_barrier(xbar); } while (0)

    REPS(0) if (IN(0)) {
        RSYNC(0);
        LAS float* scr = (LAS float*)(lds + wave * 16640);
        const int gw = wave * G + bx, NGW = G * NWAVES;
        for (int it = gw; it < IT_TOTAL; it += NGW) {
            int r = it;
            if (r < IT_GEMV) { p0_gemv_item(in[1], in[3], modp, modf, in[4], (unsigned*)(ws + WS_CNT), scr, r, lane); continue; } r -= IT_GEMV;
            if (r < IT_SSM) { const int g = r / 193, sub = r % 193;
                if (sub < 65) p0_ktab_item(in, ktab, a64, scr, g, sub, lane); else if (sub < 129) p0_gtab_item(in, gtab, g, sub - 65, lane); else p0_htab_item(in, htab, g, sub - 129, lane);
                continue; } r -= IT_SSM;
            if (r < IT_ROPE) { p0_rope_item((const int*)in[2], cosT, sinT, r, lane); continue; } r -= IT_ROPE;
            if (r < IT_WIN) { p0_transpose_item<1>(in[6], DM, PROJW, Win, scr, r, lane, nullptr, nullptr); continue; } r -= IT_WIN;
            if (r < IT_WGLU) { p0_transpose_item<0>(in[15], SSMW, SSMW, Wglu, scr, r, lane, nullptr, nullptr); continue; } r -= IT_WGLU;
            if (r < IT_WOUT) { p0_transpose_item<4>(in[19], DM, DM, Wout, scr, r, lane, in[17], in[18]); continue; } r -= IT_WOUT;
            if (r < IT_WG) { p0_transpose_item<2>(in[21], DM, DFF, Wgu, scr, r, lane, nullptr, nullptr); continue; } r -= IT_WG;
            if (r < IT_WG) { p0_transpose_item<3>(in[22], DM, DFF, Wgu, scr, r, lane, nullptr, nullptr); continue; } r -= IT_WG;
            p0_transpose_item<0>(in[23], DFF, DM, Wdn, scr, r, lane, nullptr, nullptr);
        }
        __syncthreads();
    }
    SEAM(0);
    REPS(1) if (IN(1)) {
        RSYNC(1);
        modnorm_phase<false>(lds, in[0], Hb, in[5], modp, in[4], modf, 0, 1, tid, lane, wave);
    }
    SEAM(1);
    if (IN(2)) {
        pg8::Gemm g{Hb, Win, MTOK, PROJW, DM}; pg8::StaticOrder S; S.init(MTOK, PROJW, G, bx);
        pg8::EpiProj E{proj, cosT, sinT, 0.08838834764831845f * 1.4426950408889634f};
        pg8::gemm_phase<pg8::EpiProj, pg8::StaticOrder, true, true>(lds, g, S, E);
    }
    SEAM(2);
    REPS(3) if (IN(3)) {
        RSYNC(3);
        int tid = threadIdx.x; asm volatile("" : "+v"(tid)); const int lane = tid & 63, wave = __builtin_amdgcn_readfirstlane(tid >> 6);
        for (int u = bx; u < BATCH * NGRP; u += G) ssm_unit(lds, u / NGRP, u % NGRP, proj, ktab, gtab, htab, a64, in[14], vg, tid, lane, wave);
        for (int u = bx; u < BATCH * NHEAD * 48; u += G) { const int bh = u / 48, w = u % 48; int di, dil, res, blk;
            if (w < 16) { di = 0; dil = 1; res = 0; blk = w; } else if (w < 32) { di = 1; dil = 4; res = (w - 16) >> 2; blk = (w - 16) & 3; } else { di = 2; dil = 16; res = w - 32; blk = 0; }
            attn_unit(lds, bh / NHEAD, bh % NHEAD, di, dil, res, blk, proj, obr, lse, tid, lane, wave); }
    }
    SEAM(3);
    if (IN(4)) {
        pg8::Gemm g{vg, Wglu, MTOK, SSMW, SSMW}; pg8::StaticOrder S; S.init(MTOK, SSMW, G, bx);
        pg8::EpiGlu E{ycat, vg, in[16]};
        pg8::gemm_phase<pg8::EpiGlu, pg8::StaticOrder, true, true>(lds, g, S, E);
    }
    SEAM(4);
    REPS(5) if (IN(5)) ynorm_phase(ycat, obr, lse, lane, wave);
    SEAM(5);
    if (IN(6)) {
        pg8::Gemm g{ycat, Wout, MTOK, DM, DM}; pg8::StaticOrder S; S.init(MTOK, DM, G, bx);
        pg8::EpiResid E{in[0], args.out, modf + 2 * DM};
        pg8::gemm_phase<pg8::EpiResid, pg8::StaticOrder, true, true>(lds, g, S, E);
    }
    SEAM(6);
    REPS(7) if (IN(7)) modnorm_phase<false>(lds, args.out, Hb, in[20], modp, in[4], modf, 3, 4, tid, lane, wave);
    SEAM(7);
    if (IN(8)) {
        pg8::Gemm g{Hb, Wgu, MTOK, 2 * DFF, DM}; pg8::StaticOrder S; S.init(MTOK, 2 * DFF, G, bx);
        pg8::EpiSwiglu E{ff};
        pg8::gemm_phase<pg8::EpiSwiglu, pg8::StaticOrder, true, true>(lds, g, S, E);
    }
    SEAM(8);
    if (IN(9)) {
        pg8::Gemm g{ff, Wdn, MTOK, DM, DFF}; pg8::StaticOrder S; S.init(MTOK, DM, G, bx);
        pg8::EpiResid E{args.out, args.out, modf + 5 * DM};
        pg8::gemm_phase<pg8::EpiResid, pg8::StaticOrder, true, true>(lds, g, S, E);
    }
    SEAM(9);
    if (IN(10)) final_norm_phase(args.out, in[24], lane, wave);
#undef IN
#undef SEAM
}

#ifndef MK_PER_PHASE
#define MK_PER_PHASE 0
#endif
extern "C" void kernel_launch(void* const* d_in, const int* in_sizes, int n_in, void* d_out, int out_size, void* d_ws, size_t ws_size, hipStream_t stream) {
    static int ready = 0;
    if (ready == 0) {
        ready = 1;
        if (n_in != 25 || out_size != MTOK * DM || ws_size < WS_END) { fprintf(stderr, "kernel_launch: unexpected shapes (n_in %d out %d ws %zu)\n", n_in, out_size, ws_size); ready = -1; }
        else if (hipFuncSetAttribute((const void*)hymba_fwd, hipFuncAttributeMaxDynamicSharedMemorySize, LDS_BYTES) != hipSuccess) { fprintf(stderr, "kernel_launch: hipFuncSetAttribute failed\n"); ready = -1; }
        else { int per_cu = 0; (void)hipOccupancyMaxActiveBlocksPerMultiprocessor(&per_cu, (const void*)hymba_fwd, NWAVES * 64, LDS_BYTES); (void)hipGetLastError();
               if (per_cu < 1) fprintf(stderr, "kernel_launch: occupancy query reports %d blocks per CU\n", per_cu); }
    }
    if (ready < 0) return;
    if (hipMemsetAsync((char*)d_ws + WS_CTL, 0, CTL_ZERO_BYTES, stream) != hipSuccess) { fprintf(stderr, "kernel_launch: memset failed\n"); return; }
    Args a{};
    for (int i = 0; i < 25; ++i) a.in[i] = (const float*)d_in[i];
    a.out = (float*)d_out; a.ws = (unsigned char*)d_ws;
#if MK_PER_PHASE
    for (int p = 0; p < NPH; ++p) { a.ph_lo = p; a.ph_hi = p + 1; hipLaunchKernelGGL(hymba_fwd, dim3(256), dim3(NWAVES * 64), LDS_BYTES, stream, a); }
#else
    a.ph_lo = 0; a.ph_hi = NPH;
    void* kargs[] = {&a};
    hipError_t e = hipLaunchCooperativeKernel((const void*)hymba_fwd, dim3(256), dim3(NWAVES * 64), kargs, LDS_BYTES, stream);
    if (e != hipSuccess) fprintf(stderr, "kernel_launch: cooperative launch failed: %s\n", hipGetErrorString(e));
#endif
}
```

```cpp
#include <hip/hip_runtime.h>
#include <hip/hip_cooperative_groups.h>
#include <cstdio>
#include <cstdint>
namespace cg = cooperative_groups;
namespace pg8 {
#define PG8_LAS __attribute__((address_space(3)))
typedef unsigned short bf16_t;
typedef short bf16x8 __attribute__((ext_vector_type(8)));
typedef float f32x4 __attribute__((ext_vector_type(4)));
typedef unsigned u32x4 __attribute__((ext_vector_type(4)));
constexpr int BM = 256, BK = 64, HALF = 128, HTB = HALF * BK * 2  , STAGE_BYTES = 8 * HTB, NXCD = 8, WGM = 8;

__host__ __device__ __forceinline__ int lds_byte(int r, int c) { const int st = (r >> 4) * 2 + (c >> 5), rr = r & 15, cc = c & 31, ob = rr * 64 + cc * 2; return st * 1024 + (ob ^ (((ob >> 9) & 1) << 5)); }
__host__ __device__ __forceinline__ void stage_rc(int b, int& R, int& C) { const int st = b / 1024, sb = b % 1024, swz = sb ^ (((sb >> 9) & 1) << 5); R = (st >> 1) * 16 + swz / 64; C = (st & 1) * 32 + (swz % 64) / 2; }
__host__ __device__ __forceinline__ int perm32(int rho) { const int n = rho >> 4, i = rho & 15; return 8 * (i >> 2) + 4 * n + (i & 3); }

struct Unit { int pm, pn; };
struct Gemm { const bf16_t* A; const bf16_t* Bt; int M, N, K; };

struct StaticOrder {
    int nM, nN, nwg, G, c;
    __host__ __device__ void init(int M, int N, int G_, int c_) { nM = M / BM; nN = N / BM; nwg = nM * nN; G = G_; c = c_; }
    __host__ __device__ bool next(int i, Unit& u) const {
        const long L = (long)i * G + c; if (L >= nwg) return false;
        int wgid = (int)L; { const int q = nwg / NXCD, r = nwg % NXCD, xcd = wgid % NXCD, off = wgid / NXCD; wgid = (xcd < r ? xcd * (q + 1) : r * (q + 1) + (xcd - r) * q) + off; }
        const int nig = WGM * nN, gid = wgid / nig, fm = gid * WGM, gsz = (nM - fm) < WGM ? (nM - fm) : WGM;
        u.pm = fm + ((wgid % nig) % gsz); u.pn = (wgid % nig) / gsz; return true;
    }
    __device__ __forceinline__ void a_ready(const Unit&) const {}
    __device__ __forceinline__ void done(const Unit&) const {}
};

__device__ __forceinline__ unsigned cvt_pk_bf16(float lo, float hi) { unsigned r; asm volatile("v_cvt_pk_bf16_f32 %0, %1, %2" : "=v"(r) : "v"(lo), "v"(hi)); return r; }
typedef float f32x2 __attribute__((ext_vector_type(2)));
__device__ __forceinline__ f32x2 gelu_pk(f32x2 v) {
    const f32x2 av = __builtin_elementwise_abs(v), d = av * 0.2316418882f + 1.0f;
    f32x2 t; t.x = __builtin_amdgcn_rcpf(d.x); t.y = __builtin_amdgcn_rcpf(d.y);
    f32x2 q = t * 0.5307027145f + (-0.7265760135f); q = q * t + 0.7107068705f; q = q * t + (-0.142248368f); q = q * t + 0.127414796f; q = q * t;
    const f32x2 s = (v * v) * (-0.72134752044f);
    f32x2 e; e.x = __builtin_amdgcn_exp2f(s.x); e.y = __builtin_amdgcn_exp2f(s.y);
    const f32x2 m = v * (q * e), r = v - m;
    f32x2 o; o.x = v.x < 0.f ? m.x : r.x; o.y = v.y < 0.f ? m.y : r.y; return o;
}

__device__ __forceinline__ float bflo(unsigned w) { return __uint_as_float(w << 16); }
__device__ __forceinline__ float bfhi(unsigned w) { return __uint_as_float(w & 0xffff0000u); }
__device__ __forceinline__ float fast_sigmoid(float v) { return __builtin_amdgcn_rcpf(1.0f + __builtin_amdgcn_exp2f(-1.4426950408889634f * v)); }
struct EpiProj {
    static constexpr bool PERM = true, AFTER_DRAIN = false;
    bf16_t* O; bf16_t* UT; const float* cosT; const float* sinT; float qscale;
    __device__ __forceinline__ void operator()(const f32x4 (&acc)[2][2][4][2], const Unit& u, int wr, int wc, int fr, int fq) const {
        const int row0 = u.pm * BM + wr * 64 + fr; const int col0 = u.pn * BM + wc * 32 + 8 * fq;
        const int sect = u.pn >> 2;
        const int j0 = 4 * (4 * wc + fq);
        const float sc = (sect == 1) ? qscale : 1.f;
#pragma unroll
        for (int ai = 0; ai < 2; ++ai)
#pragma unroll
            for (int m = 0; m < 4; ++m) { const int row = row0 + ai * HALF + m * 16; bf16_t* rowp = O + (size_t)row * 4096 + col0;
                f32x4 cs = (f32x4){1.f, 1.f, 1.f, 1.f}, sn = (f32x4){0.f, 0.f, 0.f, 0.f};
                if (sect == 1 || sect == 2) { cs = *(const f32x4*)(cosT + (size_t)row * 64 + j0); sn = *(const f32x4*)(sinT + (size_t)row * 64 + j0); }
#pragma unroll
                for (int bj = 0; bj < 2; ++bj) { const f32x4 t1 = acc[ai][bj][m][0], t2 = acc[ai][bj][m][1];
                    f32x4 v0 = (t1 * cs - t2 * sn) * sc, v1 = (t1 * sn + t2 * cs) * sc;
                    u32x4 w; w.x = cvt_pk_bf16(v0[0], v0[1]); w.y = cvt_pk_bf16(v0[2], v0[3]); w.z = cvt_pk_bf16(v1[0], v1[1]); w.w = cvt_pk_bf16(v1[2], v1[3]);
                    if (sect == 0) { const int col = col0 + bj * HALF; *(u32x4*)(UT + ((size_t)((row >> 11) * 64 + (col >> 4)) * 2048 + (row & 2047)) * 16 + (col & 15)) = w; }
                    else *(u32x4*)(rowp + bj * HALF) = w; } }
    }
};
struct EpiGlu {
    static constexpr bool PERM = true, AFTER_DRAIN = false;
    bf16_t* O; const bf16_t* VG; const float* bias;
    __device__ __forceinline__ void operator()(const f32x4 (&acc)[2][2][4][2], const Unit& u, int wr, int wc, int fr, int fq) const {
        const int row0 = u.pm * BM + wr * 64 + fr; const int col0 = u.pn * BM + wc * 32 + 8 * fq;
        f32x4 bv[2][2];
#pragma unroll
        for (int bj = 0; bj < 2; ++bj)
#pragma unroll
            for (int n = 0; n < 2; ++n) bv[bj][n] = *(const f32x4*)(bias + col0 + bj * HALF + 4 * n);
#pragma unroll
        for (int ai = 0; ai < 2; ++ai)
#pragma unroll
            for (int m = 0; m < 4; ++m) { const int row = row0 + ai * HALF + m * 16;
#pragma unroll
                for (int bj = 0; bj < 2; ++bj) { const u32x4 g = *(const u32x4*)(VG + (size_t)row * 1024 + col0 + bj * HALF);
                    const f32x4 a0 = acc[ai][bj][m][0] + bv[bj][0], a1 = acc[ai][bj][m][1] + bv[bj][1];
                    u32x4 w; w.x = cvt_pk_bf16(bflo(g.x) * fast_sigmoid(a0[0]), bfhi(g.x) * fast_sigmoid(a0[1])); w.y = cvt_pk_bf16(bflo(g.y) * fast_sigmoid(a0[2]), bfhi(g.y) * fast_sigmoid(a0[3]));
                    w.z = cvt_pk_bf16(bflo(g.z) * fast_sigmoid(a1[0]), bfhi(g.z) * fast_sigmoid(a1[1])); w.w = cvt_pk_bf16(bflo(g.w) * fast_sigmoid(a1[2]), bfhi(g.w) * fast_sigmoid(a1[3]));
                    *(u32x4*)(O + (size_t)row * 2048 + col0 + bj * HALF) = w; } }
    }
};
struct EpiResid {
    static constexpr bool PERM = false, AFTER_DRAIN = false;
    const float* base; float* out; const float* gate;
    __device__ __forceinline__ void operator()(const f32x4 (&acc)[2][2][4][2], const Unit& u, int wr, int wc, int fr, int fq) const {
        const int col0 = u.pn * BM + wc * 32 + 4 * fq; const int b = u.pm >> 3;
        f32x4 gv[2][2];
#pragma unroll
        for (int bj = 0; bj < 2; ++bj)
#pragma unroll
            for (int n = 0; n < 2; ++n) gv[bj][n] = *(const f32x4*)(gate + (size_t)b * 12288 + col0 + bj * HALF + n * 16);
#pragma unroll
        for (int ai = 0; ai < 2; ++ai)
#pragma unroll
            for (int m = 0; m < 4; ++m) { const size_t off = (size_t)(u.pm * BM + ai * HALF + wr * 64 + m * 16 + fr) * 2048 + col0;
#pragma unroll
                for (int bj = 0; bj < 2; ++bj)
#pragma unroll
                    for (int n = 0; n < 2; ++n) { const f32x4 bs = *(const f32x4*)(base + off + bj * HALF + n * 16);
                        *(f32x4*)(out + off + bj * HALF + n * 16) = bs + gv[bj][n] * acc[ai][bj][m][n]; } }
    }
};
template <int MODE> struct EpiNormX {
    static constexpr bool PERM = true, AFTER_DRAIN = true;
    const float* base; float* xout; bf16_t* hout; const float* gate; const float* gvec; const float* scv; const float* shv; float* slots; unsigned* cnt;
    __device__ __forceinline__ void fused(f32x4 (&acc)[2][2][4][2], const Unit& u, int wr, int wc, int fr, int fq, PG8_LAS unsigned char* lds, int wid, int lane) const {
        PG8_LAS float* P = (PG8_LAS float*)lds; PG8_LAS float* S = (PG8_LAS float*)(lds + 8192); PG8_LAS unsigned* flag = (PG8_LAS unsigned*)(lds + 8192 + 2048);
        const int col0 = u.pn * BM + wc * 32 + 8 * fq; const int b = u.pm >> 3; const int tid = wid * 64 + lane;
        { f32x4 gv[2][2];
#pragma unroll
          for (int bj = 0; bj < 2; ++bj)
#pragma unroll
              for (int n = 0; n < 2; ++n) gv[bj][n] = *(const f32x4*)(gate + (size_t)b * 12288 + col0 + bj * HALF + 4 * n);
#pragma unroll
          for (int ai = 0; ai < 2; ++ai)
#pragma unroll
              for (int m = 0; m < 4; ++m) { const int r = ai * HALF + wr * 64 + m * 16 + fr; const size_t off = (size_t)(u.pm * BM + r) * 2048 + col0; float sq = 0.f;
#pragma unroll
                  for (int bj = 0; bj < 2; ++bj)
#pragma unroll
                      for (int n = 0; n < 2; ++n) { const f32x4 bs = __builtin_nontemporal_load((const f32x4*)(base + off + bj * HALF + 4 * n)); const f32x4 v = bs + gv[bj][n] * acc[ai][bj][m][n]; acc[ai][bj][m][n] = v;
                          sq += (v[0] * v[0] + v[1] * v[1]) + (v[2] * v[2] + v[3] * v[3]); }
                  sq += __shfl_xor(sq, 16); sq += __shfl_xor(sq, 32);
                  if (fq == 0) P[r * 4 + wc] = sq;
                  if (m & 1) asm volatile("" ::: "memory"); } }
        asm volatile("s_waitcnt lgkmcnt(0)" ::: "memory"); __builtin_amdgcn_s_barrier(); asm volatile("" ::: "memory");
        if (tid < 256) { const float tot = (P[tid * 4 + 0] + P[tid * 4 + 1]) + (P[tid * 4 + 2] + P[tid * 4 + 3]);
            unsigned* sl = (unsigned*)slots + ((size_t)(u.pm * 8 + u.pn) * 256 + tid);
            __hip_atomic_store(sl, __float_as_uint(tot), __ATOMIC_RELAXED, __HIP_MEMORY_SCOPE_AGENT);
            asm volatile("s_waitcnt vmcnt(0)" ::: "memory");
            const unsigned rb = __hip_atomic_load(sl, __ATOMIC_RELAXED, __HIP_MEMORY_SCOPE_AGENT);
            asm volatile("s_waitcnt vmcnt(0)" :: "v"(rb) : "memory"); }
        asm volatile("s_waitcnt vmcnt(0)" ::: "memory");
        if (wid < 4 && lane == 0) __hip_atomic_fetch_add(cnt + 64 * u.pm, 1u, __ATOMIC_RELAXED, __HIP_MEMORY_SCOPE_AGENT);
        if (wid == 0) { unsigned sp = 0u;
            while ((unsigned)__builtin_amdgcn_readfirstlane((int)__hip_atomic_load(cnt + 64 * u.pm, __ATOMIC_RELAXED, __HIP_MEMORY_SCOPE_AGENT)) < 32u) { __builtin_amdgcn_s_sleep(2); if (++sp > (1u << 22)) break; }
            if (lane == 0) flag[0] = sp; }
        asm volatile("s_waitcnt vmcnt(0) lgkmcnt(0)" ::: "memory"); __builtin_amdgcn_s_barrier(); asm volatile("" ::: "memory");
        if (tid < 256) { float tot = 0.f;
#pragma unroll
            for (int t = 0; t < 8; ++t) tot += __uint_as_float(__hip_atomic_load((unsigned*)slots + ((size_t)(u.pm * 8 + t) * 256 + tid), __ATOMIC_RELAXED, __HIP_MEMORY_SCOPE_AGENT));
            S[tid] = 1.0f / sqrtf(tot * (1.0f / 2048.0f) + 1e-6f); }
        asm volatile("s_waitcnt vmcnt(0) lgkmcnt(0)" ::: "memory"); __builtin_amdgcn_s_barrier(); asm volatile("" ::: "memory");
        f32x4 ga[2][2], sh[2][2];
#pragma unroll
        for (int bj = 0; bj < 2; ++bj)
#pragma unroll
            for (int n = 0; n < 2; ++n) { const int c = col0 + bj * HALF + 4 * n; ga[bj][n] = *(const f32x4*)(gvec + c);
                if (MODE == 0) { ga[bj][n] = ga[bj][n] * (*(const f32x4*)(scv + (size_t)b * 12288 + c) + 1.0f); sh[bj][n] = *(const f32x4*)(shv + (size_t)b * 12288 + c); } }
#pragma unroll
        for (int ai = 0; ai < 2; ++ai)
#pragma unroll
            for (int m = 0; m < 4; ++m) { const int r = ai * HALF + wr * 64 + m * 16 + fr; const size_t off = (size_t)(u.pm * BM + r) * 2048 + col0; const float rstd = S[r];
#pragma unroll
                for (int bj = 0; bj < 2; ++bj) { const f32x4 v0 = acc[ai][bj][m][0], v1 = acc[ai][bj][m][1];
                    if (MODE == 0) { *(f32x4*)(xout + off + bj * HALF) = v0; *(f32x4*)(xout + off + bj * HALF + 4) = v1;
                        const f32x4 h0 = v0 * rstd * ga[bj][0] + sh[bj][0], h1 = v1 * rstd * ga[bj][1] + sh[bj][1];
                        u32x4 w; w.x = cvt_pk_bf16(h0[0], h0[1]); w.y = cvt_pk_bf16(h0[2], h0[3]); w.z = cvt_pk_bf16(h1[0], h1[1]); w.w = cvt_pk_bf16(h1[2], h1[3]);
                        *(u32x4*)(hout + off + bj * HALF) = w; }
                    else { *(f32x4*)(xout + off + bj * HALF) = v0 * rstd * ga[bj][0]; *(f32x4*)(xout + off + bj * HALF + 4) = v1 * rstd * ga[bj][1]; } }
                asm volatile("" ::: "memory"); }
    }
};
struct EpiSwiglu {
    static constexpr bool PERM = true, AFTER_DRAIN = false;
    bf16_t* O;
    __device__ __forceinline__ void operator()(const f32x4 (&acc)[2][2][4][2], const Unit& u, int wr, int wc, int fr, int fq) const {
        const int row0 = u.pm * BM + wr * 64 + fr; const int col0 = u.pn * HALF + wc * 32 + 8 * fq;
#pragma unroll
        for (int ai = 0; ai < 2; ++ai)
#pragma unroll
            for (int m = 0; m < 4; ++m) { const int row = row0 + ai * HALF + m * 16;
                const f32x4 g0 = acc[ai][0][m][0], g1 = acc[ai][0][m][1], u0 = acc[ai][1][m][0], u1 = acc[ai][1][m][1];
                f32x4 v0, v1;
#pragma unroll
                for (int i = 0; i < 4; ++i) { v0[i] = g0[i] * fast_sigmoid(g0[i]) * u0[i]; v1[i] = g1[i] * fast_sigmoid(g1[i]) * u1[i]; }
                u32x4 w; w.x = cvt_pk_bf16(v0[0], v0[1]); w.y = cvt_pk_bf16(v0[2], v0[3]); w.z = cvt_pk_bf16(v1[0], v1[1]); w.w = cvt_pk_bf16(v1[2], v1[3]);
                *(u32x4*)(O + (size_t)row * 5632 + col0) = w; }
    }
};

template <class Epi, class Sched, bool ALIGN_EPI = false, bool SP2 = false>
__device__ __forceinline__ void gemm_phase(PG8_LAS unsigned char* lds, const Gemm g, const Sched& S, const Epi& E) {
    const int tid = threadIdx.x, wid = __builtin_amdgcn_readfirstlane(tid >> 6), lane = tid & 63, wr = wid >> 2, wc = wid & 3, fr = lane & 15, fq = lane >> 4;
    const int K = g.K, nt = K / BK;
    unsigned voffA[2], voffB[2];
#pragma unroll
    for (int i = 0; i < 2; ++i) { int R, C; stage_rc(tid * 16 + i * 8192, R, C); const int Rb = Epi::PERM ? ((R & ~31) + perm32(R & 31)) : R;
        voffA[i] = (unsigned)(R * K + C) * 2u; voffB[i] = (unsigned)(Rb * K + C) * 2u; }
    const size_t kstep = (size_t)(BK * 2);
    const size_t hstep = (size_t)HALF * K * 2;
    const size_t tstep = 2 * hstep;
    const unsigned ldsw = (unsigned)wid * 1024u;
    const int aoff = lds_byte(wr * 64 + fr, fq * 8), boff = lds_byte(wc * 32 + fr, fq * 8);
#define PG8_SA(b, h) (((b) * 2 + (h)) * HTB)
#define PG8_SB(b, h) ((4 + (b) * 2 + (h)) * HTB)
#define PG8_STAGE(bufoff, gbase, voff) do { _Pragma("unroll") for (int _i = 0; _i < 2; ++_i) \
        __builtin_amdgcn_global_load_lds((const unsigned*)((const char*)(gbase) + (voff)[_i]), (PG8_LAS unsigned*)(lds + (bufoff) + ldsw + _i * 8192), 16, 0, 0); } while (0)
#define PG8_LDA(dst, b, h) do { _Pragma("unroll") for (int m = 0; m < 4; ++m) _Pragma("unroll") for (int k = 0; k < 2; ++k) dst[m][k] = *(const PG8_LAS bf16x8*)(lds + PG8_SA(b, h) + aoff + m * 2048 + k * 1024); } while (0)
#define PG8_LDB(dst, b, h) do { _Pragma("unroll") for (int n = 0; n < 2; ++n) _Pragma("unroll") for (int k = 0; k < 2; ++k) dst[n][k] = *(const PG8_LAS bf16x8*)(lds + PG8_SB(b, h) + boff + n * 2048 + k * 1024); } while (0)
#define PG8_MMA(ai, bj, At, Bt) do { __builtin_amdgcn_s_setprio(1); _Pragma("unroll") for (int m = 0; m < 4; ++m) _Pragma("unroll") for (int n = 0; n < 2; ++n) _Pragma("unroll") for (int k = 0; k < 2; ++k) \
        acc[ai][bj][m][n] = __builtin_amdgcn_mfma_f32_16x16x32_bf16(Bt[n][k], At[m][k], acc[ai][bj][m][n], 0, 0, 0); __builtin_amdgcn_s_setprio(0); } while (0)
#define PG8_WAIT_V(n) asm volatile("s_waitcnt vmcnt(" #n ")" ::: "memory")
#define PG8_WAIT_L(n) asm volatile("s_waitcnt lgkmcnt(" #n ")" ::: "memory")
#define PG8_BAR __builtin_amdgcn_s_barrier()
#define PG8_SCHED __builtin_amdgcn_sched_barrier(0)
    Unit cur, nxt; int ui = 0;
    if (!S.next(0, cur)) return;
    f32x4 acc[2][2][4][2];
#pragma unroll
    for (int a = 0; a < 2; ++a)
#pragma unroll
        for (int b = 0; b < 2; ++b)
#pragma unroll
            for (int m = 0; m < 4; ++m)
#pragma unroll
                for (int n = 0; n < 2; ++n) acc[a][b][m][n] = (f32x4){0.f, 0.f, 0.f, 0.f};
    bf16x8 At[4][2], B0[2][2], B1[2][2];
    const char* cA = (const char*)g.A + (size_t)cur.pm * tstep; const char* cB = (const char*)g.Bt + (size_t)cur.pn * tstep;
    S.a_ready(cur);
    if constexpr (SP2) {
        PG8_STAGE(PG8_SB(0, 0), cB, voffB); PG8_STAGE(PG8_SB(0, 1), cB + hstep, voffB); PG8_STAGE(PG8_SA(0, 0), cA, voffA); PG8_STAGE(PG8_SA(0, 1), cA + hstep, voffA);
        if (wr == 1) PG8_BAR;
        PG8_WAIT_V(2); PG8_BAR;
        PG8_STAGE(PG8_SB(1, 0), cB + kstep, voffB); PG8_STAGE(PG8_SA(1, 0), cA + kstep, voffA); PG8_STAGE(PG8_SB(1, 1), cB + hstep + kstep, voffB);
        PG8_WAIT_V(6); PG8_BAR;
    } else {
        PG8_STAGE(PG8_SB(0, 0), cB, voffB); PG8_STAGE(PG8_SA(0, 0), cA, voffA); PG8_STAGE(PG8_SB(0, 1), cB + hstep, voffB); PG8_STAGE(PG8_SA(0, 1), cA + hstep, voffA);
        if (wr == 1) PG8_BAR;
        PG8_WAIT_V(4); PG8_BAR;
        PG8_STAGE(PG8_SB(1, 0), cB + kstep, voffB); PG8_STAGE(PG8_SA(1, 0), cA + kstep, voffA); PG8_STAGE(PG8_SB(1, 1), cB + hstep + kstep, voffB);
        PG8_WAIT_V(6); PG8_BAR;
    }
    for (;;) {
        const bool has_next = S.next(ui + 1, nxt);
        const char* nA = has_next ? (const char*)g.A + (size_t)nxt.pm * tstep : cA; const char* nB = has_next ? (const char*)g.Bt + (size_t)nxt.pn * tstep : cB;
        for (int t = 0; t < nt; t += 2) {
            const bool last = (t == nt - 2);
            const char* a1 = cA + (size_t)(t + 1) * kstep;
            const char* a2 = last ? nA : cA + (size_t)(t + 2) * kstep; const char* b2 = last ? nB : cB + (size_t)(t + 2) * kstep;
            const char* a3 = a2 + kstep; const char* b3 = b2 + kstep;
            if (last && has_next) S.a_ready(nxt);
            if constexpr (SP2) {
            PG8_LDB(B0, 0, 0); PG8_LDB(B1, 0, 1); PG8_SCHED; PG8_LDA(At, 0, 0); PG8_STAGE(PG8_SA(1, 1), a1 + hstep, voffA);
            PG8_WAIT_V(8); PG8_WAIT_L(0); PG8_BAR; PG8_MMA(0, 0, At, B0); PG8_MMA(0, 1, At, B1); PG8_BAR; PG8_SCHED;
            PG8_LDA(At, 0, 1); PG8_STAGE(PG8_SB(0, 0), b2, voffB); PG8_STAGE(PG8_SB(0, 1), b2 + hstep, voffB); PG8_STAGE(PG8_SA(0, 0), a2, voffA);
            PG8_WAIT_V(8); PG8_WAIT_L(0); PG8_BAR; PG8_MMA(1, 0, At, B0); PG8_MMA(1, 1, At, B1); PG8_BAR; PG8_SCHED;
            PG8_LDB(B0, 1, 0); PG8_LDB(B1, 1, 1); PG8_SCHED; PG8_LDA(At, 1, 0); PG8_STAGE(PG8_SA(0, 1), a2 + hstep, voffA);
            PG8_WAIT_V(8); PG8_WAIT_L(0); PG8_BAR; PG8_MMA(0, 0, At, B0); PG8_MMA(0, 1, At, B1); PG8_BAR; PG8_SCHED;
            PG8_LDA(At, 1, 1); PG8_STAGE(PG8_SB(1, 0), b3, voffB); PG8_STAGE(PG8_SB(1, 1), b3 + hstep, voffB); PG8_STAGE(PG8_SA(1, 0), a3, voffA);
            PG8_WAIT_V(8); PG8_WAIT_L(0); PG8_BAR; PG8_MMA(1, 0, At, B0); PG8_MMA(1, 1, At, B1); PG8_BAR; PG8_SCHED;
            } else {
            PG8_LDB(B0, 0, 0); PG8_SCHED; PG8_LDA(At, 0, 0); PG8_STAGE(PG8_SA(1, 1), a1 + hstep, voffA);
            PG8_WAIT_L(8); PG8_BAR; PG8_WAIT_L(0); PG8_MMA(0, 0, At, B0); PG8_BAR; PG8_SCHED;
            PG8_LDB(B1, 0, 1); PG8_STAGE(PG8_SB(0, 0), b2, voffB);
            PG8_BAR; PG8_WAIT_L(0); PG8_MMA(0, 1, At, B1); PG8_BAR;
            PG8_LDA(At, 0, 1); PG8_STAGE(PG8_SA(0, 0), a2, voffA);
            PG8_BAR; PG8_WAIT_L(0); PG8_MMA(1, 0, At, B0); PG8_BAR; PG8_SCHED;
            PG8_STAGE(PG8_SB(0, 1), b2 + hstep, voffB);
            PG8_WAIT_V(6); PG8_BAR; PG8_MMA(1, 1, At, B1); PG8_BAR;
            PG8_LDB(B0, 1, 0); PG8_SCHED; PG8_LDA(At, 1, 0); PG8_STAGE(PG8_SA(0, 1), a2 + hstep, voffA);
            PG8_WAIT_L(8); PG8_BAR; PG8_WAIT_L(0); PG8_MMA(0, 0, At, B0); PG8_BAR; PG8_SCHED;
            PG8_LDB(B1, 1, 1); PG8_STAGE(PG8_SB(1, 0), b3, voffB);
            PG8_BAR; PG8_WAIT_L(0); PG8_MMA(0, 1, At, B1); PG8_BAR;
            PG8_LDA(At, 1, 1); PG8_STAGE(PG8_SA(1, 0), a3, voffA);
            PG8_BAR; PG8_WAIT_L(0); PG8_MMA(1, 0, At, B0); PG8_BAR; PG8_SCHED;
            PG8_STAGE(PG8_SB(1, 1), b3 + hstep, voffB);
            PG8_WAIT_V(6); PG8_BAR; PG8_MMA(1, 1, At, B1); PG8_BAR;
            }
        }
        if constexpr (ALIGN_EPI) { if (wr == 0) PG8_BAR; }
        if constexpr (!Epi::AFTER_DRAIN) { E(acc, cur, wr, wc, fr, fq); S.done(cur); }
        if (!has_next) break;
#pragma unroll
        for (int a = 0; a < 2; ++a)
#pragma unroll
            for (int b = 0; b < 2; ++b)
#pragma unroll
                for (int m = 0; m < 4; ++m)
#pragma unroll
                    for (int n = 0; n < 2; ++n) acc[a][b][m][n] = (f32x4){0.f, 0.f, 0.f, 0.f};
        cur = nxt; cA = nA; cB = nB; ++ui;
        if constexpr (ALIGN_EPI) { if (wr == 1) PG8_BAR; }
    }
    PG8_WAIT_V(0);
    if constexpr (!ALIGN_EPI) { if (wr == 0) PG8_BAR; }
    PG8_BAR;
    if constexpr (Epi::AFTER_DRAIN) { E.fused(acc, cur, wr, wc, fr, fq, lds, wid, lane); S.done(cur); }
#undef PG8_SA
#undef PG8_SB
#undef PG8_STAGE
#undef PG8_LDA
#undef PG8_LDB
#undef PG8_MMA
#undef PG8_WAIT_V
#undef PG8_WAIT_L
#undef PG8_BAR
#undef PG8_SCHED
}
}

constexpr int NWAVES = 8;
constexpr int BATCH = 4, SEQ = 2048, DM = 2048, MTOK = BATCH * SEQ, SSMW = 1024, ATTW = 1024, NGRP = 64, NST = 64, NHEAD = 8, HDIM = 128, DFF = 5632, PROJW = 4096, NMODW = 6 * DM;
constexpr int KSPLIT = 32;
constexpr size_t MiB = 1u << 20;
constexpr size_t WS_MODP = 2 * MiB, WS_MODF = 8 * MiB, WS_ROPE = 9 * MiB, WS_KTAB = 13 * MiB, WS_GTAB = 16 * MiB, WS_HTAB = 32 * MiB, WS_A64 = 48 * MiB;
constexpr size_t WS_WIN = 49 * MiB, WS_WGLU = 65 * MiB, WS_WOUT = 67 * MiB, WS_WGU = 75 * MiB, WS_WDN = 119 * MiB, WS_H = 141 * MiB, WS_PROJ = 173 * MiB, WS_VG = 237 * MiB;
constexpr size_t WS_YCAT = 253 * MiB, WS_OBR = 285 * MiB, WS_LSE = 333 * MiB, WS_FF = 173 * MiB, WS_UT = 334 * MiB, WS_END = 350 * MiB;
static_assert(WS_FF + (size_t)MTOK * DFF * 2 <= WS_OBR, "ff overlay");
constexpr int LDS_BYTES = 147456, MISC_OFF = 147456 - 256;
constexpr size_t WS_CTL = 0, CTL_ZERO_BYTES = 49152, WS_CNT = 16384, WS_PCNT = 32768, WS_SLOTS = 1u << 20;

#define GAS __attribute__((address_space(1)))
#define LAS __attribute__((address_space(3)))
typedef unsigned short bf16;
typedef unsigned v4u __attribute__((ext_vector_type(4)));
typedef unsigned v2u __attribute__((ext_vector_type(2)));
typedef float f32x4 __attribute__((ext_vector_type(4)));
typedef float f32x16 __attribute__((ext_vector_type(16)));
typedef short bf16x8 __attribute__((ext_vector_type(8)));
typedef short s16x4 __attribute__((ext_vector_type(4)));
#define LDS_WAIT() asm volatile("s_waitcnt lgkmcnt(0)" ::: "memory")
__device__ __forceinline__ unsigned f2bf(float f) { unsigned u = __builtin_bit_cast(unsigned, f); return (u + 0x7fffu + ((u >> 16) & 1u)) >> 16; }
__device__ __forceinline__ unsigned pk2(float lo, float hi) { return f2bf(lo) | (f2bf(hi) << 16); }
__device__ __forceinline__ float bf_lo(unsigned w) { return __uint_as_float(w << 16); }
__device__ __forceinline__ float bf_hi(unsigned w) { return __uint_as_float(w & 0xffff0000u); }
__device__ __forceinline__ float wave_sum(float v) {
#pragma unroll
    for (int o = 1; o < 64; o <<= 1) v += __shfl_xor(v, o);
    return v;
}

struct Args { const float* in[25]; float* out; unsigned char* ws; int ph_lo, ph_hi; };

template <int MODE>
__device__ __forceinline__ void p0_transpose_item(const float* __restrict__ W, int K, int N, bf16* WT, LAS float* scr, int item, int lane, const float* gs, const float* ga) {
    const int nblk = N / 64, kb = item / nblk, nb = item % nblk, k0 = 64 * kb, n0 = 64 * nb;
    const int lr = lane >> 4, lc = lane & 15;
    f32x4 v[16];
#pragma unroll
    for (int i = 0; i < 16; ++i) v[i] = __builtin_nontemporal_load((const f32x4*)(W + (size_t)(k0 + 4 * i + lr) * N + n0 + 4 * lc));
#pragma unroll
    for (int i = 0; i < 16; ++i) { const int kk = 4 * i + lr; f32x4 t = v[i];
        if (MODE == 4) { const int k = k0 + kk; t = t * ((k < SSMW) ? gs[k] : ga[k - SSMW]); }
        LAS float* d = scr + kk * 65 + 4 * lc; d[0] = t.x; d[1] = t.y; d[2] = t.z; d[3] = t.w; }
    LDS_WAIT(); asm volatile("" ::: "memory");
    const int c = lane & 7;
#pragma unroll
    for (int j = 0; j < 8; ++j) { const int n = (lane >> 3) + 8 * j; const LAS float* s = scr + (8 * c) * 65 + n;
        v4u o; o.x = pk2(s[0 * 65], s[1 * 65]); o.y = pk2(s[2 * 65], s[3 * 65]); o.z = pk2(s[4 * 65], s[5 * 65]); o.w = pk2(s[6 * 65], s[7 * 65]);
        int col = n0 + n, row = col;
        if (MODE == 1) { if (col >= 1024 && col < 3072) { const int e = col & 127, half = e >> 6, ep = e & 63; row = (col - e) + ((ep >> 2) << 3) + (half << 2) + (ep & 3); } }
        if (MODE == 2) row = (col >> 7) * 256 + (col & 127);
        if (MODE == 3) row = (col >> 7) * 256 + 128 + (col & 127);
        *(GAS v4u*)(WT + (size_t)row * K + k0 + 8 * c) = o; }
    LDS_WAIT(); asm volatile("" ::: "memory");
}
__device__ __forceinline__ void wt_readback(const unsigned long long* p0, const unsigned long long* p1) {
    const unsigned long long a = __hip_atomic_load(p0, __ATOMIC_RELAXED, __HIP_MEMORY_SCOPE_AGENT), b = __hip_atomic_load(p1, __ATOMIC_RELAXED, __HIP_MEMORY_SCOPE_AGENT);
    asm volatile("s_waitcnt vmcnt(0)" :: "v"(a), "v"(b) : "memory");
}
__device__ __forceinline__ void p0_gemv_item(const float* __restrict__ cvec, const float* __restrict__ wmod, float* modp, float* modf, const float* __restrict__ bmod, unsigned* cnt, LAS float* scr, int item, int lane) {
    const int ks = item / 48, cb = item % 48, k0 = ks * 64, col = cb * 256 + lane * 4;
#pragma unroll
    for (int b = 0; b < 4; ++b) { const float v = cvec[b * DM + k0 + lane]; scr[lane * 4 + b] = v / (1.0f + __expf(-v)); }
    LDS_WAIT(); asm volatile("" ::: "memory");
    f32x4 a0 = {0, 0, 0, 0}, a1 = a0, a2 = a0, a3 = a0;
#pragma unroll 16
    for (int k = 0; k < 64; ++k) { const f32x4 w = __builtin_nontemporal_load((const f32x4*)(wmod + (size_t)(k0 + k) * NMODW + col)); const f32x4 s = *(const LAS f32x4*)(scr + 4 * k);
        a0 += w * s[0]; a1 += w * s[1]; a2 += w * s[2]; a3 += w * s[3]; }
    unsigned long long* o = (unsigned long long*)(modp + (size_t)(ks * 4) * NMODW + col);
#define GV_ST(p, v) do { __hip_atomic_store((p), ((unsigned long long)__float_as_uint((v).y) << 32) | __float_as_uint((v).x), __ATOMIC_RELAXED, __HIP_MEMORY_SCOPE_AGENT); \
                         __hip_atomic_store((p) + 1, ((unsigned long long)__float_as_uint((v).w) << 32) | __float_as_uint((v).z), __ATOMIC_RELAXED, __HIP_MEMORY_SCOPE_AGENT); } while (0)
    GV_ST(o, a0); GV_ST(o + NMODW / 2, a1); GV_ST(o + NMODW, a2); GV_ST(o + 3 * (NMODW / 2), a3);
#undef GV_ST
    LDS_WAIT(); asm volatile("s_waitcnt vmcnt(0)" ::: "memory");
    wt_readback(o, o + 1); wt_readback(o + NMODW / 2, o + NMODW / 2 + 1); wt_readback(o + NMODW, o + NMODW + 1); wt_readback(o + 3 * (NMODW / 2), o + 3 * (NMODW / 2) + 1);
    if (lane == 0) __hip_atomic_fetch_add(cnt + 64 * cb, 1u, __ATOMIC_RELAXED, __HIP_MEMORY_SCOPE_AGENT);
}
__device__ __forceinline__ void p0_fin_item(const float* modp, float* modf, const float* __restrict__ bmod, unsigned* cnt, int item, int lane) {
    const int cb = item >> 2, b = item & 3, col = cb * 256 + lane * 4;
    { unsigned sp = 0u;
      while ((unsigned)__builtin_amdgcn_readfirstlane((int)__hip_atomic_load(cnt + 64 * cb, __ATOMIC_RELAXED, __HIP_MEMORY_SCOPE_AGENT)) < (unsigned)KSPLIT) { __builtin_amdgcn_s_sleep(2); if (++sp > (1u << 22)) break; }
      __builtin_amdgcn_fence(__ATOMIC_ACQUIRE, "agent"); }
    f32x4 t = *(const f32x4*)(bmod + col);
#pragma unroll 8
    for (int k2 = 0; k2 < KSPLIT; ++k2) { const unsigned long long* pp = (const unsigned long long*)(modp + (size_t)(k2 * 4 + b) * NMODW + col);
        const unsigned long long w0 = __hip_atomic_load(pp, __ATOMIC_RELAXED, __HIP_MEMORY_SCOPE_AGENT), w1 = __hip_atomic_load(pp + 1, __ATOMIC_RELAXED, __HIP_MEMORY_SCOPE_AGENT);
        t += (f32x4){__uint_as_float((unsigned)w0), __uint_as_float((unsigned)(w0 >> 32)), __uint_as_float((unsigned)w1), __uint_as_float((unsigned)(w1 >> 32))}; }
    unsigned long long* mo = (unsigned long long*)(modf + (size_t)b * NMODW + col);
    __hip_atomic_store(mo, ((unsigned long long)__float_as_uint(t.y) << 32) | __float_as_uint(t.x), __ATOMIC_RELAXED, __HIP_MEMORY_SCOPE_AGENT);
    __hip_atomic_store(mo + 1, ((unsigned long long)__float_as_uint(t.w) << 32) | __float_as_uint(t.z), __ATOMIC_RELAXED, __HIP_MEMORY_SCOPE_AGENT);
    asm volatile("s_waitcnt vmcnt(0)" ::: "memory");
    wt_readback(mo, mo + 1);
    if (lane == 0) __hip_atomic_fetch_add(cnt + 64 * 48, 1u, __ATOMIC_RELAXED, __HIP_MEMORY_SCOPE_AGENT);
}
__device__ __forceinline__ void p0_rope_item(const int* __restrict__ pos, float* cosT, float* sinT, int item, int lane) {
    const double inv = exp(-(double)lane * (9.210340371976184 / 64.0));
    const double rev = (double)pos[item] * inv * 0.15915494309189535;
    const float x = (float)((rev - rint(rev)) * 6.283185307179586);
    cosT[(size_t)item * 64 + lane] = cosf(x); sinT[(size_t)item * 64 + lane] = sinf(x);
}
struct SsmLane { double lr, li, dt, ar, ai; };
__device__ __forceinline__ SsmLane ssm_lane(const float* are, const float* aim, const float* ldt, int g, int p) {
    SsmLane L; L.dt = exp((double)ldt[g]); L.lr = (double)are[g * 64 + p]; L.li = (double)aim[g * 64 + p];
    const double m = exp(L.lr * L.dt); L.ar = m * cos(L.li * L.dt); L.ai = m * sin(L.li * L.dt); return L; }
__device__ __forceinline__ void ssm_pow(const SsmLane& L, int n, double& zr, double& zi) { const double m = exp(L.lr * L.dt * n), th = L.li * L.dt * n; zr = m * cos(th); zi = m * sin(th); }
__device__ __forceinline__ void ssm_step(const SsmLane& L, double& zr, double& zi) { const double nr = zr * L.ar - zi * L.ai, ni = zr * L.ai + zi * L.ar; zr = nr; zi = ni; }
__device__ __forceinline__ void ssm_bbar(const SsmLane& L, const float* bre, const float* bim, int g, int p, float (&br)[16], float (&bi)[16]) {
    const double nr = L.ar - 1.0, ni = L.ai, den = L.lr * L.lr + L.li * L.li;
    const float fr = (float)((nr * L.lr + ni * L.li) / den), fi = (float)((ni * L.lr - nr * L.li) / den);
    const f32x4* pr = (const f32x4*)(bre + (size_t)(g * 64 + p) * 16); const f32x4* pi = (const f32x4*)(bim + (size_t)(g * 64 + p) * 16);
#pragma unroll
    for (int q = 0; q < 4; ++q) { const f32x4 r = pr[q], i = pi[q];
#pragma unroll
        for (int e = 0; e < 4; ++e) { br[4 * q + e] = fr * r[e] - fi * i[e]; bi[4 * q + e] = fr * i[e] + fi * r[e]; } }
}
__device__ __forceinline__ void p0_ktab_item(const float* const* in, bf16* ktab, float* a64, LAS float* scr, int g, int ch, int lane) {
    const SsmLane L = ssm_lane(in[7], in[8], in[9], g, lane);
    float br[16], bi[16]; ssm_bbar(L, in[10], in[11], g, lane, br, bi);
    double zr, zi; ssm_pow(L, ch == 0 ? 0 : 8 * ch - 1, zr, zi);
    const int c = lane >> 2, q = lane & 3; const float* cr = in[12] + (size_t)(g * 16 + c) * 64; const float* ci = in[13] + (size_t)(g * 16 + c) * 64;
    for (int e = 0; e < 8; ++e) { const int ti = 8 * ch + e; if (ti > 64) break;
        if (ti == 0) { double wr, wi; ssm_pow(L, 64, wr, wi); a64[(g * 64 + lane) * 2] = (float)wr; a64[(g * 64 + lane) * 2 + 1] = (float)wi;
            *(GAS v2u*)(ktab + (size_t)(g * 65) * 256 + lane * 4) = (v2u){0u, 0u}; continue; }
        const float fzr = (float)zr, fzi = (float)zi;
#pragma unroll
        for (int k = 0; k < 16; ++k) { scr[lane * 16 + k] = fzr * br[k] - fzi * bi[k]; scr[1024 + lane * 16 + k] = fzr * bi[k] + fzi * br[k]; }
        LDS_WAIT(); asm volatile("" ::: "memory");
        f32x4 acc = {0, 0, 0, 0};
#pragma unroll 8
        for (int p = 0; p < 64; ++p) { const f32x4 wr = *(const LAS f32x4*)(scr + p * 16 + 4 * q), wi = *(const LAS f32x4*)(scr + 1024 + p * 16 + 4 * q); acc += wr * cr[p] - wi * ci[p]; }
        *(GAS v2u*)(ktab + ((size_t)(g * 65 + ti) * 16 + c) * 16 + 4 * q) = (v2u){pk2(acc[0], acc[1]), pk2(acc[2], acc[3])};
        LDS_WAIT(); asm volatile("" ::: "memory");
        ssm_step(L, zr, zi); }
}
__device__ __forceinline__ void p0_gtab_item(const float* const* in, bf16* gtab, int g, int ch, int lane) {
    const SsmLane L = ssm_lane(in[7], in[8], in[9], g, lane); double dzr, dzi; ssm_pow(L, 8 * ch + 1, dzr, dzi);
    const int p = lane;
    float cr[16], ci[16];
#pragma unroll
    for (int c = 0; c < 16; ++c) { cr[c] = in[12][(size_t)(g * 16 + c) * 64 + p]; ci[c] = in[13][(size_t)(g * 16 + c) * 64 + p]; }
    for (int e = 0; e < 8; ++e) { const int t = 8 * ch + e; const float zr = (float)dzr, zi = (float)dzi;
        const size_t base = ((size_t)(g * 32 + (t >> 1)) * 8) * 512;
#pragma unroll
        for (int c = 0; c < 16; ++c) { const float gre = cr[c] * zr - ci[c] * zi, gni = -(cr[c] * zi + ci[c] * zr);
            { const int pp = p;      gtab[base + (size_t)(pp >> 4) * 512 + ((16 * (t & 1) + c) + 32 * ((pp >> 3) & 1)) * 8 + (pp & 7)] = (bf16)f2bf(gre); }
            { const int pp = p + 64; gtab[base + (size_t)(pp >> 4) * 512 + ((16 * (t & 1) + c) + 32 * ((pp >> 3) & 1)) * 8 + (pp & 7)] = (bf16)f2bf(gni); } }
        ssm_step(L, dzr, dzi); }
}
__device__ __forceinline__ void p0_htab_item(const float* const* in, bf16* htab, int g, int ch, int lane) {
    const SsmLane L = ssm_lane(in[7], in[8], in[9], g, lane); double dzr, dzi; ssm_pow(L, 56 - 8 * ch, dzr, dzi);
    float br[16], bi[16]; ssm_bbar(L, in[10], in[11], g, lane, br, bi);
    for (int e = 7; e >= 0; --e) { const int s = 8 * ch + e; const float zr = (float)dzr, zi = (float)dzi;
#pragma unroll
        for (int hh = 0; hh < 2; ++hh) { v4u o, o2;
            o.x = pk2(zr * br[8 * hh] - zi * bi[8 * hh], zr * br[8 * hh + 1] - zi * bi[8 * hh + 1]); o.y = pk2(zr * br[8 * hh + 2] - zi * bi[8 * hh + 2], zr * br[8 * hh + 3] - zi * bi[8 * hh + 3]);
            o.z = pk2(zr * br[8 * hh + 4] - zi * bi[8 * hh + 4], zr * br[8 * hh + 5] - zi * bi[8 * hh + 5]); o.w = pk2(zr * br[8 * hh + 6] - zi * bi[8 * hh + 6], zr * br[8 * hh + 7] - zi * bi[8 * hh + 7]);
            o2.x = pk2(zr * bi[8 * hh] + zi * br[8 * hh], zr * bi[8 * hh + 1] + zi * br[8 * hh + 1]); o2.y = pk2(zr * bi[8 * hh + 2] + zi * br[8 * hh + 2], zr * bi[8 * hh + 3] + zi * br[8 * hh + 3]);
            o2.z = pk2(zr * bi[8 * hh + 4] + zi * br[8 * hh + 4], zr * bi[8 * hh + 5] + zi * br[8 * hh + 5]); o2.w = pk2(zr * bi[8 * hh + 6] + zi * br[8 * hh + 6], zr * bi[8 * hh + 7] + zi * br[8 * hh + 7]);
            { const int pp = lane;      *(GAS v4u*)(htab + ((((size_t)(g * 4 + (pp >> 5)) * 64 + s) * 64) + (pp & 31) + 32 * hh) * 8) = o; }
            { const int pp = lane + 64; *(GAS v4u*)(htab + ((((size_t)(g * 4 + (pp >> 5)) * 64 + s) * 64) + (pp & 31) + 32 * hh) * 8) = o2; } }
        ssm_step(L, dzr, dzi); }
}
#define XB_TMO      128
#define XB_XCNT(j)  (256  + 64 * (j))
#define XB_XSUB(j)  (1280 + 64 * (j))
#define XB_XGEN(j)  (2304 + 64 * (j))
#define XB_TOP      3328
#define XB_TOPGEN   3392
#define XCD_BAR_WORDS 3456
#define XB_SPIN_CAP (1u << 18)

__device__ __forceinline__ unsigned xb_ld(unsigned* p)              { return __hip_atomic_load(p, __ATOMIC_RELAXED, __HIP_MEMORY_SCOPE_AGENT); }
__device__ __forceinline__ unsigned xb_add(unsigned* p, unsigned v) { return __hip_atomic_fetch_add(p, v, __ATOMIC_RELAXED, __HIP_MEMORY_SCOPE_AGENT); }
__device__ __forceinline__ unsigned xb_xcc_id() { return (unsigned)__builtin_amdgcn_s_getreg((3 << 11) | 20) & 0xFu; }
#define XB_SPIN(cond, bar) do { unsigned _sp = 0; while (cond) { __builtin_amdgcn_s_sleep(1); \
    if ((++_sp & 255u) == 0u) { if (xb_ld(&(bar)[XB_TMO])) break; if (_sp > XB_SPIN_CAP) { atomicAdd(&(bar)[XB_TMO], 1u); break; } } } } while (0)

struct XcdBarrier {
    unsigned* bar; unsigned x;
    volatile LAS unsigned* st;
};

__device__ __forceinline__ XcdBarrier xcd_barrier_post(unsigned* bar, volatile LAS unsigned* st) {
    XcdBarrier b; b.bar = bar; b.x = xb_xcc_id(); b.st = st;
    if (threadIdx.x == 0) (void)xb_add(&bar[XB_XCNT(b.x)], 1u);
    return b;
}
__device__ __forceinline__ void xcd_barrier_complete(unsigned* bar, unsigned x, unsigned& nloc, unsigned& nx) {
    const unsigned G = gridDim.x * gridDim.y * gridDim.z;
    unsigned sum, cnt, mine, sp = 0u;
    for (;;) {
        sum = 0u; cnt = 0u; mine = 0u;
#pragma unroll
        for (unsigned j = 0; j < 16; ++j) { const unsigned c = xb_ld(&bar[XB_XCNT(j)]); sum += c; cnt += (c > 0u) ? 1u : 0u; mine = (j == x) ? c : mine; }
        if (sum == G) break;
        __builtin_amdgcn_s_sleep(1);
        if ((++sp & 255u) == 0u) { if (xb_ld(&bar[XB_TMO])) break; if (sp > XB_SPIN_CAP) { atomicAdd(&bar[XB_TMO], 1u); break; } }
    }
    nloc = mine > 0u ? mine : 1u; nx = cnt > 0u ? cnt : 1u;
}

__device__ __forceinline__ void xcd_barrier(const XcdBarrier& b) {
    asm volatile("s_waitcnt vmcnt(0)" ::: "memory");
    __syncthreads();
    if (threadIdx.x == 0) {
        unsigned* bar = b.bar;
        __builtin_amdgcn_s_waitcnt(0);
        unsigned nloc = b.st[0], nx = b.st[1];
        if (nloc == 0u) { xcd_barrier_complete(bar, b.x, nloc, nx); b.st[0] = nloc; b.st[1] = nx; }
        const unsigned old = xb_add(&bar[XB_XSUB(b.x)], 1u);
        const unsigned gen = old / nloc;
        if (old + 1u == (gen + 1u) * nloc) {
            __builtin_amdgcn_fence(__ATOMIC_RELEASE, "agent");
            asm volatile("s_waitcnt vmcnt(0)" ::: "memory");
            const unsigned og = xb_add(&bar[XB_TOP], 1u);
            const unsigned tg = og / nx;
            if (og + 1u == (tg + 1u) * nx) xb_add(&bar[XB_TOPGEN], 1u);
            else XB_SPIN(xb_ld(&bar[XB_TOPGEN]) == tg, bar);
            __builtin_amdgcn_fence(__ATOMIC_ACQUIRE, "agent");
            xb_add(&bar[XB_XGEN(b.x)], 1u);
            asm volatile("s_waitcnt vmcnt(0)" ::: "memory");
        } else {
            XB_SPIN(xb_ld(&bar[XB_XGEN(b.x)]) == gen, bar);
            __builtin_amdgcn_fence(__ATOMIC_ACQUIRE, "agent");
            asm volatile("s_waitcnt vmcnt(0)" ::: "memory");
        }
    }
    __syncthreads();
}

__device__ __forceinline__ int pass_row_base() { const int x = blockIdx.x & 7, j = blockIdx.x >> 3; return 2048 * (x >> 1) + 32 * (((x & 1) << 5) + j); }
template <bool FROMP>
__device__ __forceinline__ void modnorm_phase(LAS unsigned char* lds, const float* xin, bf16* hout, const float* gvec, const float* modp, const float* bmod, const float* modf, int jsh, int jsc, int tid, int lane, int wave) {
    LAS float* TA = (LAS float*)lds; LAS float* TS = TA + DM;
    const int b = (pass_row_base()) / SEQ;
    for (int k = tid; k < DM; k += NWAVES * 64) {
        float sh, sc;
        if (FROMP) { sh = bmod[jsh * DM + k]; sc = bmod[jsc * DM + k];
            for (int ks = 0; ks < KSPLIT; ++ks) { sh += modp[(size_t)(ks * 4 + b) * NMODW + jsh * DM + k]; sc += modp[(size_t)(ks * 4 + b) * NMODW + jsc * DM + k]; } }
        else { sh = modf[(size_t)b * NMODW + jsh * DM + k]; sc = modf[(size_t)b * NMODW + jsc * DM + k]; }
        TA[k] = gvec[k] * (1.0f + sc); TS[k] = sh; }
    __syncthreads();
    for (int r = 0; r < 4; ++r) { const int row = pass_row_base() + wave * 4 + r;
        const f32x4* xr = (const f32x4*)(xin + (size_t)row * DM) + lane;
        f32x4 v[8]; float s = 0.f;
#pragma unroll
        for (int j = 0; j < 8; ++j) { v[j] = __builtin_nontemporal_load(xr + 64 * j); s += (v[j].x * v[j].x + v[j].y * v[j].y) + (v[j].z * v[j].z + v[j].w * v[j].w); }
        const float rstd = 1.0f / sqrtf(wave_sum(s) * (1.0f / DM) + 1e-6f);
        GAS v2u* o8 = (GAS v2u*)(hout + (size_t)row * DM) + lane;
#pragma unroll
        for (int j = 0; j < 8; ++j) { const f32x4 a = *(const LAS f32x4*)(TA + 4 * (lane + 64 * j)), sft = *(const LAS f32x4*)(TS + 4 * (lane + 64 * j));
            const f32x4 o = v[j] * rstd * a + sft; o8[64 * j] = (v2u){pk2(o.x, o.y), pk2(o.z, o.w)}; } }
    __syncthreads();
}

#define TS_A (-1)
#define TS_MASK 0
#define TS_SCALE 1e-5f
#define TS_X (-1)
#define TS_Y (-1)
#define STAMP(k) do { if (TS_A >= 0 && bx == 0 && threadIdx.x == 0) ((volatile LAS unsigned long long*)(lds + MISC_OFF + 16))[k] = __builtin_amdgcn_s_memrealtime(); } while (0)
#define SSTAMP(k) do { if (TS_A >= 0 && blockIdx.x == 0 && threadIdx.x == 0) ((volatile LAS unsigned long long*)(lds + MISC_OFF + 16))[k] = __builtin_amdgcn_s_memrealtime(); } while (0)
constexpr int SS_UST = 2064;
constexpr int SS_U = 0, SS_K = 32 * SS_UST, SS_E = SS_K + 65 * 512, SS_C = SS_E + 2 * 128 * 33 * 4, SS_CST = 272, SS_END = SS_C + 32 * SS_CST;
static_assert(SS_END <= 147456 - 1024, "ssm LDS");
__device__ __forceinline__ float gelu_tanh(float v) { const float t = 0.7978845608028654f * (v + 0.044715f * v * v * v); const float e = __builtin_amdgcn_exp2f(-2.885390081777927f * t); return v * __builtin_amdgcn_rcpf(1.0f + e); }
__device__ __forceinline__ void ssm_unit(LAS unsigned char* lds, int b, int g, const bf16* proj, const bf16* ktab, const bf16* gtab, const bf16* htab, const float* a64, const float* dskip, bf16* vg, int tid, int lane, int wave) {
    const int n = lane & 31, h = lane >> 5;
    const int mt1 = wave & 3, kh = wave >> 2;
    bf16x8 hf[32];
    { const bf16* hp = htab + (((size_t)(g * 4 + mt1) * 64 + kh * 32) * 64 + lane) * 8;
#pragma unroll
      for (int s = 0; s < 32; ++s) hf[s] = *(const GAS bf16x8*)(hp + (size_t)s * 512); }
    { v4u ur[8];
#pragma unroll
      for (int it = 0; it < 8; ++it) { const int i = tid + 512 * it; ur[it] = *(const GAS v4u*)(proj + ((size_t)(b * NGRP + g) * SEQ * 16 + (size_t)i * 8)); }
      v4u kr[5];
#pragma unroll
      for (int it = 0; it < 5; ++it) { const int i = tid + 512 * it; kr[it] = (v4u){0u, 0u, 0u, 0u}; if (i < 2080) kr[it] = *(const GAS v4u*)(ktab + (size_t)g * 65 * 256 + i * 8); }
#pragma unroll
      for (int it = 0; it < 8; ++it) { const int i = tid + 512 * it, t = i >> 1, hf2 = i & 1; *(LAS v4u*)(lds + SS_U + (t >> 6) * SS_UST + (t & 63) * 32 + hf2 * 16) = ur[it]; }
#pragma unroll
      for (int it = 0; it < 5; ++it) { const int i = tid + 512 * it; if (i < 2080) *(LAS v4u*)(lds + SS_K + i * 16) = kr[it]; } }
    __syncthreads(); SSTAMP(24);
    { f32x16 acc;
#pragma unroll
      for (int i = 0; i < 16; ++i) acc[i] = 0.f;
#pragma unroll
      for (int s = 0; s < 32; ++s) { const bf16x8 bb = *(const LAS bf16x8*)(lds + SS_U + n * SS_UST + (kh * 32 + s) * 32 + h * 16);
          acc = __builtin_amdgcn_mfma_f32_32x32x16_bf16(hf[s], bb, acc, 0, 0, 0); }
      LAS float* E = (LAS float*)(lds + SS_E) + kh * 128 * 33;
#pragma unroll
      for (int r = 0; r < 16; ++r) E[(32 * mt1 + (r & 3) + 8 * (r >> 2) + 4 * h) * 33 + n] = acc[r]; }
    __syncthreads(); SSTAMP(25);
    if (wave == 0) { const int p = lane; const float ar = a64[(g * 64 + p) * 2], ai = a64[(g * 64 + p) * 2 + 1]; float cr = 0.f, ci = 0.f;
        const LAS float* E0 = (const LAS float*)(lds + SS_E); const LAS float* E1 = E0 + 128 * 33;
#pragma unroll 8
        for (int j = 0; j < 32; ++j) { *(LAS bf16*)(lds + SS_C + j * SS_CST + p * 2) = (bf16)f2bf(cr); *(LAS bf16*)(lds + SS_C + j * SS_CST + (64 + p) * 2) = (bf16)f2bf(ci);
            const float er = E0[p * 33 + j] + E1[p * 33 + j], ei = E0[(64 + p) * 33 + j] + E1[(64 + p) * 33 + j];
            const float nr = ar * cr - ai * ci + er, ni = ar * ci + ai * cr + ei; cr = nr; ci = ni; } }
    f32x16 acc4[4];
#pragma unroll
    for (int q = 0; q < 4; ++q)
#pragma unroll
        for (int i = 0; i < 16; ++i) acc4[q][i] = 0.f;
    const int c_l = n & 15, tl = n >> 4;
    const int bbase = SS_U + n * SS_UST + h * 16;
    const int kb0 = SS_K + ((tl + 1) * 16 + c_l) * 32 + h * 16;
    const int mtq0 = wave, mtq1 = 15 - wave, mtq2 = 16 + wave, mtq3 = 31 - wave;
    const int nsmax = 2 * mtq3 + 2;
    bf16x8 gfb[2][8];
    for (int s = 0; s < nsmax; s += 2) {
        const bf16x8 bb0 = *(const LAS bf16x8*)(lds + bbase + s * 32), bb1 = *(const LAS bf16x8*)(lds + bbase + s * 32 + 32);
        const bool c0 = s < 2 * mtq0 + 2, c1 = s < 2 * mtq1 + 2, c2 = s < 2 * mtq2 + 2;
        bf16x8 a00, a01, a10, a11, a20, a21;
        if (c0) { a00 = *(const LAS bf16x8*)(lds + kb0 + mtq0 * 1024 - s * 512); a01 = *(const LAS bf16x8*)(lds + kb0 + mtq0 * 1024 - s * 512 - 512); }
        if (c1) { a10 = *(const LAS bf16x8*)(lds + kb0 + mtq1 * 1024 - s * 512); a11 = *(const LAS bf16x8*)(lds + kb0 + mtq1 * 1024 - s * 512 - 512); }
        if (c2) { a20 = *(const LAS bf16x8*)(lds + kb0 + mtq2 * 1024 - s * 512); a21 = *(const LAS bf16x8*)(lds + kb0 + mtq2 * 1024 - s * 512 - 512); }
        const bf16x8 a30 = *(const LAS bf16x8*)(lds + kb0 + mtq3 * 1024 - s * 512), a31 = *(const LAS bf16x8*)(lds + kb0 + mtq3 * 1024 - s * 512 - 512);
        acc4[3] = __builtin_amdgcn_mfma_f32_32x32x16_bf16(a30, bb0, acc4[3], 0, 0, 0);
        if (c2) acc4[2] = __builtin_amdgcn_mfma_f32_32x32x16_bf16(a20, bb0, acc4[2], 0, 0, 0);
        if (c1) acc4[1] = __builtin_amdgcn_mfma_f32_32x32x16_bf16(a10, bb0, acc4[1], 0, 0, 0);
        if (c0) acc4[0] = __builtin_amdgcn_mfma_f32_32x32x16_bf16(a00, bb0, acc4[0], 0, 0, 0);
        acc4[3] = __builtin_amdgcn_mfma_f32_32x32x16_bf16(a31, bb1, acc4[3], 0, 0, 0);
        if (c2) acc4[2] = __builtin_amdgcn_mfma_f32_32x32x16_bf16(a21, bb1, acc4[2], 0, 0, 0);
        if (c1) acc4[1] = __builtin_amdgcn_mfma_f32_32x32x16_bf16(a11, bb1, acc4[1], 0, 0, 0);
        if (c0) acc4[0] = __builtin_amdgcn_mfma_f32_32x32x16_bf16(a01, bb1, acc4[0], 0, 0, 0); }
#pragma unroll
    for (int q = 0; q < 2; ++q) { const bf16* gp = gtab + (((size_t)(g * 32 + (q == 0 ? mtq0 : mtq1)) * 8) * 64 + lane) * 8;
#pragma unroll
        for (int ks = 0; ks < 8; ++ks) gfb[q][ks] = *(const GAS bf16x8*)(gp + (size_t)ks * 512); }
    asm volatile("" ::: "memory");
    SSTAMP(26); __syncthreads(); SSTAMP(27);
#pragma unroll
    for (int q = 0; q < 2; ++q) {
#pragma unroll
        for (int ks = 0; ks < 8; ++ks) { const bf16x8 bb = *(const LAS bf16x8*)(lds + SS_C + n * SS_CST + (16 * ks + 8 * h) * 2);
            acc4[q] = __builtin_amdgcn_mfma_f32_32x32x16_bf16(gfb[q][ks], bb, acc4[q], 0, 0, 0); } }
#pragma unroll
    for (int q = 2; q < 4; ++q) { const bf16* gp = gtab + (((size_t)(g * 32 + (q == 2 ? mtq2 : mtq3)) * 8) * 64 + lane) * 8;
        bf16x8 gf[8];
#pragma unroll
        for (int ks = 0; ks < 8; ++ks) gf[ks] = *(const GAS bf16x8*)(gp + (size_t)ks * 512);
#pragma unroll
        for (int ks = 0; ks < 8; ++ks) { const bf16x8 bb = *(const LAS bf16x8*)(lds + SS_C + n * SS_CST + (16 * ks + 8 * h) * 2);
            acc4[q] = __builtin_amdgcn_mfma_f32_32x32x16_bf16(gf[ks], bb, acc4[q], 0, 0, 0); } }
    SSTAMP(28);
#pragma unroll
    for (int q = 0; q < 4; ++q) { const int mt = (q == 0) ? mtq0 : (q == 1) ? mtq1 : (q == 2) ? mtq2 : mtq3;
#pragma unroll
        for (int q4 = 0; q4 < 4; ++q4) { const int t = 2 * mt + (q4 >> 1), c0 = 8 * (q4 & 1) + 4 * h;
            const v2u uu = *(const LAS v2u*)(lds + SS_U + n * SS_UST + t * 32 + c0 * 2);
            const f32x4 dv = *(const f32x4*)(dskip + 16 * g + c0);
            const float y0 = acc4[q][4 * q4 + 0] + dv[0] * bf_lo(uu.x), y1 = acc4[q][4 * q4 + 1] + dv[1] * bf_hi(uu.x), y2 = acc4[q][4 * q4 + 2] + dv[2] * bf_lo(uu.y), y3 = acc4[q][4 * q4 + 3] + dv[3] * bf_hi(uu.y);
            *(GAS v2u*)(vg + (size_t)(b * SEQ + 64 * n + t) * SSMW + 16 * g + c0) = (v2u){pk2(gelu_tanh(y0), gelu_tanh(y1)), pk2(gelu_tanh(y2), gelu_tanh(y3))}; } }
    __syncthreads();
}

constexpr int AT_K = 0, AT_V = 272 * 256, AT_END = 2 * 272 * 256;
static_assert(AT_END <= 147456 - 1024, "attn LDS");
__device__ __forceinline__ unsigned off_b(unsigned row, unsigned ch) { return 256u * row + 16u * (ch ^ (((row & 3) << 2) | ((row >> 2) & 3))); }
typedef short v4i16_t __attribute__((ext_vector_type(4)));
__device__ __forceinline__ s16x4 tr_read(LAS unsigned char* p) { return __builtin_bit_cast(s16x4, __builtin_amdgcn_ds_read_tr16_b64_v4i16((LAS v4i16_t*)p)); }
struct AttnDesc { int b, hd, di, dil, res, blk; };
__device__ __forceinline__ AttnDesc attn_decode(int u) { AttnDesc d; const int bh = u / 48, w = u % 48; d.b = bh / NHEAD; d.hd = bh % NHEAD;
    if (w < 16) { d.di = 0; d.dil = 1; d.res = 0; d.blk = w; } else if (w < 32) { d.di = 1; d.dil = 4; d.res = (w - 16) >> 2; d.blk = (w - 16) & 3; } else { d.di = 2; d.dil = 16; d.res = w - 32; d.blk = 0; }
    return d; }
__device__ __forceinline__ void attn_run(LAS unsigned char* lds, int u0, int ustride, int uend, const bf16* proj, bf16* obr, float* lse, int tid, int lane, int wave) {
    if (u0 >= uend) return;
    if (tid < 256) { const int row = 256 + (tid >> 4), ch = tid & 15; *(LAS v4u*)(lds + AT_K + off_b(row, ch)) = (v4u){0u, 0u, 0u, 0u}; *(LAS v4u*)(lds + AT_V + off_b(row, ch)) = (v4u){0u, 0u, 0u, 0u}; }
    const int qn = lane & 15, g = lane >> 4, q4 = (lane & 15) >> 2, p4 = lane & 3;
    const int r0s = tid >> 4, chs = tid & 15; const unsigned soff = off_b(r0s, chs);
    v4u kr[8], vr[8]; bf16x8 qnx[4];
    int u = u0; AttnDesc nd = attn_decode(u);
#define AT_ISSUE(D) do { const size_t rowb_ = (size_t)(D).b * SEQ; \
        _Pragma("unroll") for (int it = 0; it < 8; ++it) { const int sub = 128 * (D).blk - 128 + r0s + 32 * it; kr[it] = (v4u){0u, 0u, 0u, 0u}; vr[it] = kr[it]; \
            if (sub >= 0) { const bf16* src = proj + (rowb_ + (D).res + (D).dil * sub) * PROJW + 2048 + (D).hd * HDIM + chs * 8; kr[it] = *(const GAS v4u*)src; vr[it] = *(const GAS v4u*)(src + 1024); } } \
        const int qt_ = (D).res + (D).dil * (128 * (D).blk + 16 * wave + qn); \
        _Pragma("unroll") for (int s_ = 0; s_ < 4; ++s_) qnx[s_] = *(const GAS bf16x8*)(proj + (rowb_ + qt_) * PROJW + 1024 + (D).hd * HDIM + 32 * s_ + 8 * g); } while (0)
    AT_ISSUE(nd);
    for (;;) {
        const AttnDesc d = nd;
#pragma unroll
        for (int it = 0; it < 8; ++it) { *(LAS v4u*)(lds + AT_K + soff + 8192 * it) = kr[it]; *(LAS v4u*)(lds + AT_V + soff + 8192 * it) = vr[it]; }
        bf16x8 qf[4];
#pragma unroll
        for (int s = 0; s < 4; ++s) qf[s] = qnx[s];
        __syncthreads();
        const int un = u + ustride; const bool has = un < uend;
        if (has) { nd = attn_decode(un); AT_ISSUE(nd); }
        const bool first = (d.blk == 0); const int tskip = first ? 8 - wave : 0;
        f32x4 sc[10];
#pragma unroll
        for (int kt = 0; kt < 10; ++kt) { f32x4 a = {0.f, 0.f, 0.f, 0.f};
            if (kt < 9 && kt >= tskip) {
#pragma unroll
                for (int s = 0; s < 4; ++s) { const bf16x8 kf = *(const LAS bf16x8*)(lds + AT_K + off_b(16 * (wave + kt) + qn, 4 * s + g));
                    a = __builtin_amdgcn_mfma_f32_16x16x32_bf16(kf, qf[s], a, 0, 0, 0); } }
            sc[kt] = a; }
        float mx = -1e30f;
#pragma unroll
        for (int kt = 0; kt < 10; ++kt)
#pragma unroll
            for (int r = 0; r < 4; ++r) { const int rel = 16 * kt + 4 * g + r; bool ok = (rel >= qn) && (rel <= qn + 128) && (kt >= tskip);
                sc[kt][r] = ok ? sc[kt][r] : -1e30f; mx = fmaxf(mx, sc[kt][r]); }
        mx = fmaxf(mx, __shfl_xor(mx, 16)); mx = fmaxf(mx, __shfl_xor(mx, 32));
        float ls = 0.f;
#pragma unroll
        for (int kt = 0; kt < 10; ++kt)
#pragma unroll
            for (int r = 0; r < 4; ++r) { const float p = (sc[kt][r] > -1e29f) ? __builtin_amdgcn_exp2f(sc[kt][r] - mx) : 0.f; sc[kt][r] = p; ls += p; }
        ls += __shfl_xor(ls, 16); ls += __shfl_xor(ls, 32);
        f32x4 o[8];
#pragma unroll
        for (int c = 0; c < 8; ++c) o[c] = (f32x4){0.f, 0.f, 0.f, 0.f};
#pragma unroll
        for (int ks = 0; ks < 5; ++ks) {
            if (2 * ks + 1 >= tskip) {
                union { unsigned uu[4]; bf16x8 v; } pb;
                pb.uu[0] = pk2(sc[2 * ks][0], sc[2 * ks][1]); pb.uu[1] = pk2(sc[2 * ks][2], sc[2 * ks][3]); pb.uu[2] = pk2(sc[2 * ks + 1][0], sc[2 * ks + 1][1]); pb.uu[3] = pk2(sc[2 * ks + 1][2], sc[2 * ks + 1][3]);
                const unsigned r0 = 16 * wave + 32 * ks + 4 * g + q4;
#pragma unroll
                for (int c = 0; c < 8; ++c) {
                    const s16x4 v0 = tr_read(lds + AT_V + off_b(r0, 2 * c + (p4 >> 1)) + 8 * (p4 & 1));
                    const s16x4 v1 = tr_read(lds + AT_V + off_b(r0 + 16, 2 * c + (p4 >> 1)) + 8 * (p4 & 1));
                    bf16x8 va; va[0] = v0[0]; va[1] = v0[1]; va[2] = v0[2]; va[3] = v0[3]; va[4] = v1[0]; va[5] = v1[1]; va[6] = v1[2]; va[7] = v1[3];
                    o[c] = __builtin_amdgcn_mfma_f32_16x16x32_bf16(va, pb.v, o[c], 0, 0, 0); } } }
        const float inv = 1.0f / ls;
        const size_t qrow = (size_t)d.b * SEQ + d.res + d.dil * (128 * d.blk + 16 * wave + qn);
        bf16* op = obr + (size_t)d.di * MTOK * ATTW + qrow * ATTW + d.hd * HDIM + 4 * g;
#pragma unroll
        for (int c = 0; c < 8; ++c) *(GAS v2u*)(op + 16 * c) = (v2u){pk2(o[c][0] * inv, o[c][1] * inv), pk2(o[c][2] * inv, o[c][3] * inv)};
        if (g == 0) lse[(size_t)d.di * MTOK * NHEAD + qrow * NHEAD + d.hd] = mx + __builtin_amdgcn_logf(ls);
        __syncthreads();
        if (!has) break;
        u = un;
    }
#undef AT_ISSUE
}

__device__ __forceinline__ void ynorm_phase(bf16* ycat, const bf16* obr, const float* lse, int lane, int wave) {
    for (int r = 0; r < 4; ++r) { const int row = pass_row_base() + wave * 4 + r;
        { bf16* p = ycat + (size_t)row * DM + lane * 16; const v4u a = *(const GAS v4u*)p, c = *(const GAS v4u*)(p + 8);
          float v[16] = {bf_lo(a.x), bf_hi(a.x), bf_lo(a.y), bf_hi(a.y), bf_lo(a.z), bf_hi(a.z), bf_lo(a.w), bf_hi(a.w), bf_lo(c.x), bf_hi(c.x), bf_lo(c.y), bf_hi(c.y), bf_lo(c.z), bf_hi(c.z), bf_lo(c.w), bf_hi(c.w)};
          float s = 0.f;
#pragma unroll
          for (int i = 0; i < 16; ++i) s += v[i] * v[i];
          const float rstd = 1.0f / sqrtf(wave_sum(s) * (1.0f / SSMW) + 1e-6f);
          *(GAS v4u*)p = (v4u){pk2(v[0] * rstd, v[1] * rstd), pk2(v[2] * rstd, v[3] * rstd), pk2(v[4] * rstd, v[5] * rstd), pk2(v[6] * rstd, v[7] * rstd)};
          *(GAS v4u*)(p + 8) = (v4u){pk2(v[8] * rstd, v[9] * rstd), pk2(v[10] * rstd, v[11] * rstd), pk2(v[12] * rstd, v[13] * rstd), pk2(v[14] * rstd, v[15] * rstd)}; }
        { const int hd = lane >> 3;
          const float l0 = lse[(size_t)row * NHEAD + hd], l1 = lse[(size_t)MTOK * NHEAD + (size_t)row * NHEAD + hd], l2 = lse[(size_t)2 * MTOK * NHEAD + (size_t)row * NHEAD + hd];
          const float lm = fmaxf(l0, fmaxf(l1, l2)); float w0 = __builtin_amdgcn_exp2f(l0 - lm), w1 = __builtin_amdgcn_exp2f(l1 - lm), w2 = __builtin_amdgcn_exp2f(l2 - lm);
          const float wi = 1.0f / (w0 + w1 + w2); w0 *= wi; w1 *= wi; w2 *= wi;
          float v[16];
#pragma unroll
          for (int i = 0; i < 16; ++i) v[i] = 0.f;
#pragma unroll
          for (int d = 0; d < 3; ++d) { const bf16* p = obr + (size_t)d * MTOK * ATTW + (size_t)row * ATTW + lane * 16; const v4u a = *(const GAS v4u*)p, c = *(const GAS v4u*)(p + 8); const float w = d == 0 ? w0 : d == 1 ? w1 : w2;
              v[0] += w * bf_lo(a.x); v[1] += w * bf_hi(a.x); v[2] += w * bf_lo(a.y); v[3] += w * bf_hi(a.y); v[4] += w * bf_lo(a.z); v[5] += w * bf_hi(a.z); v[6] += w * bf_lo(a.w); v[7] += w * bf_hi(a.w);
              v[8] += w * bf_lo(c.x); v[9] += w * bf_hi(c.x); v[10] += w * bf_lo(c.y); v[11] += w * bf_hi(c.y); v[12] += w * bf_lo(c.z); v[13] += w * bf_hi(c.z); v[14] += w * bf_lo(c.w); v[15] += w * bf_hi(c.w); }
          float s = 0.f;
#pragma unroll
          for (int i = 0; i < 16; ++i) s += v[i] * v[i];
          const float rstd = 1.0f / sqrtf(wave_sum(s) * (1.0f / ATTW) + 1e-6f);
          bf16* p = ycat + (size_t)row * DM + SSMW + lane * 16;
          *(GAS v4u*)p = (v4u){pk2(v[0] * rstd, v[1] * rstd), pk2(v[2] * rstd, v[3] * rstd), pk2(v[4] * rstd, v[5] * rstd), pk2(v[6] * rstd, v[7] * rstd)};
          *(GAS v4u*)(p + 8) = (v4u){pk2(v[8] * rstd, v[9] * rstd), pk2(v[10] * rstd, v[11] * rstd), pk2(v[12] * rstd, v[13] * rstd), pk2(v[14] * rstd, v[15] * rstd)}; } }
}
__device__ __forceinline__ void final_norm_phase(float* out, const float* gfin, int lane, int wave) {
    for (int r = 0; r < 4; ++r) { const int row = pass_row_base() + wave * 4 + r;
        f32x4* xr = (f32x4*)(out + (size_t)row * DM) + lane; f32x4 v[8]; float s = 0.f;
#pragma unroll
        for (int j = 0; j < 8; ++j) { v[j] = xr[64 * j]; s += (v[j].x * v[j].x + v[j].y * v[j].y) + (v[j].z * v[j].z + v[j].w * v[j].w); }
        const float rstd = 1.0f / sqrtf(wave_sum(s) * (1.0f / DM) + 1e-6f);
#pragma unroll
        for (int j = 0; j < 8; ++j) { const f32x4 gq = *((const f32x4*)gfin + lane + 64 * j); xr[64 * j] = v[j] * rstd * gq; } }
}

constexpr int NPH = 11;
constexpr int ATT_P3_UNITS = 512;
constexpr int IT_GEMV = KSPLIT * 48, IT_SSM = NGRP * 25, IT_FIN = 48 * 4, IT_ROPE = MTOK, IT_WIN = (DM / 64) * (PROJW / 64), IT_WGLU = (SSMW / 64) * (SSMW / 64), IT_WOUT = (DM / 64) * (DM / 64),
              IT_WG = (DM / 64) * (DFF / 64), IT_WD = (DFF / 64) * (DM / 64), IT_TOTAL = IT_GEMV + IT_SSM + IT_FIN + IT_ROPE + IT_WIN + IT_WGLU + IT_WOUT + 2 * IT_WG;
__global__ void __launch_bounds__(NWAVES * 64, 2) hymba_fwd(Args args) {
    extern __shared__ __attribute__((aligned(16))) unsigned char lds_raw[];
    LAS unsigned char* lds = (LAS unsigned char*)lds_raw;
    cg::grid_group grid = cg::this_grid();
    const int tid = threadIdx.x, lane = tid & 63, wave = __builtin_amdgcn_readfirstlane(tid >> 6);
    const int G = gridDim.x, bx = blockIdx.x;
    unsigned char* ws = args.ws;
    const float* const* in = args.in;
    float* modp = (float*)(ws + WS_MODP); float* modf = (float*)(ws + WS_MODF); float* cosT = (float*)(ws + WS_ROPE); float* sinT = cosT + (size_t)MTOK * 64;
    bf16* ktab = (bf16*)(ws + WS_KTAB); bf16* gtab = (bf16*)(ws + WS_GTAB); bf16* htab = (bf16*)(ws + WS_HTAB); float* a64 = (float*)(ws + WS_A64);
    bf16* Win = (bf16*)(ws + WS_WIN); bf16* Wglu = (bf16*)(ws + WS_WGLU); bf16* Wout = (bf16*)(ws + WS_WOUT); bf16* Wgu = (bf16*)(ws + WS_WGU); bf16* Wdn = (bf16*)(ws + WS_WDN);
    bf16* Hb = (bf16*)(ws + WS_H); bf16* proj = (bf16*)(ws + WS_PROJ); bf16* vg = (bf16*)(ws + WS_VG); bf16* ycat = (bf16*)(ws + WS_YCAT); bf16* obr = (bf16*)(ws + WS_OBR); float* lse = (float*)(ws + WS_LSE);
    bf16* ff = (bf16*)(ws + WS_FF); bf16* ut = (bf16*)(ws + WS_UT);
    const int lo = args.ph_lo, hi = args.ph_hi;
#ifndef PHMASK
#define PHMASK 0x7ff
#endif
#define IN(k) (((PHMASK >> (k)) & 1) && lo <= (k) && (k) < hi)
    volatile LAS unsigned* MISC = (volatile LAS unsigned*)(lds + MISC_OFF);
    if (tid < 2) MISC[tid] = 0u;
    __syncthreads();
    if (args.ph_lo < 0) grid.sync();
    const XcdBarrier xbar = xcd_barrier_post((unsigned*)(ws + WS_CTL), MISC);
    STAMP(0);
#define SEAM(k) do { if (IN(k) && IN((k) + 1)) xcd_barrier(xbar); } while (0)
#ifndef DOUBLE_MASK
#define DOUBLE_MASK 0
#endif
#define P0SUB 8
#define P3SUB 1
#define REPS(k) for (int rep_ = 0; rep_ < 1 + ((DOUBLE_MASK >> (k)) & 1); ++rep_)
#define RSYNC(k) do { if ((DOUBLE_MASK >> (k)) & 1) xcd_barrier(xbar); } while (0)

    REPS(0) if (IN(0)) {
        RSYNC(0);
        LAS float* scr = (LAS float*)(lds + wave * 16640);
        const int gw = wave * G + bx, NGW = G * NWAVES;
        const int nmine = (IT_TOTAL - gw + NGW - 1) / NGW;
        for (int kk = 0; kk < nmine; ++kk) {
            const bool gfirst = (gw < IT_GEMV);
            const int it = gw + ((wave & 1) ? ((gfirst && kk == 0) ? 0 : (gfirst ? nmine - kk : nmine - 1 - kk)) : kk) * NGW;
            int r = it;
#if DOUBLE_MASK & 1
            if (rep_ == 1) { const int ty = (it < IT_GEMV) ? 1 : (it < IT_GEMV + IT_SSM) ? 2 : (it < IT_GEMV + IT_SSM + IT_ROPE) ? 4 : 8; if (!(P0SUB & ty)) continue; }
#endif
            if (r < IT_GEMV) { p0_gemv_item(in[1], in[3], modp, modf, in[4], (unsigned*)(ws + WS_CNT), scr, r, lane); continue; } r -= IT_GEMV;
            if (r < IT_SSM) { const int g = r / 25, sub = r % 25;
                if (sub < 9) p0_ktab_item(in, ktab, a64, scr, g, sub, lane); else if (sub < 17) p0_gtab_item(in, gtab, g, sub - 9, lane); else p0_htab_item(in, htab, g, sub - 17, lane);
                continue; } r -= IT_SSM;
            if (r < IT_FIN) { p0_fin_item(modp, modf, in[4], (unsigned*)(ws + WS_CNT), r, lane); continue; } r -= IT_FIN;
            if (r < IT_ROPE) { p0_rope_item((const int*)in[2], cosT, sinT, r, lane); continue; } r -= IT_ROPE;
            if (r < IT_WIN) { p0_transpose_item<1>(in[6], DM, PROJW, Win, scr, r, lane, nullptr, nullptr); continue; } r -= IT_WIN;
            if (r < IT_WGLU) { p0_transpose_item<0>(in[15], SSMW, SSMW, Wglu, scr, r, lane, nullptr, nullptr); continue; } r -= IT_WGLU;
            if (r < IT_WOUT) { p0_transpose_item<4>(in[19], DM, DM, Wout, scr, r, lane, in[17], in[18]); continue; } r -= IT_WOUT;
            if (r < IT_WG) { p0_transpose_item<2>(in[21], DM, DFF, Wgu, scr, r, lane, nullptr, nullptr); continue; } r -= IT_WG;
            p0_transpose_item<3>(in[22], DM, DFF, Wgu, scr, r, lane, nullptr, nullptr);
        }
        __syncthreads();
    }
    STAMP(1); STAMP(2);
    REPS(1) if (IN(1)) {
        RSYNC(1);
        unsigned* gcnt = (unsigned*)(ws + WS_CNT);
        if (wave == 0) { unsigned sp = 0u; unsigned* dn = gcnt + 64 * 48;
            while ((unsigned)__builtin_amdgcn_readfirstlane((int)__hip_atomic_load(dn, __ATOMIC_RELAXED, __HIP_MEMORY_SCOPE_AGENT)) < 192u) { __builtin_amdgcn_s_sleep(4); if (++sp > (1u << 22)) break; }
            __builtin_amdgcn_fence(__ATOMIC_ACQUIRE, "agent"); asm volatile("s_waitcnt vmcnt(0)" ::: "memory"); }
        __syncthreads();
        modnorm_phase<false>(lds, in[0], Hb, in[5], modp, in[4], modf, 0, 1, tid, lane, wave);
    }
    STAMP(3); SEAM(1); STAMP(4);
    if (IN(2)) {
        pg8::Gemm g{Hb, Win, MTOK, PROJW, DM}; pg8::StaticOrder S; S.init(MTOK, PROJW, G, bx);
        pg8::EpiProj E{proj, ut, cosT, sinT, 0.08838834764831845f * 1.4426950408889634f};
        pg8::gemm_phase<pg8::EpiProj, pg8::StaticOrder, true, true>(lds, g, S, E);
    }
    STAMP(5); SEAM(2); STAMP(6);
    REPS(3) if (IN(3)) {
        RSYNC(3);
        int tid = threadIdx.x; asm volatile("" : "+v"(tid)); const int lane = tid & 63, wave = __builtin_amdgcn_readfirstlane(tid >> 6);
#if DOUBLE_MASK & 8
        if (rep_ == 0 || (P3SUB & 1))
#endif
        for (int u0 = bx; u0 < BATCH * NGRP; u0 += G) { const int u = ((u0 & 7) * 32 + ((u0 >> 3) & 31)) + (u0 & ~255);
            ssm_unit(lds, u / NGRP, u % NGRP, ut, ktab, gtab, htab, a64, in[14], vg, tid, lane, wave); }
        STAMP(7);
#if DOUBLE_MASK & 8
        if (rep_ == 0 || (P3SUB & 2))
#endif
        { const int ax = 192 * (bx & 7), aj = bx >> 3;
          attn_run(lds, ax + aj, 32, ax + 64, proj, obr, lse, tid, lane, wave); }
    }
    STAMP(8); SEAM(3); STAMP(9);
    if (IN(4)) {
        pg8::Gemm g{vg, Wglu, MTOK, SSMW, SSMW}; pg8::StaticOrder S; S.init(MTOK, SSMW, G, bx);
        pg8::EpiGlu E{ycat, vg, in[16]};
        pg8::gemm_phase<pg8::EpiGlu, pg8::StaticOrder, true, true>(lds, g, S, E);
        STAMP(10);
        { int tid = threadIdx.x; asm volatile("" : "+v"(tid)); const int lane = tid & 63, wave = __builtin_amdgcn_readfirstlane(tid >> 6);
          const bool glu = bx < 128; const int ax = 192 * (bx & 7), aj = bx >> 3;
          attn_run(lds, glu ? ax + 64 + aj : ax + 80 + (aj - 16), 16, glu ? ax + 80 : ax + 192, proj, obr, lse, tid, lane, wave); }
    }
    STAMP(11); SEAM(4); STAMP(12);
    REPS(5) if (IN(5)) ynorm_phase(ycat, obr, lse, lane, wave);
    STAMP(13); SEAM(5); STAMP(14);
    if (IN(6)) {
        pg8::Gemm g{ycat, Wout, MTOK, DM, DM}; pg8::StaticOrder S; S.init(MTOK, DM, G, bx);
        pg8::EpiNormX<0> E{in[0], args.out, Hb, modf + 2 * DM, in[20], modf + 4 * DM, modf + 3 * DM, (float*)(ws + WS_SLOTS), (unsigned*)(ws + WS_PCNT)};
        pg8::gemm_phase<pg8::EpiNormX<0>, pg8::StaticOrder, false, true>(lds, g, S, E);
    }
    STAMP(15); SEAM(6); STAMP(16);
    if (IN(8)) {
        pg8::Gemm g{Hb, Wgu, MTOK, 2 * DFF, DM}; pg8::StaticOrder S; S.init(MTOK, 2 * DFF, G, bx);
        pg8::EpiSwiglu E{ff};
        pg8::gemm_phase<pg8::EpiSwiglu, pg8::StaticOrder, true, true>(lds, g, S, E);
        if (bx >= 128) { int tid2 = threadIdx.x; asm volatile("" : "+v"(tid2)); const int lane2 = tid2 & 63, wave2 = __builtin_amdgcn_readfirstlane(tid2 >> 6);
            LAS float* scr = (LAS float*)(lds + wave2 * 16640);
            for (int it = (bx - 128) * NWAVES + wave2; it < IT_WD; it += 128 * NWAVES) p0_transpose_item<0>(in[23], DFF, DM, Wdn, scr, it, lane2, nullptr, nullptr); }
    }
    STAMP(19); SEAM(8); STAMP(20);
    if (IN(9)) {
        pg8::Gemm g{ff, Wdn, MTOK, DM, DFF}; pg8::StaticOrder S; S.init(MTOK, DM, G, bx);
        pg8::EpiNormX<1> E{args.out, args.out, nullptr, modf + 5 * DM, in[24], nullptr, nullptr, (float*)(ws + WS_SLOTS) + 65536, (unsigned*)(ws + WS_PCNT) + 32 * 64};
        pg8::gemm_phase<pg8::EpiNormX<1>, pg8::StaticOrder, false, true>(lds, g, S, E);
    }
    STAMP(21); STAMP(22);
    if (TS_A >= 0 && bx == 0) { STAMP(23); __syncthreads();
        const volatile LAS unsigned long long* ts = (const volatile LAS unsigned long long*)(lds + MISC_OFF + 16);
        unsigned long long tot = 0ull;
        for (int i = 0; i < 23; ++i) if ((TS_MASK >> i) & 1) tot += ts[i + 1] - ts[i];
        if (TS_X >= 0) tot = ts[TS_Y < 0 ? 0 : TS_Y] - ts[TS_X < 0 ? 0 : TS_X];
        const float dl = (float)tot * TS_SCALE;
        for (int i = threadIdx.x; i < 4096; i += NWAVES * 64) args.out[i] += dl; }
#undef IN
#undef SEAM
}

#ifndef MK_PER_PHASE
#define MK_PER_PHASE 0
#endif
extern "C" void kernel_launch(void* const* d_in, const int* in_sizes, int n_in, void* d_out, int out_size, void* d_ws, size_t ws_size, hipStream_t stream) {
    static int ready = 0;
    if (ready == 0) {
        ready = 1;
        if (n_in != 25 || out_size != MTOK * DM || ws_size < WS_END) { fprintf(stderr, "kernel_launch: unexpected shapes (n_in %d out %d ws %zu)\n", n_in, out_size, ws_size); ready = -1; }
        else if (hipFuncSetAttribute((const void*)hymba_fwd, hipFuncAttributeMaxDynamicSharedMemorySize, LDS_BYTES) != hipSuccess) { fprintf(stderr, "kernel_launch: hipFuncSetAttribute failed\n"); ready = -1; }
        else { int per_cu = 0; (void)hipOccupancyMaxActiveBlocksPerMultiprocessor(&per_cu, (const void*)hymba_fwd, NWAVES * 64, LDS_BYTES); (void)hipGetLastError();
               if (per_cu < 1) fprintf(stderr, "kernel_launch: occupancy query reports %d blocks per CU\n", per_cu); }
    }
    if (ready < 0) return;
    if (hipMemsetAsync((char*)d_ws + WS_CTL, 0, CTL_ZERO_BYTES, stream) != hipSuccess) { fprintf(stderr, "kernel_launch: memset failed\n"); return; }
    Args a{};
    for (int i = 0; i < 25; ++i) a.in[i] = (const float*)d_in[i];
    a.out = (float*)d_out; a.ws = (unsigned char*)d_ws;
#if MK_PER_PHASE
    for (int p = 0; p < NPH; ++p) { a.ph_lo = p; a.ph_hi = p + 1; hipLaunchKernelGGL(hymba_fwd, dim3(256), dim3(NWAVES * 64), LDS_BYTES, stream, a); }
#else
    a.ph_lo = 0; a.ph_hi = NPH;
    void* kargs[] = {&a};
    hipError_t e = hipLaunchCooperativeKernel((const void*)hymba_fwd, dim3(256), dim3(NWAVES * 64), kargs, LDS_BYTES, stream);
    if (e != hipSuccess) fprintf(stderr, "kernel_launch: cooperative launch failed: %s\n", hipGetErrorString(e));
#endif
}
```

```cpp
#include <hip/hip_runtime.h>
#include <hip/hip_cooperative_groups.h>
#include <cstdio>
#include <cstdint>
namespace cg = cooperative_groups;
namespace pg8 {
#define PG8_LAS __attribute__((address_space(3)))
typedef unsigned short bf16_t;
typedef short bf16x8 __attribute__((ext_vector_type(8)));
typedef float f32x4 __attribute__((ext_vector_type(4)));
typedef unsigned u32x4 __attribute__((ext_vector_type(4)));
constexpr int BM = 256, BK = 64, HALF = 128, HTB = HALF * BK * 2  , STAGE_BYTES = 8 * HTB, NXCD = 8, WGM = 8;

__host__ __device__ __forceinline__ int lds_byte(int r, int c) { const int st = (r >> 4) * 2 + (c >> 5), rr = r & 15, cc = c & 31, ob = rr * 64 + cc * 2; return st * 1024 + (ob ^ (((ob >> 9) & 1) << 5)); }
__host__ __device__ __forceinline__ void stage_rc(int b, int& R, int& C) { const int st = b / 1024, sb = b % 1024, swz = sb ^ (((sb >> 9) & 1) << 5); R = (st >> 1) * 16 + swz / 64; C = (st & 1) * 32 + (swz % 64) / 2; }
__host__ __device__ __forceinline__ int perm32(int rho) { const int n = rho >> 4, i = rho & 15; return 8 * (i >> 2) + 4 * n + (i & 3); }

struct Unit { int pm, pn; };
struct Gemm { const bf16_t* A; const bf16_t* Bt; int M, N, K; };

struct StaticOrder {
    int nM, nN, nwg, G, c;
    __host__ __device__ void init(int M, int N, int G_, int c_) { nM = M / BM; nN = N / BM; nwg = nM * nN; G = G_; c = c_; }
    __host__ __device__ bool next(int i, Unit& u) const {
        const long L = (long)i * G + c; if (L >= nwg) return false;
        int wgid = (int)L; { const int q = nwg / NXCD, r = nwg % NXCD, xcd = wgid % NXCD, off = wgid / NXCD; wgid = (xcd < r ? xcd * (q + 1) : r * (q + 1) + (xcd - r) * q) + off; }
        const int nig = WGM * nN, gid = wgid / nig, fm = gid * WGM, gsz = (nM - fm) < WGM ? (nM - fm) : WGM;
        u.pm = fm + ((wgid % nig) % gsz); u.pn = (wgid % nig) / gsz; return true;
    }
    __device__ __forceinline__ void a_ready(const Unit&) const {}
    __device__ __forceinline__ void done(const Unit&) const {}
};

__device__ __forceinline__ unsigned cvt_pk_bf16(float lo, float hi) { unsigned r; asm volatile("v_cvt_pk_bf16_f32 %0, %1, %2" : "=v"(r) : "v"(lo), "v"(hi)); return r; }
typedef float f32x2 __attribute__((ext_vector_type(2)));
__device__ __forceinline__ f32x2 gelu_pk(f32x2 v) {
    const f32x2 av = __builtin_elementwise_abs(v), d = av * 0.2316418882f + 1.0f;
    f32x2 t; t.x = __builtin_amdgcn_rcpf(d.x); t.y = __builtin_amdgcn_rcpf(d.y);
    f32x2 q = t * 0.5307027145f + (-0.7265760135f); q = q * t + 0.7107068705f; q = q * t + (-0.142248368f); q = q * t + 0.127414796f; q = q * t;
    const f32x2 s = (v * v) * (-0.72134752044f);
    f32x2 e; e.x = __builtin_amdgcn_exp2f(s.x); e.y = __builtin_amdgcn_exp2f(s.y);
    const f32x2 m = v * (q * e), r = v - m;
    f32x2 o; o.x = v.x < 0.f ? m.x : r.x; o.y = v.y < 0.f ? m.y : r.y; return o;
}

__device__ __forceinline__ float bflo(unsigned w) { return __uint_as_float(w << 16); }
__device__ __forceinline__ float bfhi(unsigned w) { return __uint_as_float(w & 0xffff0000u); }
__device__ __forceinline__ float fast_sigmoid(float v) { return __builtin_amdgcn_rcpf(1.0f + __builtin_amdgcn_exp2f(-1.4426950408889634f * v)); }
struct EpiProj {
    static constexpr bool PERM = true, AFTER_DRAIN = false;
    bf16_t* O; bf16_t* UT; const float* cosT; const float* sinT; float qscale;
    __device__ __forceinline__ void operator()(const f32x4 (&acc)[2][2][4][2], const Unit& u, int wr, int wc, int fr, int fq) const {
        const int row0 = u.pm * BM + wr * 64 + fr; const int col0 = u.pn * BM + wc * 32 + 8 * fq;
        const int sect = u.pn >> 2;
        const int j0 = 4 * (4 * wc + fq);
        const float sc = (sect == 1) ? qscale : 1.f;
#pragma unroll
        for (int ai = 0; ai < 2; ++ai)
#pragma unroll
            for (int m = 0; m < 4; ++m) { const int row = row0 + ai * HALF + m * 16; bf16_t* rowp = O + (size_t)row * 4096 + col0;
                f32x4 cs = (f32x4){1.f, 1.f, 1.f, 1.f}, sn = (f32x4){0.f, 0.f, 0.f, 0.f};
                if (sect == 1 || sect == 2) { cs = *(const f32x4*)(cosT + (size_t)row * 64 + j0); sn = *(const f32x4*)(sinT + (size_t)row * 64 + j0); }
#pragma unroll
                for (int bj = 0; bj < 2; ++bj) { const f32x4 t1 = acc[ai][bj][m][0], t2 = acc[ai][bj][m][1];
                    f32x4 v0 = (t1 * cs - t2 * sn) * sc, v1 = (t1 * sn + t2 * cs) * sc;
                    u32x4 w; w.x = cvt_pk_bf16(v0[0], v0[1]); w.y = cvt_pk_bf16(v0[2], v0[3]); w.z = cvt_pk_bf16(v1[0], v1[1]); w.w = cvt_pk_bf16(v1[2], v1[3]);
                    if (sect == 0) { const int col = col0 + bj * HALF; *(u32x4*)(UT + ((size_t)((row >> 11) * 64 + (col >> 4)) * 2048 + (row & 2047)) * 16 + (col & 15)) = w; }
                    else *(u32x4*)(rowp + bj * HALF) = w; } }
    }
};
struct EpiGlu {
    static constexpr bool PERM = true, AFTER_DRAIN = false;
    bf16_t* O; const bf16_t* VG; const float* bias;
    __device__ __forceinline__ void operator()(const f32x4 (&acc)[2][2][4][2], const Unit& u, int wr, int wc, int fr, int fq) const {
        const int row0 = u.pm * BM + wr * 64 + fr; const int col0 = u.pn * BM + wc * 32 + 8 * fq;
        f32x4 bv[2][2];
#pragma unroll
        for (int bj = 0; bj < 2; ++bj)
#pragma unroll
            for (int n = 0; n < 2; ++n) bv[bj][n] = *(const f32x4*)(bias + col0 + bj * HALF + 4 * n);
#pragma unroll
        for (int ai = 0; ai < 2; ++ai)
#pragma unroll
            for (int m = 0; m < 4; ++m) { const int row = row0 + ai * HALF + m * 16;
#pragma unroll
                for (int bj = 0; bj < 2; ++bj) { const u32x4 g = *(const u32x4*)(VG + (size_t)row * 1024 + col0 + bj * HALF);
                    const f32x4 a0 = acc[ai][bj][m][0] + bv[bj][0], a1 = acc[ai][bj][m][1] + bv[bj][1];
                    u32x4 w; w.x = cvt_pk_bf16(bflo(g.x) * fast_sigmoid(a0[0]), bfhi(g.x) * fast_sigmoid(a0[1])); w.y = cvt_pk_bf16(bflo(g.y) * fast_sigmoid(a0[2]), bfhi(g.y) * fast_sigmoid(a0[3]));
                    w.z = cvt_pk_bf16(bflo(g.z) * fast_sigmoid(a1[0]), bfhi(g.z) * fast_sigmoid(a1[1])); w.w = cvt_pk_bf16(bflo(g.w) * fast_sigmoid(a1[2]), bfhi(g.w) * fast_sigmoid(a1[3]));
                    *(u32x4*)(O + (size_t)row * 2048 + col0 + bj * HALF) = w; } }
    }
};
struct EpiResid {
    static constexpr bool PERM = false, AFTER_DRAIN = false;
    const float* base; float* out; const float* gate;
    __device__ __forceinline__ void operator()(const f32x4 (&acc)[2][2][4][2], const Unit& u, int wr, int wc, int fr, int fq) const {
        const int col0 = u.pn * BM + wc * 32 + 4 * fq; const int b = u.pm >> 3;
        f32x4 gv[2][2];
#pragma unroll
        for (int bj = 0; bj < 2; ++bj)
#pragma unroll
            for (int n = 0; n < 2; ++n) gv[bj][n] = *(const f32x4*)(gate + (size_t)b * 12288 + col0 + bj * HALF + n * 16);
#pragma unroll
        for (int ai = 0; ai < 2; ++ai)
#pragma unroll
            for (int m = 0; m < 4; ++m) { const size_t off = (size_t)(u.pm * BM + ai * HALF + wr * 64 + m * 16 + fr) * 2048 + col0;
#pragma unroll
                for (int bj = 0; bj < 2; ++bj)
#pragma unroll
                    for (int n = 0; n < 2; ++n) { const f32x4 bs = *(const f32x4*)(base + off + bj * HALF + n * 16);
                        *(f32x4*)(out + off + bj * HALF + n * 16) = bs + gv[bj][n] * acc[ai][bj][m][n]; } }
    }
};
template <int MODE> struct EpiNormX {
    static constexpr bool PERM = true, AFTER_DRAIN = true;
    const float* base; float* xout; bf16_t* hout; const float* gate; const float* gvec; const float* scv; const float* shv; float* slots; unsigned* cnt;
    __device__ __forceinline__ void fused(f32x4 (&acc)[2][2][4][2], const Unit& u, int wr, int wc, int fr, int fq, PG8_LAS unsigned char* lds, int wid, int lane) const {
        PG8_LAS float* P = (PG8_LAS float*)lds; PG8_LAS float* S = (PG8_LAS float*)(lds + 8192); PG8_LAS unsigned* flag = (PG8_LAS unsigned*)(lds + 8192 + 2048);
        const int col0 = u.pn * BM + wc * 32 + 8 * fq; const int b = u.pm >> 3; const int tid = wid * 64 + lane;
        { f32x4 gv[2][2];
#pragma unroll
          for (int bj = 0; bj < 2; ++bj)
#pragma unroll
              for (int n = 0; n < 2; ++n) gv[bj][n] = *(const f32x4*)(gate + (size_t)b * 12288 + col0 + bj * HALF + 4 * n);
#pragma unroll
          for (int ai = 0; ai < 2; ++ai)
#pragma unroll
              for (int m = 0; m < 4; ++m) { const int r = ai * HALF + wr * 64 + m * 16 + fr; const size_t off = (size_t)(u.pm * BM + r) * 2048 + col0; float sq = 0.f;
#pragma unroll
                  for (int bj = 0; bj < 2; ++bj)
#pragma unroll
                      for (int n = 0; n < 2; ++n) { const f32x4 bs = __builtin_nontemporal_load((const f32x4*)(base + off + bj * HALF + 4 * n)); const f32x4 v = bs + gv[bj][n] * acc[ai][bj][m][n]; acc[ai][bj][m][n] = v;
                          sq += (v[0] * v[0] + v[1] * v[1]) + (v[2] * v[2] + v[3] * v[3]); }
                  sq += __shfl_xor(sq, 16); sq += __shfl_xor(sq, 32);
                  if (fq == 0) P[r * 4 + wc] = sq;
                  if (m & 1) asm volatile("" ::: "memory"); } }
        asm volatile("s_waitcnt lgkmcnt(0)" ::: "memory"); __builtin_amdgcn_s_barrier(); asm volatile("" ::: "memory");
        if (tid < 256) { const float tot = (P[tid * 4 + 0] + P[tid * 4 + 1]) + (P[tid * 4 + 2] + P[tid * 4 + 3]);
            unsigned* sl = (unsigned*)slots + ((size_t)(u.pm * 8 + u.pn) * 256 + tid);
            __hip_atomic_store(sl, __float_as_uint(tot), __ATOMIC_RELAXED, __HIP_MEMORY_SCOPE_AGENT);
            asm volatile("s_waitcnt vmcnt(0)" ::: "memory");
            const unsigned rb = __hip_atomic_load(sl, __ATOMIC_RELAXED, __HIP_MEMORY_SCOPE_AGENT);
            asm volatile("s_waitcnt vmcnt(0)" :: "v"(rb) : "memory"); }
        asm volatile("s_waitcnt vmcnt(0)" ::: "memory");
        if (wid < 4 && lane == 0) __hip_atomic_fetch_add(cnt + 64 * u.pm, 1u, __ATOMIC_RELAXED, __HIP_MEMORY_SCOPE_AGENT);
        if (wid == 0) { unsigned sp = 0u;
            while ((unsigned)__builtin_amdgcn_readfirstlane((int)__hip_atomic_load(cnt + 64 * u.pm, __ATOMIC_RELAXED, __HIP_MEMORY_SCOPE_AGENT)) < 32u) { __builtin_amdgcn_s_sleep(2); if (++sp > (1u << 22)) break; }
            if (lane == 0) flag[0] = sp; }
        asm volatile("s_waitcnt vmcnt(0) lgkmcnt(0)" ::: "memory"); __builtin_amdgcn_s_barrier(); asm volatile("" ::: "memory");
        if (tid < 256) { float tot = 0.f;
#pragma unroll
            for (int t = 0; t < 8; ++t) tot += __uint_as_float(__hip_atomic_load((unsigned*)slots + ((size_t)(u.pm * 8 + t) * 256 + tid), __ATOMIC_RELAXED, __HIP_MEMORY_SCOPE_AGENT));
            S[tid] = 1.0f / sqrtf(tot * (1.0f / 2048.0f) + 1e-6f); }
        asm volatile("s_waitcnt vmcnt(0) lgkmcnt(0)" ::: "memory"); __builtin_amdgcn_s_barrier(); asm volatile("" ::: "memory");
        f32x4 ga[2][2], sh[2][2];
#pragma unroll
        for (int bj = 0; bj < 2; ++bj)
#pragma unroll
            for (int n = 0; n < 2; ++n) { const int c = col0 + bj * HALF + 4 * n; ga[bj][n] = *(const f32x4*)(gvec + c);
                if (MODE == 0) { ga[bj][n] = ga[bj][n] * (*(const f32x4*)(scv + (size_t)b * 12288 + c) + 1.0f); sh[bj][n] = *(const f32x4*)(shv + (size_t)b * 12288 + c); } }
#pragma unroll
        for (int ai = 0; ai < 2; ++ai)
#pragma unroll
            for (int m = 0; m < 4; ++m) { const int r = ai * HALF + wr * 64 + m * 16 + fr; const size_t off = (size_t)(u.pm * BM + r) * 2048 + col0; const float rstd = S[r];
#pragma unroll
                for (int bj = 0; bj < 2; ++bj) { const f32x4 v0 = acc[ai][bj][m][0], v1 = acc[ai][bj][m][1];
                    if (MODE == 0) { *(f32x4*)(xout + off + bj * HALF) = v0; *(f32x4*)(xout + off + bj * HALF + 4) = v1;
                        const f32x4 h0 = v0 * rstd * ga[bj][0] + sh[bj][0], h1 = v1 * rstd * ga[bj][1] + sh[bj][1];
                        u32x4 w; w.x = cvt_pk_bf16(h0[0], h0[1]); w.y = cvt_pk_bf16(h0[2], h0[3]); w.z = cvt_pk_bf16(h1[0], h1[1]); w.w = cvt_pk_bf16(h1[2], h1[3]);
                        *(u32x4*)(hout + off + bj * HALF) = w; }
                    else { *(f32x4*)(xout + off + bj * HALF) = v0 * rstd * ga[bj][0]; *(f32x4*)(xout + off + bj * HALF + 4) = v1 * rstd * ga[bj][1]; } }
                asm volatile("" ::: "memory"); }
    }
};
struct EpiGluNorm {
    static constexpr bool PERM = true, AFTER_DRAIN = true;
    bf16_t* O; const bf16_t* VG; const float* bias; float* slots; unsigned* cnt;
    __device__ __forceinline__ void fused(f32x4 (&acc)[2][2][4][2], const Unit& u, int wr, int wc, int fr, int fq, PG8_LAS unsigned char* lds, int wid, int lane) const {
        PG8_LAS float* P = (PG8_LAS float*)lds; PG8_LAS float* S = (PG8_LAS float*)(lds + 8192); PG8_LAS unsigned* flag = (PG8_LAS unsigned*)(lds + 8192 + 2048);
        const int col0 = u.pn * BM + wc * 32 + 8 * fq; const int tid = wid * 64 + lane;
        { f32x4 bv[2][2];
#pragma unroll
          for (int bj = 0; bj < 2; ++bj)
#pragma unroll
              for (int n = 0; n < 2; ++n) bv[bj][n] = *(const f32x4*)(bias + col0 + bj * HALF + 4 * n);
#pragma unroll
          for (int ai = 0; ai < 2; ++ai)
#pragma unroll
              for (int m = 0; m < 4; ++m) { const int r = ai * HALF + wr * 64 + m * 16 + fr; const size_t row = (size_t)(u.pm * BM + r); float sq = 0.f;
#pragma unroll
                  for (int bj = 0; bj < 2; ++bj) { const u32x4 g = *(const u32x4*)(VG + row * 1024 + col0 + bj * HALF);
                      const f32x4 a0 = acc[ai][bj][m][0] + bv[bj][0], a1 = acc[ai][bj][m][1] + bv[bj][1];
                      const f32x4 v0 = {bflo(g.x) * fast_sigmoid(a0[0]), bfhi(g.x) * fast_sigmoid(a0[1]), bflo(g.y) * fast_sigmoid(a0[2]), bfhi(g.y) * fast_sigmoid(a0[3])};
                      const f32x4 v1 = {bflo(g.z) * fast_sigmoid(a1[0]), bfhi(g.z) * fast_sigmoid(a1[1]), bflo(g.w) * fast_sigmoid(a1[2]), bfhi(g.w) * fast_sigmoid(a1[3])};
                      acc[ai][bj][m][0] = v0; acc[ai][bj][m][1] = v1;
                      sq += ((v0[0] * v0[0] + v0[1] * v0[1]) + (v0[2] * v0[2] + v0[3] * v0[3])) + ((v1[0] * v1[0] + v1[1] * v1[1]) + (v1[2] * v1[2] + v1[3] * v1[3])); }
                  sq += __shfl_xor(sq, 16); sq += __shfl_xor(sq, 32);
                  if (fq == 0) P[r * 4 + wc] = sq;
                  if (m & 1) asm volatile("" ::: "memory"); } }
        asm volatile("s_waitcnt lgkmcnt(0)" ::: "memory"); __builtin_amdgcn_s_barrier(); asm volatile("" ::: "memory");
        if (tid < 256) { const float tot = (P[tid * 4 + 0] + P[tid * 4 + 1]) + (P[tid * 4 + 2] + P[tid * 4 + 3]);
            unsigned* sl = (unsigned*)slots + ((size_t)(u.pm * 4 + u.pn) * 256 + tid);
            __hip_atomic_store(sl, __float_as_uint(tot), __ATOMIC_RELAXED, __HIP_MEMORY_SCOPE_AGENT);
            asm volatile("s_waitcnt vmcnt(0)" ::: "memory");
            const unsigned rb = __hip_atomic_load(sl, __ATOMIC_RELAXED, __HIP_MEMORY_SCOPE_AGENT);
            asm volatile("s_waitcnt vmcnt(0)" :: "v"(rb) : "memory"); }
        asm volatile("s_waitcnt vmcnt(0)" ::: "memory");
        if (wid < 4 && lane == 0) __hip_atomic_fetch_add(cnt + 64 * u.pm, 1u, __ATOMIC_RELAXED, __HIP_MEMORY_SCOPE_AGENT);
        if (wid == 0) { unsigned sp = 0u;
            while ((unsigned)__builtin_amdgcn_readfirstlane((int)__hip_atomic_load(cnt + 64 * u.pm, __ATOMIC_RELAXED, __HIP_MEMORY_SCOPE_AGENT)) < 16u) { __builtin_amdgcn_s_sleep(2); if (++sp > (1u << 22)) break; }
            __builtin_amdgcn_fence(__ATOMIC_ACQUIRE, "agent");
            if (lane == 0) flag[0] = sp; }
        asm volatile("s_waitcnt vmcnt(0) lgkmcnt(0)" ::: "memory"); __builtin_amdgcn_s_barrier(); asm volatile("" ::: "memory");
        if (tid < 256) { float tot = 0.f;
#pragma unroll
            for (int t = 0; t < 4; ++t) tot += __uint_as_float(__hip_atomic_load((unsigned*)slots + ((size_t)(u.pm * 4 + t) * 256 + tid), __ATOMIC_RELAXED, __HIP_MEMORY_SCOPE_AGENT));
            S[tid] = 1.0f / sqrtf(tot * (1.0f / 1024.0f) + 1e-6f); }
        asm volatile("s_waitcnt vmcnt(0) lgkmcnt(0)" ::: "memory"); __builtin_amdgcn_s_barrier(); asm volatile("" ::: "memory");
#pragma unroll
        for (int ai = 0; ai < 2; ++ai)
#pragma unroll
            for (int m = 0; m < 4; ++m) { const int r = ai * HALF + wr * 64 + m * 16 + fr; const size_t row = (size_t)(u.pm * BM + r); const float rstd = S[r];
#pragma unroll
                for (int bj = 0; bj < 2; ++bj) { const f32x4 v0 = acc[ai][bj][m][0] * rstd, v1 = acc[ai][bj][m][1] * rstd;
                    u32x4 w; w.x = cvt_pk_bf16(v0[0], v0[1]); w.y = cvt_pk_bf16(v0[2], v0[3]); w.z = cvt_pk_bf16(v1[0], v1[1]); w.w = cvt_pk_bf16(v1[2], v1[3]);
                    *(u32x4*)(O + row * 2048 + col0 + bj * HALF) = w; } }
    }
};
struct EpiSwiglu {
    static constexpr bool PERM = true, AFTER_DRAIN = false;
    bf16_t* O;
    __device__ __forceinline__ void operator()(const f32x4 (&acc)[2][2][4][2], const Unit& u, int wr, int wc, int fr, int fq) const {
        const int row0 = u.pm * BM + wr * 64 + fr; const int col0 = u.pn * HALF + wc * 32 + 8 * fq;
#pragma unroll
        for (int ai = 0; ai < 2; ++ai)
#pragma unroll
            for (int m = 0; m < 4; ++m) { const int row = row0 + ai * HALF + m * 16;
                const f32x4 g0 = acc[ai][0][m][0], g1 = acc[ai][0][m][1], u0 = acc[ai][1][m][0], u1 = acc[ai][1][m][1];
                f32x4 v0, v1;
#pragma unroll
                for (int i = 0; i < 4; ++i) { v0[i] = g0[i] * fast_sigmoid(g0[i]) * u0[i]; v1[i] = g1[i] * fast_sigmoid(g1[i]) * u1[i]; }
                u32x4 w; w.x = cvt_pk_bf16(v0[0], v0[1]); w.y = cvt_pk_bf16(v0[2], v0[3]); w.z = cvt_pk_bf16(v1[0], v1[1]); w.w = cvt_pk_bf16(v1[2], v1[3]);
                *(u32x4*)(O + (size_t)row * 5632 + col0) = w; }
    }
};

template <class Epi, class Sched, bool ALIGN_EPI = false, bool SP2 = false>
__device__ __forceinline__ void gemm_phase(PG8_LAS unsigned char* lds, const Gemm g, const Sched& S, const Epi& E) {
    const int tid = threadIdx.x, wid = __builtin_amdgcn_readfirstlane(tid >> 6), lane = tid & 63, wr = wid >> 2, wc = wid & 3, fr = lane & 15, fq = lane >> 4;
    const int K = g.K, nt = K / BK;
    unsigned voffA[2], voffB[2];
#pragma unroll
    for (int i = 0; i < 2; ++i) { int R, C; stage_rc(tid * 16 + i * 8192, R, C); const int Rb = Epi::PERM ? ((R & ~31) + perm32(R & 31)) : R;
        voffA[i] = (unsigned)(R * K + C) * 2u; voffB[i] = (unsigned)(Rb * K + C) * 2u; }
    const size_t kstep = (size_t)(BK * 2);
    const size_t hstep = (size_t)HALF * K * 2;
    const size_t tstep = 2 * hstep;
    const unsigned ldsw = (unsigned)wid * 1024u;
    const int aoff = lds_byte(wr * 64 + fr, fq * 8), boff = lds_byte(wc * 32 + fr, fq * 8);
#define PG8_SA(b, h) (((b) * 2 + (h)) * HTB)
#define PG8_SB(b, h) ((4 + (b) * 2 + (h)) * HTB)
#define PG8_STAGE(bufoff, gbase, voff) do { _Pragma("unroll") for (int _i = 0; _i < 2; ++_i) \
        __builtin_amdgcn_global_load_lds((const unsigned*)((const char*)(gbase) + (voff)[_i]), (PG8_LAS unsigned*)(lds + (bufoff) + ldsw + _i * 8192), 16, 0, 0); } while (0)
#define PG8_LDA(dst, b, h) do { _Pragma("unroll") for (int m = 0; m < 4; ++m) _Pragma("unroll") for (int k = 0; k < 2; ++k) dst[m][k] = *(const PG8_LAS bf16x8*)(lds + PG8_SA(b, h) + aoff + m * 2048 + k * 1024); } while (0)
#define PG8_LDB(dst, b, h) do { _Pragma("unroll") for (int n = 0; n < 2; ++n) _Pragma("unroll") for (int k = 0; k < 2; ++k) dst[n][k] = *(const PG8_LAS bf16x8*)(lds + PG8_SB(b, h) + boff + n * 2048 + k * 1024); } while (0)
#define PG8_MMA(ai, bj, At, Bt) do { __builtin_amdgcn_s_setprio(1); _Pragma("unroll") for (int m = 0; m < 4; ++m) _Pragma("unroll") for (int n = 0; n < 2; ++n) _Pragma("unroll") for (int k = 0; k < 2; ++k) \
        acc[ai][bj][m][n] = __builtin_amdgcn_mfma_f32_16x16x32_bf16(Bt[n][k], At[m][k], acc[ai][bj][m][n], 0, 0, 0); __builtin_amdgcn_s_setprio(0); } while (0)
#define PG8_WAIT_V(n) asm volatile("s_waitcnt vmcnt(" #n ")" ::: "memory")
#define PG8_WAIT_L(n) asm volatile("s_waitcnt lgkmcnt(" #n ")" ::: "memory")
#define PG8_BAR __builtin_amdgcn_s_barrier()
#define PG8_SCHED __builtin_amdgcn_sched_barrier(0)
    Unit cur, nxt; int ui = 0;
    if (!S.next(0, cur)) return;
    f32x4 acc[2][2][4][2];
#pragma unroll
    for (int a = 0; a < 2; ++a)
#pragma unroll
        for (int b = 0; b < 2; ++b)
#pragma unroll
            for (int m = 0; m < 4; ++m)
#pragma unroll
                for (int n = 0; n < 2; ++n) acc[a][b][m][n] = (f32x4){0.f, 0.f, 0.f, 0.f};
    bf16x8 At[4][2], B0[2][2], B1[2][2];
    const char* cA = (const char*)g.A + (size_t)cur.pm * tstep; const char* cB = (const char*)g.Bt + (size_t)cur.pn * tstep;
    S.a_ready(cur);
    if constexpr (SP2) {
        PG8_STAGE(PG8_SB(0, 0), cB, voffB); PG8_STAGE(PG8_SB(0, 1), cB + hstep, voffB); PG8_STAGE(PG8_SA(0, 0), cA, voffA); PG8_STAGE(PG8_SA(0, 1), cA + hstep, voffA);
        if (wr == 1) PG8_BAR;
        PG8_WAIT_V(2); PG8_BAR;
        PG8_STAGE(PG8_SB(1, 0), cB + kstep, voffB); PG8_STAGE(PG8_SA(1, 0), cA + kstep, voffA); PG8_STAGE(PG8_SB(1, 1), cB + hstep + kstep, voffB);
        PG8_WAIT_V(6); PG8_BAR;
    } else {
        PG8_STAGE(PG8_SB(0, 0), cB, voffB); PG8_STAGE(PG8_SA(0, 0), cA, voffA); PG8_STAGE(PG8_SB(0, 1), cB + hstep, voffB); PG8_STAGE(PG8_SA(0, 1), cA + hstep, voffA);
        if (wr == 1) PG8_BAR;
        PG8_WAIT_V(4); PG8_BAR;
        PG8_STAGE(PG8_SB(1, 0), cB + kstep, voffB); PG8_STAGE(PG8_SA(1, 0), cA + kstep, voffA); PG8_STAGE(PG8_SB(1, 1), cB + hstep + kstep, voffB);
        PG8_WAIT_V(6); PG8_BAR;
    }
    for (;;) {
        const bool has_next = S.next(ui + 1, nxt);
        const char* nA = has_next ? (const char*)g.A + (size_t)nxt.pm * tstep : cA; const char* nB = has_next ? (const char*)g.Bt + (size_t)nxt.pn * tstep : cB;
        for (int t = 0; t < nt; t += 2) {
            const bool last = (t == nt - 2);
            const char* a1 = cA + (size_t)(t + 1) * kstep;
            const char* a2 = last ? nA : cA + (size_t)(t + 2) * kstep; const char* b2 = last ? nB : cB + (size_t)(t + 2) * kstep;
            const char* a3 = a2 + kstep; const char* b3 = b2 + kstep;
            if (last && has_next) S.a_ready(nxt);
            if constexpr (SP2) {
            PG8_LDB(B0, 0, 0); PG8_LDB(B1, 0, 1); PG8_SCHED; PG8_LDA(At, 0, 0); PG8_STAGE(PG8_SA(1, 1), a1 + hstep, voffA);
            PG8_WAIT_V(8); PG8_WAIT_L(0); PG8_BAR; PG8_MMA(0, 0, At, B0); PG8_MMA(0, 1, At, B1); PG8_BAR; PG8_SCHED;
            PG8_LDA(At, 0, 1); PG8_STAGE(PG8_SB(0, 0), b2, voffB); PG8_STAGE(PG8_SB(0, 1), b2 + hstep, voffB); PG8_STAGE(PG8_SA(0, 0), a2, voffA);
            PG8_WAIT_V(8); PG8_WAIT_L(0); PG8_BAR; PG8_MMA(1, 0, At, B0); PG8_MMA(1, 1, At, B1); PG8_BAR; PG8_SCHED;
            PG8_LDB(B0, 1, 0); PG8_LDB(B1, 1, 1); PG8_SCHED; PG8_LDA(At, 1, 0); PG8_STAGE(PG8_SA(0, 1), a2 + hstep, voffA);
            PG8_WAIT_V(8); PG8_WAIT_L(0); PG8_BAR; PG8_MMA(0, 0, At, B0); PG8_MMA(0, 1, At, B1); PG8_BAR; PG8_SCHED;
            PG8_LDA(At, 1, 1); PG8_STAGE(PG8_SB(1, 0), b3, voffB); PG8_STAGE(PG8_SB(1, 1), b3 + hstep, voffB); PG8_STAGE(PG8_SA(1, 0), a3, voffA);
            PG8_WAIT_V(8); PG8_WAIT_L(0); PG8_BAR; PG8_MMA(1, 0, At, B0); PG8_MMA(1, 1, At, B1); PG8_BAR; PG8_SCHED;
            } else {
            PG8_LDB(B0, 0, 0); PG8_SCHED; PG8_LDA(At, 0, 0); PG8_STAGE(PG8_SA(1, 1), a1 + hstep, voffA);
            PG8_WAIT_L(8); PG8_BAR; PG8_WAIT_L(0); PG8_MMA(0, 0, At, B0); PG8_BAR; PG8_SCHED;
            PG8_LDB(B1, 0, 1); PG8_STAGE(PG8_SB(0, 0), b2, voffB);
            PG8_BAR; PG8_WAIT_L(0); PG8_MMA(0, 1, At, B1); PG8_BAR;
            PG8_LDA(At, 0, 1); PG8_STAGE(PG8_SA(0, 0), a2, voffA);
            PG8_BAR; PG8_WAIT_L(0); PG8_MMA(1, 0, At, B0); PG8_BAR; PG8_SCHED;
            PG8_STAGE(PG8_SB(0, 1), b2 + hstep, voffB);
            PG8_WAIT_V(6); PG8_BAR; PG8_MMA(1, 1, At, B1); PG8_BAR;
            PG8_LDB(B0, 1, 0); PG8_SCHED; PG8_LDA(At, 1, 0); PG8_STAGE(PG8_SA(0, 1), a2 + hstep, voffA);
            PG8_WAIT_L(8); PG8_BAR; PG8_WAIT_L(0); PG8_MMA(0, 0, At, B0); PG8_BAR; PG8_SCHED;
            PG8_LDB(B1, 1, 1); PG8_STAGE(PG8_SB(1, 0), b3, voffB);
            PG8_BAR; PG8_WAIT_L(0); PG8_MMA(0, 1, At, B1); PG8_BAR;
            PG8_LDA(At, 1, 1); PG8_STAGE(PG8_SA(1, 0), a3, voffA);
            PG8_BAR; PG8_WAIT_L(0); PG8_MMA(1, 0, At, B0); PG8_BAR; PG8_SCHED;
            PG8_STAGE(PG8_SB(1, 1), b3 + hstep, voffB);
            PG8_WAIT_V(6); PG8_BAR; PG8_MMA(1, 1, At, B1); PG8_BAR;
            }
        }
        if constexpr (ALIGN_EPI) { if (wr == 0) PG8_BAR; }
        if constexpr (!Epi::AFTER_DRAIN) { E(acc, cur, wr, wc, fr, fq); S.done(cur); }
        if (!has_next) break;
#pragma unroll
        for (int a = 0; a < 2; ++a)
#pragma unroll
            for (int b = 0; b < 2; ++b)
#pragma unroll
                for (int m = 0; m < 4; ++m)
#pragma unroll
                    for (int n = 0; n < 2; ++n) acc[a][b][m][n] = (f32x4){0.f, 0.f, 0.f, 0.f};
        cur = nxt; cA = nA; cB = nB; ++ui;
        if constexpr (ALIGN_EPI) { if (wr == 1) PG8_BAR; }
    }
    PG8_WAIT_V(0);
    if constexpr (!ALIGN_EPI) { if (wr == 0) PG8_BAR; }
    PG8_BAR;
    if constexpr (Epi::AFTER_DRAIN) { E.fused(acc, cur, wr, wc, fr, fq, lds, wid, lane); S.done(cur); }
#undef PG8_SA
#undef PG8_SB
#undef PG8_STAGE
#undef PG8_LDA
#undef PG8_LDB
#undef PG8_MMA
#undef PG8_WAIT_V
#undef PG8_WAIT_L
#undef PG8_BAR
#undef PG8_SCHED
}
}

constexpr int NWAVES = 8;
constexpr int BATCH = 4, SEQ = 2048, DM = 2048, MTOK = BATCH * SEQ, SSMW = 1024, ATTW = 1024, NGRP = 64, NST = 64, NHEAD = 8, HDIM = 128, DFF = 5632, PROJW = 4096, NMODW = 6 * DM;
constexpr int KSPLIT = 32;
constexpr size_t MiB = 1u << 20;
constexpr size_t WS_MODP = 2 * MiB, WS_MODF = 8 * MiB, WS_ROPE = 9 * MiB, WS_KTAB = 13 * MiB, WS_GTAB = 16 * MiB, WS_HTAB = 32 * MiB, WS_A64 = 48 * MiB;
constexpr size_t WS_WIN = 49 * MiB, WS_WGLU = 65 * MiB, WS_WOUT = 67 * MiB, WS_WGU = 75 * MiB, WS_WDN = 119 * MiB, WS_H = 141 * MiB, WS_PROJ = 173 * MiB, WS_VG = 237 * MiB;
constexpr size_t WS_YCAT = 253 * MiB, WS_OBR = 285 * MiB, WS_LSE = 333 * MiB, WS_FF = 173 * MiB, WS_UT = 334 * MiB, WS_END = 350 * MiB;
static_assert(WS_FF + (size_t)MTOK * DFF * 2 <= WS_OBR, "ff overlay");
constexpr int LDS_BYTES = 147456, MISC_OFF = 147456 - 256;
constexpr size_t WS_CTL = 0, CTL_ZERO_BYTES = 57344, WS_CNT = 16384, WS_PCNT = 32768, WS_GCNT = 49152  , WS_SLOTS = 1u << 20;

#define GAS __attribute__((address_space(1)))
#define LAS __attribute__((address_space(3)))
typedef unsigned short bf16;
typedef unsigned v4u __attribute__((ext_vector_type(4)));
typedef unsigned v2u __attribute__((ext_vector_type(2)));
typedef float f32x4 __attribute__((ext_vector_type(4)));
typedef float f32x16 __attribute__((ext_vector_type(16)));
typedef short bf16x8 __attribute__((ext_vector_type(8)));
typedef short s16x4 __attribute__((ext_vector_type(4)));
#define LDS_WAIT() asm volatile("s_waitcnt lgkmcnt(0)" ::: "memory")
__device__ __forceinline__ unsigned f2bf(float f) { unsigned u = __builtin_bit_cast(unsigned, f); return (u + 0x7fffu + ((u >> 16) & 1u)) >> 16; }
__device__ __forceinline__ unsigned pk2(float lo, float hi) { return f2bf(lo) | (f2bf(hi) << 16); }
__device__ __forceinline__ float bf_lo(unsigned w) { return __uint_as_float(w << 16); }
__device__ __forceinline__ float bf_hi(unsigned w) { return __uint_as_float(w & 0xffff0000u); }
__device__ __forceinline__ float wave_sum(float v) {
#pragma unroll
    for (int o = 1; o < 64; o <<= 1) v += __shfl_xor(v, o);
    return v;
}

struct Args { const float* in[25]; float* out; unsigned char* ws; int ph_lo, ph_hi; };

template <int MODE>
__device__ __forceinline__ void p0_transpose_item(const float* __restrict__ W, int K, int N, bf16* WT, LAS float* scr, int item, int lane, const float* gs, const float* ga) {
    const int nblk = N / 64, kb = item / nblk, nb = item % nblk, k0 = 64 * kb, n0 = 64 * nb;
    const int lr = lane >> 4, lc = lane & 15;
    f32x4 v[16];
#pragma unroll
    for (int i = 0; i < 16; ++i) v[i] = __builtin_nontemporal_load((const f32x4*)(W + (size_t)(k0 + 4 * i + lr) * N + n0 + 4 * lc));
#pragma unroll
    for (int i = 0; i < 16; ++i) { const int kk = 4 * i + lr; f32x4 t = v[i];
        if (MODE == 4) { const int k = k0 + kk; t = t * ((k < SSMW) ? gs[k] : ga[k - SSMW]); }
        LAS float* d = scr + kk * 65 + 4 * lc; d[0] = t.x; d[1] = t.y; d[2] = t.z; d[3] = t.w; }
    LDS_WAIT(); asm volatile("" ::: "memory");
    const int c = lane & 7;
#pragma unroll
    for (int j = 0; j < 8; ++j) { const int n = (lane >> 3) + 8 * j; const LAS float* s = scr + (8 * c) * 65 + n;
        v4u o; o.x = pk2(s[0 * 65], s[1 * 65]); o.y = pk2(s[2 * 65], s[3 * 65]); o.z = pk2(s[4 * 65], s[5 * 65]); o.w = pk2(s[6 * 65], s[7 * 65]);
        int col = n0 + n, row = col;
        if (MODE == 1) { if (col >= 1024 && col < 3072) { const int e = col & 127, half = e >> 6, ep = e & 63; row = (col - e) + ((ep >> 2) << 3) + (half << 2) + (ep & 3); } }
        if (MODE == 2) row = (col >> 7) * 256 + (col & 127);
        if (MODE == 3) row = (col >> 7) * 256 + 128 + (col & 127);
        *(GAS v4u*)(WT + (size_t)row * K + k0 + 8 * c) = o; }
    LDS_WAIT(); asm volatile("" ::: "memory");
}
__device__ __forceinline__ void wt_readback(const unsigned long long* p0, const unsigned long long* p1) {
    const unsigned long long a = __hip_atomic_load(p0, __ATOMIC_RELAXED, __HIP_MEMORY_SCOPE_AGENT), b = __hip_atomic_load(p1, __ATOMIC_RELAXED, __HIP_MEMORY_SCOPE_AGENT);
    asm volatile("s_waitcnt vmcnt(0)" :: "v"(a), "v"(b) : "memory");
}
__device__ __forceinline__ void p0_gemv_item(const float* __restrict__ cvec, const float* __restrict__ wmod, float* modp, float* modf, const float* __restrict__ bmod, unsigned* cnt, LAS float* scr, int item, int lane) {
    const int ks = item / 48, cb = item % 48, k0 = ks * 64, col = cb * 256 + lane * 4;
#pragma unroll
    for (int b = 0; b < 4; ++b) { const float v = cvec[b * DM + k0 + lane]; scr[lane * 4 + b] = v / (1.0f + __expf(-v)); }
    LDS_WAIT(); asm volatile("" ::: "memory");
    f32x4 a0 = {0, 0, 0, 0}, a1 = a0, a2 = a0, a3 = a0;
#pragma unroll 16
    for (int k = 0; k < 64; ++k) { const f32x4 w = __builtin_nontemporal_load((const f32x4*)(wmod + (size_t)(k0 + k) * NMODW + col)); const f32x4 s = *(const LAS f32x4*)(scr + 4 * k);
        a0 += w * s[0]; a1 += w * s[1]; a2 += w * s[2]; a3 += w * s[3]; }
    unsigned long long* o = (unsigned long long*)(modp + (size_t)(ks * 4) * NMODW + col);
#define GV_ST(p, v) do { __hip_atomic_store((p), ((unsigned long long)__float_as_uint((v).y) << 32) | __float_as_uint((v).x), __ATOMIC_RELAXED, __HIP_MEMORY_SCOPE_AGENT); \
                         __hip_atomic_store((p) + 1, ((unsigned long long)__float_as_uint((v).w) << 32) | __float_as_uint((v).z), __ATOMIC_RELAXED, __HIP_MEMORY_SCOPE_AGENT); } while (0)
    GV_ST(o, a0); GV_ST(o + NMODW / 2, a1); GV_ST(o + NMODW, a2); GV_ST(o + 3 * (NMODW / 2), a3);
#undef GV_ST
    LDS_WAIT(); asm volatile("s_waitcnt vmcnt(0)" ::: "memory");
    wt_readback(o, o + 1); wt_readback(o + NMODW / 2, o + NMODW / 2 + 1); wt_readback(o + NMODW, o + NMODW + 1); wt_readback(o + 3 * (NMODW / 2), o + 3 * (NMODW / 2) + 1);
    if (lane == 0) __hip_atomic_fetch_add(cnt + 64 * cb, 1u, __ATOMIC_RELAXED, __HIP_MEMORY_SCOPE_AGENT);
}
__device__ __forceinline__ void p0_fin_item(const float* modp, float* modf, const float* __restrict__ bmod, unsigned* cnt, int item, int lane) {
    const int cb = item >> 2, b = item & 3, col = cb * 256 + lane * 4;
    { unsigned sp = 0u;
      while ((unsigned)__builtin_amdgcn_readfirstlane((int)__hip_atomic_load(cnt + 64 * cb, __ATOMIC_RELAXED, __HIP_MEMORY_SCOPE_AGENT)) < (unsigned)KSPLIT) { __builtin_amdgcn_s_sleep(2); if (++sp > (1u << 22)) break; }
      __builtin_amdgcn_fence(__ATOMIC_ACQUIRE, "agent"); }
    f32x4 t = *(const f32x4*)(bmod + col);
#pragma unroll 8
    for (int k2 = 0; k2 < KSPLIT; ++k2) { const unsigned long long* pp = (const unsigned long long*)(modp + (size_t)(k2 * 4 + b) * NMODW + col);
        const unsigned long long w0 = __hip_atomic_load(pp, __ATOMIC_RELAXED, __HIP_MEMORY_SCOPE_AGENT), w1 = __hip_atomic_load(pp + 1, __ATOMIC_RELAXED, __HIP_MEMORY_SCOPE_AGENT);
        t += (f32x4){__uint_as_float((unsigned)w0), __uint_as_float((unsigned)(w0 >> 32)), __uint_as_float((unsigned)w1), __uint_as_float((unsigned)(w1 >> 32))}; }
    unsigned long long* mo = (unsigned long long*)(modf + (size_t)b * NMODW + col);
    __hip_atomic_store(mo, ((unsigned long long)__float_as_uint(t.y) << 32) | __float_as_uint(t.x), __ATOMIC_RELAXED, __HIP_MEMORY_SCOPE_AGENT);
    __hip_atomic_store(mo + 1, ((unsigned long long)__float_as_uint(t.w) << 32) | __float_as_uint(t.z), __ATOMIC_RELAXED, __HIP_MEMORY_SCOPE_AGENT);
    asm volatile("s_waitcnt vmcnt(0)" ::: "memory");
    wt_readback(mo, mo + 1);
    if (lane == 0) __hip_atomic_fetch_add(cnt + 64 * 48, 1u, __ATOMIC_RELAXED, __HIP_MEMORY_SCOPE_AGENT);
}
__device__ __forceinline__ void p0_rope_item(const int* __restrict__ pos, float* cosT, float* sinT, int item, int lane) {
    const double inv = exp(-(double)lane * (9.210340371976184 / 64.0));
    const double rev = (double)pos[item] * inv * 0.15915494309189535;
    const float x = (float)((rev - rint(rev)) * 6.283185307179586);
    cosT[(size_t)item * 64 + lane] = cosf(x); sinT[(size_t)item * 64 + lane] = sinf(x);
}
struct SsmLane { double lr, li, dt, ar, ai; };
__device__ __forceinline__ SsmLane ssm_lane(const float* are, const float* aim, const float* ldt, int g, int p) {
    SsmLane L; L.dt = exp((double)ldt[g]); L.lr = (double)are[g * 64 + p]; L.li = (double)aim[g * 64 + p];
    const double m = exp(L.lr * L.dt); L.ar = m * cos(L.li * L.dt); L.ai = m * sin(L.li * L.dt); return L; }
__device__ __forceinline__ void ssm_pow(const SsmLane& L, int n, double& zr, double& zi) { const double m = exp(L.lr * L.dt * n), th = L.li * L.dt * n; zr = m * cos(th); zi = m * sin(th); }
__device__ __forceinline__ void ssm_step(const SsmLane& L, double& zr, double& zi) { const double nr = zr * L.ar - zi * L.ai, ni = zr * L.ai + zi * L.ar; zr = nr; zi = ni; }
__device__ __forceinline__ void ssm_bbar(const SsmLane& L, const float* bre, const float* bim, int g, int p, float (&br)[16], float (&bi)[16]) {
    const double nr = L.ar - 1.0, ni = L.ai, den = L.lr * L.lr + L.li * L.li;
    const float fr = (float)((nr * L.lr + ni * L.li) / den), fi = (float)((ni * L.lr - nr * L.li) / den);
    const f32x4* pr = (const f32x4*)(bre + (size_t)(g * 64 + p) * 16); const f32x4* pi = (const f32x4*)(bim + (size_t)(g * 64 + p) * 16);
#pragma unroll
    for (int q = 0; q < 4; ++q) { const f32x4 r = pr[q], i = pi[q];
#pragma unroll
        for (int e = 0; e < 4; ++e) { br[4 * q + e] = fr * r[e] - fi * i[e]; bi[4 * q + e] = fr * i[e] + fi * r[e]; } }
}
__device__ __forceinline__ void p0_ktab_item(const float* const* in, bf16* ktab, float* a64, LAS float* scr, int g, int ch, int lane) {
    const SsmLane L = ssm_lane(in[7], in[8], in[9], g, lane);
    float br[16], bi[16]; ssm_bbar(L, in[10], in[11], g, lane, br, bi);
    double zr, zi; ssm_pow(L, ch == 0 ? 0 : 8 * ch - 1, zr, zi);
    const int c = lane >> 2, q = lane & 3; const float* cr = in[12] + (size_t)(g * 16 + c) * 64; const float* ci = in[13] + (size_t)(g * 16 + c) * 64;
    for (int e = 0; e < 8; ++e) { const int ti = 8 * ch + e; if (ti > 64) break;
        if (ti == 0) { double wr, wi; ssm_pow(L, 64, wr, wi); a64[(g * 64 + lane) * 2] = (float)wr; a64[(g * 64 + lane) * 2 + 1] = (float)wi;
            *(GAS v2u*)(ktab + (size_t)(g * 65) * 256 + lane * 4) = (v2u){0u, 0u}; continue; }
        const float fzr = (float)zr, fzi = (float)zi;
#pragma unroll
        for (int k = 0; k < 16; ++k) { scr[lane * 16 + k] = fzr * br[k] - fzi * bi[k]; scr[1024 + lane * 16 + k] = fzr * bi[k] + fzi * br[k]; }
        LDS_WAIT(); asm volatile("" ::: "memory");
        f32x4 acc = {0, 0, 0, 0};
#pragma unroll 8
        for (int p = 0; p < 64; ++p) { const f32x4 wr = *(const LAS f32x4*)(scr + p * 16 + 4 * q), wi = *(const LAS f32x4*)(scr + 1024 + p * 16 + 4 * q); acc += wr * cr[p] - wi * ci[p]; }
        *(GAS v2u*)(ktab + ((size_t)(g * 65 + ti) * 16 + c) * 16 + 4 * q) = (v2u){pk2(acc[0], acc[1]), pk2(acc[2], acc[3])};
        LDS_WAIT(); asm volatile("" ::: "memory");
        ssm_step(L, zr, zi); }
}
__device__ __forceinline__ void p0_gtab_item(const float* const* in, bf16* gtab, int g, int ch, int lane) {
    const SsmLane L = ssm_lane(in[7], in[8], in[9], g, lane); double dzr, dzi; ssm_pow(L, 8 * ch + 1, dzr, dzi);
    const int p = lane;
    float cr[16], ci[16];
#pragma unroll
    for (int c = 0; c < 16; ++c) { cr[c] = in[12][(size_t)(g * 16 + c) * 64 + p]; ci[c] = in[13][(size_t)(g * 16 + c) * 64 + p]; }
    for (int e = 0; e < 8; ++e) { const int t = 8 * ch + e; const float zr = (float)dzr, zi = (float)dzi;
        const size_t base = ((size_t)(g * 32 + (t >> 1)) * 8) * 512;
#pragma unroll
        for (int c = 0; c < 16; ++c) { const float gre = cr[c] * zr - ci[c] * zi, gni = -(cr[c] * zi + ci[c] * zr);
            { const int pp = p;      gtab[base + (size_t)(pp >> 4) * 512 + ((16 * (t & 1) + c) + 32 * ((pp >> 3) & 1)) * 8 + (pp & 7)] = (bf16)f2bf(gre); }
            { const int pp = p + 64; gtab[base + (size_t)(pp >> 4) * 512 + ((16 * (t & 1) + c) + 32 * ((pp >> 3) & 1)) * 8 + (pp & 7)] = (bf16)f2bf(gni); } }
        ssm_step(L, dzr, dzi); }
}
__device__ __forceinline__ void p0_htab_item(const float* const* in, bf16* htab, int g, int ch, int lane) {
    const SsmLane L = ssm_lane(in[7], in[8], in[9], g, lane); double dzr, dzi; ssm_pow(L, 56 - 8 * ch, dzr, dzi);
    float br[16], bi[16]; ssm_bbar(L, in[10], in[11], g, lane, br, bi);
    for (int e = 7; e >= 0; --e) { const int s = 8 * ch + e; const float zr = (float)dzr, zi = (float)dzi;
#pragma unroll
        for (int hh = 0; hh < 2; ++hh) { v4u o, o2;
            o.x = pk2(zr * br[8 * hh] - zi * bi[8 * hh], zr * br[8 * hh + 1] - zi * bi[8 * hh + 1]); o.y = pk2(zr * br[8 * hh + 2] - zi * bi[8 * hh + 2], zr * br[8 * hh + 3] - zi * bi[8 * hh + 3]);
            o.z = pk2(zr * br[8 * hh + 4] - zi * bi[8 * hh + 4], zr * br[8 * hh + 5] - zi * bi[8 * hh + 5]); o.w = pk2(zr * br[8 * hh + 6] - zi * bi[8 * hh + 6], zr * br[8 * hh + 7] - zi * bi[8 * hh + 7]);
            o2.x = pk2(zr * bi[8 * hh] + zi * br[8 * hh], zr * bi[8 * hh + 1] + zi * br[8 * hh + 1]); o2.y = pk2(zr * bi[8 * hh + 2] + zi * br[8 * hh + 2], zr * bi[8 * hh + 3] + zi * br[8 * hh + 3]);
            o2.z = pk2(zr * bi[8 * hh + 4] + zi * br[8 * hh + 4], zr * bi[8 * hh + 5] + zi * br[8 * hh + 5]); o2.w = pk2(zr * bi[8 * hh + 6] + zi * br[8 * hh + 6], zr * bi[8 * hh + 7] + zi * br[8 * hh + 7]);
            { const int pp = lane;      *(GAS v4u*)(htab + ((((size_t)(g * 4 + (pp >> 5)) * 64 + s) * 64) + (pp & 31) + 32 * hh) * 8) = o; }
            { const int pp = lane + 64; *(GAS v4u*)(htab + ((((size_t)(g * 4 + (pp >> 5)) * 64 + s) * 64) + (pp & 31) + 32 * hh) * 8) = o2; } }
        ssm_step(L, dzr, dzi); }
}
#define XB_TMO      128
#define XB_XCNT(j)  (256  + 64 * (j))
#define XB_XSUB(j)  (1280 + 64 * (j))
#define XB_XGEN(j)  (2304 + 64 * (j))
#define XB_TOP      3328
#define XB_TOPGEN   3392
#define XCD_BAR_WORDS 3456
#define XB_SPIN_CAP (1u << 18)

__device__ __forceinline__ unsigned xb_ld(unsigned* p)              { return __hip_atomic_load(p, __ATOMIC_RELAXED, __HIP_MEMORY_SCOPE_AGENT); }
__device__ __forceinline__ unsigned xb_add(unsigned* p, unsigned v) { return __hip_atomic_fetch_add(p, v, __ATOMIC_RELAXED, __HIP_MEMORY_SCOPE_AGENT); }
__device__ __forceinline__ unsigned xb_xcc_id() { return (unsigned)__builtin_amdgcn_s_getreg((3 << 11) | 20) & 0xFu; }
#define XB_SPIN(cond, bar) do { unsigned _sp = 0; while (cond) { __builtin_amdgcn_s_sleep(1); \
    if ((++_sp & 255u) == 0u) { if (xb_ld(&(bar)[XB_TMO])) break; if (_sp > XB_SPIN_CAP) { atomicAdd(&(bar)[XB_TMO], 1u); break; } } } } while (0)

struct XcdBarrier {
    unsigned* bar; unsigned x;
    volatile LAS unsigned* st;
};

__device__ __forceinline__ XcdBarrier xcd_barrier_post(unsigned* bar, volatile LAS unsigned* st) {
    XcdBarrier b; b.bar = bar; b.x = xb_xcc_id(); b.st = st;
    if (threadIdx.x == 0) (void)xb_add(&bar[XB_XCNT(b.x)], 1u);
    return b;
}
__device__ __forceinline__ void xcd_barrier_complete(unsigned* bar, unsigned x, unsigned& nloc, unsigned& nx) {
    const unsigned G = gridDim.x * gridDim.y * gridDim.z;
    unsigned sum, cnt, mine, sp = 0u;
    for (;;) {
        sum = 0u; cnt = 0u; mine = 0u;
#pragma unroll
        for (unsigned j = 0; j < 16; ++j) { const unsigned c = xb_ld(&bar[XB_XCNT(j)]); sum += c; cnt += (c > 0u) ? 1u : 0u; mine = (j == x) ? c : mine; }
        if (sum == G) break;
        __builtin_amdgcn_s_sleep(1);
        if ((++sp & 255u) == 0u) { if (xb_ld(&bar[XB_TMO])) break; if (sp > XB_SPIN_CAP) { atomicAdd(&bar[XB_TMO], 1u); break; } }
    }
    nloc = mine > 0u ? mine : 1u; nx = cnt > 0u ? cnt : 1u;
}

__device__ __forceinline__ void xcd_barrier(const XcdBarrier& b) {
    asm volatile("s_waitcnt vmcnt(0)" ::: "memory");
    __syncthreads();
    if (threadIdx.x == 0) {
        unsigned* bar = b.bar;
        __builtin_amdgcn_s_waitcnt(0);
        unsigned nloc = b.st[0], nx = b.st[1];
        if (nloc == 0u) { xcd_barrier_complete(bar, b.x, nloc, nx); b.st[0] = nloc; b.st[1] = nx; }
        const unsigned old = xb_add(&bar[XB_XSUB(b.x)], 1u);
        const unsigned gen = old / nloc;
        if (old + 1u == (gen + 1u) * nloc) {
            __builtin_amdgcn_fence(__ATOMIC_RELEASE, "agent");
            asm volatile("s_waitcnt vmcnt(0)" ::: "memory");
            const unsigned og = xb_add(&bar[XB_TOP], 1u);
            const unsigned tg = og / nx;
            if (og + 1u == (tg + 1u) * nx) xb_add(&bar[XB_TOPGEN], 1u);
            else XB_SPIN(xb_ld(&bar[XB_TOPGEN]) == tg, bar);
            __builtin_amdgcn_fence(__ATOMIC_ACQUIRE, "agent");
            xb_add(&bar[XB_XGEN(b.x)], 1u);
            asm volatile("s_waitcnt vmcnt(0)" ::: "memory");
        } else {
            XB_SPIN(xb_ld(&bar[XB_XGEN(b.x)]) == gen, bar);
            __builtin_amdgcn_fence(__ATOMIC_ACQUIRE, "agent");
            asm volatile("s_waitcnt vmcnt(0)" ::: "memory");
        }
    }
    __syncthreads();
}

template <bool FROMP>
__device__ __forceinline__ void modnorm_phase(LAS unsigned char* lds, const float* xin, bf16* hout, const float* gvec, const float* modp, const float* bmod, const float* modf, int jsh, int jsc, int tid, int lane, int wave) {
    LAS float* TA = (LAS float*)lds; LAS float* TS = TA + DM;
    const int b = (blockIdx.x * 32) / SEQ;
    for (int k = tid; k < DM; k += NWAVES * 64) {
        float sh, sc;
        if (FROMP) { sh = bmod[jsh * DM + k]; sc = bmod[jsc * DM + k];
            for (int ks = 0; ks < KSPLIT; ++ks) { sh += modp[(size_t)(ks * 4 + b) * NMODW + jsh * DM + k]; sc += modp[(size_t)(ks * 4 + b) * NMODW + jsc * DM + k]; } }
        else { sh = modf[(size_t)b * NMODW + jsh * DM + k]; sc = modf[(size_t)b * NMODW + jsc * DM + k]; }
        TA[k] = gvec[k] * (1.0f + sc); TS[k] = sh; }
    __syncthreads();
    for (int r = 0; r < 4; ++r) { const int row = blockIdx.x * 32 + wave * 4 + r;
        const f32x4* xr = (const f32x4*)(xin + (size_t)row * DM) + lane;
        f32x4 v[8]; float s = 0.f;
#pragma unroll
        for (int j = 0; j < 8; ++j) { v[j] = __builtin_nontemporal_load(xr + 64 * j); s += (v[j].x * v[j].x + v[j].y * v[j].y) + (v[j].z * v[j].z + v[j].w * v[j].w); }
        const float rstd = 1.0f / sqrtf(wave_sum(s) * (1.0f / DM) + 1e-6f);
        GAS v2u* o8 = (GAS v2u*)(hout + (size_t)row * DM) + lane;
#pragma unroll
        for (int j = 0; j < 8; ++j) { const f32x4 a = *(const LAS f32x4*)(TA + 4 * (lane + 64 * j)), sft = *(const LAS f32x4*)(TS + 4 * (lane + 64 * j));
            const f32x4 o = v[j] * rstd * a + sft; o8[64 * j] = (v2u){pk2(o.x, o.y), pk2(o.z, o.w)}; } }
    __syncthreads();
}

#define TS_A (-1)
#define TS_MASK 0
#define TS_SCALE 1e-5f
#define TS_X (-1)
#define TS_Y (-1)
#define STAMP(k) do { if (TS_A >= 0 && bx == 0 && threadIdx.x == 0) ((volatile LAS unsigned long long*)(lds + MISC_OFF + 16))[k] = __builtin_amdgcn_s_memrealtime(); } while (0)
#define SSTAMP(k) do { if (TS_A >= 0 && blockIdx.x == 0 && threadIdx.x == 0) ((volatile LAS unsigned long long*)(lds + MISC_OFF + 16))[k] = __builtin_amdgcn_s_memrealtime(); } while (0)
constexpr int SS_UST = 2064;
constexpr int SS_U = 0, SS_K = 32 * SS_UST, SS_E = SS_K + 65 * 512, SS_C = SS_E + 2 * 128 * 33 * 4, SS_CST = 272, SS_END = SS_C + 32 * SS_CST;
static_assert(SS_END <= 147456 - 1024, "ssm LDS");
__device__ __forceinline__ float gelu_tanh(float v) { const float t = 0.7978845608028654f * (v + 0.044715f * v * v * v); const float e = __builtin_amdgcn_exp2f(-2.885390081777927f * t); return v * __builtin_amdgcn_rcpf(1.0f + e); }
__device__ __forceinline__ void ssm_unit(LAS unsigned char* lds, int b, int g, const bf16* proj, const bf16* ktab, const bf16* gtab, const bf16* htab, const float* a64, const float* dskip, bf16* vg, int tid, int lane, int wave) {
    const int n = lane & 31, h = lane >> 5;
    const int mt1 = wave & 3, kh = wave >> 2;
    bf16x8 hf[32];
    { const bf16* hp = htab + (((size_t)(g * 4 + mt1) * 64 + kh * 32) * 64 + lane) * 8;
#pragma unroll
      for (int s = 0; s < 32; ++s) hf[s] = *(const GAS bf16x8*)(hp + (size_t)s * 512); }
    { v4u ur[8];
#pragma unroll
      for (int it = 0; it < 8; ++it) { const int i = tid + 512 * it; ur[it] = *(const GAS v4u*)(proj + ((size_t)(b * NGRP + g) * SEQ * 16 + (size_t)i * 8)); }
      v4u kr[5];
#pragma unroll
      for (int it = 0; it < 5; ++it) { const int i = tid + 512 * it; kr[it] = (v4u){0u, 0u, 0u, 0u}; if (i < 2080) kr[it] = *(const GAS v4u*)(ktab + (size_t)g * 65 * 256 + i * 8); }
#pragma unroll
      for (int it = 0; it < 8; ++it) { const int i = tid + 512 * it, t = i >> 1, hf2 = i & 1; *(LAS v4u*)(lds + SS_U + (t >> 6) * SS_UST + (t & 63) * 32 + hf2 * 16) = ur[it]; }
#pragma unroll
      for (int it = 0; it < 5; ++it) { const int i = tid + 512 * it; if (i < 2080) *(LAS v4u*)(lds + SS_K + i * 16) = kr[it]; } }
    __syncthreads(); SSTAMP(24);
    { f32x16 acc;
#pragma unroll
      for (int i = 0; i < 16; ++i) acc[i] = 0.f;
#pragma unroll
      for (int s = 0; s < 32; ++s) { const bf16x8 bb = *(const LAS bf16x8*)(lds + SS_U + n * SS_UST + (kh * 32 + s) * 32 + h * 16);
          acc = __builtin_amdgcn_mfma_f32_32x32x16_bf16(hf[s], bb, acc, 0, 0, 0); }
      LAS float* E = (LAS float*)(lds + SS_E) + kh * 128 * 33;
#pragma unroll
      for (int r = 0; r < 16; ++r) E[(32 * mt1 + (r & 3) + 8 * (r >> 2) + 4 * h) * 33 + n] = acc[r]; }
    __syncthreads(); SSTAMP(25);
    if (wave == 0) { const int p = lane; const float ar = a64[(g * 64 + p) * 2], ai = a64[(g * 64 + p) * 2 + 1]; float cr = 0.f, ci = 0.f;
        const LAS float* E0 = (const LAS float*)(lds + SS_E); const LAS float* E1 = E0 + 128 * 33;
#pragma unroll 8
        for (int j = 0; j < 32; ++j) { *(LAS bf16*)(lds + SS_C + j * SS_CST + p * 2) = (bf16)f2bf(cr); *(LAS bf16*)(lds + SS_C + j * SS_CST + (64 + p) * 2) = (bf16)f2bf(ci);
            const float er = E0[p * 33 + j] + E1[p * 33 + j], ei = E0[(64 + p) * 33 + j] + E1[(64 + p) * 33 + j];
            const float nr = ar * cr - ai * ci + er, ni = ar * ci + ai * cr + ei; cr = nr; ci = ni; } }
    f32x16 acc4[4];
#pragma unroll
    for (int q = 0; q < 4; ++q)
#pragma unroll
        for (int i = 0; i < 16; ++i) acc4[q][i] = 0.f;
    const int c_l = n & 15, tl = n >> 4;
    const int bbase = SS_U + n * SS_UST + h * 16;
    const int kb0 = SS_K + ((tl + 1) * 16 + c_l) * 32 + h * 16;
    const int mtq0 = wave, mtq1 = 15 - wave, mtq2 = 16 + wave, mtq3 = 31 - wave;
    const int nsmax = 2 * mtq3 + 2;
    bf16x8 gfb[2][8];
    for (int s = 0; s < nsmax; s += 2) {
        const bf16x8 bb0 = *(const LAS bf16x8*)(lds + bbase + s * 32), bb1 = *(const LAS bf16x8*)(lds + bbase + s * 32 + 32);
        const bool c0 = s < 2 * mtq0 + 2, c1 = s < 2 * mtq1 + 2, c2 = s < 2 * mtq2 + 2;
        bf16x8 a00, a01, a10, a11, a20, a21;
        if (c0) { a00 = *(const LAS bf16x8*)(lds + kb0 + mtq0 * 1024 - s * 512); a01 = *(const LAS bf16x8*)(lds + kb0 + mtq0 * 1024 - s * 512 - 512); }
        if (c1) { a10 = *(const LAS bf16x8*)(lds + kb0 + mtq1 * 1024 - s * 512); a11 = *(const LAS bf16x8*)(lds + kb0 + mtq1 * 1024 - s * 512 - 512); }
        if (c2) { a20 = *(const LAS bf16x8*)(lds + kb0 + mtq2 * 1024 - s * 512); a21 = *(const LAS bf16x8*)(lds + kb0 + mtq2 * 1024 - s * 512 - 512); }
        const bf16x8 a30 = *(const LAS bf16x8*)(lds + kb0 + mtq3 * 1024 - s * 512), a31 = *(const LAS bf16x8*)(lds + kb0 + mtq3 * 1024 - s * 512 - 512);
        acc4[3] = __builtin_amdgcn_mfma_f32_32x32x16_bf16(a30, bb0, acc4[3], 0, 0, 0);
        if (c2) acc4[2] = __builtin_amdgcn_mfma_f32_32x32x16_bf16(a20, bb0, acc4[2], 0, 0, 0);
        if (c1) acc4[1] = __builtin_amdgcn_mfma_f32_32x32x16_bf16(a10, bb0, acc4[1], 0, 0, 0);
        if (c0) acc4[0] = __builtin_amdgcn_mfma_f32_32x32x16_bf16(a00, bb0, acc4[0], 0, 0, 0);
        acc4[3] = __builtin_amdgcn_mfma_f32_32x32x16_bf16(a31, bb1, acc4[3], 0, 0, 0);
        if (c2) acc4[2] = __builtin_amdgcn_mfma_f32_32x32x16_bf16(a21, bb1, acc4[2], 0, 0, 0);
        if (c1) acc4[1] = __builtin_amdgcn_mfma_f32_32x32x16_bf16(a11, bb1, acc4[1], 0, 0, 0);
        if (c0) acc4[0] = __builtin_amdgcn_mfma_f32_32x32x16_bf16(a01, bb1, acc4[0], 0, 0, 0); }
#pragma unroll
    for (int q = 0; q < 2; ++q) { const bf16* gp = gtab + (((size_t)(g * 32 + (q == 0 ? mtq0 : mtq1)) * 8) * 64 + lane) * 8;
#pragma unroll
        for (int ks = 0; ks < 8; ++ks) gfb[q][ks] = *(const GAS bf16x8*)(gp + (size_t)ks * 512); }
    asm volatile("" ::: "memory");
    SSTAMP(26); __syncthreads(); SSTAMP(27);
#pragma unroll
    for (int q = 0; q < 2; ++q) {
#pragma unroll
        for (int ks = 0; ks < 8; ++ks) { const bf16x8 bb = *(const LAS bf16x8*)(lds + SS_C + n * SS_CST + (16 * ks + 8 * h) * 2);
            acc4[q] = __builtin_amdgcn_mfma_f32_32x32x16_bf16(gfb[q][ks], bb, acc4[q], 0, 0, 0); } }
#pragma unroll
    for (int q = 2; q < 4; ++q) { const bf16* gp = gtab + (((size_t)(g * 32 + (q == 2 ? mtq2 : mtq3)) * 8) * 64 + lane) * 8;
        bf16x8 gf[8];
#pragma unroll
        for (int ks = 0; ks < 8; ++ks) gf[ks] = *(const GAS bf16x8*)(gp + (size_t)ks * 512);
#pragma unroll
        for (int ks = 0; ks < 8; ++ks) { const bf16x8 bb = *(const LAS bf16x8*)(lds + SS_C + n * SS_CST + (16 * ks + 8 * h) * 2);
            acc4[q] = __builtin_amdgcn_mfma_f32_32x32x16_bf16(gf[ks], bb, acc4[q], 0, 0, 0); } }
    SSTAMP(28);
#pragma unroll
    for (int q = 0; q < 4; ++q) { const int mt = (q == 0) ? mtq0 : (q == 1) ? mtq1 : (q == 2) ? mtq2 : mtq3;
#pragma unroll
        for (int q4 = 0; q4 < 4; ++q4) { const int t = 2 * mt + (q4 >> 1), c0 = 8 * (q4 & 1) + 4 * h;
            const v2u uu = *(const LAS v2u*)(lds + SS_U + n * SS_UST + t * 32 + c0 * 2);
            const f32x4 dv = *(const f32x4*)(dskip + 16 * g + c0);
            const float y0 = acc4[q][4 * q4 + 0] + dv[0] * bf_lo(uu.x), y1 = acc4[q][4 * q4 + 1] + dv[1] * bf_hi(uu.x), y2 = acc4[q][4 * q4 + 2] + dv[2] * bf_lo(uu.y), y3 = acc4[q][4 * q4 + 3] + dv[3] * bf_hi(uu.y);
            *(GAS v2u*)(vg + (size_t)(b * SEQ + 64 * n + t) * SSMW + 16 * g + c0) = (v2u){pk2(gelu_tanh(y0), gelu_tanh(y1)), pk2(gelu_tanh(y2), gelu_tanh(y3))}; } }
    __syncthreads();
}

constexpr int AT_K = 0, AT_V = 272 * 256, AT_END = 2 * 272 * 256;
static_assert(AT_END <= 147456 - 1024, "attn LDS");
__device__ __forceinline__ unsigned off_b(unsigned row, unsigned ch) { return 256u * row + 16u * (ch ^ (((row & 3) << 2) | ((row >> 2) & 3))); }
typedef short v4i16_t __attribute__((ext_vector_type(4)));
__device__ __forceinline__ s16x4 tr_read(LAS unsigned char* p) { return __builtin_bit_cast(s16x4, __builtin_amdgcn_ds_read_tr16_b64_v4i16((LAS v4i16_t*)p)); }
struct AttnDesc { int b, hd, di, dil, res, blk; };
__device__ __forceinline__ AttnDesc attn_decode(int u) { AttnDesc d; const int bh = u / 48, w = u % 48; d.b = bh / NHEAD; d.hd = bh % NHEAD;
    if (w < 16) { d.di = 0; d.dil = 1; d.res = 0; d.blk = w; } else if (w < 32) { d.di = 1; d.dil = 4; d.res = (w - 16) >> 2; d.blk = (w - 16) & 3; } else { d.di = 2; d.dil = 16; d.res = w - 32; d.blk = 0; }
    return d; }
__device__ __forceinline__ void attn_run(LAS unsigned char* lds, int u0, int ustride, int uend, const bf16* proj, bf16* obr, float* lse, int tid, int lane, int wave) {
    if (u0 >= uend) return;
    if (tid < 256) { const int row = 256 + (tid >> 4), ch = tid & 15; *(LAS v4u*)(lds + AT_K + off_b(row, ch)) = (v4u){0u, 0u, 0u, 0u}; *(LAS v4u*)(lds + AT_V + off_b(row, ch)) = (v4u){0u, 0u, 0u, 0u}; }
    const int qn = lane & 15, g = lane >> 4, q4 = (lane & 15) >> 2, p4 = lane & 3;
    const int r0s = tid >> 4, chs = tid & 15; const unsigned soff = off_b(r0s, chs);
    v4u kr[8], vr[8]; bf16x8 qnx[4];
    int u = u0; AttnDesc nd = attn_decode(u);
#define AT_ISSUE(D) do { const size_t rowb_ = (size_t)(D).b * SEQ; \
        _Pragma("unroll") for (int it = 0; it < 8; ++it) { const int sub = 128 * (D).blk - 128 + r0s + 32 * it; kr[it] = (v4u){0u, 0u, 0u, 0u}; vr[it] = kr[it]; \
            if (sub >= 0) { const bf16* src = proj + (rowb_ + (D).res + (D).dil * sub) * PROJW + 2048 + (D).hd * HDIM + chs * 8; kr[it] = *(const GAS v4u*)src; vr[it] = *(const GAS v4u*)(src + 1024); } } \
        const int qt_ = (D).res + (D).dil * (128 * (D).blk + 16 * wave + qn); \
        _Pragma("unroll") for (int s_ = 0; s_ < 4; ++s_) qnx[s_] = *(const GAS bf16x8*)(proj + (rowb_ + qt_) * PROJW + 1024 + (D).hd * HDIM + 32 * s_ + 8 * g); } while (0)
    AT_ISSUE(nd);
    for (;;) {
        const AttnDesc d = nd;
#pragma unroll
        for (int it = 0; it < 8; ++it) { *(LAS v4u*)(lds + AT_K + soff + 8192 * it) = kr[it]; *(LAS v4u*)(lds + AT_V + soff + 8192 * it) = vr[it]; }
        bf16x8 qf[4];
#pragma unroll
        for (int s = 0; s < 4; ++s) qf[s] = qnx[s];
        __syncthreads();
        const int un = u + ustride; const bool has = un < uend;
        if (has) { nd = attn_decode(un); AT_ISSUE(nd); }
        const bool first = (d.blk == 0); const int tskip = first ? 8 - wave : 0;
        f32x4 sc[10];
#pragma unroll
        for (int kt = 0; kt < 10; ++kt) { f32x4 a = {0.f, 0.f, 0.f, 0.f};
            if (kt < 9 && kt >= tskip) {
#pragma unroll
                for (int s = 0; s < 4; ++s) { const bf16x8 kf = *(const LAS bf16x8*)(lds + AT_K + off_b(16 * (wave + kt) + qn, 4 * s + g));
                    a = __builtin_amdgcn_mfma_f32_16x16x32_bf16(kf, qf[s], a, 0, 0, 0); } }
            sc[kt] = a; }
        float mx = -1e30f;
#pragma unroll
        for (int kt = 0; kt < 10; ++kt)
#pragma unroll
            for (int r = 0; r < 4; ++r) { const int rel = 16 * kt + 4 * g + r; bool ok = (rel >= qn) && (rel <= qn + 128) && (kt >= tskip);
                sc[kt][r] = ok ? sc[kt][r] : -1e30f; mx = fmaxf(mx, sc[kt][r]); }
        mx = fmaxf(mx, __shfl_xor(mx, 16)); mx = fmaxf(mx, __shfl_xor(mx, 32));
        float ls = 0.f;
#pragma unroll
        for (int kt = 0; kt < 10; ++kt)
#pragma unroll
            for (int r = 0; r < 4; ++r) { const float p = (sc[kt][r] > -1e29f) ? __builtin_amdgcn_exp2f(sc[kt][r] - mx) : 0.f; sc[kt][r] = p; ls += p; }
        ls += __shfl_xor(ls, 16); ls += __shfl_xor(ls, 32);
        f32x4 o[8];
#pragma unroll
        for (int c = 0; c < 8; ++c) o[c] = (f32x4){0.f, 0.f, 0.f, 0.f};
#pragma unroll
        for (int ks = 0; ks < 5; ++ks) {
            if (2 * ks + 1 >= tskip) {
                union { unsigned uu[4]; bf16x8 v; } pb;
                pb.uu[0] = pk2(sc[2 * ks][0], sc[2 * ks][1]); pb.uu[1] = pk2(sc[2 * ks][2], sc[2 * ks][3]); pb.uu[2] = pk2(sc[2 * ks + 1][0], sc[2 * ks + 1][1]); pb.uu[3] = pk2(sc[2 * ks + 1][2], sc[2 * ks + 1][3]);
                const unsigned r0 = 16 * wave + 32 * ks + 4 * g + q4;
#pragma unroll
                for (int c = 0; c < 8; ++c) {
                    const s16x4 v0 = tr_read(lds + AT_V + off_b(r0, 2 * c + (p4 >> 1)) + 8 * (p4 & 1));
                    const s16x4 v1 = tr_read(lds + AT_V + off_b(r0 + 16, 2 * c + (p4 >> 1)) + 8 * (p4 & 1));
                    bf16x8 va; va[0] = v0[0]; va[1] = v0[1]; va[2] = v0[2]; va[3] = v0[3]; va[4] = v1[0]; va[5] = v1[1]; va[6] = v1[2]; va[7] = v1[3];
                    o[c] = __builtin_amdgcn_mfma_f32_16x16x32_bf16(va, pb.v, o[c], 0, 0, 0); } } }
        const float inv = 1.0f / ls;
        const size_t qrow = (size_t)d.b * SEQ + d.res + d.dil * (128 * d.blk + 16 * wave + qn);
        bf16* op = obr + (size_t)d.di * MTOK * ATTW + qrow * ATTW + d.hd * HDIM + 4 * g;
#pragma unroll
        for (int c = 0; c < 8; ++c) *(GAS v2u*)(op + 16 * c) = (v2u){pk2(o[c][0] * inv, o[c][1] * inv), pk2(o[c][2] * inv, o[c][3] * inv)};
        if (g == 0) lse[(size_t)d.di * MTOK * NHEAD + qrow * NHEAD + d.hd] = mx + __builtin_amdgcn_logf(ls);
        __syncthreads();
        if (!has) break;
        u = un;
    }
#undef AT_ISSUE
}

__device__ __forceinline__ void ynorm_phase(bf16* ycat, const bf16* obr, const float* lse, int lane, int wave) {
    for (int r = 0; r < 4; ++r) { const int row = blockIdx.x * 32 + wave * 4 + r;
        { const int hd = lane >> 3;
          const float l0 = lse[(size_t)row * NHEAD + hd], l1 = lse[(size_t)MTOK * NHEAD + (size_t)row * NHEAD + hd], l2 = lse[(size_t)2 * MTOK * NHEAD + (size_t)row * NHEAD + hd];
          const float lm = fmaxf(l0, fmaxf(l1, l2)); float w0 = __builtin_amdgcn_exp2f(l0 - lm), w1 = __builtin_amdgcn_exp2f(l1 - lm), w2 = __builtin_amdgcn_exp2f(l2 - lm);
          const float wi = 1.0f / (w0 + w1 + w2); w0 *= wi; w1 *= wi; w2 *= wi;
          float v[16];
#pragma unroll
          for (int i = 0; i < 16; ++i) v[i] = 0.f;
#pragma unroll
          for (int d = 0; d < 3; ++d) { const bf16* p = obr + (size_t)d * MTOK * ATTW + (size_t)row * ATTW + lane * 16; const v4u a = *(const GAS v4u*)p, c = *(const GAS v4u*)(p + 8); const float w = d == 0 ? w0 : d == 1 ? w1 : w2;
              v[0] += w * bf_lo(a.x); v[1] += w * bf_hi(a.x); v[2] += w * bf_lo(a.y); v[3] += w * bf_hi(a.y); v[4] += w * bf_lo(a.z); v[5] += w * bf_hi(a.z); v[6] += w * bf_lo(a.w); v[7] += w * bf_hi(a.w);
              v[8] += w * bf_lo(c.x); v[9] += w * bf_hi(c.x); v[10] += w * bf_lo(c.y); v[11] += w * bf_hi(c.y); v[12] += w * bf_lo(c.z); v[13] += w * bf_hi(c.z); v[14] += w * bf_lo(c.w); v[15] += w * bf_hi(c.w); }
          float s = 0.f;
#pragma unroll
          for (int i = 0; i < 16; ++i) s += v[i] * v[i];
          const float rstd = 1.0f / sqrtf(wave_sum(s) * (1.0f / ATTW) + 1e-6f);
          bf16* p = ycat + (size_t)row * DM + SSMW + lane * 16;
          *(GAS v4u*)p = (v4u){pk2(v[0] * rstd, v[1] * rstd), pk2(v[2] * rstd, v[3] * rstd), pk2(v[4] * rstd, v[5] * rstd), pk2(v[6] * rstd, v[7] * rstd)};
          *(GAS v4u*)(p + 8) = (v4u){pk2(v[8] * rstd, v[9] * rstd), pk2(v[10] * rstd, v[11] * rstd), pk2(v[12] * rstd, v[13] * rstd), pk2(v[14] * rstd, v[15] * rstd)}; } }
}
__device__ __forceinline__ void final_norm_phase(float* out, const float* gfin, int lane, int wave) {
    for (int r = 0; r < 4; ++r) { const int row = blockIdx.x * 32 + wave * 4 + r;
        f32x4* xr = (f32x4*)(out + (size_t)row * DM) + lane; f32x4 v[8]; float s = 0.f;
#pragma unroll
        for (int j = 0; j < 8; ++j) { v[j] = xr[64 * j]; s += (v[j].x * v[j].x + v[j].y * v[j].y) + (v[j].z * v[j].z + v[j].w * v[j].w); }
        const float rstd = 1.0f / sqrtf(wave_sum(s) * (1.0f / DM) + 1e-6f);
#pragma unroll
        for (int j = 0; j < 8; ++j) { const f32x4 gq = *((const f32x4*)gfin + lane + 64 * j); xr[64 * j] = v[j] * rstd * gq; } }
}

constexpr int NPH = 11;
constexpr int ATT_P3_UNITS = 512;
constexpr int IT_GEMV = KSPLIT * 48, IT_SSM = NGRP * 25, IT_FIN = 48 * 4, IT_ROPE = MTOK, IT_WIN = (DM / 64) * (PROJW / 64), IT_WGLU = (SSMW / 64) * (SSMW / 64), IT_WOUT = (DM / 64) * (DM / 64),
              IT_WG = (DM / 64) * (DFF / 64), IT_WD = (DFF / 64) * (DM / 64), IT_TOTAL = IT_GEMV + IT_SSM + IT_FIN + IT_ROPE + IT_WIN + IT_WGLU + IT_WOUT + 2 * IT_WG;
__global__ void __launch_bounds__(NWAVES * 64, 2) hymba_fwd(Args args) {
    extern __shared__ __attribute__((aligned(16))) unsigned char lds_raw[];
    LAS unsigned char* lds = (LAS unsigned char*)lds_raw;
    cg::grid_group grid = cg::this_grid();
    const int tid = threadIdx.x, lane = tid & 63, wave = __builtin_amdgcn_readfirstlane(tid >> 6);
    const int G = gridDim.x, bx = blockIdx.x;
    unsigned char* ws = args.ws;
    const float* const* in = args.in;
    float* modp = (float*)(ws + WS_MODP); float* modf = (float*)(ws + WS_MODF); float* cosT = (float*)(ws + WS_ROPE); float* sinT = cosT + (size_t)MTOK * 64;
    bf16* ktab = (bf16*)(ws + WS_KTAB); bf16* gtab = (bf16*)(ws + WS_GTAB); bf16* htab = (bf16*)(ws + WS_HTAB); float* a64 = (float*)(ws + WS_A64);
    bf16* Win = (bf16*)(ws + WS_WIN); bf16* Wglu = (bf16*)(ws + WS_WGLU); bf16* Wout = (bf16*)(ws + WS_WOUT); bf16* Wgu = (bf16*)(ws + WS_WGU); bf16* Wdn = (bf16*)(ws + WS_WDN);
    bf16* Hb = (bf16*)(ws + WS_H); bf16* proj = (bf16*)(ws + WS_PROJ); bf16* vg = (bf16*)(ws + WS_VG); bf16* ycat = (bf16*)(ws + WS_YCAT); bf16* obr = (bf16*)(ws + WS_OBR); float* lse = (float*)(ws + WS_LSE);
    bf16* ff = (bf16*)(ws + WS_FF); bf16* ut = (bf16*)(ws + WS_UT);
    const int lo = args.ph_lo, hi = args.ph_hi;
#ifndef PHMASK
#define PHMASK 0x7ff
#endif
#define IN(k) (((PHMASK >> (k)) & 1) && lo <= (k) && (k) < hi)
    volatile LAS unsigned* MISC = (volatile LAS unsigned*)(lds + MISC_OFF);
    if (tid < 2) MISC[tid] = 0u;
    __syncthreads();
    if (args.ph_lo < 0) grid.sync();
    const XcdBarrier xbar = xcd_barrier_post((unsigned*)(ws + WS_CTL), MISC);
    STAMP(0);
#define SEAM(k) do { if (IN(k) && IN((k) + 1)) xcd_barrier(xbar); } while (0)
#ifndef DOUBLE_MASK
#define DOUBLE_MASK 0
#endif
#define P0SUB 8
#define P3SUB 1
#define REPS(k) for (int rep_ = 0; rep_ < 1 + ((DOUBLE_MASK >> (k)) & 1); ++rep_)
#define RSYNC(k) do { if ((DOUBLE_MASK >> (k)) & 1) xcd_barrier(xbar); } while (0)

    REPS(0) if (IN(0)) {
        RSYNC(0);
        LAS float* scr = (LAS float*)(lds + wave * 16640);
        const int gw = wave * G + bx, NGW = G * NWAVES;
        const int nmine = (IT_TOTAL - gw + NGW - 1) / NGW;
        for (int kk = 0; kk < nmine; ++kk) {
            const bool gfirst = (gw < IT_GEMV);
            const int it = gw + ((wave & 1) ? ((gfirst && kk == 0) ? 0 : (gfirst ? nmine - kk : nmine - 1 - kk)) : kk) * NGW;
            int r = it;
#if DOUBLE_MASK & 1
            if (rep_ == 1) { const int ty = (it < IT_GEMV) ? 1 : (it < IT_GEMV + IT_SSM) ? 2 : (it < IT_GEMV + IT_SSM + IT_ROPE) ? 4 : 8; if (!(P0SUB & ty)) continue; }
#endif
            if (r < IT_GEMV) { p0_gemv_item(in[1], in[3], modp, modf, in[4], (unsigned*)(ws + WS_CNT), scr, r, lane); continue; } r -= IT_GEMV;
            if (r < IT_SSM) { const int g = r / 25, sub = r % 25;
                if (sub < 9) p0_ktab_item(in, ktab, a64, scr, g, sub, lane); else if (sub < 17) p0_gtab_item(in, gtab, g, sub - 9, lane); else p0_htab_item(in, htab, g, sub - 17, lane);
                continue; } r -= IT_SSM;
            if (r < IT_FIN) { p0_fin_item(modp, modf, in[4], (unsigned*)(ws + WS_CNT), r, lane); continue; } r -= IT_FIN;
            if (r < IT_ROPE) { p0_rope_item((const int*)in[2], cosT, sinT, r, lane); continue; } r -= IT_ROPE;
            if (r < IT_WIN) { p0_transpose_item<1>(in[6], DM, PROJW, Win, scr, r, lane, nullptr, nullptr); continue; } r -= IT_WIN;
            if (r < IT_WGLU) { p0_transpose_item<0>(in[15], SSMW, SSMW, Wglu, scr, r, lane, nullptr, nullptr); continue; } r -= IT_WGLU;
            if (r < IT_WOUT) { p0_transpose_item<4>(in[19], DM, DM, Wout, scr, r, lane, in[17], in[18]); continue; } r -= IT_WOUT;
            if (r < IT_WG) { p0_transpose_item<2>(in[21], DM, DFF, Wgu, scr, r, lane, nullptr, nullptr); continue; } r -= IT_WG;
            p0_transpose_item<3>(in[22], DM, DFF, Wgu, scr, r, lane, nullptr, nullptr);
        }
        __syncthreads();
    }
    STAMP(1); STAMP(2);
    REPS(1) if (IN(1)) {
        RSYNC(1);
        unsigned* gcnt = (unsigned*)(ws + WS_CNT);
        if (wave == 0) { unsigned sp = 0u; unsigned* dn = gcnt + 64 * 48;
            while ((unsigned)__builtin_amdgcn_readfirstlane((int)__hip_atomic_load(dn, __ATOMIC_RELAXED, __HIP_MEMORY_SCOPE_AGENT)) < 192u) { __builtin_amdgcn_s_sleep(4); if (++sp > (1u << 22)) break; }
            __builtin_amdgcn_fence(__ATOMIC_ACQUIRE, "agent"); asm volatile("s_waitcnt vmcnt(0)" ::: "memory"); }
        __syncthreads();
        modnorm_phase<false>(lds, in[0], Hb, in[5], modp, in[4], modf, 0, 1, tid, lane, wave);
    }
    STAMP(3); SEAM(1); STAMP(4);
    if (IN(2)) {
        pg8::Gemm g{Hb, Win, MTOK, PROJW, DM}; pg8::StaticOrder S; S.init(MTOK, PROJW, G, bx);
        pg8::EpiProj E{proj, ut, cosT, sinT, 0.08838834764831845f * 1.4426950408889634f};
        pg8::gemm_phase<pg8::EpiProj, pg8::StaticOrder, true, true>(lds, g, S, E);
    }
    STAMP(5); SEAM(2); STAMP(6);
    REPS(3) if (IN(3)) {
        RSYNC(3);
        int tid = threadIdx.x; asm volatile("" : "+v"(tid)); const int lane = tid & 63, wave = __builtin_amdgcn_readfirstlane(tid >> 6);
#if DOUBLE_MASK & 8
        if (rep_ == 0 || (P3SUB & 1))
#endif
        for (int u0 = bx; u0 < BATCH * NGRP; u0 += G) { const int u = ((u0 & 7) * 32 + ((u0 >> 3) & 31)) + (u0 & ~255);
            ssm_unit(lds, u / NGRP, u % NGRP, ut, ktab, gtab, htab, a64, in[14], vg, tid, lane, wave); }
        STAMP(7);
#if DOUBLE_MASK & 8
        if (rep_ == 0 || (P3SUB & 2))
#endif
        { const int ax = 192 * (bx & 7), aj = bx >> 3;
          attn_run(lds, ax + aj, 32, ax + 64, proj, obr, lse, tid, lane, wave); }
    }
    STAMP(8); SEAM(3); STAMP(9);
    if (IN(4)) {
        pg8::Gemm g{vg, Wglu, MTOK, SSMW, SSMW}; pg8::StaticOrder S; S.init(MTOK, SSMW, G, bx);
        pg8::EpiGluNorm E{ycat, vg, in[16], (float*)(ws + WS_SLOTS) + 2 * 65536, (unsigned*)(ws + WS_GCNT)};
        pg8::gemm_phase<pg8::EpiGluNorm, pg8::StaticOrder, false, true>(lds, g, S, E);
        __syncthreads();
        STAMP(10);
        { int tid = threadIdx.x; asm volatile("" : "+v"(tid)); const int lane = tid & 63, wave = __builtin_amdgcn_readfirstlane(tid >> 6);
          const bool glu = bx < 128; const int ax = 192 * (bx & 7), aj = bx >> 3;
          attn_run(lds, glu ? ax + 64 + aj : ax + 80 + (aj - 16), 16, glu ? ax + 80 : ax + 192, proj, obr, lse, tid, lane, wave); }
    }
    STAMP(11); SEAM(4); STAMP(12);
    REPS(5) if (IN(5)) ynorm_phase(ycat, obr, lse, lane, wave);
    STAMP(13); SEAM(5); STAMP(14);
    if (IN(6)) {
        pg8::Gemm g{ycat, Wout, MTOK, DM, DM}; pg8::StaticOrder S; S.init(MTOK, DM, G, bx);
        pg8::EpiNormX<0> E{in[0], args.out, Hb, modf + 2 * DM, in[20], modf + 4 * DM, modf + 3 * DM, (float*)(ws + WS_SLOTS), (unsigned*)(ws + WS_PCNT)};
        pg8::gemm_phase<pg8::EpiNormX<0>, pg8::StaticOrder, false, true>(lds, g, S, E);
    }
    STAMP(15); SEAM(6); STAMP(16);
    if (IN(8)) {
        pg8::Gemm g{Hb, Wgu, MTOK, 2 * DFF, DM}; pg8::StaticOrder S; S.init(MTOK, 2 * DFF, G, bx);
        pg8::EpiSwiglu E{ff};
        pg8::gemm_phase<pg8::EpiSwiglu, pg8::StaticOrder, true, true>(lds, g, S, E);
        if (bx >= 128) { int tid2 = threadIdx.x; asm volatile("" : "+v"(tid2)); const int lane2 = tid2 & 63, wave2 = __builtin_amdgcn_readfirstlane(tid2 >> 6);
            LAS float* scr = (LAS float*)(lds + wave2 * 16640);
            for (int it = (bx - 128) * NWAVES + wave2; it < IT_WD; it += 128 * NWAVES) p0_transpose_item<0>(in[23], DFF, DM, Wdn, scr, it, lane2, nullptr, nullptr); }
    }
    STAMP(19); SEAM(8); STAMP(20);
    if (IN(9)) {
        pg8::Gemm g{ff, Wdn, MTOK, DM, DFF}; pg8::StaticOrder S; S.init(MTOK, DM, G, bx);
        pg8::EpiNormX<1> E{args.out, args.out, nullptr, modf + 5 * DM, in[24], nullptr, nullptr, (float*)(ws + WS_SLOTS) + 65536, (unsigned*)(ws + WS_PCNT) + 32 * 64};
        pg8::gemm_phase<pg8::EpiNormX<1>, pg8::StaticOrder, false, true>(lds, g, S, E);
    }
    STAMP(21); STAMP(22);
    if (TS_A >= 0 && bx == 0) { STAMP(23); __syncthreads();
        const volatile LAS unsigned long long* ts = (const volatile LAS unsigned long long*)(lds + MISC_OFF + 16);
        unsigned long long tot = 0ull;
        for (int i = 0; i < 23; ++i) if ((TS_MASK >> i) & 1) tot += ts[i + 1] - ts[i];
        if (TS_X >= 0) tot = ts[TS_Y < 0 ? 0 : TS_Y] - ts[TS_X < 0 ? 0 : TS_X];
        const float dl = (float)tot * TS_SCALE;
        for (int i = threadIdx.x; i < 4096; i += NWAVES * 64) args.out[i] += dl; }
#undef IN
#undef SEAM
}

#ifndef MK_PER_PHASE
#define MK_PER_PHASE 0
#endif
extern "C" void kernel_launch(void* const* d_in, const int* in_sizes, int n_in, void* d_out, int out_size, void* d_ws, size_t ws_size, hipStream_t stream) {
    static int ready = 0;
    if (ready == 0) {
        ready = 1;
        if (n_in != 25 || out_size != MTOK * DM || ws_size < WS_END) { fprintf(stderr, "kernel_launch: unexpected shapes (n_in %d out %d ws %zu)\n", n_in, out_size, ws_size); ready = -1; }
        else if (hipFuncSetAttribute((const void*)hymba_fwd, hipFuncAttributeMaxDynamicSharedMemorySize, LDS_BYTES) != hipSuccess) { fprintf(stderr, "kernel_launch: hipFuncSetAttribute failed\n"); ready = -1; }
        else { int per_cu = 0; (void)hipOccupancyMaxActiveBlocksPerMultiprocessor(&per_cu, (const void*)hymba_fwd, NWAVES * 64, LDS_BYTES); (void)hipGetLastError();
               if (per_cu < 1) fprintf(stderr, "kernel_launch: occupancy query reports %d blocks per CU\n", per_cu); }
    }
    if (ready < 0) return;
    if (hipMemsetAsync((char*)d_ws + WS_CTL, 0, CTL_ZERO_BYTES, stream) != hipSuccess) { fprintf(stderr, "kernel_launch: memset failed\n"); return; }
    Args a{};
    for (int i = 0; i < 25; ++i) a.in[i] = (const float*)d_in[i];
    a.out = (float*)d_out; a.ws = (unsigned char*)d_ws;
#if MK_PER_PHASE
    for (int p = 0; p < NPH; ++p) { a.ph_lo = p; a.ph_hi = p + 1; hipLaunchKernelGGL(hymba_fwd, dim3(256), dim3(NWAVES * 64), LDS_BYTES, stream, a); }
#else
    a.ph_lo = 0; a.ph_hi = NPH;
    void* kargs[] = {&a};
    hipError_t e = hipLaunchCooperativeKernel((const void*)hymba_fwd, dim3(256), dim3(NWAVES * 64), kargs, LDS_BYTES, stream);
    if (e != hipSuccess) fprintf(stderr, "kernel_launch: cooperative launch failed: %s\n", hipGetErrorString(e));
#endif
}
```

```cpp
#include <hip/hip_runtime.h>
#include <hip/hip_cooperative_groups.h>
#include <cstdio>
#include <cstdint>
namespace cg = cooperative_groups;
namespace pg8 {
#define PG8_LAS __attribute__((address_space(3)))
typedef unsigned short bf16_t;
typedef short bf16x8 __attribute__((ext_vector_type(8)));
typedef float f32x4 __attribute__((ext_vector_type(4)));
typedef unsigned u32x4 __attribute__((ext_vector_type(4)));
constexpr int BM = 256, BK = 64, HALF = 128, HTB = HALF * BK * 2  , STAGE_BYTES = 8 * HTB, NXCD = 8, WGM = 8;

__host__ __device__ __forceinline__ int lds_byte(int r, int c) { const int st = (r >> 4) * 2 + (c >> 5), rr = r & 15, cc = c & 31, ob = rr * 64 + cc * 2; return st * 1024 + (ob ^ (((ob >> 9) & 1) << 5)); }
__host__ __device__ __forceinline__ void stage_rc(int b, int& R, int& C) { const int st = b / 1024, sb = b % 1024, swz = sb ^ (((sb >> 9) & 1) << 5); R = (st >> 1) * 16 + swz / 64; C = (st & 1) * 32 + (swz % 64) / 2; }
__host__ __device__ __forceinline__ int perm32(int rho) { const int n = rho >> 4, i = rho & 15; return 8 * (i >> 2) + 4 * n + (i & 3); }

struct Unit { int pm, pn; };
struct Gemm { const bf16_t* A; const bf16_t* Bt; int M, N, K; };

struct StaticOrder {
    int nM, nN, nwg, G, c;
    __host__ __device__ void init(int M, int N, int G_, int c_) { nM = M / BM; nN = N / BM; nwg = nM * nN; G = G_; c = c_; }
    __host__ __device__ bool next(int i, Unit& u) const {
        const long L = (long)i * G + c; if (L >= nwg) return false;
        int wgid = (int)L; { const int q = nwg / NXCD, r = nwg % NXCD, xcd = wgid % NXCD, off = wgid / NXCD; wgid = (xcd < r ? xcd * (q + 1) : r * (q + 1) + (xcd - r) * q) + off; }
        const int nig = WGM * nN, gid = wgid / nig, fm = gid * WGM, gsz = (nM - fm) < WGM ? (nM - fm) : WGM;
        u.pm = fm + ((wgid % nig) % gsz); u.pn = (wgid % nig) / gsz; return true;
    }
    __device__ __forceinline__ void a_ready(const Unit&) const {}
    __device__ __forceinline__ void done(const Unit&) const {}
};

__device__ __forceinline__ unsigned cvt_pk_bf16(float lo, float hi) { unsigned r; asm volatile("v_cvt_pk_bf16_f32 %0, %1, %2" : "=v"(r) : "v"(lo), "v"(hi)); return r; }
typedef float f32x2 __attribute__((ext_vector_type(2)));
__device__ __forceinline__ f32x2 gelu_pk(f32x2 v) {
    const f32x2 av = __builtin_elementwise_abs(v), d = av * 0.2316418882f + 1.0f;
    f32x2 t; t.x = __builtin_amdgcn_rcpf(d.x); t.y = __builtin_amdgcn_rcpf(d.y);
    f32x2 q = t * 0.5307027145f + (-0.7265760135f); q = q * t + 0.7107068705f; q = q * t + (-0.142248368f); q = q * t + 0.127414796f; q = q * t;
    const f32x2 s = (v * v) * (-0.72134752044f);
    f32x2 e; e.x = __builtin_amdgcn_exp2f(s.x); e.y = __builtin_amdgcn_exp2f(s.y);
    const f32x2 m = v * (q * e), r = v - m;
    f32x2 o; o.x = v.x < 0.f ? m.x : r.x; o.y = v.y < 0.f ? m.y : r.y; return o;
}

__device__ __forceinline__ float bflo(unsigned w) { return __uint_as_float(w << 16); }
__device__ __forceinline__ float bfhi(unsigned w) { return __uint_as_float(w & 0xffff0000u); }
__device__ __forceinline__ float fast_sigmoid(float v) { return __builtin_amdgcn_rcpf(1.0f + __builtin_amdgcn_exp2f(-1.4426950408889634f * v)); }
struct EpiProj {
    static constexpr bool PERM = true, AFTER_DRAIN = false;
    bf16_t* O; bf16_t* UT; const float* cosT; const float* sinT; float qscale;
    __device__ __forceinline__ void operator()(const f32x4 (&acc)[2][2][4][2], const Unit& u, int wr, int wc, int fr, int fq) const {
        const int row0 = u.pm * BM + wr * 64 + fr; const int col0 = u.pn * BM + wc * 32 + 8 * fq;
        const int sect = u.pn >> 2;
        const int j0 = 4 * (4 * wc + fq);
        const float sc = (sect == 1) ? qscale : 1.f;
#pragma unroll
        for (int ai = 0; ai < 2; ++ai)
#pragma unroll
            for (int m = 0; m < 4; ++m) { const int row = row0 + ai * HALF + m * 16; bf16_t* rowp = O + (size_t)row * 4096 + col0;
                f32x4 cs = (f32x4){1.f, 1.f, 1.f, 1.f}, sn = (f32x4){0.f, 0.f, 0.f, 0.f};
                if (sect == 1 || sect == 2) { cs = *(const f32x4*)(cosT + (size_t)row * 64 + j0); sn = *(const f32x4*)(sinT + (size_t)row * 64 + j0); }
#pragma unroll
                for (int bj = 0; bj < 2; ++bj) { const f32x4 t1 = acc[ai][bj][m][0], t2 = acc[ai][bj][m][1];
                    f32x4 v0 = (t1 * cs - t2 * sn) * sc, v1 = (t1 * sn + t2 * cs) * sc;
                    u32x4 w; w.x = cvt_pk_bf16(v0[0], v0[1]); w.y = cvt_pk_bf16(v0[2], v0[3]); w.z = cvt_pk_bf16(v1[0], v1[1]); w.w = cvt_pk_bf16(v1[2], v1[3]);
                    if (sect == 0) { const int col = col0 + bj * HALF; *(u32x4*)(UT + ((size_t)((row >> 11) * 64 + (col >> 4)) * 2048 + (row & 2047)) * 16 + (col & 15)) = w; }
                    else *(u32x4*)(rowp + bj * HALF) = w; } }
    }
};
struct EpiGlu {
    static constexpr bool PERM = true, AFTER_DRAIN = false;
    bf16_t* O; const bf16_t* VG; const float* bias;
    __device__ __forceinline__ void operator()(const f32x4 (&acc)[2][2][4][2], const Unit& u, int wr, int wc, int fr, int fq) const {
        const int row0 = u.pm * BM + wr * 64 + fr; const int col0 = u.pn * BM + wc * 32 + 8 * fq;
        f32x4 bv[2][2];
#pragma unroll
        for (int bj = 0; bj < 2; ++bj)
#pragma unroll
            for (int n = 0; n < 2; ++n) bv[bj][n] = *(const f32x4*)(bias + col0 + bj * HALF + 4 * n);
#pragma unroll
        for (int ai = 0; ai < 2; ++ai)
#pragma unroll
            for (int m = 0; m < 4; ++m) { const int row = row0 + ai * HALF + m * 16;
#pragma unroll
                for (int bj = 0; bj < 2; ++bj) { const u32x4 g = *(const u32x4*)(VG + (size_t)row * 1024 + col0 + bj * HALF);
                    const f32x4 a0 = acc[ai][bj][m][0] + bv[bj][0], a1 = acc[ai][bj][m][1] + bv[bj][1];
                    u32x4 w; w.x = cvt_pk_bf16(bflo(g.x) * fast_sigmoid(a0[0]), bfhi(g.x) * fast_sigmoid(a0[1])); w.y = cvt_pk_bf16(bflo(g.y) * fast_sigmoid(a0[2]), bfhi(g.y) * fast_sigmoid(a0[3]));
                    w.z = cvt_pk_bf16(bflo(g.z) * fast_sigmoid(a1[0]), bfhi(g.z) * fast_sigmoid(a1[1])); w.w = cvt_pk_bf16(bflo(g.w) * fast_sigmoid(a1[2]), bfhi(g.w) * fast_sigmoid(a1[3]));
                    *(u32x4*)(O + (size_t)row * 2048 + col0 + bj * HALF) = w; } }
    }
};
struct EpiResid {
    static constexpr bool PERM = false, AFTER_DRAIN = false;
    const float* base; float* out; const float* gate;
    __device__ __forceinline__ void operator()(const f32x4 (&acc)[2][2][4][2], const Unit& u, int wr, int wc, int fr, int fq) const {
        const int col0 = u.pn * BM + wc * 32 + 4 * fq; const int b = u.pm >> 3;
        f32x4 gv[2][2];
#pragma unroll
        for (int bj = 0; bj < 2; ++bj)
#pragma unroll
            for (int n = 0; n < 2; ++n) gv[bj][n] = *(const f32x4*)(gate + (size_t)b * 12288 + col0 + bj * HALF + n * 16);
#pragma unroll
        for (int ai = 0; ai < 2; ++ai)
#pragma unroll
            for (int m = 0; m < 4; ++m) { const size_t off = (size_t)(u.pm * BM + ai * HALF + wr * 64 + m * 16 + fr) * 2048 + col0;
#pragma unroll
                for (int bj = 0; bj < 2; ++bj)
#pragma unroll
                    for (int n = 0; n < 2; ++n) { const f32x4 bs = *(const f32x4*)(base + off + bj * HALF + n * 16);
                        *(f32x4*)(out + off + bj * HALF + n * 16) = bs + gv[bj][n] * acc[ai][bj][m][n]; } }
    }
};
template <int MODE> struct EpiNormX {
    static constexpr bool PERM = true, AFTER_DRAIN = true;
    const float* base; float* xout; bf16_t* hout; const float* gate; const float* gvec; const float* scv; const float* shv; float* slots; unsigned* cnt; bf16_t* xb;
    __device__ __forceinline__ void fused(f32x4 (&acc)[2][2][4][2], const Unit& u, int wr, int wc, int fr, int fq, PG8_LAS unsigned char* lds, int wid, int lane) const {
        PG8_LAS float* P = (PG8_LAS float*)lds; PG8_LAS float* S = (PG8_LAS float*)(lds + 8192); PG8_LAS unsigned* flag = (PG8_LAS unsigned*)(lds + 8192 + 2048);
        const int col0 = u.pn * BM + wc * 32 + 8 * fq; const int b = u.pm >> 3; const int tid = wid * 64 + lane;
        { f32x4 gv[2][2];
#pragma unroll
          for (int bj = 0; bj < 2; ++bj)
#pragma unroll
              for (int n = 0; n < 2; ++n) gv[bj][n] = *(const f32x4*)(gate + (size_t)b * 12288 + col0 + bj * HALF + 4 * n);
#pragma unroll
          for (int ai = 0; ai < 2; ++ai)
#pragma unroll
              for (int m = 0; m < 4; ++m) { const int r = ai * HALF + wr * 64 + m * 16 + fr; const size_t off = (size_t)(u.pm * BM + r) * 2048 + col0; float sq = 0.f;
#pragma unroll
                  for (int bj = 0; bj < 2; ++bj) { u32x4 xw; if (MODE == 1) xw = __builtin_nontemporal_load((const u32x4*)(xb + off + bj * HALF));
#pragma unroll
                      for (int n = 0; n < 2; ++n) { f32x4 bs;
                          if (MODE == 1) { const unsigned w0 = n ? xw.z : xw.x, w1 = n ? xw.w : xw.y; bs = (f32x4){bflo(w0), bfhi(w0), bflo(w1), bfhi(w1)}; }
                          else bs = __builtin_nontemporal_load((const f32x4*)(base + off + bj * HALF + 4 * n));
                          const f32x4 v = bs + gv[bj][n] * acc[ai][bj][m][n]; acc[ai][bj][m][n] = v;
                          sq += (v[0] * v[0] + v[1] * v[1]) + (v[2] * v[2] + v[3] * v[3]); } }
                  sq += __shfl_xor(sq, 16); sq += __shfl_xor(sq, 32);
                  if (fq == 0) P[r * 4 + wc] = sq;
                  if (m & 1) asm volatile("" ::: "memory"); } }
        asm volatile("s_waitcnt lgkmcnt(0)" ::: "memory"); __builtin_amdgcn_s_barrier(); asm volatile("" ::: "memory");
        if (tid < 256) { const float tot = (P[tid * 4 + 0] + P[tid * 4 + 1]) + (P[tid * 4 + 2] + P[tid * 4 + 3]);
            unsigned* sl = (unsigned*)slots + ((size_t)(u.pm * 8 + u.pn) * 256 + tid);
            __hip_atomic_store(sl, __float_as_uint(tot), __ATOMIC_RELAXED, __HIP_MEMORY_SCOPE_AGENT);
            asm volatile("s_waitcnt vmcnt(0)" ::: "memory");
            const unsigned rb = __hip_atomic_load(sl, __ATOMIC_RELAXED, __HIP_MEMORY_SCOPE_AGENT);
            asm volatile("s_waitcnt vmcnt(0)" :: "v"(rb) : "memory"); }
        asm volatile("s_waitcnt vmcnt(0)" ::: "memory");
        if (wid < 4 && lane == 0) __hip_atomic_fetch_add(cnt + 64 * u.pm, 1u, __ATOMIC_RELAXED, __HIP_MEMORY_SCOPE_AGENT);
        if (wid == 0) { unsigned sp = 0u;
            while ((unsigned)__builtin_amdgcn_readfirstlane((int)__hip_atomic_load(cnt + 64 * u.pm, __ATOMIC_RELAXED, __HIP_MEMORY_SCOPE_AGENT)) < 32u) { __builtin_amdgcn_s_sleep(2); if (++sp > (1u << 22)) break; }
            if (lane == 0) flag[0] = sp; }
        asm volatile("s_waitcnt vmcnt(0) lgkmcnt(0)" ::: "memory"); __builtin_amdgcn_s_barrier(); asm volatile("" ::: "memory");
        if (tid < 256) { float tot = 0.f;
#pragma unroll
            for (int t = 0; t < 8; ++t) tot += __uint_as_float(__hip_atomic_load((unsigned*)slots + ((size_t)(u.pm * 8 + t) * 256 + tid), __ATOMIC_RELAXED, __HIP_MEMORY_SCOPE_AGENT));
            S[tid] = 1.0f / sqrtf(tot * (1.0f / 2048.0f) + 1e-6f); }
        asm volatile("s_waitcnt vmcnt(0) lgkmcnt(0)" ::: "memory"); __builtin_amdgcn_s_barrier(); asm volatile("" ::: "memory");
        f32x4 ga[2][2], sh[2][2];
#pragma unroll
        for (int bj = 0; bj < 2; ++bj)
#pragma unroll
            for (int n = 0; n < 2; ++n) { const int c = col0 + bj * HALF + 4 * n; ga[bj][n] = *(const f32x4*)(gvec + c);
                if (MODE == 0) { ga[bj][n] = ga[bj][n] * (*(const f32x4*)(scv + (size_t)b * 12288 + c) + 1.0f); sh[bj][n] = *(const f32x4*)(shv + (size_t)b * 12288 + c); } }
#pragma unroll
        for (int ai = 0; ai < 2; ++ai)
#pragma unroll
            for (int m = 0; m < 4; ++m) { const int r = ai * HALF + wr * 64 + m * 16 + fr; const size_t off = (size_t)(u.pm * BM + r) * 2048 + col0; const float rstd = S[r];
#pragma unroll
                for (int bj = 0; bj < 2; ++bj) { const f32x4 v0 = acc[ai][bj][m][0], v1 = acc[ai][bj][m][1];
                    if (MODE == 0) { { u32x4 xw; xw.x = cvt_pk_bf16(v0[0], v0[1]); xw.y = cvt_pk_bf16(v0[2], v0[3]); xw.z = cvt_pk_bf16(v1[0], v1[1]); xw.w = cvt_pk_bf16(v1[2], v1[3]); *(u32x4*)(xb + off + bj * HALF) = xw; }
                        const f32x4 h0 = v0 * rstd * ga[bj][0] + sh[bj][0], h1 = v1 * rstd * ga[bj][1] + sh[bj][1];
                        u32x4 w; w.x = cvt_pk_bf16(h0[0], h0[1]); w.y = cvt_pk_bf16(h0[2], h0[3]); w.z = cvt_pk_bf16(h1[0], h1[1]); w.w = cvt_pk_bf16(h1[2], h1[3]);
                        *(u32x4*)(hout + off + bj * HALF) = w; }
                    else { *(f32x4*)(xout + off + bj * HALF) = v0 * rstd * ga[bj][0]; *(f32x4*)(xout + off + bj * HALF + 4) = v1 * rstd * ga[bj][1]; } }
                asm volatile("" ::: "memory"); }
    }
};
struct EpiGluNorm {
    static constexpr bool PERM = true, AFTER_DRAIN = true;
    bf16_t* O; const bf16_t* VG; const float* bias; float* slots; unsigned* cnt;
    __device__ __forceinline__ void fused(f32x4 (&acc)[2][2][4][2], const Unit& u, int wr, int wc, int fr, int fq, PG8_LAS unsigned char* lds, int wid, int lane) const {
        PG8_LAS float* P = (PG8_LAS float*)lds; PG8_LAS float* S = (PG8_LAS float*)(lds + 8192); PG8_LAS unsigned* flag = (PG8_LAS unsigned*)(lds + 8192 + 2048);
        const int col0 = u.pn * BM + wc * 32 + 8 * fq; const int tid = wid * 64 + lane;
        { f32x4 bv[2][2];
#pragma unroll
          for (int bj = 0; bj < 2; ++bj)
#pragma unroll
              for (int n = 0; n < 2; ++n) bv[bj][n] = *(const f32x4*)(bias + col0 + bj * HALF + 4 * n);
#pragma unroll
          for (int ai = 0; ai < 2; ++ai)
#pragma unroll
              for (int m = 0; m < 4; ++m) { const int r = ai * HALF + wr * 64 + m * 16 + fr; const size_t row = (size_t)(u.pm * BM + r); float sq = 0.f;
#pragma unroll
                  for (int bj = 0; bj < 2; ++bj) { const u32x4 g = *(const u32x4*)(VG + row * 1024 + col0 + bj * HALF);
                      const f32x4 a0 = acc[ai][bj][m][0] + bv[bj][0], a1 = acc[ai][bj][m][1] + bv[bj][1];
                      const f32x4 v0 = {bflo(g.x) * fast_sigmoid(a0[0]), bfhi(g.x) * fast_sigmoid(a0[1]), bflo(g.y) * fast_sigmoid(a0[2]), bfhi(g.y) * fast_sigmoid(a0[3])};
                      const f32x4 v1 = {bflo(g.z) * fast_sigmoid(a1[0]), bfhi(g.z) * fast_sigmoid(a1[1]), bflo(g.w) * fast_sigmoid(a1[2]), bfhi(g.w) * fast_sigmoid(a1[3])};
                      acc[ai][bj][m][0] = v0; acc[ai][bj][m][1] = v1;
                      sq += ((v0[0] * v0[0] + v0[1] * v0[1]) + (v0[2] * v0[2] + v0[3] * v0[3])) + ((v1[0] * v1[0] + v1[1] * v1[1]) + (v1[2] * v1[2] + v1[3] * v1[3])); }
                  sq += __shfl_xor(sq, 16); sq += __shfl_xor(sq, 32);
                  if (fq == 0) P[r * 4 + wc] = sq;
                  if (m & 1) asm volatile("" ::: "memory"); } }
        asm volatile("s_waitcnt lgkmcnt(0)" ::: "memory"); __builtin_amdgcn_s_barrier(); asm volatile("" ::: "memory");
        if (tid < 256) { const float tot = (P[tid * 4 + 0] + P[tid * 4 + 1]) + (P[tid * 4 + 2] + P[tid * 4 + 3]);
            unsigned* sl = (unsigned*)slots + ((size_t)(u.pm * 4 + u.pn) * 256 + tid);
            __hip_atomic_store(sl, __float_as_uint(tot), __ATOMIC_RELAXED, __HIP_MEMORY_SCOPE_AGENT);
            asm volatile("s_waitcnt vmcnt(0)" ::: "memory");
            const unsigned rb = __hip_atomic_load(sl, __ATOMIC_RELAXED, __HIP_MEMORY_SCOPE_AGENT);
            asm volatile("s_waitcnt vmcnt(0)" :: "v"(rb) : "memory"); }
        asm volatile("s_waitcnt vmcnt(0)" ::: "memory");
        if (wid < 4 && lane == 0) __hip_atomic_fetch_add(cnt + 64 * u.pm, 1u, __ATOMIC_RELAXED, __HIP_MEMORY_SCOPE_AGENT);
        if (wid == 0) { unsigned sp = 0u;
            while ((unsigned)__builtin_amdgcn_readfirstlane((int)__hip_atomic_load(cnt + 64 * u.pm, __ATOMIC_RELAXED, __HIP_MEMORY_SCOPE_AGENT)) < 16u) { __builtin_amdgcn_s_sleep(2); if (++sp > (1u << 22)) break; }
            __builtin_amdgcn_fence(__ATOMIC_ACQUIRE, "agent");
            if (lane == 0) flag[0] = sp; }
        asm volatile("s_waitcnt vmcnt(0) lgkmcnt(0)" ::: "memory"); __builtin_amdgcn_s_barrier(); asm volatile("" ::: "memory");
        if (tid < 256) { float tot = 0.f;
#pragma unroll
            for (int t = 0; t < 4; ++t) tot += __uint_as_float(__hip_atomic_load((unsigned*)slots + ((size_t)(u.pm * 4 + t) * 256 + tid), __ATOMIC_RELAXED, __HIP_MEMORY_SCOPE_AGENT));
            S[tid] = 1.0f / sqrtf(tot * (1.0f / 1024.0f) + 1e-6f); }
        asm volatile("s_waitcnt vmcnt(0) lgkmcnt(0)" ::: "memory"); __builtin_amdgcn_s_barrier(); asm volatile("" ::: "memory");
#pragma unroll
        for (int ai = 0; ai < 2; ++ai)
#pragma unroll
            for (int m = 0; m < 4; ++m) { const int r = ai * HALF + wr * 64 + m * 16 + fr; const size_t row = (size_t)(u.pm * BM + r); const float rstd = S[r];
#pragma unroll
                for (int bj = 0; bj < 2; ++bj) { const f32x4 v0 = acc[ai][bj][m][0] * rstd, v1 = acc[ai][bj][m][1] * rstd;
                    u32x4 w; w.x = cvt_pk_bf16(v0[0], v0[1]); w.y = cvt_pk_bf16(v0[2], v0[3]); w.z = cvt_pk_bf16(v1[0], v1[1]); w.w = cvt_pk_bf16(v1[2], v1[3]);
                    *(u32x4*)(O + row * 2048 + col0 + bj * HALF) = w; } }
    }
};
struct EpiSwiglu {
    static constexpr bool PERM = true, AFTER_DRAIN = false;
    bf16_t* O;
    __device__ __forceinline__ void operator()(const f32x4 (&acc)[2][2][4][2], const Unit& u, int wr, int wc, int fr, int fq) const {
        const int row0 = u.pm * BM + wr * 64 + fr; const int col0 = u.pn * HALF + wc * 32 + 8 * fq;
#pragma unroll
        for (int ai = 0; ai < 2; ++ai)
#pragma unroll
            for (int m = 0; m < 4; ++m) { const int row = row0 + ai * HALF + m * 16;
                const f32x4 g0 = acc[ai][0][m][0], g1 = acc[ai][0][m][1], u0 = acc[ai][1][m][0], u1 = acc[ai][1][m][1];
                f32x4 v0, v1;
#pragma unroll
                for (int i = 0; i < 4; ++i) { v0[i] = g0[i] * fast_sigmoid(g0[i]) * u0[i]; v1[i] = g1[i] * fast_sigmoid(g1[i]) * u1[i]; }
                u32x4 w; w.x = cvt_pk_bf16(v0[0], v0[1]); w.y = cvt_pk_bf16(v0[2], v0[3]); w.z = cvt_pk_bf16(v1[0], v1[1]); w.w = cvt_pk_bf16(v1[2], v1[3]);
                *(u32x4*)(O + (size_t)row * 5632 + col0) = w; }
    }
};

template <class Epi, class Sched, bool ALIGN_EPI = false, bool SP2 = false>
__device__ __forceinline__ void gemm_phase(PG8_LAS unsigned char* lds, const Gemm g, const Sched& S, const Epi& E) {
    const int tid = threadIdx.x, wid = __builtin_amdgcn_readfirstlane(tid >> 6), lane = tid & 63, wr = wid >> 2, wc = wid & 3, fr = lane & 15, fq = lane >> 4;
    const int K = g.K, nt = K / BK;
    unsigned voffA[2], voffB[2];
#pragma unroll
    for (int i = 0; i < 2; ++i) { int R, C; stage_rc(tid * 16 + i * 8192, R, C); const int Rb = Epi::PERM ? ((R & ~31) + perm32(R & 31)) : R;
        voffA[i] = (unsigned)(R * K + C) * 2u; voffB[i] = (unsigned)(Rb * K + C) * 2u; }
    const size_t kstep = (size_t)(BK * 2);
    const size_t hstep = (size_t)HALF * K * 2;
    const size_t tstep = 2 * hstep;
    const unsigned ldsw = (unsigned)wid * 1024u;
    const int aoff = lds_byte(wr * 64 + fr, fq * 8), boff = lds_byte(wc * 32 + fr, fq * 8);
#define PG8_SA(b, h) (((b) * 2 + (h)) * HTB)
#define PG8_SB(b, h) ((4 + (b) * 2 + (h)) * HTB)
#define PG8_STAGE(bufoff, gbase, voff) do { _Pragma("unroll") for (int _i = 0; _i < 2; ++_i) \
        __builtin_amdgcn_global_load_lds((const unsigned*)((const char*)(gbase) + (voff)[_i]), (PG8_LAS unsigned*)(lds + (bufoff) + ldsw + _i * 8192), 16, 0, 0); } while (0)
#define PG8_LDA(dst, b, h) do { _Pragma("unroll") for (int m = 0; m < 4; ++m) _Pragma("unroll") for (int k = 0; k < 2; ++k) dst[m][k] = *(const PG8_LAS bf16x8*)(lds + PG8_SA(b, h) + aoff + m * 2048 + k * 1024); } while (0)
#define PG8_LDB(dst, b, h) do { _Pragma("unroll") for (int n = 0; n < 2; ++n) _Pragma("unroll") for (int k = 0; k < 2; ++k) dst[n][k] = *(const PG8_LAS bf16x8*)(lds + PG8_SB(b, h) + boff + n * 2048 + k * 1024); } while (0)
#define PG8_MMA(ai, bj, At, Bt) do { __builtin_amdgcn_s_setprio(1); _Pragma("unroll") for (int m = 0; m < 4; ++m) _Pragma("unroll") for (int n = 0; n < 2; ++n) _Pragma("unroll") for (int k = 0; k < 2; ++k) \
        acc[ai][bj][m][n] = __builtin_amdgcn_mfma_f32_16x16x32_bf16(Bt[n][k], At[m][k], acc[ai][bj][m][n], 0, 0, 0); __builtin_amdgcn_s_setprio(0); } while (0)
#define PG8_WAIT_V(n) asm volatile("s_waitcnt vmcnt(" #n ")" ::: "memory")
#define PG8_WAIT_L(n) asm volatile("s_waitcnt lgkmcnt(" #n ")" ::: "memory")
#define PG8_BAR __builtin_amdgcn_s_barrier()
#define PG8_SCHED __builtin_amdgcn_sched_barrier(0)
    Unit cur, nxt; int ui = 0;
    if (!S.next(0, cur)) return;
    f32x4 acc[2][2][4][2];
#pragma unroll
    for (int a = 0; a < 2; ++a)
#pragma unroll
        for (int b = 0; b < 2; ++b)
#pragma unroll
            for (int m = 0; m < 4; ++m)
#pragma unroll
                for (int n = 0; n < 2; ++n) acc[a][b][m][n] = (f32x4){0.f, 0.f, 0.f, 0.f};
    bf16x8 At[4][2], B0[2][2], B1[2][2];
    const char* cA = (const char*)g.A + (size_t)cur.pm * tstep; const char* cB = (const char*)g.Bt + (size_t)cur.pn * tstep;
    S.a_ready(cur);
    if constexpr (SP2) {
        PG8_STAGE(PG8_SB(0, 0), cB, voffB); PG8_STAGE(PG8_SB(0, 1), cB + hstep, voffB); PG8_STAGE(PG8_SA(0, 0), cA, voffA); PG8_STAGE(PG8_SA(0, 1), cA + hstep, voffA);
        if (wr == 1) PG8_BAR;
        PG8_WAIT_V(2); PG8_BAR;
        PG8_STAGE(PG8_SB(1, 0), cB + kstep, voffB); PG8_STAGE(PG8_SA(1, 0), cA + kstep, voffA); PG8_STAGE(PG8_SB(1, 1), cB + hstep + kstep, voffB);
        PG8_WAIT_V(6); PG8_BAR;
    } else {
        PG8_STAGE(PG8_SB(0, 0), cB, voffB); PG8_STAGE(PG8_SA(0, 0), cA, voffA); PG8_STAGE(PG8_SB(0, 1), cB + hstep, voffB); PG8_STAGE(PG8_SA(0, 1), cA + hstep, voffA);
        if (wr == 1) PG8_BAR;
        PG8_WAIT_V(4); PG8_BAR;
        PG8_STAGE(PG8_SB(1, 0), cB + kstep, voffB); PG8_STAGE(PG8_SA(1, 0), cA + kstep, voffA); PG8_STAGE(PG8_SB(1, 1), cB + hstep + kstep, voffB);
        PG8_WAIT_V(6); PG8_BAR;
    }
    for (;;) {
        const bool has_next = S.next(ui + 1, nxt);
        const char* nA = has_next ? (const char*)g.A + (size_t)nxt.pm * tstep : cA; const char* nB = has_next ? (const char*)g.Bt + (size_t)nxt.pn * tstep : cB;
        for (int t = 0; t < nt; t += 2) {
            const bool last = (t == nt - 2);
            const char* a1 = cA + (size_t)(t + 1) * kstep;
            const char* a2 = last ? nA : cA + (size_t)(t + 2) * kstep; const char* b2 = last ? nB : cB + (size_t)(t + 2) * kstep;
            const char* a3 = a2 + kstep; const char* b3 = b2 + kstep;
            if (last && has_next) S.a_ready(nxt);
            if constexpr (SP2) {
            PG8_LDB(B0, 0, 0); PG8_LDB(B1, 0, 1); PG8_SCHED; PG8_LDA(At, 0, 0); PG8_STAGE(PG8_SA(1, 1), a1 + hstep, voffA);
            PG8_WAIT_V(8); PG8_WAIT_L(0); PG8_BAR; PG8_MMA(0, 0, At, B0); PG8_MMA(0, 1, At, B1); PG8_BAR; PG8_SCHED;
            PG8_LDA(At, 0, 1); PG8_STAGE(PG8_SB(0, 0), b2, voffB); PG8_STAGE(PG8_SB(0, 1), b2 + hstep, voffB); PG8_STAGE(PG8_SA(0, 0), a2, voffA);
            PG8_WAIT_V(8); PG8_WAIT_L(0); PG8_BAR; PG8_MMA(1, 0, At, B0); PG8_MMA(1, 1, At, B1); PG8_BAR; PG8_SCHED;
            PG8_LDB(B0, 1, 0); PG8_LDB(B1, 1, 1); PG8_SCHED; PG8_LDA(At, 1, 0); PG8_STAGE(PG8_SA(0, 1), a2 + hstep, voffA);
            PG8_WAIT_V(8); PG8_WAIT_L(0); PG8_BAR; PG8_MMA(0, 0, At, B0); PG8_MMA(0, 1, At, B1); PG8_BAR; PG8_SCHED;
            PG8_LDA(At, 1, 1); PG8_STAGE(PG8_SB(1, 0), b3, voffB); PG8_STAGE(PG8_SB(1, 1), b3 + hstep, voffB); PG8_STAGE(PG8_SA(1, 0), a3, voffA);
            PG8_WAIT_V(8); PG8_WAIT_L(0); PG8_BAR; PG8_MMA(1, 0, At, B0); PG8_MMA(1, 1, At, B1); PG8_BAR; PG8_SCHED;
            } else {
            PG8_LDB(B0, 0, 0); PG8_SCHED; PG8_LDA(At, 0, 0); PG8_STAGE(PG8_SA(1, 1), a1 + hstep, voffA);
            PG8_WAIT_L(8); PG8_BAR; PG8_WAIT_L(0); PG8_MMA(0, 0, At, B0); PG8_BAR; PG8_SCHED;
            PG8_LDB(B1, 0, 1); PG8_STAGE(PG8_SB(0, 0), b2, voffB);
            PG8_BAR; PG8_WAIT_L(0); PG8_MMA(0, 1, At, B1); PG8_BAR;
            PG8_LDA(At, 0, 1); PG8_STAGE(PG8_SA(0, 0), a2, voffA);
            PG8_BAR; PG8_WAIT_L(0); PG8_MMA(1, 0, At, B0); PG8_BAR; PG8_SCHED;
            PG8_STAGE(PG8_SB(0, 1), b2 + hstep, voffB);
            PG8_WAIT_V(6); PG8_BAR; PG8_MMA(1, 1, At, B1); PG8_BAR;
            PG8_LDB(B0, 1, 0); PG8_SCHED; PG8_LDA(At, 1, 0); PG8_STAGE(PG8_SA(0, 1), a2 + hstep, voffA);
            PG8_WAIT_L(8); PG8_BAR; PG8_WAIT_L(0); PG8_MMA(0, 0, At, B0); PG8_BAR; PG8_SCHED;
            PG8_LDB(B1, 1, 1); PG8_STAGE(PG8_SB(1, 0), b3, voffB);
            PG8_BAR; PG8_WAIT_L(0); PG8_MMA(0, 1, At, B1); PG8_BAR;
            PG8_LDA(At, 1, 1); PG8_STAGE(PG8_SA(1, 0), a3, voffA);
            PG8_BAR; PG8_WAIT_L(0); PG8_MMA(1, 0, At, B0); PG8_BAR; PG8_SCHED;
            PG8_STAGE(PG8_SB(1, 1), b3 + hstep, voffB);
            PG8_WAIT_V(6); PG8_BAR; PG8_MMA(1, 1, At, B1); PG8_BAR;
            }
        }
        if constexpr (ALIGN_EPI) { if (wr == 0) PG8_BAR; }
        if constexpr (!Epi::AFTER_DRAIN) { E(acc, cur, wr, wc, fr, fq); S.done(cur); }
        if (!has_next) break;
#pragma unroll
        for (int a = 0; a < 2; ++a)
#pragma unroll
            for (int b = 0; b < 2; ++b)
#pragma unroll
                for (int m = 0; m < 4; ++m)
#pragma unroll
                    for (int n = 0; n < 2; ++n) acc[a][b][m][n] = (f32x4){0.f, 0.f, 0.f, 0.f};
        cur = nxt; cA = nA; cB = nB; ++ui;
        if constexpr (ALIGN_EPI) { if (wr == 1) PG8_BAR; }
    }
    PG8_WAIT_V(0);
    if constexpr (!ALIGN_EPI) { if (wr == 0) PG8_BAR; }
    PG8_BAR;
    if constexpr (Epi::AFTER_DRAIN) { E.fused(acc, cur, wr, wc, fr, fq, lds, wid, lane); S.done(cur); }
#undef PG8_SA
#undef PG8_SB
#undef PG8_STAGE
#undef PG8_LDA
#undef PG8_LDB
#undef PG8_MMA
#undef PG8_WAIT_V
#undef PG8_WAIT_L
#undef PG8_BAR
#undef PG8_SCHED
}
}

constexpr int NWAVES = 8;
constexpr int BATCH = 4, SEQ = 2048, DM = 2048, MTOK = BATCH * SEQ, SSMW = 1024, ATTW = 1024, NGRP = 64, NST = 64, NHEAD = 8, HDIM = 128, DFF = 5632, PROJW = 4096, NMODW = 6 * DM;
constexpr int KSPLIT = 32;
constexpr size_t MiB = 1u << 20;
constexpr size_t WS_MODP = 2 * MiB, WS_MODF = 8 * MiB, WS_ROPE = 9 * MiB, WS_KTAB = 13 * MiB, WS_GTAB = 16 * MiB, WS_HTAB = 32 * MiB, WS_A64 = 48 * MiB;
constexpr size_t WS_WIN = 49 * MiB, WS_WGLU = 65 * MiB, WS_WOUT = 67 * MiB, WS_WGU = 75 * MiB, WS_WDN = 119 * MiB, WS_H = 141 * MiB, WS_PROJ = 173 * MiB, WS_VG = 237 * MiB;
constexpr size_t WS_YCAT = 253 * MiB, WS_OBR = 285 * MiB, WS_LSE = 333 * MiB, WS_FF = 173 * MiB, WS_UT = 334 * MiB, WS_END = 350 * MiB;
static_assert(WS_FF + (size_t)MTOK * DFF * 2 <= WS_OBR, "ff overlay");
constexpr int LDS_BYTES = 147456, MISC_OFF = 147456 - 256;
constexpr size_t WS_CTL = 0, CTL_ZERO_BYTES = 57344, WS_CNT = 16384, WS_PCNT = 32768, WS_GCNT = 49152  , WS_SLOTS = 1u << 20;

#define GAS __attribute__((address_space(1)))
#define LAS __attribute__((address_space(3)))
typedef unsigned short bf16;
typedef unsigned v4u __attribute__((ext_vector_type(4)));
typedef unsigned v2u __attribute__((ext_vector_type(2)));
typedef float f32x4 __attribute__((ext_vector_type(4)));
typedef float f32x16 __attribute__((ext_vector_type(16)));
typedef short bf16x8 __attribute__((ext_vector_type(8)));
typedef short s16x4 __attribute__((ext_vector_type(4)));
#define LDS_WAIT() asm volatile("s_waitcnt lgkmcnt(0)" ::: "memory")
__device__ __forceinline__ unsigned f2bf(float f) { unsigned u = __builtin_bit_cast(unsigned, f); return (u + 0x7fffu + ((u >> 16) & 1u)) >> 16; }
__device__ __forceinline__ unsigned pk2(float lo, float hi) { return f2bf(lo) | (f2bf(hi) << 16); }
__device__ __forceinline__ float bf_lo(unsigned w) { return __uint_as_float(w << 16); }
__device__ __forceinline__ float bf_hi(unsigned w) { return __uint_as_float(w & 0xffff0000u); }
__device__ __forceinline__ float wave_sum(float v) {
#pragma unroll
    for (int o = 1; o < 64; o <<= 1) v += __shfl_xor(v, o);
    return v;
}

struct Args { const float* in[25]; float* out; unsigned char* ws; int ph_lo, ph_hi; };

template <int MODE>
__device__ __forceinline__ void p0_transpose_item(const float* __restrict__ W, int K, int N, bf16* WT, LAS float* scr, int item, int lane, const float* gs, const float* ga) {
    const int nblk = N / 64, kb = item / nblk, nb = item % nblk, k0 = 64 * kb, n0 = 64 * nb;
    const int lr = lane >> 4, lc = lane & 15;
    f32x4 v[16];
#pragma unroll
    for (int i = 0; i < 16; ++i) v[i] = __builtin_nontemporal_load((const f32x4*)(W + (size_t)(k0 + 4 * i + lr) * N + n0 + 4 * lc));
#pragma unroll
    for (int i = 0; i < 16; ++i) { const int kk = 4 * i + lr; f32x4 t = v[i];
        if (MODE == 4) { const int k = k0 + kk; t = t * ((k < SSMW) ? gs[k] : ga[k - SSMW]); }
        LAS float* d = scr + kk * 65 + 4 * lc; d[0] = t.x; d[1] = t.y; d[2] = t.z; d[3] = t.w; }
    LDS_WAIT(); asm volatile("" ::: "memory");
    const int c = lane & 7;
#pragma unroll
    for (int j = 0; j < 8; ++j) { const int n = (lane >> 3) + 8 * j; const LAS float* s = scr + (8 * c) * 65 + n;
        v4u o; o.x = pk2(s[0 * 65], s[1 * 65]); o.y = pk2(s[2 * 65], s[3 * 65]); o.z = pk2(s[4 * 65], s[5 * 65]); o.w = pk2(s[6 * 65], s[7 * 65]);
        int col = n0 + n, row = col;
        if (MODE == 1) { if (col >= 1024 && col < 3072) { const int e = col & 127, half = e >> 6, ep = e & 63; row = (col - e) + ((ep >> 2) << 3) + (half << 2) + (ep & 3); } }
        if (MODE == 2) row = (col >> 7) * 256 + (col & 127);
        if (MODE == 3) row = (col >> 7) * 256 + 128 + (col & 127);
        *(GAS v4u*)(WT + (size_t)row * K + k0 + 8 * c) = o; }
    LDS_WAIT(); asm volatile("" ::: "memory");
}
__device__ __forceinline__ void wt_readback(const unsigned long long* p0, const unsigned long long* p1) {
    const unsigned long long a = __hip_atomic_load(p0, __ATOMIC_RELAXED, __HIP_MEMORY_SCOPE_AGENT), b = __hip_atomic_load(p1, __ATOMIC_RELAXED, __HIP_MEMORY_SCOPE_AGENT);
    asm volatile("s_waitcnt vmcnt(0)" :: "v"(a), "v"(b) : "memory");
}
__device__ __forceinline__ void p0_gemv_item(const float* __restrict__ cvec, const float* __restrict__ wmod, float* modp, float* modf, const float* __restrict__ bmod, unsigned* cnt, LAS float* scr, int item, int lane) {
    const int ks = item / 48, cb = item % 48, k0 = ks * 64, col = cb * 256 + lane * 4;
#pragma unroll
    for (int b = 0; b < 4; ++b) { const float v = cvec[b * DM + k0 + lane]; scr[lane * 4 + b] = v / (1.0f + __expf(-v)); }
    LDS_WAIT(); asm volatile("" ::: "memory");
    f32x4 a0 = {0, 0, 0, 0}, a1 = a0, a2 = a0, a3 = a0;
#pragma unroll 16
    for (int k = 0; k < 64; ++k) { const f32x4 w = __builtin_nontemporal_load((const f32x4*)(wmod + (size_t)(k0 + k) * NMODW + col)); const f32x4 s = *(const LAS f32x4*)(scr + 4 * k);
        a0 += w * s[0]; a1 += w * s[1]; a2 += w * s[2]; a3 += w * s[3]; }
    unsigned long long* o = (unsigned long long*)(modp + (size_t)(ks * 4) * NMODW + col);
#define GV_ST(p, v) do { __hip_atomic_store((p), ((unsigned long long)__float_as_uint((v).y) << 32) | __float_as_uint((v).x), __ATOMIC_RELAXED, __HIP_MEMORY_SCOPE_AGENT); \
                         __hip_atomic_store((p) + 1, ((unsigned long long)__float_as_uint((v).w) << 32) | __float_as_uint((v).z), __ATOMIC_RELAXED, __HIP_MEMORY_SCOPE_AGENT); } while (0)
    GV_ST(o, a0); GV_ST(o + NMODW / 2, a1); GV_ST(o + NMODW, a2); GV_ST(o + 3 * (NMODW / 2), a3);
#undef GV_ST
    LDS_WAIT(); asm volatile("s_waitcnt vmcnt(0)" ::: "memory");
    wt_readback(o, o + 1); wt_readback(o + NMODW / 2, o + NMODW / 2 + 1); wt_readback(o + NMODW, o + NMODW + 1); wt_readback(o + 3 * (NMODW / 2), o + 3 * (NMODW / 2) + 1);
    if (lane == 0) __hip_atomic_fetch_add(cnt + 64 * cb, 1u, __ATOMIC_RELAXED, __HIP_MEMORY_SCOPE_AGENT);
}
__device__ __forceinline__ void p0_fin_item(const float* modp, float* modf, const float* __restrict__ bmod, unsigned* cnt, int item, int lane) {
    const int cb = item >> 2, b = item & 3, col = cb * 256 + lane * 4;
    { unsigned sp = 0u;
      while ((unsigned)__builtin_amdgcn_readfirstlane((int)__hip_atomic_load(cnt + 64 * cb, __ATOMIC_RELAXED, __HIP_MEMORY_SCOPE_AGENT)) < (unsigned)KSPLIT) { __builtin_amdgcn_s_sleep(2); if (++sp > (1u << 22)) break; }
      __builtin_amdgcn_fence(__ATOMIC_ACQUIRE, "agent"); }
    f32x4 t = *(const f32x4*)(bmod + col);
#pragma unroll 8
    for (int k2 = 0; k2 < KSPLIT; ++k2) { const unsigned long long* pp = (const unsigned long long*)(modp + (size_t)(k2 * 4 + b) * NMODW + col);
        const unsigned long long w0 = __hip_atomic_load(pp, __ATOMIC_RELAXED, __HIP_MEMORY_SCOPE_AGENT), w1 = __hip_atomic_load(pp + 1, __ATOMIC_RELAXED, __HIP_MEMORY_SCOPE_AGENT);
        t += (f32x4){__uint_as_float((unsigned)w0), __uint_as_float((unsigned)(w0 >> 32)), __uint_as_float((unsigned)w1), __uint_as_float((unsigned)(w1 >> 32))}; }
    unsigned long long* mo = (unsigned long long*)(modf + (size_t)b * NMODW + col);
    __hip_atomic_store(mo, ((unsigned long long)__float_as_uint(t.y) << 32) | __float_as_uint(t.x), __ATOMIC_RELAXED, __HIP_MEMORY_SCOPE_AGENT);
    __hip_atomic_store(mo + 1, ((unsigned long long)__float_as_uint(t.w) << 32) | __float_as_uint(t.z), __ATOMIC_RELAXED, __HIP_MEMORY_SCOPE_AGENT);
    asm volatile("s_waitcnt vmcnt(0)" ::: "memory");
    wt_readback(mo, mo + 1);
    if (lane == 0) __hip_atomic_fetch_add(cnt + 64 * 48, 1u, __ATOMIC_RELAXED, __HIP_MEMORY_SCOPE_AGENT);
}
__device__ __forceinline__ void p0_rope_item(const int* __restrict__ pos, float* cosT, float* sinT, int item, int lane) {
    const double inv = exp(-(double)lane * (9.210340371976184 / 64.0));
    const double rev = (double)pos[item] * inv * 0.15915494309189535;
    const float x = (float)((rev - rint(rev)) * 6.283185307179586);
    cosT[(size_t)item * 64 + lane] = cosf(x); sinT[(size_t)item * 64 + lane] = sinf(x);
}
struct SsmLane { double lr, li, dt, ar, ai; };
__device__ __forceinline__ SsmLane ssm_lane(const float* are, const float* aim, const float* ldt, int g, int p) {
    SsmLane L; L.dt = exp((double)ldt[g]); L.lr = (double)are[g * 64 + p]; L.li = (double)aim[g * 64 + p];
    const double m = exp(L.lr * L.dt); L.ar = m * cos(L.li * L.dt); L.ai = m * sin(L.li * L.dt); return L; }
__device__ __forceinline__ void ssm_pow(const SsmLane& L, int n, double& zr, double& zi) { const double m = exp(L.lr * L.dt * n), th = L.li * L.dt * n; zr = m * cos(th); zi = m * sin(th); }
__device__ __forceinline__ void ssm_step(const SsmLane& L, double& zr, double& zi) { const double nr = zr * L.ar - zi * L.ai, ni = zr * L.ai + zi * L.ar; zr = nr; zi = ni; }
__device__ __forceinline__ void ssm_bbar(const SsmLane& L, const float* bre, const float* bim, int g, int p, float (&br)[16], float (&bi)[16]) {
    const double nr = L.ar - 1.0, ni = L.ai, den = L.lr * L.lr + L.li * L.li;
    const float fr = (float)((nr * L.lr + ni * L.li) / den), fi = (float)((ni * L.lr - nr * L.li) / den);
    const f32x4* pr = (const f32x4*)(bre + (size_t)(g * 64 + p) * 16); const f32x4* pi = (const f32x4*)(bim + (size_t)(g * 64 + p) * 16);
#pragma unroll
    for (int q = 0; q < 4; ++q) { const f32x4 r = pr[q], i = pi[q];
#pragma unroll
        for (int e = 0; e < 4; ++e) { br[4 * q + e] = fr * r[e] - fi * i[e]; bi[4 * q + e] = fr * i[e] + fi * r[e]; } }
}
__device__ __forceinline__ void p0_ktab_item(const float* const* in, bf16* ktab, float* a64, LAS float* scr, int g, int ch, int lane) {
    const SsmLane L = ssm_lane(in[7], in[8], in[9], g, lane);
    float br[16], bi[16]; ssm_bbar(L, in[10], in[11], g, lane, br, bi);
    double zr, zi; ssm_pow(L, ch == 0 ? 0 : 8 * ch - 1, zr, zi);
    const int c = lane >> 2, q = lane & 3; const float* cr = in[12] + (size_t)(g * 16 + c) * 64; const float* ci = in[13] + (size_t)(g * 16 + c) * 64;
    for (int e = 0; e < 8; ++e) { const int ti = 8 * ch + e; if (ti > 64) break;
        if (ti == 0) { double wr, wi; ssm_pow(L, 64, wr, wi); a64[(g * 64 + lane) * 2] = (float)wr; a64[(g * 64 + lane) * 2 + 1] = (float)wi;
            *(GAS v2u*)(ktab + (size_t)(g * 65) * 256 + lane * 4) = (v2u){0u, 0u}; continue; }
        const float fzr = (float)zr, fzi = (float)zi;
#pragma unroll
        for (int k = 0; k < 16; ++k) { scr[lane * 16 + k] = fzr * br[k] - fzi * bi[k]; scr[1024 + lane * 16 + k] = fzr * bi[k] + fzi * br[k]; }
        LDS_WAIT(); asm volatile("" ::: "memory");
        f32x4 acc = {0, 0, 0, 0};
#pragma unroll 8
        for (int p = 0; p < 64; ++p) { const f32x4 wr = *(const LAS f32x4*)(scr + p * 16 + 4 * q), wi = *(const LAS f32x4*)(scr + 1024 + p * 16 + 4 * q); acc += wr * cr[p] - wi * ci[p]; }
        *(GAS v2u*)(ktab + ((size_t)(g * 65 + ti) * 16 + c) * 16 + 4 * q) = (v2u){pk2(acc[0], acc[1]), pk2(acc[2], acc[3])};
        LDS_WAIT(); asm volatile("" ::: "memory");
        ssm_step(L, zr, zi); }
}
__device__ __forceinline__ void p0_gtab_item(const float* const* in, bf16* gtab, int g, int ch, int lane) {
    const SsmLane L = ssm_lane(in[7], in[8], in[9], g, lane); double dzr, dzi; ssm_pow(L, 8 * ch + 1, dzr, dzi);
    const int p = lane;
    float cr[16], ci[16];
#pragma unroll
    for (int c = 0; c < 16; ++c) { cr[c] = in[12][(size_t)(g * 16 + c) * 64 + p]; ci[c] = in[13][(size_t)(g * 16 + c) * 64 + p]; }
    for (int e = 0; e < 8; ++e) { const int t = 8 * ch + e; const float zr = (float)dzr, zi = (float)dzi;
        const size_t base = ((size_t)(g * 32 + (t >> 1)) * 8) * 512;
#pragma unroll
        for (int c = 0; c < 16; ++c) { const float gre = cr[c] * zr - ci[c] * zi, gni = -(cr[c] * zi + ci[c] * zr);
            { const int pp = p;      gtab[base + (size_t)(pp >> 4) * 512 + ((16 * (t & 1) + c) + 32 * ((pp >> 3) & 1)) * 8 + (pp & 7)] = (bf16)f2bf(gre); }
            { const int pp = p + 64; gtab[base + (size_t)(pp >> 4) * 512 + ((16 * (t & 1) + c) + 32 * ((pp >> 3) & 1)) * 8 + (pp & 7)] = (bf16)f2bf(gni); } }
        ssm_step(L, dzr, dzi); }
}
__device__ __forceinline__ void p0_htab_item(const float* const* in, bf16* htab, int g, int ch, int lane) {
    const SsmLane L = ssm_lane(in[7], in[8], in[9], g, lane); double dzr, dzi; ssm_pow(L, 56 - 8 * ch, dzr, dzi);
    float br[16], bi[16]; ssm_bbar(L, in[10], in[11], g, lane, br, bi);
    for (int e = 7; e >= 0; --e) { const int s = 8 * ch + e; const float zr = (float)dzr, zi = (float)dzi;
#pragma unroll
        for (int hh = 0; hh < 2; ++hh) { v4u o, o2;
            o.x = pk2(zr * br[8 * hh] - zi * bi[8 * hh], zr * br[8 * hh + 1] - zi * bi[8 * hh + 1]); o.y = pk2(zr * br[8 * hh + 2] - zi * bi[8 * hh + 2], zr * br[8 * hh + 3] - zi * bi[8 * hh + 3]);
            o.z = pk2(zr * br[8 * hh + 4] - zi * bi[8 * hh + 4], zr * br[8 * hh + 5] - zi * bi[8 * hh + 5]); o.w = pk2(zr * br[8 * hh + 6] - zi * bi[8 * hh + 6], zr * br[8 * hh + 7] - zi * bi[8 * hh + 7]);
            o2.x = pk2(zr * bi[8 * hh] + zi * br[8 * hh], zr * bi[8 * hh + 1] + zi * br[8 * hh + 1]); o2.y = pk2(zr * bi[8 * hh + 2] + zi * br[8 * hh + 2], zr * bi[8 * hh + 3] + zi * br[8 * hh + 3]);
            o2.z = pk2(zr * bi[8 * hh + 4] + zi * br[8 * hh + 4], zr * bi[8 * hh + 5] + zi * br[8 * hh + 5]); o2.w = pk2(zr * bi[8 * hh + 6] + zi * br[8 * hh + 6], zr * bi[8 * hh + 7] + zi * br[8 * hh + 7]);
            { const int pp = lane;      *(GAS v4u*)(htab + ((((size_t)(g * 4 + (pp >> 5)) * 64 + s) * 64) + (pp & 31) + 32 * hh) * 8) = o; }
            { const int pp = lane + 64; *(GAS v4u*)(htab + ((((size_t)(g * 4 + (pp >> 5)) * 64 + s) * 64) + (pp & 31) + 32 * hh) * 8) = o2; } }
        ssm_step(L, dzr, dzi); }
}
#define XB_TMO      128
#define XB_XCNT(j)  (256  + 64 * (j))
#define XB_XSUB(j)  (1280 + 64 * (j))
#define XB_XGEN(j)  (2304 + 64 * (j))
#define XB_TOP      3328
#define XB_TOPGEN   3392
#define XCD_BAR_WORDS 3456
#define XB_SPIN_CAP (1u << 18)

__device__ __forceinline__ unsigned xb_ld(unsigned* p)              { return __hip_atomic_load(p, __ATOMIC_RELAXED, __HIP_MEMORY_SCOPE_AGENT); }
__device__ __forceinline__ unsigned xb_add(unsigned* p, unsigned v) { return __hip_atomic_fetch_add(p, v, __ATOMIC_RELAXED, __HIP_MEMORY_SCOPE_AGENT); }
__device__ __forceinline__ unsigned xb_xcc_id() { return (unsigned)__builtin_amdgcn_s_getreg((3 << 11) | 20) & 0xFu; }
#define XB_SPIN(cond, bar) do { unsigned _sp = 0; while (cond) { __builtin_amdgcn_s_sleep(1); \
    if ((++_sp & 255u) == 0u) { if (xb_ld(&(bar)[XB_TMO])) break; if (_sp > XB_SPIN_CAP) { atomicAdd(&(bar)[XB_TMO], 1u); break; } } } } while (0)

struct XcdBarrier {
    unsigned* bar; unsigned x;
    volatile LAS unsigned* st;
};

__device__ __forceinline__ XcdBarrier xcd_barrier_post(unsigned* bar, volatile LAS unsigned* st) {
    XcdBarrier b; b.bar = bar; b.x = xb_xcc_id(); b.st = st;
    if (threadIdx.x == 0) (void)xb_add(&bar[XB_XCNT(b.x)], 1u);
    return b;
}
__device__ __forceinline__ void xcd_barrier_complete(unsigned* bar, unsigned x, unsigned& nloc, unsigned& nx) {
    const unsigned G = gridDim.x * gridDim.y * gridDim.z;
    unsigned sum, cnt, mine, sp = 0u;
    for (;;) {
        sum = 0u; cnt = 0u; mine = 0u;
#pragma unroll
        for (unsigned j = 0; j < 16; ++j) { const unsigned c = xb_ld(&bar[XB_XCNT(j)]); sum += c; cnt += (c > 0u) ? 1u : 0u; mine = (j == x) ? c : mine; }
        if (sum == G) break;
        __builtin_amdgcn_s_sleep(1);
        if ((++sp & 255u) == 0u) { if (xb_ld(&bar[XB_TMO])) break; if (sp > XB_SPIN_CAP) { atomicAdd(&bar[XB_TMO], 1u); break; } }
    }
    nloc = mine > 0u ? mine : 1u; nx = cnt > 0u ? cnt : 1u;
}

__device__ __forceinline__ void xcd_barrier(const XcdBarrier& b) {
    asm volatile("s_waitcnt vmcnt(0)" ::: "memory");
    __syncthreads();
    if (threadIdx.x == 0) {
        unsigned* bar = b.bar;
        __builtin_amdgcn_s_waitcnt(0);
        unsigned nloc = b.st[0], nx = b.st[1];
        if (nloc == 0u) { xcd_barrier_complete(bar, b.x, nloc, nx); b.st[0] = nloc; b.st[1] = nx; }
        const unsigned old = xb_add(&bar[XB_XSUB(b.x)], 1u);
        const unsigned gen = old / nloc;
        if (old + 1u == (gen + 1u) * nloc) {
            __builtin_amdgcn_fence(__ATOMIC_RELEASE, "agent");
            asm volatile("s_waitcnt vmcnt(0)" ::: "memory");
            const unsigned og = xb_add(&bar[XB_TOP], 1u);
            const unsigned tg = og / nx;
            if (og + 1u == (tg + 1u) * nx) xb_add(&bar[XB_TOPGEN], 1u);
            else XB_SPIN(xb_ld(&bar[XB_TOPGEN]) == tg, bar);
            __builtin_amdgcn_fence(__ATOMIC_ACQUIRE, "agent");
            xb_add(&bar[XB_XGEN(b.x)], 1u);
            asm volatile("s_waitcnt vmcnt(0)" ::: "memory");
        } else {
            XB_SPIN(xb_ld(&bar[XB_XGEN(b.x)]) == gen, bar);
            __builtin_amdgcn_fence(__ATOMIC_ACQUIRE, "agent");
            asm volatile("s_waitcnt vmcnt(0)" ::: "memory");
        }
    }
    __syncthreads();
}

template <bool FROMP>
__device__ __forceinline__ void modnorm_phase(LAS unsigned char* lds, const float* xin, bf16* hout, const float* gvec, const float* modp, const float* bmod, const float* modf, int jsh, int jsc, int tid, int lane, int wave) {
    LAS float* TA = (LAS float*)lds; LAS float* TS = TA + DM;
    const int b = (blockIdx.x * 32) / SEQ;
    for (int k = tid; k < DM; k += NWAVES * 64) {
        float sh, sc;
        if (FROMP) { sh = bmod[jsh * DM + k]; sc = bmod[jsc * DM + k];
            for (int ks = 0; ks < KSPLIT; ++ks) { sh += modp[(size_t)(ks * 4 + b) * NMODW + jsh * DM + k]; sc += modp[(size_t)(ks * 4 + b) * NMODW + jsc * DM + k]; } }
        else { sh = modf[(size_t)b * NMODW + jsh * DM + k]; sc = modf[(size_t)b * NMODW + jsc * DM + k]; }
        TA[k] = gvec[k] * (1.0f + sc); TS[k] = sh; }
    __syncthreads();
    for (int r = 0; r < 4; ++r) { const int row = blockIdx.x * 32 + wave * 4 + r;
        const f32x4* xr = (const f32x4*)(xin + (size_t)row * DM) + lane;
        f32x4 v[8]; float s = 0.f;
#pragma unroll
        for (int j = 0; j < 8; ++j) { v[j] = __builtin_nontemporal_load(xr + 64 * j); s += (v[j].x * v[j].x + v[j].y * v[j].y) + (v[j].z * v[j].z + v[j].w * v[j].w); }
        const float rstd = 1.0f / sqrtf(wave_sum(s) * (1.0f / DM) + 1e-6f);
        GAS v2u* o8 = (GAS v2u*)(hout + (size_t)row * DM) + lane;
#pragma unroll
        for (int j = 0; j < 8; ++j) { const f32x4 a = *(const LAS f32x4*)(TA + 4 * (lane + 64 * j)), sft = *(const LAS f32x4*)(TS + 4 * (lane + 64 * j));
            const f32x4 o = v[j] * rstd * a + sft; o8[64 * j] = (v2u){pk2(o.x, o.y), pk2(o.z, o.w)}; } }
    __syncthreads();
}

#define TS_A (-1)
#define TS_MASK 0
#define TS_SCALE 1e-5f
#define TS_X (-1)
#define TS_Y (-1)
#define STAMP(k) do { if (TS_A >= 0 && bx == 0 && threadIdx.x == 0) ((volatile LAS unsigned long long*)(lds + MISC_OFF + 16))[k] = __builtin_amdgcn_s_memrealtime(); } while (0)
#define SSTAMP(k) do { if (TS_A >= 0 && blockIdx.x == 0 && threadIdx.x == 0) ((volatile LAS unsigned long long*)(lds + MISC_OFF + 16))[k] = __builtin_amdgcn_s_memrealtime(); } while (0)
constexpr int SS_UST = 2064;
constexpr int SS_U = 0, SS_K = 32 * SS_UST, SS_E = SS_K + 65 * 512, SS_C = SS_E + 2 * 128 * 33 * 4, SS_CST = 272, SS_END = SS_C + 32 * SS_CST;
static_assert(SS_END <= 147456 - 1024, "ssm LDS");
__device__ __forceinline__ float gelu_tanh(float v) { const float t = 0.7978845608028654f * (v + 0.044715f * v * v * v); const float e = __builtin_amdgcn_exp2f(-2.885390081777927f * t); return v * __builtin_amdgcn_rcpf(1.0f + e); }
__device__ __forceinline__ void ssm_unit(LAS unsigned char* lds, int b, int g, const bf16* proj, const bf16* ktab, const bf16* gtab, const bf16* htab, const float* a64, const float* dskip, bf16* vg, int tid, int lane, int wave) {
    const int n = lane & 31, h = lane >> 5;
    const int mt1 = wave & 3, kh = wave >> 2;
    bf16x8 hf[32];
    { const bf16* hp = htab + (((size_t)(g * 4 + mt1) * 64 + kh * 32) * 64 + lane) * 8;
#pragma unroll
      for (int s = 0; s < 32; ++s) hf[s] = *(const GAS bf16x8*)(hp + (size_t)s * 512); }
    { v4u ur[8];
#pragma unroll
      for (int it = 0; it < 8; ++it) { const int i = tid + 512 * it; ur[it] = *(const GAS v4u*)(proj + ((size_t)(b * NGRP + g) * SEQ * 16 + (size_t)i * 8)); }
      v4u kr[5];
#pragma unroll
      for (int it = 0; it < 5; ++it) { const int i = tid + 512 * it; kr[it] = (v4u){0u, 0u, 0u, 0u}; if (i < 2080) kr[it] = *(const GAS v4u*)(ktab + (size_t)g * 65 * 256 + i * 8); }
#pragma unroll
      for (int it = 0; it < 8; ++it) { const int i = tid + 512 * it, t = i >> 1, hf2 = i & 1; *(LAS v4u*)(lds + SS_U + (t >> 6) * SS_UST + (t & 63) * 32 + hf2 * 16) = ur[it]; }
#pragma unroll
      for (int it = 0; it < 5; ++it) { const int i = tid + 512 * it; if (i < 2080) *(LAS v4u*)(lds + SS_K + i * 16) = kr[it]; } }
    __syncthreads(); SSTAMP(24);
    { f32x16 acc;
#pragma unroll
      for (int i = 0; i < 16; ++i) acc[i] = 0.f;
#pragma unroll
      for (int s = 0; s < 32; ++s) { const bf16x8 bb = *(const LAS bf16x8*)(lds + SS_U + n * SS_UST + (kh * 32 + s) * 32 + h * 16);
          acc = __builtin_amdgcn_mfma_f32_32x32x16_bf16(hf[s], bb, acc, 0, 0, 0); }
      LAS float* E = (LAS float*)(lds + SS_E) + kh * 128 * 33;
#pragma unroll
      for (int r = 0; r < 16; ++r) E[(32 * mt1 + (r & 3) + 8 * (r >> 2) + 4 * h) * 33 + n] = acc[r]; }
    __syncthreads(); SSTAMP(25);
    if (wave == 0) { const int p = lane; const float ar = a64[(g * 64 + p) * 2], ai = a64[(g * 64 + p) * 2 + 1]; float cr = 0.f, ci = 0.f;
        const LAS float* E0 = (const LAS float*)(lds + SS_E); const LAS float* E1 = E0 + 128 * 33;
#pragma unroll 8
        for (int j = 0; j < 32; ++j) { *(LAS bf16*)(lds + SS_C + j * SS_CST + p * 2) = (bf16)f2bf(cr); *(LAS bf16*)(lds + SS_C + j * SS_CST + (64 + p) * 2) = (bf16)f2bf(ci);
            const float er = E0[p * 33 + j] + E1[p * 33 + j], ei = E0[(64 + p) * 33 + j] + E1[(64 + p) * 33 + j];
            const float nr = ar * cr - ai * ci + er, ni = ar * ci + ai * cr + ei; cr = nr; ci = ni; } }
    f32x16 acc4[4];
#pragma unroll
    for (int q = 0; q < 4; ++q)
#pragma unroll
        for (int i = 0; i < 16; ++i) acc4[q][i] = 0.f;
    const int c_l = n & 15, tl = n >> 4;
    const int bbase = SS_U + n * SS_UST + h * 16;
    const int kb0 = SS_K + ((tl + 1) * 16 + c_l) * 32 + h * 16;
    const int mtq0 = wave, mtq1 = 15 - wave, mtq2 = 16 + wave, mtq3 = 31 - wave;
    const int nsmax = 2 * mtq3 + 2;
    bf16x8 gfb[2][8];
    for (int s = 0; s < nsmax; s += 2) {
        const bf16x8 bb0 = *(const LAS bf16x8*)(lds + bbase + s * 32), bb1 = *(const LAS bf16x8*)(lds + bbase + s * 32 + 32);
        const bool c0 = s < 2 * mtq0 + 2, c1 = s < 2 * mtq1 + 2, c2 = s < 2 * mtq2 + 2;
        bf16x8 a00, a01, a10, a11, a20, a21;
        if (c0) { a00 = *(const LAS bf16x8*)(lds + kb0 + mtq0 * 1024 - s * 512); a01 = *(const LAS bf16x8*)(lds + kb0 + mtq0 * 1024 - s * 512 - 512); }
        if (c1) { a10 = *(const LAS bf16x8*)(lds + kb0 + mtq1 * 1024 - s * 512); a11 = *(const LAS bf16x8*)(lds + kb0 + mtq1 * 1024 - s * 512 - 512); }
        if (c2) { a20 = *(const LAS bf16x8*)(lds + kb0 + mtq2 * 1024 - s * 512); a21 = *(const LAS bf16x8*)(lds + kb0 + mtq2 * 1024 - s * 512 - 512); }
        const bf16x8 a30 = *(const LAS bf16x8*)(lds + kb0 + mtq3 * 1024 - s * 512), a31 = *(const LAS bf16x8*)(lds + kb0 + mtq3 * 1024 - s * 512 - 512);
        acc4[3] = __builtin_amdgcn_mfma_f32_32x32x16_bf16(a30, bb0, acc4[3], 0, 0, 0);
        if (c2) acc4[2] = __builtin_amdgcn_mfma_f32_32x32x16_bf16(a20, bb0, acc4[2], 0, 0, 0);
        if (c1) acc4[1] = __builtin_amdgcn_mfma_f32_32x32x16_bf16(a10, bb0, acc4[1], 0, 0, 0);
        if (c0) acc4[0] = __builtin_amdgcn_mfma_f32_32x32x16_bf16(a00, bb0, acc4[0], 0, 0, 0);
        acc4[3] = __builtin_amdgcn_mfma_f32_32x32x16_bf16(a31, bb1, acc4[3], 0, 0, 0);
        if (c2) acc4[2] = __builtin_amdgcn_mfma_f32_32x32x16_bf16(a21, bb1, acc4[2], 0, 0, 0);
        if (c1) acc4[1] = __builtin_amdgcn_mfma_f32_32x32x16_bf16(a11, bb1, acc4[1], 0, 0, 0);
        if (c0) acc4[0] = __builtin_amdgcn_mfma_f32_32x32x16_bf16(a01, bb1, acc4[0], 0, 0, 0); }
#pragma unroll
    for (int q = 0; q < 2; ++q) { const bf16* gp = gtab + (((size_t)(g * 32 + (q == 0 ? mtq0 : mtq1)) * 8) * 64 + lane) * 8;
#pragma unroll
        for (int ks = 0; ks < 8; ++ks) gfb[q][ks] = *(const GAS bf16x8*)(gp + (size_t)ks * 512); }
    asm volatile("" ::: "memory");
    SSTAMP(26); __syncthreads(); SSTAMP(27);
#pragma unroll
    for (int q = 0; q < 2; ++q) {
#pragma unroll
        for (int ks = 0; ks < 8; ++ks) { const bf16x8 bb = *(const LAS bf16x8*)(lds + SS_C + n * SS_CST + (16 * ks + 8 * h) * 2);
            acc4[q] = __builtin_amdgcn_mfma_f32_32x32x16_bf16(gfb[q][ks], bb, acc4[q], 0, 0, 0); } }
#pragma unroll
    for (int q = 2; q < 4; ++q) { const bf16* gp = gtab + (((size_t)(g * 32 + (q == 2 ? mtq2 : mtq3)) * 8) * 64 + lane) * 8;
        bf16x8 gf[8];
#pragma unroll
        for (int ks = 0; ks < 8; ++ks) gf[ks] = *(const GAS bf16x8*)(gp + (size_t)ks * 512);
#pragma unroll
        for (int ks = 0; ks < 8; ++ks) { const bf16x8 bb = *(const LAS bf16x8*)(lds + SS_C + n * SS_CST + (16 * ks + 8 * h) * 2);
            acc4[q] = __builtin_amdgcn_mfma_f32_32x32x16_bf16(gf[ks], bb, acc4[q], 0, 0, 0); } }
    SSTAMP(28);
#pragma unroll
    for (int q = 0; q < 4; ++q) { const int mt = (q == 0) ? mtq0 : (q == 1) ? mtq1 : (q == 2) ? mtq2 : mtq3;
#pragma unroll
        for (int q4 = 0; q4 < 4; ++q4) { const int t = 2 * mt + (q4 >> 1), c0 = 8 * (q4 & 1) + 4 * h;
            const v2u uu = *(const LAS v2u*)(lds + SS_U + n * SS_UST + t * 32 + c0 * 2);
            const f32x4 dv = *(const f32x4*)(dskip + 16 * g + c0);
            const float y0 = acc4[q][4 * q4 + 0] + dv[0] * bf_lo(uu.x), y1 = acc4[q][4 * q4 + 1] + dv[1] * bf_hi(uu.x), y2 = acc4[q][4 * q4 + 2] + dv[2] * bf_lo(uu.y), y3 = acc4[q][4 * q4 + 3] + dv[3] * bf_hi(uu.y);
            *(GAS v2u*)(vg + (size_t)(b * SEQ + 64 * n + t) * SSMW + 16 * g + c0) = (v2u){pk2(gelu_tanh(y0), gelu_tanh(y1)), pk2(gelu_tanh(y2), gelu_tanh(y3))}; } }
    __syncthreads();
}

constexpr int AT_K = 0, AT_V = 272 * 256, AT_END = 2 * 272 * 256;
static_assert(AT_END <= 147456 - 1024, "attn LDS");
__device__ __forceinline__ unsigned off_b(unsigned row, unsigned ch) { return 256u * row + 16u * (ch ^ (((row & 3) << 2) | ((row >> 2) & 3))); }
typedef short v4i16_t __attribute__((ext_vector_type(4)));
__device__ __forceinline__ s16x4 tr_read(LAS unsigned char* p) { return __builtin_bit_cast(s16x4, __builtin_amdgcn_ds_read_tr16_b64_v4i16((LAS v4i16_t*)p)); }
struct AttnDesc { int b, hd, di, dil, res, blk; };
__device__ __forceinline__ AttnDesc attn_decode(int u) { AttnDesc d; const int bh = u / 48, w = u % 48; d.b = bh / NHEAD; d.hd = bh % NHEAD;
    if (w < 16) { d.di = 0; d.dil = 1; d.res = 0; d.blk = w; } else if (w < 32) { d.di = 1; d.dil = 4; d.res = (w - 16) >> 2; d.blk = (w - 16) & 3; } else { d.di = 2; d.dil = 16; d.res = w - 32; d.blk = 0; }
    return d; }
__device__ __forceinline__ void attn_run(LAS unsigned char* lds, int u0, int ustride, int uend, const bf16* proj, bf16* obr, float* lse, int tid, int lane, int wave) {
    if (u0 >= uend) return;
    if (tid < 256) { const int row = 256 + (tid >> 4), ch = tid & 15; *(LAS v4u*)(lds + AT_K + off_b(row, ch)) = (v4u){0u, 0u, 0u, 0u}; *(LAS v4u*)(lds + AT_V + off_b(row, ch)) = (v4u){0u, 0u, 0u, 0u}; }
    const int qn = lane & 15, g = lane >> 4, q4 = (lane & 15) >> 2, p4 = lane & 3;
    const int r0s = tid >> 4, chs = tid & 15; const unsigned soff = off_b(r0s, chs);
    v4u kr[8], vr[8]; bf16x8 qnx[4];
    int u = u0; AttnDesc nd = attn_decode(u);
#define AT_ISSUE(D) do { const size_t rowb_ = (size_t)(D).b * SEQ; \
        _Pragma("unroll") for (int it = 0; it < 8; ++it) { const int sub = 128 * (D).blk - 128 + r0s + 32 * it; kr[it] = (v4u){0u, 0u, 0u, 0u}; vr[it] = kr[it]; \
            if (sub >= 0) { const bf16* src = proj + (rowb_ + (D).res + (D).dil * sub) * PROJW + 2048 + (D).hd * HDIM + chs * 8; kr[it] = *(const GAS v4u*)src; vr[it] = *(const GAS v4u*)(src + 1024); } } \
        const int qt_ = (D).res + (D).dil * (128 * (D).blk + 16 * wave + qn); \
        _Pragma("unroll") for (int s_ = 0; s_ < 4; ++s_) qnx[s_] = *(const GAS bf16x8*)(proj + (rowb_ + qt_) * PROJW + 1024 + (D).hd * HDIM + 32 * s_ + 8 * g); } while (0)
    AT_ISSUE(nd);
    for (;;) {
        const AttnDesc d = nd;
#pragma unroll
        for (int it = 0; it < 8; ++it) { *(LAS v4u*)(lds + AT_K + soff + 8192 * it) = kr[it]; *(LAS v4u*)(lds + AT_V + soff + 8192 * it) = vr[it]; }
        bf16x8 qf[4];
#pragma unroll
        for (int s = 0; s < 4; ++s) qf[s] = qnx[s];
        __syncthreads();
        const int un = u + ustride; const bool has = un < uend;
        if (has) { nd = attn_decode(un); AT_ISSUE(nd); }
        const bool first = (d.blk == 0); const int tskip = first ? 8 - wave : 0;
        f32x4 sc[10];
#pragma unroll
        for (int kt = 0; kt < 10; ++kt) { f32x4 a = {0.f, 0.f, 0.f, 0.f};
            if (kt < 9 && kt >= tskip) {
#pragma unroll
                for (int s = 0; s < 4; ++s) { const bf16x8 kf = *(const LAS bf16x8*)(lds + AT_K + off_b(16 * (wave + kt) + qn, 4 * s + g));
                    a = __builtin_amdgcn_mfma_f32_16x16x32_bf16(kf, qf[s], a, 0, 0, 0); } }
            sc[kt] = a; }
        float mx = -1e30f;
#pragma unroll
        for (int kt = 0; kt < 10; ++kt)
#pragma unroll
            for (int r = 0; r < 4; ++r) { const int rel = 16 * kt + 4 * g + r; bool ok = (rel >= qn) && (rel <= qn + 128) && (kt >= tskip);
                sc[kt][r] = ok ? sc[kt][r] : -1e30f; mx = fmaxf(mx, sc[kt][r]); }
        mx = fmaxf(mx, __shfl_xor(mx, 16)); mx = fmaxf(mx, __shfl_xor(mx, 32));
        float ls = 0.f;
#pragma unroll
        for (int kt = 0; kt < 10; ++kt)
#pragma unroll
            for (int r = 0; r < 4; ++r) { const float p = (sc[kt][r] > -1e29f) ? __builtin_amdgcn_exp2f(sc[kt][r] - mx) : 0.f; sc[kt][r] = p; ls += p; }
        ls += __shfl_xor(ls, 16); ls += __shfl_xor(ls, 32);
        f32x4 o[8];
#pragma unroll
        for (int c = 0; c < 8; ++c) o[c] = (f32x4){0.f, 0.f, 0.f, 0.f};
#pragma unroll
        for (int ks = 0; ks < 5; ++ks) {
            if (2 * ks + 1 >= tskip) {
                union { unsigned uu[4]; bf16x8 v; } pb;
                pb.uu[0] = pk2(sc[2 * ks][0], sc[2 * ks][1]); pb.uu[1] = pk2(sc[2 * ks][2], sc[2 * ks][3]); pb.uu[2] = pk2(sc[2 * ks + 1][0], sc[2 * ks + 1][1]); pb.uu[3] = pk2(sc[2 * ks + 1][2], sc[2 * ks + 1][3]);
                const unsigned r0 = 16 * wave + 32 * ks + 4 * g + q4;
#pragma unroll
                for (int c = 0; c < 8; ++c) {
                    const s16x4 v0 = tr_read(lds + AT_V + off_b(r0, 2 * c + (p4 >> 1)) + 8 * (p4 & 1));
                    const s16x4 v1 = tr_read(lds + AT_V + off_b(r0 + 16, 2 * c + (p4 >> 1)) + 8 * (p4 & 1));
                    bf16x8 va; va[0] = v0[0]; va[1] = v0[1]; va[2] = v0[2]; va[3] = v0[3]; va[4] = v1[0]; va[5] = v1[1]; va[6] = v1[2]; va[7] = v1[3];
                    o[c] = __builtin_amdgcn_mfma_f32_16x16x32_bf16(va, pb.v, o[c], 0, 0, 0); } } }
        const float inv = 1.0f / ls;
        const size_t qrow = (size_t)d.b * SEQ + d.res + d.dil * (128 * d.blk + 16 * wave + qn);
        bf16* op = obr + (size_t)d.di * MTOK * ATTW + qrow * ATTW + d.hd * HDIM + 4 * g;
#pragma unroll
        for (int c = 0; c < 8; ++c) *(GAS v2u*)(op + 16 * c) = (v2u){pk2(o[c][0] * inv, o[c][1] * inv), pk2(o[c][2] * inv, o[c][3] * inv)};
        if (g == 0) lse[(size_t)d.di * MTOK * NHEAD + qrow * NHEAD + d.hd] = mx + __builtin_amdgcn_logf(ls);
        __syncthreads();
        if (!has) break;
        u = un;
    }
#undef AT_ISSUE
}

__device__ __forceinline__ void ynorm_phase(bf16* ycat, const bf16* obr, const float* lse, int lane, int wave) {
    for (int r = 0; r < 4; ++r) { const int row = blockIdx.x * 32 + wave * 4 + r;
        { const int hd = lane >> 3;
          const float l0 = lse[(size_t)row * NHEAD + hd], l1 = lse[(size_t)MTOK * NHEAD + (size_t)row * NHEAD + hd], l2 = lse[(size_t)2 * MTOK * NHEAD + (size_t)row * NHEAD + hd];
          const float lm = fmaxf(l0, fmaxf(l1, l2)); float w0 = __builtin_amdgcn_exp2f(l0 - lm), w1 = __builtin_amdgcn_exp2f(l1 - lm), w2 = __builtin_amdgcn_exp2f(l2 - lm);
          const float wi = 1.0f / (w0 + w1 + w2); w0 *= wi; w1 *= wi; w2 *= wi;
          float v[16];
#pragma unroll
          for (int i = 0; i < 16; ++i) v[i] = 0.f;
#pragma unroll
          for (int d = 0; d < 3; ++d) { const bf16* p = obr + (size_t)d * MTOK * ATTW + (size_t)row * ATTW + lane * 16; const v4u a = *(const GAS v4u*)p, c = *(const GAS v4u*)(p + 8); const float w = d == 0 ? w0 : d == 1 ? w1 : w2;
              v[0] += w * bf_lo(a.x); v[1] += w * bf_hi(a.x); v[2] += w * bf_lo(a.y); v[3] += w * bf_hi(a.y); v[4] += w * bf_lo(a.z); v[5] += w * bf_hi(a.z); v[6] += w * bf_lo(a.w); v[7] += w * bf_hi(a.w);
              v[8] += w * bf_lo(c.x); v[9] += w * bf_hi(c.x); v[10] += w * bf_lo(c.y); v[11] += w * bf_hi(c.y); v[12] += w * bf_lo(c.z); v[13] += w * bf_hi(c.z); v[14] += w * bf_lo(c.w); v[15] += w * bf_hi(c.w); }
          float s = 0.f;
#pragma unroll
          for (int i = 0; i < 16; ++i) s += v[i] * v[i];
          const float rstd = 1.0f / sqrtf(wave_sum(s) * (1.0f / ATTW) + 1e-6f);
          bf16* p = ycat + (size_t)row * DM + SSMW + lane * 16;
          *(GAS v4u*)p = (v4u){pk2(v[0] * rstd, v[1] * rstd), pk2(v[2] * rstd, v[3] * rstd), pk2(v[4] * rstd, v[5] * rstd), pk2(v[6] * rstd, v[7] * rstd)};
          *(GAS v4u*)(p + 8) = (v4u){pk2(v[8] * rstd, v[9] * rstd), pk2(v[10] * rstd, v[11] * rstd), pk2(v[12] * rstd, v[13] * rstd), pk2(v[14] * rstd, v[15] * rstd)}; } }
}
__device__ __forceinline__ void final_norm_phase(float* out, const float* gfin, int lane, int wave) {
    for (int r = 0; r < 4; ++r) { const int row = blockIdx.x * 32 + wave * 4 + r;
        f32x4* xr = (f32x4*)(out + (size_t)row * DM) + lane; f32x4 v[8]; float s = 0.f;
#pragma unroll
        for (int j = 0; j < 8; ++j) { v[j] = xr[64 * j]; s += (v[j].x * v[j].x + v[j].y * v[j].y) + (v[j].z * v[j].z + v[j].w * v[j].w); }
        const float rstd = 1.0f / sqrtf(wave_sum(s) * (1.0f / DM) + 1e-6f);
#pragma unroll
        for (int j = 0; j < 8; ++j) { const f32x4 gq = *((const f32x4*)gfin + lane + 64 * j); xr[64 * j] = v[j] * rstd * gq; } }
}

constexpr int NPH = 11;
constexpr int ATT_P3_UNITS = 512;
constexpr int IT_GEMV = KSPLIT * 48, IT_SSM = NGRP * 25, IT_FIN = 48 * 4, IT_ROPE = MTOK, IT_WIN = (DM / 64) * (PROJW / 64), IT_WGLU = (SSMW / 64) * (SSMW / 64), IT_WOUT = (DM / 64) * (DM / 64),
              IT_WG = (DM / 64) * (DFF / 64), IT_WD = (DFF / 64) * (DM / 64), IT_TOTAL = IT_GEMV + IT_SSM + IT_FIN + IT_ROPE + IT_WIN + IT_WGLU + IT_WOUT + 2 * IT_WG;
__global__ void __launch_bounds__(NWAVES * 64, 2) hymba_fwd(Args args) {
    extern __shared__ __attribute__((aligned(16))) unsigned char lds_raw[];
    LAS unsigned char* lds = (LAS unsigned char*)lds_raw;
    cg::grid_group grid = cg::this_grid();
    const int tid = threadIdx.x, lane = tid & 63, wave = __builtin_amdgcn_readfirstlane(tid >> 6);
    const int G = gridDim.x, bx = blockIdx.x;
    unsigned char* ws = args.ws;
    const float* const* in = args.in;
    float* modp = (float*)(ws + WS_MODP); float* modf = (float*)(ws + WS_MODF); float* cosT = (float*)(ws + WS_ROPE); float* sinT = cosT + (size_t)MTOK * 64;
    bf16* ktab = (bf16*)(ws + WS_KTAB); bf16* gtab = (bf16*)(ws + WS_GTAB); bf16* htab = (bf16*)(ws + WS_HTAB); float* a64 = (float*)(ws + WS_A64);
    bf16* Win = (bf16*)(ws + WS_WIN); bf16* Wglu = (bf16*)(ws + WS_WGLU); bf16* Wout = (bf16*)(ws + WS_WOUT); bf16* Wgu = (bf16*)(ws + WS_WGU); bf16* Wdn = (bf16*)(ws + WS_WDN);
    bf16* Hb = (bf16*)(ws + WS_H); bf16* proj = (bf16*)(ws + WS_PROJ); bf16* vg = (bf16*)(ws + WS_VG); bf16* ycat = (bf16*)(ws + WS_YCAT); bf16* obr = (bf16*)(ws + WS_OBR); float* lse = (float*)(ws + WS_LSE);
    bf16* ff = (bf16*)(ws + WS_FF); bf16* ut = (bf16*)(ws + WS_UT);
    const int lo = args.ph_lo, hi = args.ph_hi;
#ifndef PHMASK
#define PHMASK 0x7ff
#endif
#define IN(k) (((PHMASK >> (k)) & 1) && lo <= (k) && (k) < hi)
    volatile LAS unsigned* MISC = (volatile LAS unsigned*)(lds + MISC_OFF);
    if (tid < 2) MISC[tid] = 0u;
    __syncthreads();
    if (args.ph_lo < 0) grid.sync();
    const XcdBarrier xbar = xcd_barrier_post((unsigned*)(ws + WS_CTL), MISC);
    STAMP(0);
#define SEAM(k) do { if (IN(k) && IN((k) + 1)) xcd_barrier(xbar); } while (0)
#ifndef DOUBLE_MASK
#define DOUBLE_MASK 0
#endif
#define P0SUB 8
#define P3SUB 1
#define REPS(k) for (int rep_ = 0; rep_ < 1 + ((DOUBLE_MASK >> (k)) & 1); ++rep_)
#define RSYNC(k) do { if ((DOUBLE_MASK >> (k)) & 1) xcd_barrier(xbar); } while (0)

    REPS(0) if (IN(0)) {
        RSYNC(0);
        LAS float* scr = (LAS float*)(lds + wave * 16640);
        const int gw = wave * G + bx, NGW = G * NWAVES;
        const int nmine = (IT_TOTAL - gw + NGW - 1) / NGW;
        for (int kk = 0; kk < nmine; ++kk) {
            const bool gfirst = (gw < IT_GEMV);
            const int it = gw + ((wave & 1) ? ((gfirst && kk == 0) ? 0 : (gfirst ? nmine - kk : nmine - 1 - kk)) : kk) * NGW;
            int r = it;
#if DOUBLE_MASK & 1
            if (rep_ == 1) { const int ty = (it < IT_GEMV) ? 1 : (it < IT_GEMV + IT_SSM) ? 2 : (it < IT_GEMV + IT_SSM + IT_ROPE) ? 4 : 8; if (!(P0SUB & ty)) continue; }
#endif
            if (r < IT_GEMV) { p0_gemv_item(in[1], in[3], modp, modf, in[4], (unsigned*)(ws + WS_CNT), scr, r, lane); continue; } r -= IT_GEMV;
            if (r < IT_SSM) { const int g = r / 25, sub = r % 25;
                if (sub < 9) p0_ktab_item(in, ktab, a64, scr, g, sub, lane); else if (sub < 17) p0_gtab_item(in, gtab, g, sub - 9, lane); else p0_htab_item(in, htab, g, sub - 17, lane);
                continue; } r -= IT_SSM;
            if (r < IT_FIN) { p0_fin_item(modp, modf, in[4], (unsigned*)(ws + WS_CNT), r, lane); continue; } r -= IT_FIN;
            if (r < IT_ROPE) { p0_rope_item((const int*)in[2], cosT, sinT, r, lane); continue; } r -= IT_ROPE;
            if (r < IT_WIN) { p0_transpose_item<1>(in[6], DM, PROJW, Win, scr, r, lane, nullptr, nullptr); continue; } r -= IT_WIN;
            if (r < IT_WGLU) { p0_transpose_item<0>(in[15], SSMW, SSMW, Wglu, scr, r, lane, nullptr, nullptr); continue; } r -= IT_WGLU;
            if (r < IT_WOUT) { p0_transpose_item<4>(in[19], DM, DM, Wout, scr, r, lane, in[17], in[18]); continue; } r -= IT_WOUT;
            if (r < IT_WG) { p0_transpose_item<2>(in[21], DM, DFF, Wgu, scr, r, lane, nullptr, nullptr); continue; } r -= IT_WG;
            p0_transpose_item<3>(in[22], DM, DFF, Wgu, scr, r, lane, nullptr, nullptr);
        }
        __syncthreads();
    }
    STAMP(1); STAMP(2);
    REPS(1) if (IN(1)) {
        RSYNC(1);
        unsigned* gcnt = (unsigned*)(ws + WS_CNT);
        if (wave == 0) { unsigned sp = 0u; unsigned* dn = gcnt + 64 * 48;
            while ((unsigned)__builtin_amdgcn_readfirstlane((int)__hip_atomic_load(dn, __ATOMIC_RELAXED, __HIP_MEMORY_SCOPE_AGENT)) < 192u) { __builtin_amdgcn_s_sleep(4); if (++sp > (1u << 22)) break; }
            __builtin_amdgcn_fence(__ATOMIC_ACQUIRE, "agent"); asm volatile("s_waitcnt vmcnt(0)" ::: "memory"); }
        __syncthreads();
        modnorm_phase<false>(lds, in[0], Hb, in[5], modp, in[4], modf, 0, 1, tid, lane, wave);
    }
    STAMP(3); SEAM(1); STAMP(4);
    if (IN(2)) {
        pg8::Gemm g{Hb, Win, MTOK, PROJW, DM}; pg8::StaticOrder S; S.init(MTOK, PROJW, G, bx);
        pg8::EpiProj E{proj, ut, cosT, sinT, 0.08838834764831845f * 1.4426950408889634f};
        pg8::gemm_phase<pg8::EpiProj, pg8::StaticOrder, true, true>(lds, g, S, E);
    }
    STAMP(5); SEAM(2); STAMP(6);
    REPS(3) if (IN(3)) {
        RSYNC(3);
        int tid = threadIdx.x; asm volatile("" : "+v"(tid)); const int lane = tid & 63, wave = __builtin_amdgcn_readfirstlane(tid >> 6);
#if DOUBLE_MASK & 8
        if (rep_ == 0 || (P3SUB & 1))
#endif
        for (int u0 = bx; u0 < BATCH * NGRP; u0 += G) { const int u = ((u0 & 7) * 32 + ((u0 >> 3) & 31)) + (u0 & ~255);
            ssm_unit(lds, u / NGRP, u % NGRP, ut, ktab, gtab, htab, a64, in[14], vg, tid, lane, wave); }
        STAMP(7);
#if DOUBLE_MASK & 8
        if (rep_ == 0 || (P3SUB & 2))
#endif
        { const int ax = 192 * (bx & 7), aj = bx >> 3;
          attn_run(lds, ax + aj, 32, ax + 64, proj, obr, lse, tid, lane, wave); }
    }
    STAMP(8); SEAM(3); STAMP(9);
    if (IN(4)) {
        pg8::Gemm g{vg, Wglu, MTOK, SSMW, SSMW}; pg8::StaticOrder S; S.init(MTOK, SSMW, G, bx);
        pg8::EpiGluNorm E{ycat, vg, in[16], (float*)(ws + WS_SLOTS) + 2 * 65536, (unsigned*)(ws + WS_GCNT)};
        pg8::gemm_phase<pg8::EpiGluNorm, pg8::StaticOrder, false, true>(lds, g, S, E);
        __syncthreads();
        STAMP(10);
        { int tid = threadIdx.x; asm volatile("" : "+v"(tid)); const int lane = tid & 63, wave = __builtin_amdgcn_readfirstlane(tid >> 6);
          const bool glu = bx < 128; const int ax = 192 * (bx & 7), aj = bx >> 3;
          attn_run(lds, glu ? ax + 64 + aj : ax + 80 + (aj - 16), 16, glu ? ax + 80 : ax + 192, proj, obr, lse, tid, lane, wave); }
    }
    STAMP(11); SEAM(4); STAMP(12);
    REPS(5) if (IN(5)) ynorm_phase(ycat, obr, lse, lane, wave);
    STAMP(13); SEAM(5); STAMP(14);
    if (IN(6)) {
        pg8::Gemm g{ycat, Wout, MTOK, DM, DM}; pg8::StaticOrder S; S.init(MTOK, DM, G, bx);
        pg8::EpiNormX<0> E{in[0], args.out, Hb, modf + 2 * DM, in[20], modf + 4 * DM, modf + 3 * DM, (float*)(ws + WS_SLOTS), (unsigned*)(ws + WS_PCNT), (bf16*)(ws + WS_OBR)};
        pg8::gemm_phase<pg8::EpiNormX<0>, pg8::StaticOrder, false, true>(lds, g, S, E);
    }
    STAMP(15); SEAM(6); STAMP(16);
    if (IN(8)) {
        pg8::Gemm g{Hb, Wgu, MTOK, 2 * DFF, DM}; pg8::StaticOrder S; S.init(MTOK, 2 * DFF, G, bx);
        pg8::EpiSwiglu E{ff};
        pg8::gemm_phase<pg8::EpiSwiglu, pg8::StaticOrder, true, true>(lds, g, S, E);
        if (bx >= 128) { int tid2 = threadIdx.x; asm volatile("" : "+v"(tid2)); const int lane2 = tid2 & 63, wave2 = __builtin_amdgcn_readfirstlane(tid2 >> 6);
            LAS float* scr = (LAS float*)(lds + wave2 * 16640);
            for (int it = (bx - 128) * NWAVES + wave2; it < IT_WD; it += 128 * NWAVES) p0_transpose_item<0>(in[23], DFF, DM, Wdn, scr, it, lane2, nullptr, nullptr); }
    }
    STAMP(19); SEAM(8); STAMP(20);
    if (IN(9)) {
        pg8::Gemm g{ff, Wdn, MTOK, DM, DFF}; pg8::StaticOrder S; S.init(MTOK, DM, G, bx);
        pg8::EpiNormX<1> E{args.out, args.out, nullptr, modf + 5 * DM, in[24], nullptr, nullptr, (float*)(ws + WS_SLOTS) + 65536, (unsigned*)(ws + WS_PCNT) + 32 * 64, (bf16*)(ws + WS_OBR)};
        pg8::gemm_phase<pg8::EpiNormX<1>, pg8::StaticOrder, false, true>(lds, g, S, E);
    }
    STAMP(21); STAMP(22);
    if (TS_A >= 0 && bx == 0) { STAMP(23); __syncthreads();
        const volatile LAS unsigned long long* ts = (const volatile LAS unsigned long long*)(lds + MISC_OFF + 16);
        unsigned long long tot = 0ull;
        for (int i = 0; i < 23; ++i) if ((TS_MASK >> i) & 1) tot += ts[i + 1] - ts[i];
        if (TS_X >= 0) tot = ts[TS_Y < 0 ? 0 : TS_Y] - ts[TS_X < 0 ? 0 : TS_X];
        const float dl = (float)tot * TS_SCALE;
        for (int i = threadIdx.x; i < 4096; i += NWAVES * 64) args.out[i] += dl; }
#undef IN
#undef SEAM
}

#ifndef MK_PER_PHASE
#define MK_PER_PHASE 0
#endif
extern "C" void kernel_launch(void* const* d_in, const int* in_sizes, int n_in, void* d_out, int out_size, void* d_ws, size_t ws_size, hipStream_t stream) {
    static int ready = 0;
    if (ready == 0) {
        ready = 1;
        if (n_in != 25 || out_size != MTOK * DM || ws_size < WS_END) { fprintf(stderr, "kernel_launch: unexpected shapes (n_in %d out %d ws %zu)\n", n_in, out_size, ws_size); ready = -1; }
        else if (hipFuncSetAttribute((const void*)hymba_fwd, hipFuncAttributeMaxDynamicSharedMemorySize, LDS_BYTES) != hipSuccess) { fprintf(stderr, "kernel_launch: hipFuncSetAttribute failed\n"); ready = -1; }
        else { int per_cu = 0; (void)hipOccupancyMaxActiveBlocksPerMultiprocessor(&per_cu, (const void*)hymba_fwd, NWAVES * 64, LDS_BYTES); (void)hipGetLastError();
               if (per_cu < 1) fprintf(stderr, "kernel_launch: occupancy query reports %d blocks per CU\n", per_cu); }
    }
    if (ready < 0) return;
    if (hipMemsetAsync((char*)d_ws + WS_CTL, 0, CTL_ZERO_BYTES, stream) != hipSuccess) { fprintf(stderr, "kernel_launch: memset failed\n"); return; }
    Args a{};
    for (int i = 0; i < 25; ++i) a.in[i] = (const float*)d_in[i];
    a.out = (float*)d_out; a.ws = (unsigned char*)d_ws;
#if MK_PER_PHASE
    for (int p = 0; p < NPH; ++p) { a.ph_lo = p; a.ph_hi = p + 1; hipLaunchKernelGGL(hymba_fwd, dim3(256), dim3(NWAVES * 64), LDS_BYTES, stream, a); }
#else
    a.ph_lo = 0; a.ph_hi = NPH;
    void* kargs[] = {&a};
    hipError_t e = hipLaunchCooperativeKernel((const void*)hymba_fwd, dim3(256), dim3(NWAVES * 64), kargs, LDS_BYTES, stream);
    if (e != hipSuccess) fprintf(stderr, "kernel_launch: cooperative launch failed: %s\n", hipGetErrorString(e));
#endif
}
```

```cpp
#include <hip/hip_runtime.h>
#include <hip/hip_cooperative_groups.h>
#include <cstdio>
#include <cstdint>
namespace cg = cooperative_groups;
namespace pg8 {
#define PG8_LAS __attribute__((address_space(3)))
typedef unsigned short bf16_t;
typedef short bf16x8 __attribute__((ext_vector_type(8)));
typedef float f32x4 __attribute__((ext_vector_type(4)));
typedef unsigned u32x4 __attribute__((ext_vector_type(4)));
constexpr int BM = 256, BK = 64, HALF = 128, HTB = HALF * BK * 2  , STAGE_BYTES = 8 * HTB, NXCD = 8, WGM = 8;

__host__ __device__ __forceinline__ int lds_byte(int r, int c) { const int st = (r >> 4) * 2 + (c >> 5), rr = r & 15, cc = c & 31, ob = rr * 64 + cc * 2; return st * 1024 + (ob ^ (((ob >> 9) & 1) << 5)); }
__host__ __device__ __forceinline__ void stage_rc(int b, int& R, int& C) { const int st = b / 1024, sb = b % 1024, swz = sb ^ (((sb >> 9) & 1) << 5); R = (st >> 1) * 16 + swz / 64; C = (st & 1) * 32 + (swz % 64) / 2; }
__host__ __device__ __forceinline__ int perm32(int rho) { const int n = rho >> 4, i = rho & 15; return 8 * (i >> 2) + 4 * n + (i & 3); }

struct Unit { int pm, pn; };
struct Gemm { const bf16_t* A; const bf16_t* Bt; int M, N, K; };

struct StaticOrder {
    int nM, nN, nwg, G, c;
    __host__ __device__ void init(int M, int N, int G_, int c_) { nM = M / BM; nN = N / BM; nwg = nM * nN; G = G_; c = c_; }
    __host__ __device__ bool next(int i, Unit& u) const {
        const long L = (long)i * G + c; if (L >= nwg) return false;
        int wgid = (int)L; { const int q = nwg / NXCD, r = nwg % NXCD, xcd = wgid % NXCD, off = wgid / NXCD; wgid = (xcd < r ? xcd * (q + 1) : r * (q + 1) + (xcd - r) * q) + off; }
        const int nig = WGM * nN, gid = wgid / nig, fm = gid * WGM, gsz = (nM - fm) < WGM ? (nM - fm) : WGM;
        u.pm = fm + ((wgid % nig) % gsz); u.pn = (wgid % nig) / gsz; return true;
    }
    __device__ __forceinline__ void a_ready(const Unit&) const {}
    __device__ __forceinline__ void done(const Unit&) const {}
};

__device__ __forceinline__ unsigned cvt_pk_bf16(float lo, float hi) { unsigned r; asm volatile("v_cvt_pk_bf16_f32 %0, %1, %2" : "=v"(r) : "v"(lo), "v"(hi)); return r; }
typedef float f32x2 __attribute__((ext_vector_type(2)));
__device__ __forceinline__ f32x2 gelu_pk(f32x2 v) {
    const f32x2 av = __builtin_elementwise_abs(v), d = av * 0.2316418882f + 1.0f;
    f32x2 t; t.x = __builtin_amdgcn_rcpf(d.x); t.y = __builtin_amdgcn_rcpf(d.y);
    f32x2 q = t * 0.5307027145f + (-0.7265760135f); q = q * t + 0.7107068705f; q = q * t + (-0.142248368f); q = q * t + 0.127414796f; q = q * t;
    const f32x2 s = (v * v) * (-0.72134752044f);
    f32x2 e; e.x = __builtin_amdgcn_exp2f(s.x); e.y = __builtin_amdgcn_exp2f(s.y);
    const f32x2 m = v * (q * e), r = v - m;
    f32x2 o; o.x = v.x < 0.f ? m.x : r.x; o.y = v.y < 0.f ? m.y : r.y; return o;
}

__device__ __forceinline__ float bflo(unsigned w) { return __uint_as_float(w << 16); }
__device__ __forceinline__ float bfhi(unsigned w) { return __uint_as_float(w & 0xffff0000u); }
__device__ __forceinline__ float fast_sigmoid(float v) { return __builtin_amdgcn_rcpf(1.0f + __builtin_amdgcn_exp2f(-1.4426950408889634f * v)); }
struct EpiProj {
    static constexpr bool PERM = true, AFTER_DRAIN = false;
    bf16_t* O; bf16_t* UT; const float* cosT; const float* sinT; float qscale;
    __device__ __forceinline__ void operator()(const f32x4 (&acc)[2][2][4][2], const Unit& u, int wr, int wc, int fr, int fq) const {
        const int row0 = u.pm * BM + wr * 64 + fr; const int col0 = u.pn * BM + wc * 32 + 8 * fq;
        const int sect = u.pn >> 2;
        const int j0 = 4 * (4 * wc + fq);
        const float sc = (sect == 1) ? qscale : 1.f;
#pragma unroll
        for (int ai = 0; ai < 2; ++ai)
#pragma unroll
            for (int m = 0; m < 4; ++m) { const int row = row0 + ai * HALF + m * 16; bf16_t* rowp = O + (size_t)row * 4096 + col0;
                f32x4 cs = (f32x4){1.f, 1.f, 1.f, 1.f}, sn = (f32x4){0.f, 0.f, 0.f, 0.f};
                if (sect == 1 || sect == 2) { cs = *(const f32x4*)(cosT + (size_t)row * 64 + j0); sn = *(const f32x4*)(sinT + (size_t)row * 64 + j0); }
#pragma unroll
                for (int bj = 0; bj < 2; ++bj) { const f32x4 t1 = acc[ai][bj][m][0], t2 = acc[ai][bj][m][1];
                    f32x4 v0 = (t1 * cs - t2 * sn) * sc, v1 = (t1 * sn + t2 * cs) * sc;
                    u32x4 w; w.x = cvt_pk_bf16(v0[0], v0[1]); w.y = cvt_pk_bf16(v0[2], v0[3]); w.z = cvt_pk_bf16(v1[0], v1[1]); w.w = cvt_pk_bf16(v1[2], v1[3]);
                    if (sect == 0) { const int col = col0 + bj * HALF; *(u32x4*)(UT + ((size_t)((row >> 11) * 64 + (col >> 4)) * 2048 + (row & 2047)) * 16 + (col & 15)) = w; }
                    else *(u32x4*)(rowp + bj * HALF) = w; } }
    }
};
struct EpiGlu {
    static constexpr bool PERM = true, AFTER_DRAIN = false;
    bf16_t* O; const bf16_t* VG; const float* bias;
    __device__ __forceinline__ void operator()(const f32x4 (&acc)[2][2][4][2], const Unit& u, int wr, int wc, int fr, int fq) const {
        const int row0 = u.pm * BM + wr * 64 + fr; const int col0 = u.pn * BM + wc * 32 + 8 * fq;
        f32x4 bv[2][2];
#pragma unroll
        for (int bj = 0; bj < 2; ++bj)
#pragma unroll
            for (int n = 0; n < 2; ++n) bv[bj][n] = *(const f32x4*)(bias + col0 + bj * HALF + 4 * n);
#pragma unroll
        for (int ai = 0; ai < 2; ++ai)
#pragma unroll
            for (int m = 0; m < 4; ++m) { const int row = row0 + ai * HALF + m * 16;
#pragma unroll
                for (int bj = 0; bj < 2; ++bj) { const u32x4 g = *(const u32x4*)(VG + (size_t)row * 1024 + col0 + bj * HALF);
                    const f32x4 a0 = acc[ai][bj][m][0] + bv[bj][0], a1 = acc[ai][bj][m][1] + bv[bj][1];
                    u32x4 w; w.x = cvt_pk_bf16(bflo(g.x) * fast_sigmoid(a0[0]), bfhi(g.x) * fast_sigmoid(a0[1])); w.y = cvt_pk_bf16(bflo(g.y) * fast_sigmoid(a0[2]), bfhi(g.y) * fast_sigmoid(a0[3]));
                    w.z = cvt_pk_bf16(bflo(g.z) * fast_sigmoid(a1[0]), bfhi(g.z) * fast_sigmoid(a1[1])); w.w = cvt_pk_bf16(bflo(g.w) * fast_sigmoid(a1[2]), bfhi(g.w) * fast_sigmoid(a1[3]));
                    *(u32x4*)(O + (size_t)row * 2048 + col0 + bj * HALF) = w; } }
    }
};
struct EpiResid {
    static constexpr bool PERM = false, AFTER_DRAIN = false;
    const float* base; float* out; const float* gate;
    __device__ __forceinline__ void operator()(const f32x4 (&acc)[2][2][4][2], const Unit& u, int wr, int wc, int fr, int fq) const {
        const int col0 = u.pn * BM + wc * 32 + 4 * fq; const int b = u.pm >> 3;
        f32x4 gv[2][2];
#pragma unroll
        for (int bj = 0; bj < 2; ++bj)
#pragma unroll
            for (int n = 0; n < 2; ++n) gv[bj][n] = *(const f32x4*)(gate + (size_t)b * 12288 + col0 + bj * HALF + n * 16);
#pragma unroll
        for (int ai = 0; ai < 2; ++ai)
#pragma unroll
            for (int m = 0; m < 4; ++m) { const size_t off = (size_t)(u.pm * BM + ai * HALF + wr * 64 + m * 16 + fr) * 2048 + col0;
#pragma unroll
                for (int bj = 0; bj < 2; ++bj)
#pragma unroll
                    for (int n = 0; n < 2; ++n) { const f32x4 bs = *(const f32x4*)(base + off + bj * HALF + n * 16);
                        *(f32x4*)(out + off + bj * HALF + n * 16) = bs + gv[bj][n] * acc[ai][bj][m][n]; } }
    }
};
template <int MODE> struct EpiNormX {
    static constexpr bool PERM = true, AFTER_DRAIN = true;
    const float* base; float* xout; bf16_t* hout; const float* gate; const float* gvec; const float* scv; const float* shv; float* slots; unsigned* cnt; bf16_t* xb;
    __device__ __forceinline__ void fused(f32x4 (&acc)[2][2][4][2], const Unit& u, int wr, int wc, int fr, int fq, PG8_LAS unsigned char* lds, int wid, int lane) const {
        PG8_LAS float* P = (PG8_LAS float*)lds; PG8_LAS float* S = (PG8_LAS float*)(lds + 8192); PG8_LAS unsigned* flag = (PG8_LAS unsigned*)(lds + 8192 + 2048);
        const int col0 = u.pn * BM + wc * 32 + 8 * fq; const int b = u.pm >> 3; const int tid = wid * 64 + lane;
        { f32x4 gv[2][2];
#pragma unroll
          for (int bj = 0; bj < 2; ++bj)
#pragma unroll
              for (int n = 0; n < 2; ++n) gv[bj][n] = *(const f32x4*)(gate + (size_t)b * 12288 + col0 + bj * HALF + 4 * n);
#pragma unroll
          for (int ai = 0; ai < 2; ++ai)
#pragma unroll
              for (int m = 0; m < 4; ++m) { const int r = ai * HALF + wr * 64 + m * 16 + fr; const size_t off = (size_t)(u.pm * BM + r) * 2048 + col0; float sq = 0.f;
#pragma unroll
                  for (int bj = 0; bj < 2; ++bj) { u32x4 xw; if (MODE == 1) xw = __builtin_nontemporal_load((const u32x4*)(xb + off + bj * HALF));
#pragma unroll
                      for (int n = 0; n < 2; ++n) { f32x4 bs;
                          if (MODE == 1) { const unsigned w0 = n ? xw.z : xw.x, w1 = n ? xw.w : xw.y; bs = (f32x4){bflo(w0), bfhi(w0), bflo(w1), bfhi(w1)}; }
                          else bs = __builtin_nontemporal_load((const f32x4*)(base + off + bj * HALF + 4 * n));
                          const f32x4 v = bs + gv[bj][n] * acc[ai][bj][m][n]; acc[ai][bj][m][n] = v;
                          sq += (v[0] * v[0] + v[1] * v[1]) + (v[2] * v[2] + v[3] * v[3]); } }
                  sq += __shfl_xor(sq, 16); sq += __shfl_xor(sq, 32);
                  if (fq == 0) P[r * 4 + wc] = sq;
                  if (m & 1) asm volatile("" ::: "memory"); } }
        asm volatile("s_waitcnt lgkmcnt(0)" ::: "memory"); __builtin_amdgcn_s_barrier(); asm volatile("" ::: "memory");
        if (tid < 256) { const float tot = (P[tid * 4 + 0] + P[tid * 4 + 1]) + (P[tid * 4 + 2] + P[tid * 4 + 3]);
            unsigned* sl = (unsigned*)slots + ((size_t)(u.pm * 8 + u.pn) * 256 + tid);
            __hip_atomic_store(sl, __float_as_uint(tot), __ATOMIC_RELAXED, __HIP_MEMORY_SCOPE_AGENT);
            asm volatile("s_waitcnt vmcnt(0)" ::: "memory");
            const unsigned rb = __hip_atomic_load(sl, __ATOMIC_RELAXED, __HIP_MEMORY_SCOPE_AGENT);
            asm volatile("s_waitcnt vmcnt(0)" :: "v"(rb) : "memory"); }
        asm volatile("s_waitcnt vmcnt(0)" ::: "memory");
        if (wid < 4 && lane == 0) __hip_atomic_fetch_add(cnt + 64 * u.pm, 1u, __ATOMIC_RELAXED, __HIP_MEMORY_SCOPE_AGENT);
        if (wid == 0) { unsigned sp = 0u;
            while ((unsigned)__builtin_amdgcn_readfirstlane((int)__hip_atomic_load(cnt + 64 * u.pm, __ATOMIC_RELAXED, __HIP_MEMORY_SCOPE_AGENT)) < 32u) { __builtin_amdgcn_s_sleep(2); if (++sp > (1u << 22)) break; }
            if (lane == 0) flag[0] = sp; }
        asm volatile("s_waitcnt vmcnt(0) lgkmcnt(0)" ::: "memory"); __builtin_amdgcn_s_barrier(); asm volatile("" ::: "memory");
        if (tid < 256) { float tot = 0.f;
#pragma unroll
            for (int t = 0; t < 8; ++t) tot += __uint_as_float(__hip_atomic_load((unsigned*)slots + ((size_t)(u.pm * 8 + t) * 256 + tid), __ATOMIC_RELAXED, __HIP_MEMORY_SCOPE_AGENT));
            S[tid] = 1.0f / sqrtf(tot * (1.0f / 2048.0f) + 1e-6f); }
        asm volatile("s_waitcnt vmcnt(0) lgkmcnt(0)" ::: "memory"); __builtin_amdgcn_s_barrier(); asm volatile("" ::: "memory");
        f32x4 ga[2][2], sh[2][2];
#pragma unroll
        for (int bj = 0; bj < 2; ++bj)
#pragma unroll
            for (int n = 0; n < 2; ++n) { const int c = col0 + bj * HALF + 4 * n; ga[bj][n] = *(const f32x4*)(gvec + c);
                if (MODE == 0) { ga[bj][n] = ga[bj][n] * (*(const f32x4*)(scv + (size_t)b * 12288 + c) + 1.0f); sh[bj][n] = *(const f32x4*)(shv + (size_t)b * 12288 + c); } }
#pragma unroll
        for (int ai = 0; ai < 2; ++ai)
#pragma unroll
            for (int m = 0; m < 4; ++m) { const int r = ai * HALF + wr * 64 + m * 16 + fr; const size_t off = (size_t)(u.pm * BM + r) * 2048 + col0; const float rstd = S[r];
#pragma unroll
                for (int bj = 0; bj < 2; ++bj) { const f32x4 v0 = acc[ai][bj][m][0], v1 = acc[ai][bj][m][1];
                    if (MODE == 0) { { u32x4 xw; xw.x = cvt_pk_bf16(v0[0], v0[1]); xw.y = cvt_pk_bf16(v0[2], v0[3]); xw.z = cvt_pk_bf16(v1[0], v1[1]); xw.w = cvt_pk_bf16(v1[2], v1[3]); *(u32x4*)(xb + off + bj * HALF) = xw; }
                        const f32x4 h0 = v0 * rstd * ga[bj][0] + sh[bj][0], h1 = v1 * rstd * ga[bj][1] + sh[bj][1];
                        u32x4 w; w.x = cvt_pk_bf16(h0[0], h0[1]); w.y = cvt_pk_bf16(h0[2], h0[3]); w.z = cvt_pk_bf16(h1[0], h1[1]); w.w = cvt_pk_bf16(h1[2], h1[3]);
                        *(u32x4*)(hout + off + bj * HALF) = w; }
                    else { *(f32x4*)(xout + off + bj * HALF) = v0 * rstd * ga[bj][0]; *(f32x4*)(xout + off + bj * HALF + 4) = v1 * rstd * ga[bj][1]; } }
                asm volatile("" ::: "memory"); }
    }
};
struct EpiGluNorm {
    static constexpr bool PERM = true, AFTER_DRAIN = true;
    bf16_t* O; const bf16_t* VG; const float* bias; float* slots; unsigned* cnt;
    __device__ __forceinline__ void fused(f32x4 (&acc)[2][2][4][2], const Unit& u, int wr, int wc, int fr, int fq, PG8_LAS unsigned char* lds, int wid, int lane) const {
        PG8_LAS float* P = (PG8_LAS float*)lds; PG8_LAS float* S = (PG8_LAS float*)(lds + 8192); PG8_LAS unsigned* flag = (PG8_LAS unsigned*)(lds + 8192 + 2048);
        const int col0 = u.pn * BM + wc * 32 + 8 * fq; const int tid = wid * 64 + lane;
        { f32x4 bv[2][2];
#pragma unroll
          for (int bj = 0; bj < 2; ++bj)
#pragma unroll
              for (int n = 0; n < 2; ++n) bv[bj][n] = *(const f32x4*)(bias + col0 + bj * HALF + 4 * n);
#pragma unroll
          for (int ai = 0; ai < 2; ++ai)
#pragma unroll
              for (int m = 0; m < 4; ++m) { const int r = ai * HALF + wr * 64 + m * 16 + fr; const size_t row = (size_t)(u.pm * BM + r); float sq = 0.f;
#pragma unroll
                  for (int bj = 0; bj < 2; ++bj) { const u32x4 g = *(const u32x4*)(VG + row * 1024 + col0 + bj * HALF);
                      const f32x4 a0 = acc[ai][bj][m][0] + bv[bj][0], a1 = acc[ai][bj][m][1] + bv[bj][1];
                      const f32x4 v0 = {bflo(g.x) * fast_sigmoid(a0[0]), bfhi(g.x) * fast_sigmoid(a0[1]), bflo(g.y) * fast_sigmoid(a0[2]), bfhi(g.y) * fast_sigmoid(a0[3])};
                      const f32x4 v1 = {bflo(g.z) * fast_sigmoid(a1[0]), bfhi(g.z) * fast_sigmoid(a1[1]), bflo(g.w) * fast_sigmoid(a1[2]), bfhi(g.w) * fast_sigmoid(a1[3])};
                      acc[ai][bj][m][0] = v0; acc[ai][bj][m][1] = v1;
                      sq += ((v0[0] * v0[0] + v0[1] * v0[1]) + (v0[2] * v0[2] + v0[3] * v0[3])) + ((v1[0] * v1[0] + v1[1] * v1[1]) + (v1[2] * v1[2] + v1[3] * v1[3])); }
                  sq += __shfl_xor(sq, 16); sq += __shfl_xor(sq, 32);
                  if (fq == 0) P[r * 4 + wc] = sq;
                  if (m & 1) asm volatile("" ::: "memory"); } }
        asm volatile("s_waitcnt lgkmcnt(0)" ::: "memory"); __builtin_amdgcn_s_barrier(); asm volatile("" ::: "memory");
        if (tid < 256) { const float tot = (P[tid * 4 + 0] + P[tid * 4 + 1]) + (P[tid * 4 + 2] + P[tid * 4 + 3]);
            unsigned* sl = (unsigned*)slots + ((size_t)(u.pm * 4 + u.pn) * 256 + tid);
            __hip_atomic_store(sl, __float_as_uint(tot), __ATOMIC_RELAXED, __HIP_MEMORY_SCOPE_AGENT);
            asm volatile("s_waitcnt vmcnt(0)" ::: "memory");
            const unsigned rb = __hip_atomic_load(sl, __ATOMIC_RELAXED, __HIP_MEMORY_SCOPE_AGENT);
            asm volatile("s_waitcnt vmcnt(0)" :: "v"(rb) : "memory"); }
        asm volatile("s_waitcnt vmcnt(0)" ::: "memory");
        if (wid < 4 && lane == 0) __hip_atomic_fetch_add(cnt + 64 * u.pm, 1u, __ATOMIC_RELAXED, __HIP_MEMORY_SCOPE_AGENT);
        if (wid == 0) { unsigned sp = 0u;
            while ((unsigned)__builtin_amdgcn_readfirstlane((int)__hip_atomic_load(cnt + 64 * u.pm, __ATOMIC_RELAXED, __HIP_MEMORY_SCOPE_AGENT)) < 16u) { __builtin_amdgcn_s_sleep(2); if (++sp > (1u << 22)) break; }
            __builtin_amdgcn_fence(__ATOMIC_ACQUIRE, "agent");
            if (lane == 0) flag[0] = sp; }
        asm volatile("s_waitcnt vmcnt(0) lgkmcnt(0)" ::: "memory"); __builtin_amdgcn_s_barrier(); asm volatile("" ::: "memory");
        if (tid < 256) { float tot = 0.f;
#pragma unroll
            for (int t = 0; t < 4; ++t) tot += __uint_as_float(__hip_atomic_load((unsigned*)slots + ((size_t)(u.pm * 4 + t) * 256 + tid), __ATOMIC_RELAXED, __HIP_MEMORY_SCOPE_AGENT));
            S[tid] = 1.0f / sqrtf(tot * (1.0f / 1024.0f) + 1e-6f); }
        asm volatile("s_waitcnt vmcnt(0) lgkmcnt(0)" ::: "memory"); __builtin_amdgcn_s_barrier(); asm volatile("" ::: "memory");
#pragma unroll
        for (int ai = 0; ai < 2; ++ai)
#pragma unroll
            for (int m = 0; m < 4; ++m) { const int r = ai * HALF + wr * 64 + m * 16 + fr; const size_t row = (size_t)(u.pm * BM + r); const float rstd = S[r];
#pragma unroll
                for (int bj = 0; bj < 2; ++bj) { const f32x4 v0 = acc[ai][bj][m][0] * rstd, v1 = acc[ai][bj][m][1] * rstd;
                    u32x4 w; w.x = cvt_pk_bf16(v0[0], v0[1]); w.y = cvt_pk_bf16(v0[2], v0[3]); w.z = cvt_pk_bf16(v1[0], v1[1]); w.w = cvt_pk_bf16(v1[2], v1[3]);
                    *(u32x4*)(O + row * 2048 + col0 + bj * HALF) = w; } }
    }
};
struct EpiSwiglu {
    static constexpr bool PERM = true, AFTER_DRAIN = false;
    bf16_t* O;
    __device__ __forceinline__ void operator()(const f32x4 (&acc)[2][2][4][2], const Unit& u, int wr, int wc, int fr, int fq) const {
        const int row0 = u.pm * BM + wr * 64 + fr; const int col0 = u.pn * HALF + wc * 32 + 8 * fq;
#pragma unroll
        for (int ai = 0; ai < 2; ++ai)
#pragma unroll
            for (int m = 0; m < 4; ++m) { const int row = row0 + ai * HALF + m * 16;
                const f32x4 g0 = acc[ai][0][m][0], g1 = acc[ai][0][m][1], u0 = acc[ai][1][m][0], u1 = acc[ai][1][m][1];
                f32x4 v0, v1;
#pragma unroll
                for (int i = 0; i < 4; ++i) { v0[i] = g0[i] * fast_sigmoid(g0[i]) * u0[i]; v1[i] = g1[i] * fast_sigmoid(g1[i]) * u1[i]; }
                u32x4 w; w.x = cvt_pk_bf16(v0[0], v0[1]); w.y = cvt_pk_bf16(v0[2], v0[3]); w.z = cvt_pk_bf16(v1[0], v1[1]); w.w = cvt_pk_bf16(v1[2], v1[3]);
                *(u32x4*)(O + (size_t)row * 5632 + col0) = w; }
    }
};

template <class Epi, class Sched, bool ALIGN_EPI = false, bool SP2 = false>
__device__ __forceinline__ void gemm_phase(PG8_LAS unsigned char* lds, const Gemm g, const Sched& S, const Epi& E) {
    const int tid = threadIdx.x, wid = __builtin_amdgcn_readfirstlane(tid >> 6), lane = tid & 63, wr = wid >> 2, wc = wid & 3, fr = lane & 15, fq = lane >> 4;
    const int K = g.K, nt = K / BK;
    unsigned voffA[2], voffB[2];
#pragma unroll
    for (int i = 0; i < 2; ++i) { int R, C; stage_rc(tid * 16 + i * 8192, R, C); const int Rb = Epi::PERM ? ((R & ~31) + perm32(R & 31)) : R;
        voffA[i] = (unsigned)(R * K + C) * 2u; voffB[i] = (unsigned)(Rb * K + C) * 2u; }
    const size_t kstep = (size_t)(BK * 2);
    const size_t hstep = (size_t)HALF * K * 2;
    const size_t tstep = 2 * hstep;
    const unsigned ldsw = (unsigned)wid * 1024u;
    const int aoff = lds_byte(wr * 64 + fr, fq * 8), boff = lds_byte(wc * 32 + fr, fq * 8);
#define PG8_SA(b, h) (((b) * 2 + (h)) * HTB)
#define PG8_SB(b, h) ((4 + (b) * 2 + (h)) * HTB)
#define PG8_STAGE(bufoff, gbase, voff) do { _Pragma("unroll") for (int _i = 0; _i < 2; ++_i) \
        __builtin_amdgcn_global_load_lds((const unsigned*)((const char*)(gbase) + (voff)[_i]), (PG8_LAS unsigned*)(lds + (bufoff) + ldsw + _i * 8192), 16, 0, 0); } while (0)
#define PG8_LDA(dst, b, h) do { _Pragma("unroll") for (int m = 0; m < 4; ++m) _Pragma("unroll") for (int k = 0; k < 2; ++k) dst[m][k] = *(const PG8_LAS bf16x8*)(lds + PG8_SA(b, h) + aoff + m * 2048 + k * 1024); } while (0)
#define PG8_LDB(dst, b, h) do { _Pragma("unroll") for (int n = 0; n < 2; ++n) _Pragma("unroll") for (int k = 0; k < 2; ++k) dst[n][k] = *(const PG8_LAS bf16x8*)(lds + PG8_SB(b, h) + boff + n * 2048 + k * 1024); } while (0)
#define PG8_MMA(ai, bj, At, Bt) do { __builtin_amdgcn_s_setprio(1); _Pragma("unroll") for (int m = 0; m < 4; ++m) _Pragma("unroll") for (int n = 0; n < 2; ++n) _Pragma("unroll") for (int k = 0; k < 2; ++k) \
        acc[ai][bj][m][n] = __builtin_amdgcn_mfma_f32_16x16x32_bf16(Bt[n][k], At[m][k], acc[ai][bj][m][n], 0, 0, 0); __builtin_amdgcn_s_setprio(0); } while (0)
#define PG8_WAIT_V(n) asm volatile("s_waitcnt vmcnt(" #n ")" ::: "memory")
#define PG8_WAIT_L(n) asm volatile("s_waitcnt lgkmcnt(" #n ")" ::: "memory")
#define PG8_BAR __builtin_amdgcn_s_barrier()
#define PG8_SCHED __builtin_amdgcn_sched_barrier(0)
    Unit cur, nxt; int ui = 0;
    if (!S.next(0, cur)) return;
    f32x4 acc[2][2][4][2];
#pragma unroll
    for (int a = 0; a < 2; ++a)
#pragma unroll
        for (int b = 0; b < 2; ++b)
#pragma unroll
            for (int m = 0; m < 4; ++m)
#pragma unroll
                for (int n = 0; n < 2; ++n) acc[a][b][m][n] = (f32x4){0.f, 0.f, 0.f, 0.f};
    bf16x8 At[4][2], B0[2][2], B1[2][2];
    const char* cA = (const char*)g.A + (size_t)cur.pm * tstep; const char* cB = (const char*)g.Bt + (size_t)cur.pn * tstep;
    S.a_ready(cur);
    if constexpr (SP2) {
        PG8_STAGE(PG8_SB(0, 0), cB, voffB); PG8_STAGE(PG8_SB(0, 1), cB + hstep, voffB); PG8_STAGE(PG8_SA(0, 0), cA, voffA); PG8_STAGE(PG8_SA(0, 1), cA + hstep, voffA);
        if (wr == 1) PG8_BAR;
        PG8_WAIT_V(2); PG8_BAR;
        PG8_STAGE(PG8_SB(1, 0), cB + kstep, voffB); PG8_STAGE(PG8_SA(1, 0), cA + kstep, voffA); PG8_STAGE(PG8_SB(1, 1), cB + hstep + kstep, voffB);
        PG8_WAIT_V(6); PG8_BAR;
    } else {
        PG8_STAGE(PG8_SB(0, 0), cB, voffB); PG8_STAGE(PG8_SA(0, 0), cA, voffA); PG8_STAGE(PG8_SB(0, 1), cB + hstep, voffB); PG8_STAGE(PG8_SA(0, 1), cA + hstep, voffA);
        if (wr == 1) PG8_BAR;
        PG8_WAIT_V(4); PG8_BAR;
        PG8_STAGE(PG8_SB(1, 0), cB + kstep, voffB); PG8_STAGE(PG8_SA(1, 0), cA + kstep, voffA); PG8_STAGE(PG8_SB(1, 1), cB + hstep + kstep, voffB);
        PG8_WAIT_V(6); PG8_BAR;
    }
    for (;;) {
        const bool has_next = S.next(ui + 1, nxt);
        const char* nA = has_next ? (const char*)g.A + (size_t)nxt.pm * tstep : cA; const char* nB = has_next ? (const char*)g.Bt + (size_t)nxt.pn * tstep : cB;
        for (int t = 0; t < nt; t += 2) {
            const bool last = (t == nt - 2);
            const char* a1 = cA + (size_t)(t + 1) * kstep;
            const char* a2 = last ? nA : cA + (size_t)(t + 2) * kstep; const char* b2 = last ? nB : cB + (size_t)(t + 2) * kstep;
            const char* a3 = a2 + kstep; const char* b3 = b2 + kstep;
            if (last && has_next) S.a_ready(nxt);
            if constexpr (SP2) {
            PG8_LDB(B0, 0, 0); PG8_LDB(B1, 0, 1); PG8_SCHED; PG8_LDA(At, 0, 0); PG8_STAGE(PG8_SA(1, 1), a1 + hstep, voffA);
            PG8_WAIT_V(8); PG8_WAIT_L(0); PG8_BAR; PG8_MMA(0, 0, At, B0); PG8_MMA(0, 1, At, B1); PG8_BAR; PG8_SCHED;
            PG8_LDA(At, 0, 1); PG8_STAGE(PG8_SB(0, 0), b2, voffB); PG8_STAGE(PG8_SB(0, 1), b2 + hstep, voffB); PG8_STAGE(PG8_SA(0, 0), a2, voffA);
            PG8_WAIT_V(8); PG8_WAIT_L(0); PG8_BAR; PG8_MMA(1, 0, At, B0); PG8_MMA(1, 1, At, B1); PG8_BAR; PG8_SCHED;
            PG8_LDB(B0, 1, 0); PG8_LDB(B1, 1, 1); PG8_SCHED; PG8_LDA(At, 1, 0); PG8_STAGE(PG8_SA(0, 1), a2 + hstep, voffA);
            PG8_WAIT_V(8); PG8_WAIT_L(0); PG8_BAR; PG8_MMA(0, 0, At, B0); PG8_MMA(0, 1, At, B1); PG8_BAR; PG8_SCHED;
            PG8_LDA(At, 1, 1); PG8_STAGE(PG8_SB(1, 0), b3, voffB); PG8_STAGE(PG8_SB(1, 1), b3 + hstep, voffB); PG8_STAGE(PG8_SA(1, 0), a3, voffA);
            PG8_WAIT_V(8); PG8_WAIT_L(0); PG8_BAR; PG8_MMA(1, 0, At, B0); PG8_MMA(1, 1, At, B1); PG8_BAR; PG8_SCHED;
            } else {
            PG8_LDB(B0, 0, 0); PG8_SCHED; PG8_LDA(At, 0, 0); PG8_STAGE(PG8_SA(1, 1), a1 + hstep, voffA);
            PG8_WAIT_L(8); PG8_BAR; PG8_WAIT_L(0); PG8_MMA(0, 0, At, B0); PG8_BAR; PG8_SCHED;
            PG8_LDB(B1, 0, 1); PG8_STAGE(PG8_SB(0, 0), b2, voffB);
            PG8_BAR; PG8_WAIT_L(0); PG8_MMA(0, 1, At, B1); PG8_BAR;
            PG8_LDA(At, 0, 1); PG8_STAGE(PG8_SA(0, 0), a2, voffA);
            PG8_BAR; PG8_WAIT_L(0); PG8_MMA(1, 0, At, B0); PG8_BAR; PG8_SCHED;
            PG8_STAGE(PG8_SB(0, 1), b2 + hstep, voffB);
            PG8_WAIT_V(6); PG8_BAR; PG8_MMA(1, 1, At, B1); PG8_BAR;
            PG8_LDB(B0, 1, 0); PG8_SCHED; PG8_LDA(At, 1, 0); PG8_STAGE(PG8_SA(0, 1), a2 + hstep, voffA);
            PG8_WAIT_L(8); PG8_BAR; PG8_WAIT_L(0); PG8_MMA(0, 0, At, B0); PG8_BAR; PG8_SCHED;
            PG8_LDB(B1, 1, 1); PG8_STAGE(PG8_SB(1, 0), b3, voffB);
            PG8_BAR; PG8_WAIT_L(0); PG8_MMA(0, 1, At, B1); PG8_BAR;
            PG8_LDA(At, 1, 1); PG8_STAGE(PG8_SA(1, 0), a3, voffA);
            PG8_BAR; PG8_WAIT_L(0); PG8_MMA(1, 0, At, B0); PG8_BAR; PG8_SCHED;
            PG8_STAGE(PG8_SB(1, 1), b3 + hstep, voffB);
            PG8_WAIT_V(6); PG8_BAR; PG8_MMA(1, 1, At, B1); PG8_BAR;
            }
        }
        if constexpr (ALIGN_EPI) { if (wr == 0) PG8_BAR; }
        if constexpr (!Epi::AFTER_DRAIN) { E(acc, cur, wr, wc, fr, fq); S.done(cur); }
        if (!has_next) break;
#pragma unroll
        for (int a = 0; a < 2; ++a)
#pragma unroll
            for (int b = 0; b < 2; ++b)
#pragma unroll
                for (int m = 0; m < 4; ++m)
#pragma unroll
                    for (int n = 0; n < 2; ++n) acc[a][b][m][n] = (f32x4){0.f, 0.f, 0.f, 0.f};
        cur = nxt; cA = nA; cB = nB; ++ui;
        if constexpr (ALIGN_EPI) { if (wr == 1) PG8_BAR; }
    }
    PG8_WAIT_V(0);
    if constexpr (!ALIGN_EPI) { if (wr == 0) PG8_BAR; }
    PG8_BAR;
    if constexpr (Epi::AFTER_DRAIN) { E.fused(acc, cur, wr, wc, fr, fq, lds, wid, lane); S.done(cur); }
#undef PG8_SA
#undef PG8_SB
#undef PG8_STAGE
#undef PG8_LDA
#undef PG8_LDB
#undef PG8_MMA
#undef PG8_WAIT_V
#undef PG8_WAIT_L
#undef PG8_BAR
#undef PG8_SCHED
}
}

constexpr int NWAVES = 8;
constexpr int BATCH = 4, SEQ = 2048, DM = 2048, MTOK = BATCH * SEQ, SSMW = 1024, ATTW = 1024, NGRP = 64, NST = 64, NHEAD = 8, HDIM = 128, DFF = 5632, PROJW = 4096, NMODW = 6 * DM;
constexpr int KSPLIT = 32;
constexpr size_t MiB = 1u << 20;
constexpr size_t WS_MODP = 2 * MiB, WS_MODF = 8 * MiB, WS_ROPE = 9 * MiB, WS_KTAB = 13 * MiB, WS_GTAB = 16 * MiB, WS_HTAB = 32 * MiB, WS_A64 = 48 * MiB;
constexpr size_t WS_WIN = 49 * MiB, WS_WGLU = 65 * MiB, WS_WOUT = 67 * MiB, WS_WGU = 75 * MiB, WS_WDN = 119 * MiB, WS_H = 141 * MiB, WS_PROJ = 173 * MiB, WS_VG = 237 * MiB;
constexpr size_t WS_YCAT = 253 * MiB, WS_OBR = 285 * MiB, WS_LSE = 333 * MiB, WS_FF = 173 * MiB, WS_UT = 334 * MiB, WS_END = 350 * MiB;
static_assert(WS_FF + (size_t)MTOK * DFF * 2 <= WS_OBR, "ff overlay");
constexpr int LDS_BYTES = 147456, MISC_OFF = 147456 - 256;
constexpr size_t WS_CTL = 0, CTL_ZERO_BYTES = 57344, WS_CNT = 16384, WS_PCNT = 32768, WS_GCNT = 49152  , WS_SLOTS = 1u << 20;

#define GAS __attribute__((address_space(1)))
#define LAS __attribute__((address_space(3)))
typedef unsigned short bf16;
typedef unsigned v4u __attribute__((ext_vector_type(4)));
typedef unsigned v2u __attribute__((ext_vector_type(2)));
typedef float f32x4 __attribute__((ext_vector_type(4)));
typedef float f32x16 __attribute__((ext_vector_type(16)));
typedef short bf16x8 __attribute__((ext_vector_type(8)));
typedef short s16x4 __attribute__((ext_vector_type(4)));
#define LDS_WAIT() asm volatile("s_waitcnt lgkmcnt(0)" ::: "memory")
__device__ __forceinline__ unsigned f2bf(float f) { unsigned u = __builtin_bit_cast(unsigned, f); return (u + 0x7fffu + ((u >> 16) & 1u)) >> 16; }
__device__ __forceinline__ unsigned pk2(float lo, float hi) { return f2bf(lo) | (f2bf(hi) << 16); }
__device__ __forceinline__ float bf_lo(unsigned w) { return __uint_as_float(w << 16); }
__device__ __forceinline__ float bf_hi(unsigned w) { return __uint_as_float(w & 0xffff0000u); }
__device__ __forceinline__ float wave_sum(float v) {
#pragma unroll
    for (int o = 1; o < 64; o <<= 1) v += __shfl_xor(v, o);
    return v;
}

struct Args { const float* in[25]; float* out; unsigned char* ws; int ph_lo, ph_hi; };

template <int MODE>
__device__ __forceinline__ void p0_transpose_item(const float* __restrict__ W, int K, int N, bf16* WT, LAS float* scr, int item, int lane, const float* gs, const float* ga) {
    const int nblk = N / 64, kb = item / nblk, nb = item % nblk, k0 = 64 * kb, n0 = 64 * nb;
    const int lr = lane >> 4, lc = lane & 15;
    f32x4 v[16];
#pragma unroll
    for (int i = 0; i < 16; ++i) v[i] = __builtin_nontemporal_load((const f32x4*)(W + (size_t)(k0 + 4 * i + lr) * N + n0 + 4 * lc));
#pragma unroll
    for (int i = 0; i < 16; ++i) { const int kk = 4 * i + lr; f32x4 t = v[i];
        if (MODE == 4) { const int k = k0 + kk; t = t * ((k < SSMW) ? gs[k] : ga[k - SSMW]); }
        LAS float* d = scr + kk * 65 + 4 * lc; d[0] = t.x; d[1] = t.y; d[2] = t.z; d[3] = t.w; }
    LDS_WAIT(); asm volatile("" ::: "memory");
    const int c = lane & 7;
#pragma unroll
    for (int j = 0; j < 8; ++j) { const int n = (lane >> 3) + 8 * j; const LAS float* s = scr + (8 * c) * 65 + n;
        v4u o; o.x = pk2(s[0 * 65], s[1 * 65]); o.y = pk2(s[2 * 65], s[3 * 65]); o.z = pk2(s[4 * 65], s[5 * 65]); o.w = pk2(s[6 * 65], s[7 * 65]);
        int col = n0 + n, row = col;
        if (MODE == 1) { if (col >= 1024 && col < 3072) { const int e = col & 127, half = e >> 6, ep = e & 63; row = (col - e) + ((ep >> 2) << 3) + (half << 2) + (ep & 3); } }
        if (MODE == 2) row = (col >> 7) * 256 + (col & 127);
        if (MODE == 3) row = (col >> 7) * 256 + 128 + (col & 127);
        *(GAS v4u*)(WT + (size_t)row * K + k0 + 8 * c) = o; }
    LDS_WAIT(); asm volatile("" ::: "memory");
}
__device__ __forceinline__ void wt_readback(const unsigned long long* p0, const unsigned long long* p1) {
    const unsigned long long a = __hip_atomic_load(p0, __ATOMIC_RELAXED, __HIP_MEMORY_SCOPE_AGENT), b = __hip_atomic_load(p1, __ATOMIC_RELAXED, __HIP_MEMORY_SCOPE_AGENT);
    asm volatile("s_waitcnt vmcnt(0)" :: "v"(a), "v"(b) : "memory");
}
__device__ __forceinline__ void p0_gemv_item(const float* __restrict__ cvec, const float* __restrict__ wmod, float* modp, float* modf, const float* __restrict__ bmod, unsigned* cnt, LAS float* scr, int item, int lane) {
    const int ks = item / 48, cb = item % 48, k0 = ks * 64, col = cb * 256 + lane * 4;
#pragma unroll
    for (int b = 0; b < 4; ++b) { const float v = cvec[b * DM + k0 + lane]; scr[lane * 4 + b] = v / (1.0f + __expf(-v)); }
    LDS_WAIT(); asm volatile("" ::: "memory");
    f32x4 a0 = {0, 0, 0, 0}, a1 = a0, a2 = a0, a3 = a0;
#pragma unroll 16
    for (int k = 0; k < 64; ++k) { const f32x4 w = __builtin_nontemporal_load((const f32x4*)(wmod + (size_t)(k0 + k) * NMODW + col)); const f32x4 s = *(const LAS f32x4*)(scr + 4 * k);
        a0 += w * s[0]; a1 += w * s[1]; a2 += w * s[2]; a3 += w * s[3]; }
    unsigned long long* o = (unsigned long long*)(modp + (size_t)(ks * 4) * NMODW + col);
#define GV_ST(p, v) do { __hip_atomic_store((p), ((unsigned long long)__float_as_uint((v).y) << 32) | __float_as_uint((v).x), __ATOMIC_RELAXED, __HIP_MEMORY_SCOPE_AGENT); \
                         __hip_atomic_store((p) + 1, ((unsigned long long)__float_as_uint((v).w) << 32) | __float_as_uint((v).z), __ATOMIC_RELAXED, __HIP_MEMORY_SCOPE_AGENT); } while (0)
    GV_ST(o, a0); GV_ST(o + NMODW / 2, a1); GV_ST(o + NMODW, a2); GV_ST(o + 3 * (NMODW / 2), a3);
#undef GV_ST
    LDS_WAIT(); asm volatile("s_waitcnt vmcnt(0)" ::: "memory");
    wt_readback(o, o + 1); wt_readback(o + NMODW / 2, o + NMODW / 2 + 1); wt_readback(o + NMODW, o + NMODW + 1); wt_readback(o + 3 * (NMODW / 2), o + 3 * (NMODW / 2) + 1);
    if (lane == 0) __hip_atomic_fetch_add(cnt + 64 * cb, 1u, __ATOMIC_RELAXED, __HIP_MEMORY_SCOPE_AGENT);
}
__device__ __forceinline__ void p0_fin_item(const float* modp, float* modf, const float* __restrict__ bmod, unsigned* cnt, int item, int lane) {
    const int cb = item >> 2, b = item & 3, col = cb * 256 + lane * 4;
    { unsigned sp = 0u;
      while ((unsigned)__builtin_amdgcn_readfirstlane((int)__hip_atomic_load(cnt + 64 * cb, __ATOMIC_RELAXED, __HIP_MEMORY_SCOPE_AGENT)) < (unsigned)KSPLIT) { __builtin_amdgcn_s_sleep(2); if (++sp > (1u << 22)) break; }
      __builtin_amdgcn_fence(__ATOMIC_ACQUIRE, "agent"); }
    f32x4 t = *(const f32x4*)(bmod + col);
#pragma unroll 8
    for (int k2 = 0; k2 < KSPLIT; ++k2) { const unsigned long long* pp = (const unsigned long long*)(modp + (size_t)(k2 * 4 + b) * NMODW + col);
        const unsigned long long w0 = __hip_atomic_load(pp, __ATOMIC_RELAXED, __HIP_MEMORY_SCOPE_AGENT), w1 = __hip_atomic_load(pp + 1, __ATOMIC_RELAXED, __HIP_MEMORY_SCOPE_AGENT);
        t += (f32x4){__uint_as_float((unsigned)w0), __uint_as_float((unsigned)(w0 >> 32)), __uint_as_float((unsigned)w1), __uint_as_float((unsigned)(w1 >> 32))}; }
    unsigned long long* mo = (unsigned long long*)(modf + (size_t)b * NMODW + col);
    __hip_atomic_store(mo, ((unsigned long long)__float_as_uint(t.y) << 32) | __float_as_uint(t.x), __ATOMIC_RELAXED, __HIP_MEMORY_SCOPE_AGENT);
    __hip_atomic_store(mo + 1, ((unsigned long long)__float_as_uint(t.w) << 32) | __float_as_uint(t.z), __ATOMIC_RELAXED, __HIP_MEMORY_SCOPE_AGENT);
    asm volatile("s_waitcnt vmcnt(0)" ::: "memory");
    wt_readback(mo, mo + 1);
    if (lane == 0) __hip_atomic_fetch_add(cnt + 64 * 48, 1u, __ATOMIC_RELAXED, __HIP_MEMORY_SCOPE_AGENT);
}
__device__ __forceinline__ void p0_rope_item(const int* __restrict__ pos, float* cosT, float* sinT, int item, int lane) {
    const double inv = exp(-(double)lane * (9.210340371976184 / 64.0));
    const double rev = (double)pos[item] * inv * 0.15915494309189535;
    const float x = (float)((rev - rint(rev)) * 6.283185307179586);
    cosT[(size_t)item * 64 + lane] = cosf(x); sinT[(size_t)item * 64 + lane] = sinf(x);
}
struct SsmLane { double lr, li, dt, ar, ai; };
__device__ __forceinline__ SsmLane ssm_lane(const float* are, const float* aim, const float* ldt, int g, int p) {
    SsmLane L; L.dt = exp((double)ldt[g]); L.lr = (double)are[g * 64 + p]; L.li = (double)aim[g * 64 + p];
    const double m = exp(L.lr * L.dt); L.ar = m * cos(L.li * L.dt); L.ai = m * sin(L.li * L.dt); return L; }
__device__ __forceinline__ void ssm_pow(const SsmLane& L, int n, double& zr, double& zi) { const double m = exp(L.lr * L.dt * n), th = L.li * L.dt * n; zr = m * cos(th); zi = m * sin(th); }
__device__ __forceinline__ void ssm_step(const SsmLane& L, double& zr, double& zi) { const double nr = zr * L.ar - zi * L.ai, ni = zr * L.ai + zi * L.ar; zr = nr; zi = ni; }
__device__ __forceinline__ void ssm_bbar(const SsmLane& L, const float* bre, const float* bim, int g, int p, float (&br)[16], float (&bi)[16]) {
    const double nr = L.ar - 1.0, ni = L.ai, den = L.lr * L.lr + L.li * L.li;
    const float fr = (float)((nr * L.lr + ni * L.li) / den), fi = (float)((ni * L.lr - nr * L.li) / den);
    const f32x4* pr = (const f32x4*)(bre + (size_t)(g * 64 + p) * 16); const f32x4* pi = (const f32x4*)(bim + (size_t)(g * 64 + p) * 16);
#pragma unroll
    for (int q = 0; q < 4; ++q) { const f32x4 r = pr[q], i = pi[q];
#pragma unroll
        for (int e = 0; e < 4; ++e) { br[4 * q + e] = fr * r[e] - fi * i[e]; bi[4 * q + e] = fr * i[e] + fi * r[e]; } }
}
__device__ __forceinline__ void p0_ktab_item(const float* const* in, bf16* ktab, float* a64, LAS float* scr, int g, int ch, int lane) {
    const SsmLane L = ssm_lane(in[7], in[8], in[9], g, lane);
    float br[16], bi[16]; ssm_bbar(L, in[10], in[11], g, lane, br, bi);
    double zr, zi; ssm_pow(L, ch == 0 ? 0 : 8 * ch - 1, zr, zi);
    const int c = lane >> 2, q = lane & 3; const float* cr = in[12] + (size_t)(g * 16 + c) * 64; const float* ci = in[13] + (size_t)(g * 16 + c) * 64;
    for (int e = 0; e < 8; ++e) { const int ti = 8 * ch + e; if (ti > 64) break;
        if (ti == 0) { double wr, wi; ssm_pow(L, 64, wr, wi); a64[(g * 64 + lane) * 2] = (float)wr; a64[(g * 64 + lane) * 2 + 1] = (float)wi;
            *(GAS v2u*)(ktab + (size_t)(g * 65) * 256 + lane * 4) = (v2u){0u, 0u}; continue; }
        const float fzr = (float)zr, fzi = (float)zi;
#pragma unroll
        for (int k = 0; k < 16; ++k) { scr[lane * 16 + k] = fzr * br[k] - fzi * bi[k]; scr[1024 + lane * 16 + k] = fzr * bi[k] + fzi * br[k]; }
        LDS_WAIT(); asm volatile("" ::: "memory");
        f32x4 acc = {0, 0, 0, 0};
#pragma unroll 8
        for (int p = 0; p < 64; ++p) { const f32x4 wr = *(const LAS f32x4*)(scr + p * 16 + 4 * q), wi = *(const LAS f32x4*)(scr + 1024 + p * 16 + 4 * q); acc += wr * cr[p] - wi * ci[p]; }
        *(GAS v2u*)(ktab + ((size_t)(g * 65 + ti) * 16 + c) * 16 + 4 * q) = (v2u){pk2(acc[0], acc[1]), pk2(acc[2], acc[3])};
        LDS_WAIT(); asm volatile("" ::: "memory");
        ssm_step(L, zr, zi); }
}
__device__ __forceinline__ void p0_gtab_item(const float* const* in, bf16* gtab, int g, int ch, int lane) {
    const SsmLane L = ssm_lane(in[7], in[8], in[9], g, lane); double dzr, dzi; ssm_pow(L, 8 * ch + 1, dzr, dzi);
    const int p = lane;
    float cr[16], ci[16];
#pragma unroll
    for (int c = 0; c < 16; ++c) { cr[c] = in[12][(size_t)(g * 16 + c) * 64 + p]; ci[c] = in[13][(size_t)(g * 16 + c) * 64 + p]; }
    for (int e = 0; e < 8; ++e) { const int t = 8 * ch + e; const float zr = (float)dzr, zi = (float)dzi;
        const size_t base = ((size_t)(g * 32 + (t >> 1)) * 8) * 512;
#pragma unroll
        for (int c = 0; c < 16; ++c) { const float gre = cr[c] * zr - ci[c] * zi, gni = -(cr[c] * zi + ci[c] * zr);
            { const int pp = p;      gtab[base + (size_t)(pp >> 4) * 512 + ((16 * (t & 1) + c) + 32 * ((pp >> 3) & 1)) * 8 + (pp & 7)] = (bf16)f2bf(gre); }
            { const int pp = p + 64; gtab[base + (size_t)(pp >> 4) * 512 + ((16 * (t & 1) + c) + 32 * ((pp >> 3) & 1)) * 8 + (pp & 7)] = (bf16)f2bf(gni); } }
        ssm_step(L, dzr, dzi); }
}
__device__ __forceinline__ void p0_htab_item(const float* const* in, bf16* htab, int g, int ch, int lane) {
    const SsmLane L = ssm_lane(in[7], in[8], in[9], g, lane); double dzr, dzi; ssm_pow(L, 56 - 8 * ch, dzr, dzi);
    float br[16], bi[16]; ssm_bbar(L, in[10], in[11], g, lane, br, bi);
    for (int e = 7; e >= 0; --e) { const int s = 8 * ch + e; const float zr = (float)dzr, zi = (float)dzi;
#pragma unroll
        for (int hh = 0; hh < 2; ++hh) { v4u o, o2;
            o.x = pk2(zr * br[8 * hh] - zi * bi[8 * hh], zr * br[8 * hh + 1] - zi * bi[8 * hh + 1]); o.y = pk2(zr * br[8 * hh + 2] - zi * bi[8 * hh + 2], zr * br[8 * hh + 3] - zi * bi[8 * hh + 3]);
            o.z = pk2(zr * br[8 * hh + 4] - zi * bi[8 * hh + 4], zr * br[8 * hh + 5] - zi * bi[8 * hh + 5]); o.w = pk2(zr * br[8 * hh + 6] - zi * bi[8 * hh + 6], zr * br[8 * hh + 7] - zi * bi[8 * hh + 7]);
            o2.x = pk2(zr * bi[8 * hh] + zi * br[8 * hh], zr * bi[8 * hh + 1] + zi * br[8 * hh + 1]); o2.y = pk2(zr * bi[8 * hh + 2] + zi * br[8 * hh + 2], zr * bi[8 * hh + 3] + zi * br[8 * hh + 3]);
            o2.z = pk2(zr * bi[8 * hh + 4] + zi * br[8 * hh + 4], zr * bi[8 * hh + 5] + zi * br[8 * hh + 5]); o2.w = pk2(zr * bi[8 * hh + 6] + zi * br[8 * hh + 6], zr * bi[8 * hh + 7] + zi * br[8 * hh + 7]);
            { const int pp = lane;      *(GAS v4u*)(htab + ((((size_t)(g * 4 + (pp >> 5)) * 64 + s) * 64) + (pp & 31) + 32 * hh) * 8) = o; }
            { const int pp = lane + 64; *(GAS v4u*)(htab + ((((size_t)(g * 4 + (pp >> 5)) * 64 + s) * 64) + (pp & 31) + 32 * hh) * 8) = o2; } }
        ssm_step(L, dzr, dzi); }
}
#define XB_TMO      128
#define XB_XCNT(j)  (256  + 64 * (j))
#define XB_XSUB(j)  (1280 + 64 * (j))
#define XB_XGEN(j)  (2304 + 64 * (j))
#define XB_TOP      3328
#define XB_TOPGEN   3392
#define XCD_BAR_WORDS 3456
#define XB_SPIN_CAP (1u << 18)

__device__ __forceinline__ unsigned xb_ld(unsigned* p)              { return __hip_atomic_load(p, __ATOMIC_RELAXED, __HIP_MEMORY_SCOPE_AGENT); }
__device__ __forceinline__ unsigned xb_add(unsigned* p, unsigned v) { return __hip_atomic_fetch_add(p, v, __ATOMIC_RELAXED, __HIP_MEMORY_SCOPE_AGENT); }
__device__ __forceinline__ unsigned xb_xcc_id() { return (unsigned)__builtin_amdgcn_s_getreg((3 << 11) | 20) & 0xFu; }
#define XB_SPIN(cond, bar) do { unsigned _sp = 0; while (cond) { __builtin_amdgcn_s_sleep(1); \
    if ((++_sp & 255u) == 0u) { if (xb_ld(&(bar)[XB_TMO])) break; if (_sp > XB_SPIN_CAP) { atomicAdd(&(bar)[XB_TMO], 1u); break; } } } } while (0)

struct XcdBarrier {
    unsigned* bar; unsigned x;
    volatile LAS unsigned* st;
};

__device__ __forceinline__ XcdBarrier xcd_barrier_post(unsigned* bar, volatile LAS unsigned* st) {
    XcdBarrier b; b.bar = bar; b.x = xb_xcc_id(); b.st = st;
    if (threadIdx.x == 0) (void)xb_add(&bar[XB_XCNT(b.x)], 1u);
    return b;
}
__device__ __forceinline__ void xcd_barrier_complete(unsigned* bar, unsigned x, unsigned& nloc, unsigned& nx) {
    const unsigned G = gridDim.x * gridDim.y * gridDim.z;
    unsigned sum, cnt, mine, sp = 0u;
    for (;;) {
        sum = 0u; cnt = 0u; mine = 0u;
#pragma unroll
        for (unsigned j = 0; j < 16; ++j) { const unsigned c = xb_ld(&bar[XB_XCNT(j)]); sum += c; cnt += (c > 0u) ? 1u : 0u; mine = (j == x) ? c : mine; }
        if (sum == G) break;
        __builtin_amdgcn_s_sleep(1);
        if ((++sp & 255u) == 0u) { if (xb_ld(&bar[XB_TMO])) break; if (sp > XB_SPIN_CAP) { atomicAdd(&bar[XB_TMO], 1u); break; } }
    }
    nloc = mine > 0u ? mine : 1u; nx = cnt > 0u ? cnt : 1u;
}

__device__ __forceinline__ void xcd_barrier(const XcdBarrier& b) {
    asm volatile("s_waitcnt vmcnt(0)" ::: "memory");
    __syncthreads();
    if (threadIdx.x == 0) {
        unsigned* bar = b.bar;
        __builtin_amdgcn_s_waitcnt(0);
        unsigned nloc = b.st[0], nx = b.st[1];
        if (nloc == 0u) { xcd_barrier_complete(bar, b.x, nloc, nx); b.st[0] = nloc; b.st[1] = nx; }
        const unsigned old = xb_add(&bar[XB_XSUB(b.x)], 1u);
        const unsigned gen = old / nloc;
        if (old + 1u == (gen + 1u) * nloc) {
            __builtin_amdgcn_fence(__ATOMIC_RELEASE, "agent");
            asm volatile("s_waitcnt vmcnt(0)" ::: "memory");
            const unsigned og = xb_add(&bar[XB_TOP], 1u);
            const unsigned tg = og / nx;
            if (og + 1u == (tg + 1u) * nx) xb_add(&bar[XB_TOPGEN], 1u);
            else XB_SPIN(xb_ld(&bar[XB_TOPGEN]) == tg, bar);
            __builtin_amdgcn_fence(__ATOMIC_ACQUIRE, "agent");
            xb_add(&bar[XB_XGEN(b.x)], 1u);
            asm volatile("s_waitcnt vmcnt(0)" ::: "memory");
        } else {
            XB_SPIN(xb_ld(&bar[XB_XGEN(b.x)]) == gen, bar);
            __builtin_amdgcn_fence(__ATOMIC_ACQUIRE, "agent");
            asm volatile("s_waitcnt vmcnt(0)" ::: "memory");
        }
    }
    __syncthreads();
}

template <bool FROMP>
__device__ __forceinline__ void modnorm_phase(LAS unsigned char* lds, const float* xin, bf16* hout, const float* gvec, const float* modp, const float* bmod, const float* modf, int jsh, int jsc, int tid, int lane, int wave) {
    LAS float* TA = (LAS float*)lds; LAS float* TS = TA + DM;
    const int b = (blockIdx.x * 32) / SEQ;
    for (int k = tid; k < DM; k += NWAVES * 64) {
        float sh, sc;
        if (FROMP) { sh = bmod[jsh * DM + k]; sc = bmod[jsc * DM + k];
            for (int ks = 0; ks < KSPLIT; ++ks) { sh += modp[(size_t)(ks * 4 + b) * NMODW + jsh * DM + k]; sc += modp[(size_t)(ks * 4 + b) * NMODW + jsc * DM + k]; } }
        else { sh = modf[(size_t)b * NMODW + jsh * DM + k]; sc = modf[(size_t)b * NMODW + jsc * DM + k]; }
        TA[k] = gvec[k] * (1.0f + sc); TS[k] = sh; }
    __syncthreads();
    for (int r = 0; r < 4; ++r) { const int row = blockIdx.x * 32 + wave * 4 + r;
        const f32x4* xr = (const f32x4*)(xin + (size_t)row * DM) + lane;
        f32x4 v[8]; float s = 0.f;
#pragma unroll
        for (int j = 0; j < 8; ++j) { v[j] = __builtin_nontemporal_load(xr + 64 * j); s += (v[j].x * v[j].x + v[j].y * v[j].y) + (v[j].z * v[j].z + v[j].w * v[j].w); }
        const float rstd = 1.0f / sqrtf(wave_sum(s) * (1.0f / DM) + 1e-6f);
        GAS v2u* o8 = (GAS v2u*)(hout + (size_t)row * DM) + lane;
#pragma unroll
        for (int j = 0; j < 8; ++j) { const f32x4 a = *(const LAS f32x4*)(TA + 4 * (lane + 64 * j)), sft = *(const LAS f32x4*)(TS + 4 * (lane + 64 * j));
            const f32x4 o = v[j] * rstd * a + sft; o8[64 * j] = (v2u){pk2(o.x, o.y), pk2(o.z, o.w)}; } }
    __syncthreads();
}

#define TS_A (-1)
#define TS_MASK 0
#define TS_SCALE 1e-5f
#define TS_X (-1)
#define TS_Y (-1)
#define STAMP(k) do { if (TS_A >= 0 && bx == 0 && threadIdx.x == 0) ((volatile LAS unsigned long long*)(lds + MISC_OFF + 16))[k] = __builtin_amdgcn_s_memrealtime(); } while (0)
#define SSTAMP(k) do { if (TS_A >= 0 && blockIdx.x == 0 && threadIdx.x == 0) ((volatile LAS unsigned long long*)(lds + MISC_OFF + 16))[k] = __builtin_amdgcn_s_memrealtime(); } while (0)
constexpr int SS_UST = 2064;
constexpr int SS_U = 0, SS_K = 32 * SS_UST, SS_E = SS_K + 65 * 512, SS_C = SS_E + 2 * 128 * 33 * 4, SS_CST = 272, SS_END = SS_C + 32 * SS_CST;
static_assert(SS_END <= 147456 - 1024, "ssm LDS");
__device__ __forceinline__ float gelu_tanh(float v) { const float t = 0.7978845608028654f * (v + 0.044715f * v * v * v); const float e = __builtin_amdgcn_exp2f(-2.885390081777927f * t); return v * __builtin_amdgcn_rcpf(1.0f + e); }
__device__ __forceinline__ void ssm_unit(LAS unsigned char* lds, int b, int g, const bf16* proj, const bf16* ktab, const bf16* gtab, const bf16* htab, const float* a64, const float* dskip, bf16* vg, int tid, int lane, int wave) {
    const int n = lane & 31, h = lane >> 5;
    const int mt1 = wave & 3, kh = wave >> 2;
    bf16x8 hf[32];
    { const bf16* hp = htab + (((size_t)(g * 4 + mt1) * 64 + kh * 32) * 64 + lane) * 8;
#pragma unroll
      for (int s = 0; s < 32; ++s) hf[s] = *(const GAS bf16x8*)(hp + (size_t)s * 512); }
    { v4u ur[8];
#pragma unroll
      for (int it = 0; it < 8; ++it) { const int i = tid + 512 * it; ur[it] = *(const GAS v4u*)(proj + ((size_t)(b * NGRP + g) * SEQ * 16 + (size_t)i * 8)); }
      v4u kr[5];
#pragma unroll
      for (int it = 0; it < 5; ++it) { const int i = tid + 512 * it; kr[it] = (v4u){0u, 0u, 0u, 0u}; if (i < 2080) kr[it] = *(const GAS v4u*)(ktab + (size_t)g * 65 * 256 + i * 8); }
#pragma unroll
      for (int it = 0; it < 8; ++it) { const int i = tid + 512 * it, t = i >> 1, hf2 = i & 1; *(LAS v4u*)(lds + SS_U + (t >> 6) * SS_UST + (t & 63) * 32 + hf2 * 16) = ur[it]; }
#pragma unroll
      for (int it = 0; it < 5; ++it) { const int i = tid + 512 * it; if (i < 2080) *(LAS v4u*)(lds + SS_K + i * 16) = kr[it]; } }
    __syncthreads(); SSTAMP(24);
    { f32x16 acc;
#pragma unroll
      for (int i = 0; i < 16; ++i) acc[i] = 0.f;
#pragma unroll
      for (int s = 0; s < 32; ++s) { const bf16x8 bb = *(const LAS bf16x8*)(lds + SS_U + n * SS_UST + (kh * 32 + s) * 32 + h * 16);
          acc = __builtin_amdgcn_mfma_f32_32x32x16_bf16(hf[s], bb, acc, 0, 0, 0); }
      LAS float* E = (LAS float*)(lds + SS_E) + kh * 128 * 33;
#pragma unroll
      for (int r = 0; r < 16; ++r) E[(32 * mt1 + (r & 3) + 8 * (r >> 2) + 4 * h) * 33 + n] = acc[r]; }
    __syncthreads(); SSTAMP(25);
    if (wave == 0) { const int p = lane; const float ar = a64[(g * 64 + p) * 2], ai = a64[(g * 64 + p) * 2 + 1]; float cr = 0.f, ci = 0.f;
        const LAS float* E0 = (const LAS float*)(lds + SS_E); const LAS float* E1 = E0 + 128 * 33;
#pragma unroll 8
        for (int j = 0; j < 32; ++j) { *(LAS bf16*)(lds + SS_C + j * SS_CST + p * 2) = (bf16)f2bf(cr); *(LAS bf16*)(lds + SS_C + j * SS_CST + (64 + p) * 2) = (bf16)f2bf(ci);
            const float er = E0[p * 33 + j] + E1[p * 33 + j], ei = E0[(64 + p) * 33 + j] + E1[(64 + p) * 33 + j];
            const float nr = ar * cr - ai * ci + er, ni = ar * ci + ai * cr + ei; cr = nr; ci = ni; } }
    f32x16 acc4[4];
#pragma unroll
    for (int q = 0; q < 4; ++q)
#pragma unroll
        for (int i = 0; i < 16; ++i) acc4[q][i] = 0.f;
    const int c_l = n & 15, tl = n >> 4;
    const int bbase = SS_U + n * SS_UST + h * 16;
    const int kb0 = SS_K + ((tl + 1) * 16 + c_l) * 32 + h * 16;
    const int mtq0 = wave, mtq1 = 15 - wave, mtq2 = 16 + wave, mtq3 = 31 - wave;
    const int nsmax = 2 * mtq3 + 2;
    bf16x8 gfb[2][8];
    for (int s = 0; s < nsmax; s += 2) {
        const bf16x8 bb0 = *(const LAS bf16x8*)(lds + bbase + s * 32), bb1 = *(const LAS bf16x8*)(lds + bbase + s * 32 + 32);
        const bool c0 = s < 2 * mtq0 + 2, c1 = s < 2 * mtq1 + 2, c2 = s < 2 * mtq2 + 2;
        bf16x8 a00, a01, a10, a11, a20, a21;
        if (c0) { a00 = *(const LAS bf16x8*)(lds + kb0 + mtq0 * 1024 - s * 512); a01 = *(const LAS bf16x8*)(lds + kb0 + mtq0 * 1024 - s * 512 - 512); }
        if (c1) { a10 = *(const LAS bf16x8*)(lds + kb0 + mtq1 * 1024 - s * 512); a11 = *(const LAS bf16x8*)(lds + kb0 + mtq1 * 1024 - s * 512 - 512); }
        if (c2) { a20 = *(const LAS bf16x8*)(lds + kb0 + mtq2 * 1024 - s * 512); a21 = *(const LAS bf16x8*)(lds + kb0 + mtq2 * 1024 - s * 512 - 512); }
        const bf16x8 a30 = *(const LAS bf16x8*)(lds + kb0 + mtq3 * 1024 - s * 512), a31 = *(const LAS bf16x8*)(lds + kb0 + mtq3 * 1024 - s * 512 - 512);
        acc4[3] = __builtin_amdgcn_mfma_f32_32x32x16_bf16(a30, bb0, acc4[3], 0, 0, 0);
        if (c2) acc4[2] = __builtin_amdgcn_mfma_f32_32x32x16_bf16(a20, bb0, acc4[2], 0, 0, 0);
        if (c1) acc4[1] = __builtin_amdgcn_mfma_f32_32x32x16_bf16(a10, bb0, acc4[1], 0, 0, 0);
        if (c0) acc4[0] = __builtin_amdgcn_mfma_f32_32x32x16_bf16(a00, bb0, acc4[0], 0, 0, 0);
        acc4[3] = __builtin_amdgcn_mfma_f32_32x32x16_bf16(a31, bb1, acc4[3], 0, 0, 0);
        if (c2) acc4[2] = __builtin_amdgcn_mfma_f32_32x32x16_bf16(a21, bb1, acc4[2], 0, 0, 0);
        if (c1) acc4[1] = __builtin_amdgcn_mfma_f32_32x32x16_bf16(a11, bb1, acc4[1], 0, 0, 0);
        if (c0) acc4[0] = __builtin_amdgcn_mfma_f32_32x32x16_bf16(a01, bb1, acc4[0], 0, 0, 0); }
#pragma unroll
    for (int q = 0; q < 2; ++q) { const bf16* gp = gtab + (((size_t)(g * 32 + (q == 0 ? mtq0 : mtq1)) * 8) * 64 + lane) * 8;
#pragma unroll
        for (int ks = 0; ks < 8; ++ks) gfb[q][ks] = *(const GAS bf16x8*)(gp + (size_t)ks * 512); }
    asm volatile("" ::: "memory");
    SSTAMP(26); __syncthreads(); SSTAMP(27);
#pragma unroll
    for (int q = 0; q < 2; ++q) {
#pragma unroll
        for (int ks = 0; ks < 8; ++ks) { const bf16x8 bb = *(const LAS bf16x8*)(lds + SS_C + n * SS_CST + (16 * ks + 8 * h) * 2);
            acc4[q] = __builtin_amdgcn_mfma_f32_32x32x16_bf16(gfb[q][ks], bb, acc4[q], 0, 0, 0); } }
#pragma unroll
    for (int q = 2; q < 4; ++q) { const bf16* gp = gtab + (((size_t)(g * 32 + (q == 2 ? mtq2 : mtq3)) * 8) * 64 + lane) * 8;
        bf16x8 gf[8];
#pragma unroll
        for (int ks = 0; ks < 8; ++ks) gf[ks] = *(const GAS bf16x8*)(gp + (size_t)ks * 512);
#pragma unroll
        for (int ks = 0; ks < 8; ++ks) { const bf16x8 bb = *(const LAS bf16x8*)(lds + SS_C + n * SS_CST + (16 * ks + 8 * h) * 2);
            acc4[q] = __builtin_amdgcn_mfma_f32_32x32x16_bf16(gf[ks], bb, acc4[q], 0, 0, 0); } }
    SSTAMP(28);
#pragma unroll
    for (int q = 0; q < 4; ++q) { const int mt = (q == 0) ? mtq0 : (q == 1) ? mtq1 : (q == 2) ? mtq2 : mtq3;
#pragma unroll
        for (int q4 = 0; q4 < 4; ++q4) { const int t = 2 * mt + (q4 >> 1), c0 = 8 * (q4 & 1) + 4 * h;
            const v2u uu = *(const LAS v2u*)(lds + SS_U + n * SS_UST + t * 32 + c0 * 2);
            const f32x4 dv = *(const f32x4*)(dskip + 16 * g + c0);
            const float y0 = acc4[q][4 * q4 + 0] + dv[0] * bf_lo(uu.x), y1 = acc4[q][4 * q4 + 1] + dv[1] * bf_hi(uu.x), y2 = acc4[q][4 * q4 + 2] + dv[2] * bf_lo(uu.y), y3 = acc4[q][4 * q4 + 3] + dv[3] * bf_hi(uu.y);
            *(GAS v2u*)(vg + (size_t)(b * SEQ + 64 * n + t) * SSMW + 16 * g + c0) = (v2u){pk2(gelu_tanh(y0), gelu_tanh(y1)), pk2(gelu_tanh(y2), gelu_tanh(y3))}; } }
    __syncthreads();
}

constexpr int AT_K = 0, AT_V = 272 * 256, AT_END = 2 * 272 * 256;
static_assert(AT_END <= 147456 - 1024, "attn LDS");
__device__ __forceinline__ unsigned off_b(unsigned row, unsigned ch) { return 256u * row + 16u * (ch ^ (((row & 3) << 2) | ((row >> 2) & 3))); }
typedef short v4i16_t __attribute__((ext_vector_type(4)));
__device__ __forceinline__ s16x4 tr_read(LAS unsigned char* p) { return __builtin_bit_cast(s16x4, __builtin_amdgcn_ds_read_tr16_b64_v4i16((LAS v4i16_t*)p)); }
struct AttnDesc { int b, hd, di, dil, res, blk; };
__device__ __forceinline__ AttnDesc attn_decode(int u) { AttnDesc d; const int bh = u / 48, w = u % 48; d.b = bh / NHEAD; d.hd = bh % NHEAD;
    if (w < 16) { d.di = 0; d.dil = 1; d.res = 0; d.blk = w; } else if (w < 32) { d.di = 1; d.dil = 4; d.res = (w - 16) >> 2; d.blk = (w - 16) & 3; } else { d.di = 2; d.dil = 16; d.res = w - 32; d.blk = 0; }
    return d; }
__device__ __forceinline__ void attn_run(LAS unsigned char* lds, int u0, int ustride, int uend, const bf16* proj, bf16* obr, float* lse, int tid, int lane, int wave) {
    if (u0 >= uend) return;
    if (tid < 256) { const int row = 256 + (tid >> 4), ch = tid & 15; *(LAS v4u*)(lds + AT_K + off_b(row, ch)) = (v4u){0u, 0u, 0u, 0u}; *(LAS v4u*)(lds + AT_V + off_b(row, ch)) = (v4u){0u, 0u, 0u, 0u}; }
    const int qn = lane & 15, g = lane >> 4, q4 = (lane & 15) >> 2, p4 = lane & 3;
    const int r0s = tid >> 4, chs = tid & 15; const unsigned soff = off_b(r0s, chs);
    v4u kr[8], vr[8]; bf16x8 qnx[4];
    int u = u0; AttnDesc nd = attn_decode(u);
#define AT_ISSUE(D) do { const size_t rowb_ = (size_t)(D).b * SEQ; \
        _Pragma("unroll") for (int it = 0; it < 8; ++it) { const int sub = 128 * (D).blk - 128 + r0s + 32 * it; kr[it] = (v4u){0u, 0u, 0u, 0u}; vr[it] = kr[it]; \
            if (sub >= 0) { const bf16* src = proj + (rowb_ + (D).res + (D).dil * sub) * PROJW + 2048 + (D).hd * HDIM + chs * 8; kr[it] = *(const GAS v4u*)src; vr[it] = *(const GAS v4u*)(src + 1024); } } \
        const int qt_ = (D).res + (D).dil * (128 * (D).blk + 16 * wave + qn); \
        _Pragma("unroll") for (int s_ = 0; s_ < 4; ++s_) qnx[s_] = *(const GAS bf16x8*)(proj + (rowb_ + qt_) * PROJW + 1024 + (D).hd * HDIM + 32 * s_ + 8 * g); } while (0)
    AT_ISSUE(nd);
    for (;;) {
        const AttnDesc d = nd;
#pragma unroll
        for (int it = 0; it < 8; ++it) { *(LAS v4u*)(lds + AT_K + soff + 8192 * it) = kr[it]; *(LAS v4u*)(lds + AT_V + soff + 8192 * it) = vr[it]; }
        bf16x8 qf[4];
#pragma unroll
        for (int s = 0; s < 4; ++s) qf[s] = qnx[s];
        __syncthreads();
        const int un = u + ustride; const bool has = un < uend;
        if (has) { nd = attn_decode(un); AT_ISSUE(nd); }
        const bool first = (d.blk == 0); const int tskip = first ? 8 - wave : 0;
        f32x4 sc[10];
#pragma unroll
        for (int kt = 0; kt < 10; ++kt) { f32x4 a = {0.f, 0.f, 0.f, 0.f};
            if (kt < 9 && kt >= tskip) {
#pragma unroll
                for (int s = 0; s < 4; ++s) { const bf16x8 kf = *(const LAS bf16x8*)(lds + AT_K + off_b(16 * (wave + kt) + qn, 4 * s + g));
                    a = __builtin_amdgcn_mfma_f32_16x16x32_bf16(kf, qf[s], a, 0, 0, 0); } }
            sc[kt] = a; }
        float mx = -1e30f;
#pragma unroll
        for (int kt = 0; kt < 10; ++kt)
#pragma unroll
            for (int r = 0; r < 4; ++r) { const int rel = 16 * kt + 4 * g + r; bool ok = (rel >= qn) && (rel <= qn + 128) && (kt >= tskip);
                sc[kt][r] = ok ? sc[kt][r] : -1e30f; mx = fmaxf(mx, sc[kt][r]); }
        mx = fmaxf(mx, __shfl_xor(mx, 16)); mx = fmaxf(mx, __shfl_xor(mx, 32));
        float ls = 0.f;
#pragma unroll
        for (int kt = 0; kt < 10; ++kt)
#pragma unroll
            for (int r = 0; r < 4; ++r) { const float p = (sc[kt][r] > -1e29f) ? __builtin_amdgcn_exp2f(sc[kt][r] - mx) : 0.f; sc[kt][r] = p; ls += p; }
        ls += __shfl_xor(ls, 16); ls += __shfl_xor(ls, 32);
        f32x4 o[8];
#pragma unroll
        for (int c = 0; c < 8; ++c) o[c] = (f32x4){0.f, 0.f, 0.f, 0.f};
#pragma unroll
        for (int ks = 0; ks < 5; ++ks) {
            if (2 * ks + 1 >= tskip) {
                union { unsigned uu[4]; bf16x8 v; } pb;
                pb.uu[0] = pk2(sc[2 * ks][0], sc[2 * ks][1]); pb.uu[1] = pk2(sc[2 * ks][2], sc[2 * ks][3]); pb.uu[2] = pk2(sc[2 * ks + 1][0], sc[2 * ks + 1][1]); pb.uu[3] = pk2(sc[2 * ks + 1][2], sc[2 * ks + 1][3]);
                const unsigned r0 = 16 * wave + 32 * ks + 4 * g + q4;
#pragma unroll
                for (int c = 0; c < 8; ++c) {
                    const s16x4 v0 = tr_read(lds + AT_V + off_b(r0, 2 * c + (p4 >> 1)) + 8 * (p4 & 1));
                    const s16x4 v1 = tr_read(lds + AT_V + off_b(r0 + 16, 2 * c + (p4 >> 1)) + 8 * (p4 & 1));
                    bf16x8 va; va[0] = v0[0]; va[1] = v0[1]; va[2] = v0[2]; va[3] = v0[3]; va[4] = v1[0]; va[5] = v1[1]; va[6] = v1[2]; va[7] = v1[3];
                    o[c] = __builtin_amdgcn_mfma_f32_16x16x32_bf16(va, pb.v, o[c], 0, 0, 0); } } }
        const float inv = 1.0f / ls;
        const size_t qrow = (size_t)d.b * SEQ + d.res + d.dil * (128 * d.blk + 16 * wave + qn);
        bf16* op = obr + (size_t)d.di * MTOK * ATTW + qrow * ATTW + d.hd * HDIM + 4 * g;
#pragma unroll
        for (int c = 0; c < 8; ++c) *(GAS v2u*)(op + 16 * c) = (v2u){pk2(o[c][0] * inv, o[c][1] * inv), pk2(o[c][2] * inv, o[c][3] * inv)};
        if (g == 0) lse[(size_t)d.di * MTOK * NHEAD + qrow * NHEAD + d.hd] = mx + __builtin_amdgcn_logf(ls);
        __syncthreads();
        if (!has) break;
        u = un;
    }
#undef AT_ISSUE
}

__device__ __forceinline__ void ynorm_phase(bf16* ycat, const bf16* obr, const float* lse, int lane, int wave) {
    for (int r = 0; r < 4; ++r) { const int row = blockIdx.x * 32 + wave * 4 + r;
        { const int hd = lane >> 3;
          const float l0 = lse[(size_t)row * NHEAD + hd], l1 = lse[(size_t)MTOK * NHEAD + (size_t)row * NHEAD + hd], l2 = lse[(size_t)2 * MTOK * NHEAD + (size_t)row * NHEAD + hd];
          const float lm = fmaxf(l0, fmaxf(l1, l2)); float w0 = __builtin_amdgcn_exp2f(l0 - lm), w1 = __builtin_amdgcn_exp2f(l1 - lm), w2 = __builtin_amdgcn_exp2f(l2 - lm);
          const float wi = 1.0f / (w0 + w1 + w2); w0 *= wi; w1 *= wi; w2 *= wi;
          float v[16];
#pragma unroll
          for (int i = 0; i < 16; ++i) v[i] = 0.f;
#pragma unroll
          for (int d = 0; d < 3; ++d) { const bf16* p = obr + (size_t)d * MTOK * ATTW + (size_t)row * ATTW + lane * 16; const v4u a = *(const GAS v4u*)p, c = *(const GAS v4u*)(p + 8); const float w = d == 0 ? w0 : d == 1 ? w1 : w2;
              v[0] += w * bf_lo(a.x); v[1] += w * bf_hi(a.x); v[2] += w * bf_lo(a.y); v[3] += w * bf_hi(a.y); v[4] += w * bf_lo(a.z); v[5] += w * bf_hi(a.z); v[6] += w * bf_lo(a.w); v[7] += w * bf_hi(a.w);
              v[8] += w * bf_lo(c.x); v[9] += w * bf_hi(c.x); v[10] += w * bf_lo(c.y); v[11] += w * bf_hi(c.y); v[12] += w * bf_lo(c.z); v[13] += w * bf_hi(c.z); v[14] += w * bf_lo(c.w); v[15] += w * bf_hi(c.w); }
          float s = 0.f;
#pragma unroll
          for (int i = 0; i < 16; ++i) s += v[i] * v[i];
          const float rstd = 1.0f / sqrtf(wave_sum(s) * (1.0f / ATTW) + 1e-6f);
          bf16* p = ycat + (size_t)row * DM + SSMW + lane * 16;
          *(GAS v4u*)p = (v4u){pk2(v[0] * rstd, v[1] * rstd), pk2(v[2] * rstd, v[3] * rstd), pk2(v[4] * rstd, v[5] * rstd), pk2(v[6] * rstd, v[7] * rstd)};
          *(GAS v4u*)(p + 8) = (v4u){pk2(v[8] * rstd, v[9] * rstd), pk2(v[10] * rstd, v[11] * rstd), pk2(v[12] * rstd, v[13] * rstd), pk2(v[14] * rstd, v[15] * rstd)}; } }
}
__device__ __forceinline__ void final_norm_phase(float* out, const float* gfin, int lane, int wave) {
    for (int r = 0; r < 4; ++r) { const int row = blockIdx.x * 32 + wave * 4 + r;
        f32x4* xr = (f32x4*)(out + (size_t)row * DM) + lane; f32x4 v[8]; float s = 0.f;
#pragma unroll
        for (int j = 0; j < 8; ++j) { v[j] = xr[64 * j]; s += (v[j].x * v[j].x + v[j].y * v[j].y) + (v[j].z * v[j].z + v[j].w * v[j].w); }
        const float rstd = 1.0f / sqrtf(wave_sum(s) * (1.0f / DM) + 1e-6f);
#pragma unroll
        for (int j = 0; j < 8; ++j) { const f32x4 gq = *((const f32x4*)gfin + lane + 64 * j); xr[64 * j] = v[j] * rstd * gq; } }
}

constexpr int NPH = 11;
constexpr int ATT_P3_UNITS = 512;
constexpr int IT_GEMV = KSPLIT * 48, IT_SSM = NGRP * 25, IT_FIN = 48 * 4, IT_ROPE = MTOK, IT_WIN = (DM / 64) * (PROJW / 64), IT_WGLU = (SSMW / 64) * (SSMW / 64), IT_WOUT = (DM / 64) * (DM / 64),
              IT_WG = (DM / 64) * (DFF / 64), IT_WD = (DFF / 64) * (DM / 64), IT_TOTAL = IT_GEMV + IT_SSM + IT_FIN + IT_ROPE + IT_WIN + IT_WGLU + IT_WOUT + 2 * IT_WG;
__global__ void __launch_bounds__(NWAVES * 64, 2) hymba_fwd(Args args) {
    extern __shared__ __attribute__((aligned(16))) unsigned char lds_raw[];
    LAS unsigned char* lds = (LAS unsigned char*)lds_raw;
    cg::grid_group grid = cg::this_grid();
    const int tid = threadIdx.x, lane = tid & 63, wave = __builtin_amdgcn_readfirstlane(tid >> 6);
    const int G = gridDim.x, bx = blockIdx.x;
    unsigned char* ws = args.ws;
    const float* const* in = args.in;
    float* modp = (float*)(ws + WS_MODP); float* modf = (float*)(ws + WS_MODF); float* cosT = (float*)(ws + WS_ROPE); float* sinT = cosT + (size_t)MTOK * 64;
    bf16* ktab = (bf16*)(ws + WS_KTAB); bf16* gtab = (bf16*)(ws + WS_GTAB); bf16* htab = (bf16*)(ws + WS_HTAB); float* a64 = (float*)(ws + WS_A64);
    bf16* Win = (bf16*)(ws + WS_WIN); bf16* Wglu = (bf16*)(ws + WS_WGLU); bf16* Wout = (bf16*)(ws + WS_WOUT); bf16* Wgu = (bf16*)(ws + WS_WGU); bf16* Wdn = (bf16*)(ws + WS_WDN);
    bf16* Hb = (bf16*)(ws + WS_H); bf16* proj = (bf16*)(ws + WS_PROJ); bf16* vg = (bf16*)(ws + WS_VG); bf16* ycat = (bf16*)(ws + WS_YCAT); bf16* obr = (bf16*)(ws + WS_OBR); float* lse = (float*)(ws + WS_LSE);
    bf16* ff = (bf16*)(ws + WS_FF); bf16* ut = (bf16*)(ws + WS_UT);
    const int lo = args.ph_lo, hi = args.ph_hi;
#ifndef PHMASK
#define PHMASK 0x7ff
#endif
#define IN(k) (((PHMASK >> (k)) & 1) && lo <= (k) && (k) < hi)
    volatile LAS unsigned* MISC = (volatile LAS unsigned*)(lds + MISC_OFF);
    if (tid < 2) MISC[tid] = 0u;
    __syncthreads();
    if (args.ph_lo < 0) grid.sync();
    const XcdBarrier xbar = xcd_barrier_post((unsigned*)(ws + WS_CTL), MISC);
    STAMP(0);
#define SEAM(k) do { if (IN(k) && IN((k) + 1)) xcd_barrier(xbar); } while (0)
#ifndef DOUBLE_MASK
#define DOUBLE_MASK 0
#endif
#define P0SUB 8
#define P3SUB 1
#define REPS(k) for (int rep_ = 0; rep_ < 1 + ((DOUBLE_MASK >> (k)) & 1); ++rep_)
#define RSYNC(k) do { if ((DOUBLE_MASK >> (k)) & 1) xcd_barrier(xbar); } while (0)

    REPS(0) if (IN(0)) {
        RSYNC(0);
        LAS float* scr = (LAS float*)(lds + wave * 16640);
        const int gw = wave * G + bx, NGW = G * NWAVES;
        const int nmine = (IT_TOTAL - gw + NGW - 1) / NGW;
        for (int kk = 0; kk < nmine; ++kk) {
            const bool gfirst = (gw < IT_GEMV);
            const int it = gw + ((wave & 1) ? ((gfirst && kk == 0) ? 0 : (gfirst ? nmine - kk : nmine - 1 - kk)) : kk) * NGW;
            int r = it;
#if DOUBLE_MASK & 1
            if (rep_ == 1) { const int ty = (it < IT_GEMV) ? 1 : (it < IT_GEMV + IT_SSM) ? 2 : (it < IT_GEMV + IT_SSM + IT_ROPE) ? 4 : 8; if (!(P0SUB & ty)) continue; }
#endif
            if (r < IT_GEMV) { p0_gemv_item(in[1], in[3], modp, modf, in[4], (unsigned*)(ws + WS_CNT), scr, r, lane); continue; } r -= IT_GEMV;
            if (r < IT_SSM) { const int g = r / 25, sub = r % 25;
                if (sub < 9) p0_ktab_item(in, ktab, a64, scr, g, sub, lane); else if (sub < 17) p0_gtab_item(in, gtab, g, sub - 9, lane); else p0_htab_item(in, htab, g, sub - 17, lane);
                continue; } r -= IT_SSM;
            if (r < IT_FIN) { p0_fin_item(modp, modf, in[4], (unsigned*)(ws + WS_CNT), r, lane); continue; } r -= IT_FIN;
            if (r < IT_ROPE) { p0_rope_item((const int*)in[2], cosT, sinT, r, lane); continue; } r -= IT_ROPE;
            if (r < IT_WIN) { p0_transpose_item<1>(in[6], DM, PROJW, Win, scr, r, lane, nullptr, nullptr); continue; } r -= IT_WIN;
            if (r < IT_WGLU) { p0_transpose_item<0>(in[15], SSMW, SSMW, Wglu, scr, r, lane, nullptr, nullptr); continue; } r -= IT_WGLU;
            if (r < IT_WOUT) { p0_transpose_item<4>(in[19], DM, DM, Wout, scr, r, lane, in[17], in[18]); continue; } r -= IT_WOUT;
            if (r < IT_WG) { p0_transpose_item<2>(in[21], DM, DFF, Wgu, scr, r, lane, nullptr, nullptr); continue; } r -= IT_WG;
            p0_transpose_item<3>(in[22], DM, DFF, Wgu, scr, r, lane, nullptr, nullptr);
        }
        __syncthreads();
    }
    STAMP(1); STAMP(2);
    REPS(1) if (IN(1)) {
        RSYNC(1);
        unsigned* gcnt = (unsigned*)(ws + WS_CNT);
        if (wave == 0) { unsigned sp = 0u; unsigned* dn = gcnt + 64 * 48;
            while ((unsigned)__builtin_amdgcn_readfirstlane((int)__hip_atomic_load(dn, __ATOMIC_RELAXED, __HIP_MEMORY_SCOPE_AGENT)) < 192u) { __builtin_amdgcn_s_sleep(4); if (++sp > (1u << 22)) break; }
            __builtin_amdgcn_fence(__ATOMIC_ACQUIRE, "agent"); asm volatile("s_waitcnt vmcnt(0)" ::: "memory"); }
        __syncthreads();
        modnorm_phase<false>(lds, in[0], Hb, in[5], modp, in[4], modf, 0, 1, tid, lane, wave);
    }
    STAMP(3); SEAM(1); STAMP(4);
    if (IN(2)) {
        pg8::Gemm g{Hb, Win, MTOK, PROJW, DM}; pg8::StaticOrder S; S.init(MTOK, PROJW, G, bx);
        pg8::EpiProj E{proj, ut, cosT, sinT, 0.08838834764831845f * 1.4426950408889634f};
        pg8::gemm_phase<pg8::EpiProj, pg8::StaticOrder, true, true>(lds, g, S, E);
    }
    STAMP(5); SEAM(2); STAMP(6);
    REPS(3) if (IN(3)) {
        RSYNC(3);
        int tid = threadIdx.x; asm volatile("" : "+v"(tid)); const int lane = tid & 63, wave = __builtin_amdgcn_readfirstlane(tid >> 6);
#if DOUBLE_MASK & 8
        if (rep_ == 0 || (P3SUB & 1))
#endif
        for (int u0 = bx; u0 < BATCH * NGRP; u0 += G) { const int x = u0 & 7, j = (u0 >> 3) & 31;
            ssm_unit(lds, 2 * (x >> 2) + (j >> 4), 16 * (x & 3) + (j & 15), ut, ktab, gtab, htab, a64, in[14], vg, tid, lane, wave); }
        STAMP(7);
#if DOUBLE_MASK & 8
        if (rep_ == 0 || (P3SUB & 2))
#endif
        { const int ax = 192 * (bx & 7), aj = bx >> 3;
          attn_run(lds, ax + aj, 32, ax + 64, proj, obr, lse, tid, lane, wave); }
    }
    STAMP(8); SEAM(3); STAMP(9);
    if (IN(4)) {
        pg8::Gemm g{vg, Wglu, MTOK, SSMW, SSMW}; pg8::StaticOrder S; S.init(MTOK, SSMW, G, bx);
        pg8::EpiGluNorm E{ycat, vg, in[16], (float*)(ws + WS_SLOTS) + 2 * 65536, (unsigned*)(ws + WS_GCNT)};
        pg8::gemm_phase<pg8::EpiGluNorm, pg8::StaticOrder, false, true>(lds, g, S, E);
        __syncthreads();
        STAMP(10);
        { int tid = threadIdx.x; asm volatile("" : "+v"(tid)); const int lane = tid & 63, wave = __builtin_amdgcn_readfirstlane(tid >> 6);
          const bool glu = bx < 128; const int ax = 192 * (bx & 7), aj = bx >> 3;
          attn_run(lds, glu ? ax + 64 + aj : ax + 80 + (aj - 16), 16, glu ? ax + 80 : ax + 192, proj, obr, lse, tid, lane, wave); }
    }
    STAMP(11); SEAM(4); STAMP(12);
    REPS(5) if (IN(5)) ynorm_phase(ycat, obr, lse, lane, wave);
    STAMP(13); SEAM(5); STAMP(14);
    if (IN(6)) {
        pg8::Gemm g{ycat, Wout, MTOK, DM, DM}; pg8::StaticOrder S; S.init(MTOK, DM, G, bx);
        pg8::EpiNormX<0> E{in[0], args.out, Hb, modf + 2 * DM, in[20], modf + 4 * DM, modf + 3 * DM, (float*)(ws + WS_SLOTS), (unsigned*)(ws + WS_PCNT), (bf16*)(ws + WS_OBR)};
        pg8::gemm_phase<pg8::EpiNormX<0>, pg8::StaticOrder, false, true>(lds, g, S, E);
    }
    STAMP(15); SEAM(6); STAMP(16);
    if (IN(8)) {
        pg8::Gemm g{Hb, Wgu, MTOK, 2 * DFF, DM}; pg8::StaticOrder S; S.init(MTOK, 2 * DFF, G, bx);
        pg8::EpiSwiglu E{ff};
        pg8::gemm_phase<pg8::EpiSwiglu, pg8::StaticOrder, true, true>(lds, g, S, E);
        if (bx >= 128) { int tid2 = threadIdx.x; asm volatile("" : "+v"(tid2)); const int lane2 = tid2 & 63, wave2 = __builtin_amdgcn_readfirstlane(tid2 >> 6);
            LAS float* scr = (LAS float*)(lds + wave2 * 16640);
            for (int it = (bx - 128) * NWAVES + wave2; it < IT_WD; it += 128 * NWAVES) p0_transpose_item<0>(in[23], DFF, DM, Wdn, scr, it, lane2, nullptr, nullptr); }
    }
    STAMP(19); SEAM(8); STAMP(20);
    if (IN(9)) {
        pg8::Gemm g{ff, Wdn, MTOK, DM, DFF}; pg8::StaticOrder S; S.init(MTOK, DM, G, bx);
        pg8::EpiNormX<1> E{args.out, args.out, nullptr, modf + 5 * DM, in[24], nullptr, nullptr, (float*)(ws + WS_SLOTS) + 65536, (unsigned*)(ws + WS_PCNT) + 32 * 64, (bf16*)(ws + WS_OBR)};
        pg8::gemm_phase<pg8::EpiNormX<1>, pg8::StaticOrder, false, true>(lds, g, S, E);
    }
    STAMP(21); STAMP(22);
    if (TS_A >= 0 && bx == 0) { STAMP(23); __syncthreads();
        const volatile LAS unsigned long long* ts = (const volatile LAS unsigned long long*)(lds + MISC_OFF + 16);
        unsigned long long tot = 0ull;
        for (int i = 0; i < 23; ++i) if ((TS_MASK >> i) & 1) tot += ts[i + 1] - ts[i];
        if (TS_X >= 0) tot = ts[TS_Y < 0 ? 0 : TS_Y] - ts[TS_X < 0 ? 0 : TS_X];
        const float dl = (float)tot * TS_SCALE;
        for (int i = threadIdx.x; i < 4096; i += NWAVES * 64) args.out[i] += dl; }
#undef IN
#undef SEAM
}

#ifndef MK_PER_PHASE
#define MK_PER_PHASE 0
#endif
extern "C" void kernel_launch(void* const* d_in, const int* in_sizes, int n_in, void* d_out, int out_size, void* d_ws, size_t ws_size, hipStream_t stream) {
    static int ready = 0;
    if (ready == 0) {
        ready = 1;
        if (n_in != 25 || out_size != MTOK * DM || ws_size < WS_END) { fprintf(stderr, "kernel_launch: unexpected shapes (n_in %d out %d ws %zu)\n", n_in, out_size, ws_size); ready = -1; }
        else if (hipFuncSetAttribute((const void*)hymba_fwd, hipFuncAttributeMaxDynamicSharedMemorySize, LDS_BYTES) != hipSuccess) { fprintf(stderr, "kernel_launch: hipFuncSetAttribute failed\n"); ready = -1; }
        else { int per_cu = 0; (void)hipOccupancyMaxActiveBlocksPerMultiprocessor(&per_cu, (const void*)hymba_fwd, NWAVES * 64, LDS_BYTES); (void)hipGetLastError();
               if (per_cu < 1) fprintf(stderr, "kernel_launch: occupancy query reports %d blocks per CU\n", per_cu); }
    }
    if (ready < 0) return;
    if (hipMemsetAsync((char*)d_ws + WS_CTL, 0, CTL_ZERO_BYTES, stream) != hipSuccess) { fprintf(stderr, "kernel_launch: memset failed\n"); return; }
    Args a{};
    for (int i = 0; i < 25; ++i) a.in[i] = (const float*)d_in[i];
    a.out = (float*)d_out; a.ws = (unsigned char*)d_ws;
#if MK_PER_PHASE
    for (int p = 0; p < NPH; ++p) { a.ph_lo = p; a.ph_hi = p + 1; hipLaunchKernelGGL(hymba_fwd, dim3(256), dim3(NWAVES * 64), LDS_BYTES, stream, a); }
#else
    a.ph_lo = 0; a.ph_hi = NPH;
    void* kargs[] = {&a};
    hipError_t e = hipLaunchCooperativeKernel((const void*)hymba_fwd, dim3(256), dim3(NWAVES * 64), kargs, LDS_BYTES, stream);
    if (e != hipSuccess) fprintf(stderr, "kernel_launch: cooperative launch failed: %s\n", hipGetErrorString(e));
#endif
}
```

```cpp
#include <hip/hip_runtime.h>
#include <hip/hip_cooperative_groups.h>
#include <cstdio>
#include <cstdint>
namespace cg = cooperative_groups;
namespace pg8 {
#define PG8_LAS __attribute__((address_space(3)))
typedef unsigned short bf16_t;
typedef short bf16x8 __attribute__((ext_vector_type(8)));
typedef float f32x4 __attribute__((ext_vector_type(4)));
typedef unsigned u32x4 __attribute__((ext_vector_type(4)));
constexpr int BM = 256, BK = 64, HALF = 128, HTB = HALF * BK * 2  , STAGE_BYTES = 8 * HTB, NXCD = 8, WGM = 8;

__host__ __device__ __forceinline__ int lds_byte(int r, int c) { const int st = (r >> 4) * 2 + (c >> 5), rr = r & 15, cc = c & 31, ob = rr * 64 + cc * 2; return st * 1024 + (ob ^ (((ob >> 9) & 1) << 5)); }
__host__ __device__ __forceinline__ void stage_rc(int b, int& R, int& C) { const int st = b / 1024, sb = b % 1024, swz = sb ^ (((sb >> 9) & 1) << 5); R = (st >> 1) * 16 + swz / 64; C = (st & 1) * 32 + (swz % 64) / 2; }
__host__ __device__ __forceinline__ int perm32(int rho) { const int n = rho >> 4, i = rho & 15; return 8 * (i >> 2) + 4 * n + (i & 3); }

struct Unit { int pm, pn; };
struct Gemm { const bf16_t* A; const bf16_t* Bt; int M, N, K; };

struct StaticOrder {
    int nM, nN, nwg, G, c;
    __host__ __device__ void init(int M, int N, int G_, int c_) { nM = M / BM; nN = N / BM; nwg = nM * nN; G = G_; c = c_; }
    __host__ __device__ bool next(int i, Unit& u) const {
        const long L = (long)i * G + c; if (L >= nwg) return false;
        int wgid = (int)L; { const int q = nwg / NXCD, r = nwg % NXCD, xcd = wgid % NXCD, off = wgid / NXCD; wgid = (xcd < r ? xcd * (q + 1) : r * (q + 1) + (xcd - r) * q) + off; }
        const int nig = WGM * nN, gid = wgid / nig, fm = gid * WGM, gsz = (nM - fm) < WGM ? (nM - fm) : WGM;
        u.pm = fm + ((wgid % nig) % gsz); u.pn = (wgid % nig) / gsz; return true;
    }
    __device__ __forceinline__ void a_ready(const Unit&) const {}
    __device__ __forceinline__ void done(const Unit&) const {}
};

__device__ __forceinline__ unsigned cvt_pk_bf16(float lo, float hi) { unsigned r; asm volatile("v_cvt_pk_bf16_f32 %0, %1, %2" : "=v"(r) : "v"(lo), "v"(hi)); return r; }
typedef float f32x2 __attribute__((ext_vector_type(2)));
__device__ __forceinline__ f32x2 gelu_pk(f32x2 v) {
    const f32x2 av = __builtin_elementwise_abs(v), d = av * 0.2316418882f + 1.0f;
    f32x2 t; t.x = __builtin_amdgcn_rcpf(d.x); t.y = __builtin_amdgcn_rcpf(d.y);
    f32x2 q = t * 0.5307027145f + (-0.7265760135f); q = q * t + 0.7107068705f; q = q * t + (-0.142248368f); q = q * t + 0.127414796f; q = q * t;
    const f32x2 s = (v * v) * (-0.72134752044f);
    f32x2 e; e.x = __builtin_amdgcn_exp2f(s.x); e.y = __builtin_amdgcn_exp2f(s.y);
    const f32x2 m = v * (q * e), r = v - m;
    f32x2 o; o.x = v.x < 0.f ? m.x : r.x; o.y = v.y < 0.f ? m.y : r.y; return o;
}

__device__ __forceinline__ float bflo(unsigned w) { return __uint_as_float(w << 16); }
__device__ __forceinline__ float bfhi(unsigned w) { return __uint_as_float(w & 0xffff0000u); }
__device__ __forceinline__ float fast_sigmoid(float v) { return __builtin_amdgcn_rcpf(1.0f + __builtin_amdgcn_exp2f(-1.4426950408889634f * v)); }
struct EpiProj {
    static constexpr bool PERM = true, AFTER_DRAIN = false;
    bf16_t* O; bf16_t* UT; const float* cosT; const float* sinT; float qscale;
    __device__ __forceinline__ void operator()(const f32x4 (&acc)[2][2][4][2], const Unit& u, int wr, int wc, int fr, int fq) const {
        const int row0 = u.pm * BM + wr * 64 + fr; const int col0 = u.pn * BM + wc * 32 + 8 * fq;
        const int sect = u.pn >> 2;
        const int j0 = 4 * (4 * wc + fq);
        const float sc = (sect == 1) ? qscale : 1.f;
#pragma unroll
        for (int ai = 0; ai < 2; ++ai)
#pragma unroll
            for (int m = 0; m < 4; ++m) { const int row = row0 + ai * HALF + m * 16; bf16_t* rowp = O + (size_t)row * 4096 + col0;
                f32x4 cs = (f32x4){1.f, 1.f, 1.f, 1.f}, sn = (f32x4){0.f, 0.f, 0.f, 0.f};
                if (sect == 1 || sect == 2) { cs = *(const f32x4*)(cosT + (size_t)row * 64 + j0); sn = *(const f32x4*)(sinT + (size_t)row * 64 + j0); }
#pragma unroll
                for (int bj = 0; bj < 2; ++bj) { const f32x4 t1 = acc[ai][bj][m][0], t2 = acc[ai][bj][m][1];
                    f32x4 v0 = (t1 * cs - t2 * sn) * sc, v1 = (t1 * sn + t2 * cs) * sc;
                    u32x4 w; w.x = cvt_pk_bf16(v0[0], v0[1]); w.y = cvt_pk_bf16(v0[2], v0[3]); w.z = cvt_pk_bf16(v1[0], v1[1]); w.w = cvt_pk_bf16(v1[2], v1[3]);
                    if (sect == 0) { const int col = col0 + bj * HALF; *(u32x4*)(UT + ((size_t)((row >> 11) * 64 + (col >> 4)) * 2048 + (row & 2047)) * 16 + (col & 15)) = w; }
                    else *(u32x4*)(rowp + bj * HALF) = w; } }
    }
};
struct EpiGlu {
    static constexpr bool PERM = true, AFTER_DRAIN = false;
    bf16_t* O; const bf16_t* VG; const float* bias;
    __device__ __forceinline__ void operator()(const f32x4 (&acc)[2][2][4][2], const Unit& u, int wr, int wc, int fr, int fq) const {
        const int row0 = u.pm * BM + wr * 64 + fr; const int col0 = u.pn * BM + wc * 32 + 8 * fq;
        f32x4 bv[2][2];
#pragma unroll
        for (int bj = 0; bj < 2; ++bj)
#pragma unroll
            for (int n = 0; n < 2; ++n) bv[bj][n] = *(const f32x4*)(bias + col0 + bj * HALF + 4 * n);
#pragma unroll
        for (int ai = 0; ai < 2; ++ai)
#pragma unroll
            for (int m = 0; m < 4; ++m) { const int row = row0 + ai * HALF + m * 16;
#pragma unroll
                for (int bj = 0; bj < 2; ++bj) { const u32x4 g = *(const u32x4*)(VG + (size_t)row * 1024 + col0 + bj * HALF);
                    const f32x4 a0 = acc[ai][bj][m][0] + bv[bj][0], a1 = acc[ai][bj][m][1] + bv[bj][1];
                    u32x4 w; w.x = cvt_pk_bf16(bflo(g.x) * fast_sigmoid(a0[0]), bfhi(g.x) * fast_sigmoid(a0[1])); w.y = cvt_pk_bf16(bflo(g.y) * fast_sigmoid(a0[2]), bfhi(g.y) * fast_sigmoid(a0[3]));
                    w.z = cvt_pk_bf16(bflo(g.z) * fast_sigmoid(a1[0]), bfhi(g.z) * fast_sigmoid(a1[1])); w.w = cvt_pk_bf16(bflo(g.w) * fast_sigmoid(a1[2]), bfhi(g.w) * fast_sigmoid(a1[3]));
                    *(u32x4*)(O + (size_t)row * 2048 + col0 + bj * HALF) = w; } }
    }
};
struct EpiResid {
    static constexpr bool PERM = false, AFTER_DRAIN = false;
    const float* base; float* out; const float* gate;
    __device__ __forceinline__ void operator()(const f32x4 (&acc)[2][2][4][2], const Unit& u, int wr, int wc, int fr, int fq) const {
        const int col0 = u.pn * BM + wc * 32 + 4 * fq; const int b = u.pm >> 3;
        f32x4 gv[2][2];
#pragma unroll
        for (int bj = 0; bj < 2; ++bj)
#pragma unroll
            for (int n = 0; n < 2; ++n) gv[bj][n] = *(const f32x4*)(gate + (size_t)b * 12288 + col0 + bj * HALF + n * 16);
#pragma unroll
        for (int ai = 0; ai < 2; ++ai)
#pragma unroll
            for (int m = 0; m < 4; ++m) { const size_t off = (size_t)(u.pm * BM + ai * HALF + wr * 64 + m * 16 + fr) * 2048 + col0;
#pragma unroll
                for (int bj = 0; bj < 2; ++bj)
#pragma unroll
                    for (int n = 0; n < 2; ++n) { const f32x4 bs = *(const f32x4*)(base + off + bj * HALF + n * 16);
                        *(f32x4*)(out + off + bj * HALF + n * 16) = bs + gv[bj][n] * acc[ai][bj][m][n]; } }
    }
};
template <int MODE> struct EpiNormX {
    static constexpr bool PERM = true, AFTER_DRAIN = true;
    const float* base; float* xout; bf16_t* hout; const float* gate; const float* gvec; const float* scv; const float* shv; float* slots; unsigned* cnt; bf16_t* xb;
    __device__ __forceinline__ void fused(f32x4 (&acc)[2][2][4][2], const Unit& u, int wr, int wc, int fr, int fq, PG8_LAS unsigned char* lds, int wid, int lane) const {
        PG8_LAS float* P = (PG8_LAS float*)lds; PG8_LAS float* S = (PG8_LAS float*)(lds + 8192); PG8_LAS unsigned* flag = (PG8_LAS unsigned*)(lds + 8192 + 2048);
        const int col0 = u.pn * BM + wc * 32 + 8 * fq; const int b = u.pm >> 3; const int tid = wid * 64 + lane;
        { f32x4 gv[2][2];
#pragma unroll
          for (int bj = 0; bj < 2; ++bj)
#pragma unroll
              for (int n = 0; n < 2; ++n) gv[bj][n] = *(const f32x4*)(gate + (size_t)b * 12288 + col0 + bj * HALF + 4 * n);
#pragma unroll
          for (int ai = 0; ai < 2; ++ai)
#pragma unroll
              for (int m = 0; m < 4; ++m) { const int r = ai * HALF + wr * 64 + m * 16 + fr; const size_t off = (size_t)(u.pm * BM + r) * 2048 + col0; float sq = 0.f;
#pragma unroll
                  for (int bj = 0; bj < 2; ++bj) { u32x4 xw; if (MODE == 1) xw = __builtin_nontemporal_load((const u32x4*)(xb + off + bj * HALF));
#pragma unroll
                      for (int n = 0; n < 2; ++n) { f32x4 bs;
                          if (MODE == 1) { const unsigned w0 = n ? xw.z : xw.x, w1 = n ? xw.w : xw.y; bs = (f32x4){bflo(w0), bfhi(w0), bflo(w1), bfhi(w1)}; }
                          else bs = __builtin_nontemporal_load((const f32x4*)(base + off + bj * HALF + 4 * n));
                          const f32x4 v = bs + gv[bj][n] * acc[ai][bj][m][n]; acc[ai][bj][m][n] = v;
                          sq += (v[0] * v[0] + v[1] * v[1]) + (v[2] * v[2] + v[3] * v[3]); } }
                  sq += __shfl_xor(sq, 16); sq += __shfl_xor(sq, 32);
                  if (fq == 0) P[r * 4 + wc] = sq;
                  if (m & 1) asm volatile("" ::: "memory"); } }
        asm volatile("s_waitcnt lgkmcnt(0)" ::: "memory"); __builtin_amdgcn_s_barrier(); asm volatile("" ::: "memory");
        if (tid < 256) { const float tot = (P[tid * 4 + 0] + P[tid * 4 + 1]) + (P[tid * 4 + 2] + P[tid * 4 + 3]);
            unsigned* sl = (unsigned*)slots + ((size_t)(u.pm * 8 + u.pn) * 256 + tid);
            __hip_atomic_store(sl, __float_as_uint(tot), __ATOMIC_RELAXED, __HIP_MEMORY_SCOPE_AGENT);
            asm volatile("s_waitcnt vmcnt(0)" ::: "memory");
            const unsigned rb = __hip_atomic_load(sl, __ATOMIC_RELAXED, __HIP_MEMORY_SCOPE_AGENT);
            asm volatile("s_waitcnt vmcnt(0)" :: "v"(rb) : "memory"); }
        asm volatile("s_waitcnt vmcnt(0)" ::: "memory");
        if (wid < 4 && lane == 0) __hip_atomic_fetch_add(cnt + 64 * u.pm, 1u, __ATOMIC_RELAXED, __HIP_MEMORY_SCOPE_AGENT);
        if (wid == 0) { unsigned sp = 0u;
            while ((unsigned)__builtin_amdgcn_readfirstlane((int)__hip_atomic_load(cnt + 64 * u.pm, __ATOMIC_RELAXED, __HIP_MEMORY_SCOPE_AGENT)) < 32u) { __builtin_amdgcn_s_sleep(2); if (++sp > (1u << 22)) break; }
            if (lane == 0) flag[0] = sp; }
        asm volatile("s_waitcnt vmcnt(0) lgkmcnt(0)" ::: "memory"); __builtin_amdgcn_s_barrier(); asm volatile("" ::: "memory");
        if (tid < 256) { float tot = 0.f;
#pragma unroll
            for (int t = 0; t < 8; ++t) tot += __uint_as_float(__hip_atomic_load((unsigned*)slots + ((size_t)(u.pm * 8 + t) * 256 + tid), __ATOMIC_RELAXED, __HIP_MEMORY_SCOPE_AGENT));
            S[tid] = 1.0f / sqrtf(tot * (1.0f / 2048.0f) + 1e-6f); }
        asm volatile("s_waitcnt vmcnt(0) lgkmcnt(0)" ::: "memory"); __builtin_amdgcn_s_barrier(); asm volatile("" ::: "memory");
        f32x4 ga[2][2], sh[2][2];
#pragma unroll
        for (int bj = 0; bj < 2; ++bj)
#pragma unroll
            for (int n = 0; n < 2; ++n) { const int c = col0 + bj * HALF + 4 * n; ga[bj][n] = *(const f32x4*)(gvec + c);
                if (MODE == 0) { ga[bj][n] = ga[bj][n] * (*(const f32x4*)(scv + (size_t)b * 12288 + c) + 1.0f); sh[bj][n] = *(const f32x4*)(shv + (size_t)b * 12288 + c); } }
#pragma unroll
        for (int ai = 0; ai < 2; ++ai)
#pragma unroll
            for (int m = 0; m < 4; ++m) { const int r = ai * HALF + wr * 64 + m * 16 + fr; const size_t off = (size_t)(u.pm * BM + r) * 2048 + col0; const float rstd = S[r];
#pragma unroll
                for (int bj = 0; bj < 2; ++bj) { const f32x4 v0 = acc[ai][bj][m][0], v1 = acc[ai][bj][m][1];
                    if (MODE == 0) { { u32x4 xw; xw.x = cvt_pk_bf16(v0[0], v0[1]); xw.y = cvt_pk_bf16(v0[2], v0[3]); xw.z = cvt_pk_bf16(v1[0], v1[1]); xw.w = cvt_pk_bf16(v1[2], v1[3]); *(u32x4*)(xb + off + bj * HALF) = xw; }
                        const f32x4 h0 = v0 * rstd * ga[bj][0] + sh[bj][0], h1 = v1 * rstd * ga[bj][1] + sh[bj][1];
                        u32x4 w; w.x = cvt_pk_bf16(h0[0], h0[1]); w.y = cvt_pk_bf16(h0[2], h0[3]); w.z = cvt_pk_bf16(h1[0], h1[1]); w.w = cvt_pk_bf16(h1[2], h1[3]);
                        *(u32x4*)(hout + off + bj * HALF) = w; }
                    else { *(f32x4*)(xout + off + bj * HALF) = v0 * rstd * ga[bj][0]; *(f32x4*)(xout + off + bj * HALF + 4) = v1 * rstd * ga[bj][1]; } }
                asm volatile("" ::: "memory"); }
    }
};
struct EpiGluNorm {
    static constexpr bool PERM = true, AFTER_DRAIN = true;
    bf16_t* O; const bf16_t* VG; const float* bias; float* slots; unsigned* cnt;
    __device__ __forceinline__ void fused(f32x4 (&acc)[2][2][4][2], const Unit& u, int wr, int wc, int fr, int fq, PG8_LAS unsigned char* lds, int wid, int lane) const {
        PG8_LAS float* P = (PG8_LAS float*)lds; PG8_LAS float* S = (PG8_LAS float*)(lds + 8192); PG8_LAS unsigned* flag = (PG8_LAS unsigned*)(lds + 8192 + 2048);
        const int col0 = u.pn * BM + wc * 32 + 8 * fq; const int tid = wid * 64 + lane;
        { f32x4 bv[2][2];
#pragma unroll
          for (int bj = 0; bj < 2; ++bj)
#pragma unroll
              for (int n = 0; n < 2; ++n) bv[bj][n] = *(const f32x4*)(bias + col0 + bj * HALF + 4 * n);
#pragma unroll
          for (int ai = 0; ai < 2; ++ai)
#pragma unroll
              for (int m = 0; m < 4; ++m) { const int r = ai * HALF + wr * 64 + m * 16 + fr; const size_t row = (size_t)(u.pm * BM + r); float sq = 0.f;
#pragma unroll
                  for (int bj = 0; bj < 2; ++bj) { const u32x4 g = *(const u32x4*)(VG + row * 1024 + col0 + bj * HALF);
                      const f32x4 a0 = acc[ai][bj][m][0] + bv[bj][0], a1 = acc[ai][bj][m][1] + bv[bj][1];
                      const f32x4 v0 = {bflo(g.x) * fast_sigmoid(a0[0]), bfhi(g.x) * fast_sigmoid(a0[1]), bflo(g.y) * fast_sigmoid(a0[2]), bfhi(g.y) * fast_sigmoid(a0[3])};
                      const f32x4 v1 = {bflo(g.z) * fast_sigmoid(a1[0]), bfhi(g.z) * fast_sigmoid(a1[1]), bflo(g.w) * fast_sigmoid(a1[2]), bfhi(g.w) * fast_sigmoid(a1[3])};
                      acc[ai][bj][m][0] = v0; acc[ai][bj][m][1] = v1;
                      sq += ((v0[0] * v0[0] + v0[1] * v0[1]) + (v0[2] * v0[2] + v0[3] * v0[3])) + ((v1[0] * v1[0] + v1[1] * v1[1]) + (v1[2] * v1[2] + v1[3] * v1[3])); }
                  sq += __shfl_xor(sq, 16); sq += __shfl_xor(sq, 32);
                  if (fq == 0) P[r * 4 + wc] = sq;
                  if (m & 1) asm volatile("" ::: "memory"); } }
        asm volatile("s_waitcnt lgkmcnt(0)" ::: "memory"); __builtin_amdgcn_s_barrier(); asm volatile("" ::: "memory");
        if (tid < 256) { const float tot = (P[tid * 4 + 0] + P[tid * 4 + 1]) + (P[tid * 4 + 2] + P[tid * 4 + 3]);
            unsigned* sl = (unsigned*)slots + ((size_t)(u.pm * 4 + u.pn) * 256 + tid);
            __hip_atomic_store(sl, __float_as_uint(tot), __ATOMIC_RELAXED, __HIP_MEMORY_SCOPE_AGENT);
            asm volatile("s_waitcnt vmcnt(0)" ::: "memory");
            const unsigned rb = __hip_atomic_load(sl, __ATOMIC_RELAXED, __HIP_MEMORY_SCOPE_AGENT);
            asm volatile("s_waitcnt vmcnt(0)" :: "v"(rb) : "memory"); }
        asm volatile("s_waitcnt vmcnt(0)" ::: "memory");
        if (wid < 4 && lane == 0) __hip_atomic_fetch_add(cnt + 64 * u.pm, 1u, __ATOMIC_RELAXED, __HIP_MEMORY_SCOPE_AGENT);
        if (wid == 0) { unsigned sp = 0u;
            while ((unsigned)__builtin_amdgcn_readfirstlane((int)__hip_atomic_load(cnt + 64 * u.pm, __ATOMIC_RELAXED, __HIP_MEMORY_SCOPE_AGENT)) < 16u) { __builtin_amdgcn_s_sleep(2); if (++sp > (1u << 22)) break; }
            __builtin_amdgcn_fence(__ATOMIC_ACQUIRE, "agent");
            if (lane == 0) flag[0] = sp; }
        asm volatile("s_waitcnt vmcnt(0) lgkmcnt(0)" ::: "memory"); __builtin_amdgcn_s_barrier(); asm volatile("" ::: "memory");
        if (tid < 256) { float tot = 0.f;
#pragma unroll
            for (int t = 0; t < 4; ++t) tot += __uint_as_float(__hip_atomic_load((unsigned*)slots + ((size_t)(u.pm * 4 + t) * 256 + tid), __ATOMIC_RELAXED, __HIP_MEMORY_SCOPE_AGENT));
            S[tid] = 1.0f / sqrtf(tot * (1.0f / 1024.0f) + 1e-6f); }
        asm volatile("s_waitcnt vmcnt(0) lgkmcnt(0)" ::: "memory"); __builtin_amdgcn_s_barrier(); asm volatile("" ::: "memory");
#pragma unroll
        for (int ai = 0; ai < 2; ++ai)
#pragma unroll
            for (int m = 0; m < 4; ++m) { const int r = ai * HALF + wr * 64 + m * 16 + fr; const size_t row = (size_t)(u.pm * BM + r); const float rstd = S[r];
#pragma unroll
                for (int bj = 0; bj < 2; ++bj) { const f32x4 v0 = acc[ai][bj][m][0] * rstd, v1 = acc[ai][bj][m][1] * rstd;
                    u32x4 w; w.x = cvt_pk_bf16(v0[0], v0[1]); w.y = cvt_pk_bf16(v0[2], v0[3]); w.z = cvt_pk_bf16(v1[0], v1[1]); w.w = cvt_pk_bf16(v1[2], v1[3]);
                    *(u32x4*)(O + row * 2048 + col0 + bj * HALF) = w; } }
    }
};
struct EpiSwiglu {
    static constexpr bool PERM = true, AFTER_DRAIN = false;
    bf16_t* O;
    __device__ __forceinline__ void operator()(const f32x4 (&acc)[2][2][4][2], const Unit& u, int wr, int wc, int fr, int fq) const {
        const int row0 = u.pm * BM + wr * 64 + fr; const int col0 = u.pn * HALF + wc * 32 + 8 * fq;
#pragma unroll
        for (int ai = 0; ai < 2; ++ai)
#pragma unroll
            for (int m = 0; m < 4; ++m) { const int row = row0 + ai * HALF + m * 16;
                const f32x4 g0 = acc[ai][0][m][0], g1 = acc[ai][0][m][1], u0 = acc[ai][1][m][0], u1 = acc[ai][1][m][1];
                f32x4 v0, v1;
#pragma unroll
                for (int i = 0; i < 4; ++i) { v0[i] = g0[i] * fast_sigmoid(g0[i]) * u0[i]; v1[i] = g1[i] * fast_sigmoid(g1[i]) * u1[i]; }
                u32x4 w; w.x = cvt_pk_bf16(v0[0], v0[1]); w.y = cvt_pk_bf16(v0[2], v0[3]); w.z = cvt_pk_bf16(v1[0], v1[1]); w.w = cvt_pk_bf16(v1[2], v1[3]);
                *(u32x4*)(O + (size_t)row * 5632 + col0) = w; }
    }
};

template <class Epi, class Sched, bool ALIGN_EPI = false, bool SP2 = false>
__device__ __forceinline__ void gemm_phase(PG8_LAS unsigned char* lds, const Gemm g, const Sched& S, const Epi& E) {
    const int tid = threadIdx.x, wid = __builtin_amdgcn_readfirstlane(tid >> 6), lane = tid & 63, wr = wid >> 2, wc = wid & 3, fr = lane & 15, fq = lane >> 4;
    const int K = g.K, nt = K / BK;
    unsigned voffA[2], voffB[2];
#pragma unroll
    for (int i = 0; i < 2; ++i) { int R, C; stage_rc(tid * 16 + i * 8192, R, C); const int Rb = Epi::PERM ? ((R & ~31) + perm32(R & 31)) : R;
        voffA[i] = (unsigned)(R * K + C) * 2u; voffB[i] = (unsigned)(Rb * K + C) * 2u; }
    const size_t kstep = (size_t)(BK * 2);
    const size_t hstep = (size_t)HALF * K * 2;
    const size_t tstep = 2 * hstep;
    const unsigned ldsw = (unsigned)wid * 1024u;
    const int aoff = lds_byte(wr * 64 + fr, fq * 8), boff = lds_byte(wc * 32 + fr, fq * 8);
#define PG8_SA(b, h) (((b) * 2 + (h)) * HTB)
#define PG8_SB(b, h) ((4 + (b) * 2 + (h)) * HTB)
#define PG8_STAGE(bufoff, gbase, voff) do { _Pragma("unroll") for (int _i = 0; _i < 2; ++_i) \
        __builtin_amdgcn_global_load_lds((const unsigned*)((const char*)(gbase) + (voff)[_i]), (PG8_LAS unsigned*)(lds + (bufoff) + ldsw + _i * 8192), 16, 0, 0); } while (0)
#define PG8_LDA(dst, b, h) do { _Pragma("unroll") for (int m = 0; m < 4; ++m) _Pragma("unroll") for (int k = 0; k < 2; ++k) dst[m][k] = *(const PG8_LAS bf16x8*)(lds + PG8_SA(b, h) + aoff + m * 2048 + k * 1024); } while (0)
#define PG8_LDB(dst, b, h) do { _Pragma("unroll") for (int n = 0; n < 2; ++n) _Pragma("unroll") for (int k = 0; k < 2; ++k) dst[n][k] = *(const PG8_LAS bf16x8*)(lds + PG8_SB(b, h) + boff + n * 2048 + k * 1024); } while (0)
#define PG8_MMA(ai, bj, At, Bt) do { __builtin_amdgcn_s_setprio(1); _Pragma("unroll") for (int m = 0; m < 4; ++m) _Pragma("unroll") for (int n = 0; n < 2; ++n) _Pragma("unroll") for (int k = 0; k < 2; ++k) \
        acc[ai][bj][m][n] = __builtin_amdgcn_mfma_f32_16x16x32_bf16(Bt[n][k], At[m][k], acc[ai][bj][m][n], 0, 0, 0); __builtin_amdgcn_s_setprio(0); } while (0)
#define PG8_WAIT_V(n) asm volatile("s_waitcnt vmcnt(" #n ")" ::: "memory")
#define PG8_WAIT_L(n) asm volatile("s_waitcnt lgkmcnt(" #n ")" ::: "memory")
#define PG8_BAR __builtin_amdgcn_s_barrier()
#define PG8_SCHED __builtin_amdgcn_sched_barrier(0)
    Unit cur, nxt; int ui = 0;
    if (!S.next(0, cur)) return;
    f32x4 acc[2][2][4][2];
#pragma unroll
    for (int a = 0; a < 2; ++a)
#pragma unroll
        for (int b = 0; b < 2; ++b)
#pragma unroll
            for (int m = 0; m < 4; ++m)
#pragma unroll
                for (int n = 0; n < 2; ++n) acc[a][b][m][n] = (f32x4){0.f, 0.f, 0.f, 0.f};
    bf16x8 At[4][2], B0[2][2], B1[2][2];
    const char* cA = (const char*)g.A + (size_t)cur.pm * tstep; const char* cB = (const char*)g.Bt + (size_t)cur.pn * tstep;
    S.a_ready(cur);
    if constexpr (SP2) {
        PG8_STAGE(PG8_SB(0, 0), cB, voffB); PG8_STAGE(PG8_SB(0, 1), cB + hstep, voffB); PG8_STAGE(PG8_SA(0, 0), cA, voffA); PG8_STAGE(PG8_SA(0, 1), cA + hstep, voffA);
        if (wr == 1) PG8_BAR;
        PG8_WAIT_V(2); PG8_BAR;
        PG8_STAGE(PG8_SB(1, 0), cB + kstep, voffB); PG8_STAGE(PG8_SA(1, 0), cA + kstep, voffA); PG8_STAGE(PG8_SB(1, 1), cB + hstep + kstep, voffB);
        PG8_WAIT_V(6); PG8_BAR;
    } else {
        PG8_STAGE(PG8_SB(0, 0), cB, voffB); PG8_STAGE(PG8_SA(0, 0), cA, voffA); PG8_STAGE(PG8_SB(0, 1), cB + hstep, voffB); PG8_STAGE(PG8_SA(0, 1), cA + hstep, voffA);
        if (wr == 1) PG8_BAR;
        PG8_WAIT_V(4); PG8_BAR;
        PG8_STAGE(PG8_SB(1, 0), cB + kstep, voffB); PG8_STAGE(PG8_SA(1, 0), cA + kstep, voffA); PG8_STAGE(PG8_SB(1, 1), cB + hstep + kstep, voffB);
        PG8_WAIT_V(6); PG8_BAR;
    }
    for (;;) {
        const bool has_next = S.next(ui + 1, nxt);
        const char* nA = has_next ? (const char*)g.A + (size_t)nxt.pm * tstep : cA; const char* nB = has_next ? (const char*)g.Bt + (size_t)nxt.pn * tstep : cB;
        for (int t = 0; t < nt; t += 2) {
            const bool last = (t == nt - 2);
            const char* a1 = cA + (size_t)(t + 1) * kstep;
            const char* a2 = last ? nA : cA + (size_t)(t + 2) * kstep; const char* b2 = last ? nB : cB + (size_t)(t + 2) * kstep;
            const char* a3 = a2 + kstep; const char* b3 = b2 + kstep;
            if (last && has_next) S.a_ready(nxt);
            if constexpr (SP2) {
            PG8_LDB(B0, 0, 0); PG8_LDB(B1, 0, 1); PG8_SCHED; PG8_LDA(At, 0, 0); PG8_STAGE(PG8_SA(1, 1), a1 + hstep, voffA);
            PG8_WAIT_V(8); PG8_WAIT_L(0); PG8_BAR; PG8_MMA(0, 0, At, B0); PG8_MMA(0, 1, At, B1); PG8_BAR; PG8_SCHED;
            PG8_LDA(At, 0, 1); PG8_STAGE(PG8_SB(0, 0), b2, voffB); PG8_STAGE(PG8_SB(0, 1), b2 + hstep, voffB); PG8_STAGE(PG8_SA(0, 0), a2, voffA);
            PG8_WAIT_V(8); PG8_WAIT_L(0); PG8_BAR; PG8_MMA(1, 0, At, B0); PG8_MMA(1, 1, At, B1); PG8_BAR; PG8_SCHED;
            PG8_LDB(B0, 1, 0); PG8_LDB(B1, 1, 1); PG8_SCHED; PG8_LDA(At, 1, 0); PG8_STAGE(PG8_SA(0, 1), a2 + hstep, voffA);
            PG8_WAIT_V(8); PG8_WAIT_L(0); PG8_BAR; PG8_MMA(0, 0, At, B0); PG8_MMA(0, 1, At, B1); PG8_BAR; PG8_SCHED;
            PG8_LDA(At, 1, 1); PG8_STAGE(PG8_SB(1, 0), b3, voffB); PG8_STAGE(PG8_SB(1, 1), b3 + hstep, voffB); PG8_STAGE(PG8_SA(1, 0), a3, voffA);
            PG8_WAIT_V(8); PG8_WAIT_L(0); PG8_BAR; PG8_MMA(1, 0, At, B0); PG8_MMA(1, 1, At, B1); PG8_BAR; PG8_SCHED;
            } else {
            PG8_LDB(B0, 0, 0); PG8_SCHED; PG8_LDA(At, 0, 0); PG8_STAGE(PG8_SA(1, 1), a1 + hstep, voffA);
            PG8_WAIT_L(8); PG8_BAR; PG8_WAIT_L(0); PG8_MMA(0, 0, At, B0); PG8_BAR; PG8_SCHED;
            PG8_LDB(B1, 0, 1); PG8_STAGE(PG8_SB(0, 0), b2, voffB);
            PG8_BAR; PG8_WAIT_L(0); PG8_MMA(0, 1, At, B1); PG8_BAR;
            PG8_LDA(At, 0, 1); PG8_STAGE(PG8_SA(0, 0), a2, voffA);
            PG8_BAR; PG8_WAIT_L(0); PG8_MMA(1, 0, At, B0); PG8_BAR; PG8_SCHED;
            PG8_STAGE(PG8_SB(0, 1), b2 + hstep, voffB);
            PG8_WAIT_V(6); PG8_BAR; PG8_MMA(1, 1, At, B1); PG8_BAR;
            PG8_LDB(B0, 1, 0); PG8_SCHED; PG8_LDA(At, 1, 0); PG8_STAGE(PG8_SA(0, 1), a2 + hstep, voffA);
            PG8_WAIT_L(8); PG8_BAR; PG8_WAIT_L(0); PG8_MMA(0, 0, At, B0); PG8_BAR; PG8_SCHED;
            PG8_LDB(B1, 1, 1); PG8_STAGE(PG8_SB(1, 0), b3, voffB);
            PG8_BAR; PG8_WAIT_L(0); PG8_MMA(0, 1, At, B1); PG8_BAR;
            PG8_LDA(At, 1, 1); PG8_STAGE(PG8_SA(1, 0), a3, voffA);
            PG8_BAR; PG8_WAIT_L(0); PG8_MMA(1, 0, At, B0); PG8_BAR; PG8_SCHED;
            PG8_STAGE(PG8_SB(1, 1), b3 + hstep, voffB);
            PG8_WAIT_V(6); PG8_BAR; PG8_MMA(1, 1, At, B1); PG8_BAR;
            }
        }
        if constexpr (ALIGN_EPI) { if (wr == 0) PG8_BAR; }
        if constexpr (!Epi::AFTER_DRAIN) { E(acc, cur, wr, wc, fr, fq); S.done(cur); }
        if (!has_next) break;
#pragma unroll
        for (int a = 0; a < 2; ++a)
#pragma unroll
            for (int b = 0; b < 2; ++b)
#pragma unroll
                for (int m = 0; m < 4; ++m)
#pragma unroll
                    for (int n = 0; n < 2; ++n) acc[a][b][m][n] = (f32x4){0.f, 0.f, 0.f, 0.f};
        cur = nxt; cA = nA; cB = nB; ++ui;
        if constexpr (ALIGN_EPI) { if (wr == 1) PG8_BAR; }
    }
    PG8_WAIT_V(0);
    if constexpr (!ALIGN_EPI) { if (wr == 0) PG8_BAR; }
    PG8_BAR;
    if constexpr (Epi::AFTER_DRAIN) { E.fused(acc, cur, wr, wc, fr, fq, lds, wid, lane); S.done(cur); }
#undef PG8_SA
#undef PG8_SB
#undef PG8_STAGE
#undef PG8_LDA
#undef PG8_LDB
#undef PG8_MMA
#undef PG8_WAIT_V
#undef PG8_WAIT_L
#undef PG8_BAR
#undef PG8_SCHED
}
}

constexpr int NWAVES = 8;
constexpr int BATCH = 4, SEQ = 2048, DM = 2048, MTOK = BATCH * SEQ, SSMW = 1024, ATTW = 1024, NGRP = 64, NST = 64, NHEAD = 8, HDIM = 128, DFF = 5632, PROJW = 4096, NMODW = 6 * DM;
constexpr int KSPLIT = 32;
constexpr size_t MiB = 1u << 20;
constexpr size_t WS_MODP = 2 * MiB, WS_MODF = 8 * MiB, WS_ROPE = 9 * MiB, WS_KTAB = 13 * MiB, WS_GTAB = 16 * MiB, WS_HTAB = 32 * MiB, WS_A64 = 48 * MiB;
constexpr size_t WS_WIN = 49 * MiB, WS_WGLU = 65 * MiB, WS_WOUT = 67 * MiB, WS_WGU = 75 * MiB, WS_WDN = 119 * MiB, WS_H = 141 * MiB, WS_PROJ = 173 * MiB, WS_VG = 237 * MiB;
constexpr size_t WS_YCAT = 253 * MiB, WS_OBR = 285 * MiB, WS_LSE = 333 * MiB, WS_FF = 173 * MiB, WS_UT = 334 * MiB, WS_END = 350 * MiB;
static_assert(WS_FF + (size_t)MTOK * DFF * 2 <= WS_OBR, "ff overlay");
constexpr int LDS_BYTES = 147456, MISC_OFF = 147456 - 256;
constexpr size_t WS_CTL = 0, CTL_ZERO_BYTES = 57344, WS_CNT = 16384, WS_PCNT = 32768, WS_GCNT = 49152  , WS_SLOTS = 1u << 20;

#define GAS __attribute__((address_space(1)))
#define LAS __attribute__((address_space(3)))
typedef unsigned short bf16;
typedef unsigned v4u __attribute__((ext_vector_type(4)));
typedef unsigned v2u __attribute__((ext_vector_type(2)));
typedef float f32x4 __attribute__((ext_vector_type(4)));
typedef float f32x16 __attribute__((ext_vector_type(16)));
typedef short bf16x8 __attribute__((ext_vector_type(8)));
typedef short s16x4 __attribute__((ext_vector_type(4)));
#define LDS_WAIT() asm volatile("s_waitcnt lgkmcnt(0)" ::: "memory")
__device__ __forceinline__ unsigned f2bf(float f) { unsigned u = __builtin_bit_cast(unsigned, f); return (u + 0x7fffu + ((u >> 16) & 1u)) >> 16; }
__device__ __forceinline__ unsigned pk2(float lo, float hi) { return f2bf(lo) | (f2bf(hi) << 16); }
__device__ __forceinline__ float bf_lo(unsigned w) { return __uint_as_float(w << 16); }
__device__ __forceinline__ float bf_hi(unsigned w) { return __uint_as_float(w & 0xffff0000u); }
__device__ __forceinline__ float wave_sum(float v) {
#pragma unroll
    for (int o = 1; o < 64; o <<= 1) v += __shfl_xor(v, o);
    return v;
}

struct Args { const float* in[25]; float* out; unsigned char* ws; int ph_lo, ph_hi; };

template <int MODE>
__device__ __forceinline__ void p0_transpose_item(const float* __restrict__ W, int K, int N, bf16* WT, LAS float* scr, int item, int lane, const float* gs, const float* ga) {
    const int nblk = N / 64, kb = item / nblk, nb = item % nblk, k0 = 64 * kb, n0 = 64 * nb;
    const int lr = lane >> 4, lc = lane & 15;
    f32x4 v[16];
#pragma unroll
    for (int i = 0; i < 16; ++i) v[i] = __builtin_nontemporal_load((const f32x4*)(W + (size_t)(k0 + 4 * i + lr) * N + n0 + 4 * lc));
#pragma unroll
    for (int i = 0; i < 16; ++i) { const int kk = 4 * i + lr; f32x4 t = v[i];
        if (MODE == 4) { const int k = k0 + kk; t = t * ((k < SSMW) ? gs[k] : ga[k - SSMW]); }
        LAS float* d = scr + kk * 65 + 4 * lc; d[0] = t.x; d[1] = t.y; d[2] = t.z; d[3] = t.w; }
    LDS_WAIT(); asm volatile("" ::: "memory");
    const int c = lane & 7;
#pragma unroll
    for (int j = 0; j < 8; ++j) { const int n = (lane >> 3) + 8 * j; const LAS float* s = scr + (8 * c) * 65 + n;
        v4u o; o.x = pk2(s[0 * 65], s[1 * 65]); o.y = pk2(s[2 * 65], s[3 * 65]); o.z = pk2(s[4 * 65], s[5 * 65]); o.w = pk2(s[6 * 65], s[7 * 65]);
        int col = n0 + n, row = col;
        if (MODE == 1) { if (col >= 1024 && col < 3072) { const int e = col & 127, half = e >> 6, ep = e & 63; row = (col - e) + ((ep >> 2) << 3) + (half << 2) + (ep & 3); } }
        if (MODE == 2) row = (col >> 7) * 256 + (col & 127);
        if (MODE == 3) row = (col >> 7) * 256 + 128 + (col & 127);
        *(GAS v4u*)(WT + (size_t)row * K + k0 + 8 * c) = o; }
    LDS_WAIT(); asm volatile("" ::: "memory");
}
__device__ __forceinline__ void wt_readback(const unsigned long long* p0, const unsigned long long* p1) {
    const unsigned long long a = __hip_atomic_load(p0, __ATOMIC_RELAXED, __HIP_MEMORY_SCOPE_AGENT), b = __hip_atomic_load(p1, __ATOMIC_RELAXED, __HIP_MEMORY_SCOPE_AGENT);
    asm volatile("s_waitcnt vmcnt(0)" :: "v"(a), "v"(b) : "memory");
}
__device__ __forceinline__ void p0_gemv_item(const float* __restrict__ cvec, const float* __restrict__ wmod, float* modp, float* modf, const float* __restrict__ bmod, unsigned* cnt, LAS float* scr, int item, int lane) {
    const int ks = item / 48, cb = item % 48, k0 = ks * 64, col = cb * 256 + lane * 4;
#pragma unroll
    for (int b = 0; b < 4; ++b) { const float v = cvec[b * DM + k0 + lane]; scr[lane * 4 + b] = v / (1.0f + __expf(-v)); }
    LDS_WAIT(); asm volatile("" ::: "memory");
    f32x4 a0 = {0, 0, 0, 0}, a1 = a0, a2 = a0, a3 = a0;
#pragma unroll 16
    for (int k = 0; k < 64; ++k) { const f32x4 w = __builtin_nontemporal_load((const f32x4*)(wmod + (size_t)(k0 + k) * NMODW + col)); const f32x4 s = *(const LAS f32x4*)(scr + 4 * k);
        a0 += w * s[0]; a1 += w * s[1]; a2 += w * s[2]; a3 += w * s[3]; }
    unsigned long long* o = (unsigned long long*)(modp + (size_t)(ks * 4) * NMODW + col);
#define GV_ST(p, v) do { __hip_atomic_store((p), ((unsigned long long)__float_as_uint((v).y) << 32) | __float_as_uint((v).x), __ATOMIC_RELAXED, __HIP_MEMORY_SCOPE_AGENT); \
                         __hip_atomic_store((p) + 1, ((unsigned long long)__float_as_uint((v).w) << 32) | __float_as_uint((v).z), __ATOMIC_RELAXED, __HIP_MEMORY_SCOPE_AGENT); } while (0)
    GV_ST(o, a0); GV_ST(o + NMODW / 2, a1); GV_ST(o + NMODW, a2); GV_ST(o + 3 * (NMODW / 2), a3);
#undef GV_ST
    LDS_WAIT(); asm volatile("s_waitcnt vmcnt(0)" ::: "memory");
    wt_readback(o, o + 1); wt_readback(o + NMODW / 2, o + NMODW / 2 + 1); wt_readback(o + NMODW, o + NMODW + 1); wt_readback(o + 3 * (NMODW / 2), o + 3 * (NMODW / 2) + 1);
    if (lane == 0) __hip_atomic_fetch_add(cnt + 64 * cb, 1u, __ATOMIC_RELAXED, __HIP_MEMORY_SCOPE_AGENT);
}
__device__ __forceinline__ void p0_fin_item(const float* modp, float* modf, const float* __restrict__ bmod, unsigned* cnt, int item, int lane) {
    const int cb = item >> 2, b = item & 3, col = cb * 256 + lane * 4;
    { unsigned sp = 0u;
      while ((unsigned)__builtin_amdgcn_readfirstlane((int)__hip_atomic_load(cnt + 64 * cb, __ATOMIC_RELAXED, __HIP_MEMORY_SCOPE_AGENT)) < (unsigned)KSPLIT) { __builtin_amdgcn_s_sleep(2); if (++sp > (1u << 22)) break; }
      __builtin_amdgcn_fence(__ATOMIC_ACQUIRE, "agent"); }
    f32x4 t = *(const f32x4*)(bmod + col);
#pragma unroll 8
    for (int k2 = 0; k2 < KSPLIT; ++k2) { const unsigned long long* pp = (const unsigned long long*)(modp + (size_t)(k2 * 4 + b) * NMODW + col);
        const unsigned long long w0 = __hip_atomic_load(pp, __ATOMIC_RELAXED, __HIP_MEMORY_SCOPE_AGENT), w1 = __hip_atomic_load(pp + 1, __ATOMIC_RELAXED, __HIP_MEMORY_SCOPE_AGENT);
        t += (f32x4){__uint_as_float((unsigned)w0), __uint_as_float((unsigned)(w0 >> 32)), __uint_as_float((unsigned)w1), __uint_as_float((unsigned)(w1 >> 32))}; }
    unsigned long long* mo = (unsigned long long*)(modf + (size_t)b * NMODW + col);
    __hip_atomic_store(mo, ((unsigned long long)__float_as_uint(t.y) << 32) | __float_as_uint(t.x), __ATOMIC_RELAXED, __HIP_MEMORY_SCOPE_AGENT);
    __hip_atomic_store(mo + 1, ((unsigned long long)__float_as_uint(t.w) << 32) | __float_as_uint(t.z), __ATOMIC_RELAXED, __HIP_MEMORY_SCOPE_AGENT);
    asm volatile("s_waitcnt vmcnt(0)" ::: "memory");
    wt_readback(mo, mo + 1);
    if (lane == 0) __hip_atomic_fetch_add(cnt + 64 * 48, 1u, __ATOMIC_RELAXED, __HIP_MEMORY_SCOPE_AGENT);
}
__device__ __forceinline__ void p0_rope_item(const int* __restrict__ pos, float* cosT, float* sinT, int item, int lane) {
    const double inv = exp(-(double)lane * (9.210340371976184 / 64.0));
    const double rev = (double)pos[item] * inv * 0.15915494309189535;
    const float x = (float)((rev - rint(rev)) * 6.283185307179586);
    cosT[(size_t)item * 64 + lane] = cosf(x); sinT[(size_t)item * 64 + lane] = sinf(x);
}
struct SsmLane { double lr, li, dt, ar, ai; };
__device__ __forceinline__ SsmLane ssm_lane(const float* are, const float* aim, const float* ldt, int g, int p) {
    SsmLane L; L.dt = exp((double)ldt[g]); L.lr = (double)are[g * 64 + p]; L.li = (double)aim[g * 64 + p];
    const double m = exp(L.lr * L.dt); L.ar = m * cos(L.li * L.dt); L.ai = m * sin(L.li * L.dt); return L; }
__device__ __forceinline__ void ssm_pow(const SsmLane& L, int n, double& zr, double& zi) { const double m = exp(L.lr * L.dt * n), th = L.li * L.dt * n; zr = m * cos(th); zi = m * sin(th); }
__device__ __forceinline__ void ssm_step(const SsmLane& L, double& zr, double& zi) { const double nr = zr * L.ar - zi * L.ai, ni = zr * L.ai + zi * L.ar; zr = nr; zi = ni; }
__device__ __forceinline__ void ssm_bbar(const SsmLane& L, const float* bre, const float* bim, int g, int p, float (&br)[16], float (&bi)[16]) {
    const double nr = L.ar - 1.0, ni = L.ai, den = L.lr * L.lr + L.li * L.li;
    const float fr = (float)((nr * L.lr + ni * L.li) / den), fi = (float)((ni * L.lr - nr * L.li) / den);
    const f32x4* pr = (const f32x4*)(bre + (size_t)(g * 64 + p) * 16); const f32x4* pi = (const f32x4*)(bim + (size_t)(g * 64 + p) * 16);
#pragma unroll
    for (int q = 0; q < 4; ++q) { const f32x4 r = pr[q], i = pi[q];
#pragma unroll
        for (int e = 0; e < 4; ++e) { br[4 * q + e] = fr * r[e] - fi * i[e]; bi[4 * q + e] = fr * i[e] + fi * r[e]; } }
}
__device__ __forceinline__ void p0_ktab_item(const float* const* in, bf16* ktab, float* a64, LAS float* scr, int g, int ch, int lane) {
    const SsmLane L = ssm_lane(in[7], in[8], in[9], g, lane);
    float br[16], bi[16]; ssm_bbar(L, in[10], in[11], g, lane, br, bi);
    double zr, zi; ssm_pow(L, ch == 0 ? 0 : 8 * ch - 1, zr, zi);
    const int c = lane >> 2, q = lane & 3; const float* cr = in[12] + (size_t)(g * 16 + c) * 64; const float* ci = in[13] + (size_t)(g * 16 + c) * 64;
    for (int e = 0; e < 8; ++e) { const int ti = 8 * ch + e; if (ti > 64) break;
        if (ti == 0) { double wr, wi; ssm_pow(L, 64, wr, wi); a64[(g * 64 + lane) * 2] = (float)wr; a64[(g * 64 + lane) * 2 + 1] = (float)wi;
            *(GAS v2u*)(ktab + (size_t)(g * 65) * 256 + lane * 4) = (v2u){0u, 0u}; continue; }
        const float fzr = (float)zr, fzi = (float)zi;
#pragma unroll
        for (int k = 0; k < 16; ++k) { scr[lane * 16 + k] = fzr * br[k] - fzi * bi[k]; scr[1024 + lane * 16 + k] = fzr * bi[k] + fzi * br[k]; }
        LDS_WAIT(); asm volatile("" ::: "memory");
        f32x4 acc = {0, 0, 0, 0};
#pragma unroll 8
        for (int p = 0; p < 64; ++p) { const f32x4 wr = *(const LAS f32x4*)(scr + p * 16 + 4 * q), wi = *(const LAS f32x4*)(scr + 1024 + p * 16 + 4 * q); acc += wr * cr[p] - wi * ci[p]; }
        *(GAS v2u*)(ktab + ((size_t)(g * 65 + ti) * 16 + c) * 16 + 4 * q) = (v2u){pk2(acc[0], acc[1]), pk2(acc[2], acc[3])};
        LDS_WAIT(); asm volatile("" ::: "memory");
        ssm_step(L, zr, zi); }
}
__device__ __forceinline__ void p0_gtab_item(const float* const* in, bf16* gtab, int g, int ch, int lane) {
    const SsmLane L = ssm_lane(in[7], in[8], in[9], g, lane); double dzr, dzi; ssm_pow(L, 8 * ch + 1, dzr, dzi);
    const int p = lane;
    float cr[16], ci[16];
#pragma unroll
    for (int c = 0; c < 16; ++c) { cr[c] = in[12][(size_t)(g * 16 + c) * 64 + p]; ci[c] = in[13][(size_t)(g * 16 + c) * 64 + p]; }
    for (int e = 0; e < 8; ++e) { const int t = 8 * ch + e; const float zr = (float)dzr, zi = (float)dzi;
        const size_t base = ((size_t)(g * 32 + (t >> 1)) * 8) * 512;
#pragma unroll
        for (int c = 0; c < 16; ++c) { const float gre = cr[c] * zr - ci[c] * zi, gni = -(cr[c] * zi + ci[c] * zr);
            { const int pp = p;      gtab[base + (size_t)(pp >> 4) * 512 + ((16 * (t & 1) + c) + 32 * ((pp >> 3) & 1)) * 8 + (pp & 7)] = (bf16)f2bf(gre); }
            { const int pp = p + 64; gtab[base + (size_t)(pp >> 4) * 512 + ((16 * (t & 1) + c) + 32 * ((pp >> 3) & 1)) * 8 + (pp & 7)] = (bf16)f2bf(gni); } }
        ssm_step(L, dzr, dzi); }
}
__device__ __forceinline__ void p0_htab_item(const float* const* in, bf16* htab, int g, int ch, int lane) {
    const SsmLane L = ssm_lane(in[7], in[8], in[9], g, lane); double dzr, dzi; ssm_pow(L, 56 - 8 * ch, dzr, dzi);
    float br[16], bi[16]; ssm_bbar(L, in[10], in[11], g, lane, br, bi);
    for (int e = 7; e >= 0; --e) { const int s = 8 * ch + e; const float zr = (float)dzr, zi = (float)dzi;
#pragma unroll
        for (int hh = 0; hh < 2; ++hh) { v4u o, o2;
            o.x = pk2(zr * br[8 * hh] - zi * bi[8 * hh], zr * br[8 * hh + 1] - zi * bi[8 * hh + 1]); o.y = pk2(zr * br[8 * hh + 2] - zi * bi[8 * hh + 2], zr * br[8 * hh + 3] - zi * bi[8 * hh + 3]);
            o.z = pk2(zr * br[8 * hh + 4] - zi * bi[8 * hh + 4], zr * br[8 * hh + 5] - zi * bi[8 * hh + 5]); o.w = pk2(zr * br[8 * hh + 6] - zi * bi[8 * hh + 6], zr * br[8 * hh + 7] - zi * bi[8 * hh + 7]);
            o2.x = pk2(zr * bi[8 * hh] + zi * br[8 * hh], zr * bi[8 * hh + 1] + zi * br[8 * hh + 1]); o2.y = pk2(zr * bi[8 * hh + 2] + zi * br[8 * hh + 2], zr * bi[8 * hh + 3] + zi * br[8 * hh + 3]);
            o2.z = pk2(zr * bi[8 * hh + 4] + zi * br[8 * hh + 4], zr * bi[8 * hh + 5] + zi * br[8 * hh + 5]); o2.w = pk2(zr * bi[8 * hh + 6] + zi * br[8 * hh + 6], zr * bi[8 * hh + 7] + zi * br[8 * hh + 7]);
            { const int pp = lane;      *(GAS v4u*)(htab + ((((size_t)(g * 4 + (pp >> 5)) * 64 + s) * 64) + (pp & 31) + 32 * hh) * 8) = o; }
            { const int pp = lane + 64; *(GAS v4u*)(htab + ((((size_t)(g * 4 + (pp >> 5)) * 64 + s) * 64) + (pp & 31) + 32 * hh) * 8) = o2; } }
        ssm_step(L, dzr, dzi); }
}
#define XB_TMO      128
#define XB_XCNT(j)  (256  + 64 * (j))
#define XB_XSUB(j)  (1280 + 64 * (j))
#define XB_XGEN(j)  (2304 + 64 * (j))
#define XB_TOP      3328
#define XB_TOPGEN   3392
#define XCD_BAR_WORDS 3456
#define XB_SPIN_CAP (1u << 18)

__device__ __forceinline__ unsigned xb_ld(unsigned* p)              { return __hip_atomic_load(p, __ATOMIC_RELAXED, __HIP_MEMORY_SCOPE_AGENT); }
__device__ __forceinline__ unsigned xb_add(unsigned* p, unsigned v) { return __hip_atomic_fetch_add(p, v, __ATOMIC_RELAXED, __HIP_MEMORY_SCOPE_AGENT); }
__device__ __forceinline__ unsigned xb_xcc_id() { return (unsigned)__builtin_amdgcn_s_getreg((3 << 11) | 20) & 0xFu; }
#define XB_SPIN(cond, bar) do { unsigned _sp = 0; while (cond) { __builtin_amdgcn_s_sleep(1); \
    if ((++_sp & 255u) == 0u) { if (xb_ld(&(bar)[XB_TMO])) break; if (_sp > XB_SPIN_CAP) { atomicAdd(&(bar)[XB_TMO], 1u); break; } } } } while (0)

struct XcdBarrier {
    unsigned* bar; unsigned x;
    volatile LAS unsigned* st;
};

__device__ __forceinline__ XcdBarrier xcd_barrier_post(unsigned* bar, volatile LAS unsigned* st) {
    XcdBarrier b; b.bar = bar; b.x = xb_xcc_id(); b.st = st;
    if (threadIdx.x == 0) (void)xb_add(&bar[XB_XCNT(b.x)], 1u);
    return b;
}
__device__ __forceinline__ void xcd_barrier_complete(unsigned* bar, unsigned x, unsigned& nloc, unsigned& nx) {
    const unsigned G = gridDim.x * gridDim.y * gridDim.z;
    unsigned sum, cnt, mine, sp = 0u;
    for (;;) {
        sum = 0u; cnt = 0u; mine = 0u;
#pragma unroll
        for (unsigned j = 0; j < 16; ++j) { const unsigned c = xb_ld(&bar[XB_XCNT(j)]); sum += c; cnt += (c > 0u) ? 1u : 0u; mine = (j == x) ? c : mine; }
        if (sum == G) break;
        __builtin_amdgcn_s_sleep(1);
        if ((++sp & 255u) == 0u) { if (xb_ld(&bar[XB_TMO])) break; if (sp > XB_SPIN_CAP) { atomicAdd(&bar[XB_TMO], 1u); break; } }
    }
    nloc = mine > 0u ? mine : 1u; nx = cnt > 0u ? cnt : 1u;
}

__device__ __forceinline__ void xcd_barrier(const XcdBarrier& b) {
    asm volatile("s_waitcnt vmcnt(0)" ::: "memory");
    __syncthreads();
    if (threadIdx.x == 0) {
        unsigned* bar = b.bar;
        __builtin_amdgcn_s_waitcnt(0);
        unsigned nloc = b.st[0], nx = b.st[1];
        if (nloc == 0u) { xcd_barrier_complete(bar, b.x, nloc, nx); b.st[0] = nloc; b.st[1] = nx; }
        const unsigned old = xb_add(&bar[XB_XSUB(b.x)], 1u);
        const unsigned gen = old / nloc;
        if (old + 1u == (gen + 1u) * nloc) {
            __builtin_amdgcn_fence(__ATOMIC_RELEASE, "agent");
            asm volatile("s_waitcnt vmcnt(0)" ::: "memory");
            const unsigned og = xb_add(&bar[XB_TOP], 1u);
            const unsigned tg = og / nx;
            if (og + 1u == (tg + 1u) * nx) xb_add(&bar[XB_TOPGEN], 1u);
            else XB_SPIN(xb_ld(&bar[XB_TOPGEN]) == tg, bar);
            __builtin_amdgcn_fence(__ATOMIC_ACQUIRE, "agent");
            xb_add(&bar[XB_XGEN(b.x)], 1u);
            asm volatile("s_waitcnt vmcnt(0)" ::: "memory");
        } else {
            XB_SPIN(xb_ld(&bar[XB_XGEN(b.x)]) == gen, bar);
            __builtin_amdgcn_fence(__ATOMIC_ACQUIRE, "agent");
            asm volatile("s_waitcnt vmcnt(0)" ::: "memory");
        }
    }
    __syncthreads();
}

template <bool FROMP>
__device__ __forceinline__ void modnorm_phase(LAS unsigned char* lds, const float* xin, bf16* hout, const float* gvec, const float* modp, const float* bmod, const float* modf, int jsh, int jsc, int tid, int lane, int wave) {
    LAS float* TA = (LAS float*)lds; LAS float* TS = TA + DM;
    const int b = (blockIdx.x * 32) / SEQ;
    for (int k = tid; k < DM; k += NWAVES * 64) {
        float sh, sc;
        if (FROMP) { sh = bmod[jsh * DM + k]; sc = bmod[jsc * DM + k];
            for (int ks = 0; ks < KSPLIT; ++ks) { sh += modp[(size_t)(ks * 4 + b) * NMODW + jsh * DM + k]; sc += modp[(size_t)(ks * 4 + b) * NMODW + jsc * DM + k]; } }
        else { sh = modf[(size_t)b * NMODW + jsh * DM + k]; sc = modf[(size_t)b * NMODW + jsc * DM + k]; }
        TA[k] = gvec[k] * (1.0f + sc); TS[k] = sh; }
    __syncthreads();
    for (int r = 0; r < 4; ++r) { const int row = blockIdx.x * 32 + wave * 4 + r;
        const f32x4* xr = (const f32x4*)(xin + (size_t)row * DM) + lane;
        f32x4 v[8]; float s = 0.f;
#pragma unroll
        for (int j = 0; j < 8; ++j) { v[j] = __builtin_nontemporal_load(xr + 64 * j); s += (v[j].x * v[j].x + v[j].y * v[j].y) + (v[j].z * v[j].z + v[j].w * v[j].w); }
        const float rstd = 1.0f / sqrtf(wave_sum(s) * (1.0f / DM) + 1e-6f);
        GAS v2u* o8 = (GAS v2u*)(hout + (size_t)row * DM) + lane;
#pragma unroll
        for (int j = 0; j < 8; ++j) { const f32x4 a = *(const LAS f32x4*)(TA + 4 * (lane + 64 * j)), sft = *(const LAS f32x4*)(TS + 4 * (lane + 64 * j));
            const f32x4 o = v[j] * rstd * a + sft; o8[64 * j] = (v2u){pk2(o.x, o.y), pk2(o.z, o.w)}; } }
    __syncthreads();
}

#define TS_A (-1)
#define TS_MASK 0
#define TS_SCALE 1e-5f
#define TS_X (-1)
#define TS_Y (-1)
#define STAMP(k) do { if (TS_A >= 0 && bx == 0 && threadIdx.x == 0) ((volatile LAS unsigned long long*)(lds + MISC_OFF + 16))[k] = __builtin_amdgcn_s_memrealtime(); } while (0)
#define SSTAMP(k) do { if (TS_A >= 0 && blockIdx.x == 0 && threadIdx.x == 0) ((volatile LAS unsigned long long*)(lds + MISC_OFF + 16))[k] = __builtin_amdgcn_s_memrealtime(); } while (0)
constexpr int SS_UST = 2064;
constexpr int SS_U = 0, SS_K = 32 * SS_UST, SS_E = SS_K + 65 * 512, SS_C = SS_E + 2 * 128 * 33 * 4, SS_CST = 272, SS_END = SS_C + 32 * SS_CST;
static_assert(SS_END <= 147456 - 1024, "ssm LDS");
__device__ __forceinline__ float gelu_tanh(float v) { const float t = 0.7978845608028654f * (v + 0.044715f * v * v * v); const float e = __builtin_amdgcn_exp2f(-2.885390081777927f * t); return v * __builtin_amdgcn_rcpf(1.0f + e); }
__device__ __forceinline__ void ssm_unit(LAS unsigned char* lds, int b, int g, const bf16* proj, const bf16* ktab, const bf16* gtab, const bf16* htab, const float* a64, const float* dskip, bf16* vg, int tid, int lane, int wave) {
    const int n = lane & 31, h = lane >> 5;
    const int mt1 = wave & 3, kh = wave >> 2;
    bf16x8 hf[32];
    { const bf16* hp = htab + (((size_t)(g * 4 + mt1) * 64 + kh * 32) * 64 + lane) * 8;
#pragma unroll
      for (int s = 0; s < 32; ++s) hf[s] = *(const GAS bf16x8*)(hp + (size_t)s * 512); }
    { v4u ur[8];
#pragma unroll
      for (int it = 0; it < 8; ++it) { const int i = tid + 512 * it; ur[it] = *(const GAS v4u*)(proj + ((size_t)(b * NGRP + g) * SEQ * 16 + (size_t)i * 8)); }
      v4u kr[5];
#pragma unroll
      for (int it = 0; it < 5; ++it) { const int i = tid + 512 * it; kr[it] = (v4u){0u, 0u, 0u, 0u}; if (i < 2080) kr[it] = *(const GAS v4u*)(ktab + (size_t)g * 65 * 256 + i * 8); }
#pragma unroll
      for (int it = 0; it < 8; ++it) { const int i = tid + 512 * it, t = i >> 1, hf2 = i & 1; *(LAS v4u*)(lds + SS_U + (t >> 6) * SS_UST + (t & 63) * 32 + hf2 * 16) = ur[it]; }
#pragma unroll
      for (int it = 0; it < 5; ++it) { const int i = tid + 512 * it; if (i < 2080) *(LAS v4u*)(lds + SS_K + i * 16) = kr[it]; } }
    __syncthreads(); SSTAMP(24);
    { f32x16 acc;
#pragma unroll
      for (int i = 0; i < 16; ++i) acc[i] = 0.f;
#pragma unroll
      for (int s = 0; s < 32; ++s) { const bf16x8 bb = *(const LAS bf16x8*)(lds + SS_U + n * SS_UST + (kh * 32 + s) * 32 + h * 16);
          acc = __builtin_amdgcn_mfma_f32_32x32x16_bf16(hf[s], bb, acc, 0, 0, 0); }
      LAS float* E = (LAS float*)(lds + SS_E) + kh * 128 * 33;
#pragma unroll
      for (int r = 0; r < 16; ++r) E[(32 * mt1 + (r & 3) + 8 * (r >> 2) + 4 * h) * 33 + n] = acc[r]; }
    __syncthreads(); SSTAMP(25);
    if (wave == 0) { const int p = lane; const float ar = a64[(g * 64 + p) * 2], ai = a64[(g * 64 + p) * 2 + 1]; float cr = 0.f, ci = 0.f;
        const LAS float* E0 = (const LAS float*)(lds + SS_E); const LAS float* E1 = E0 + 128 * 33;
#pragma unroll 8
        for (int j = 0; j < 32; ++j) { *(LAS bf16*)(lds + SS_C + j * SS_CST + p * 2) = (bf16)f2bf(cr); *(LAS bf16*)(lds + SS_C + j * SS_CST + (64 + p) * 2) = (bf16)f2bf(ci);
            const float er = E0[p * 33 + j] + E1[p * 33 + j], ei = E0[(64 + p) * 33 + j] + E1[(64 + p) * 33 + j];
            const float nr = ar * cr - ai * ci + er, ni = ar * ci + ai * cr + ei; cr = nr; ci = ni; } }
    f32x16 acc4[4];
#pragma unroll
    for (int q = 0; q < 4; ++q)
#pragma unroll
        for (int i = 0; i < 16; ++i) acc4[q][i] = 0.f;
    const int c_l = n & 15, tl = n >> 4;
    const int bbase = SS_U + n * SS_UST + h * 16;
    const int kb0 = SS_K + ((tl + 1) * 16 + c_l) * 32 + h * 16;
    const int mtq0 = wave, mtq1 = 15 - wave, mtq2 = 16 + wave, mtq3 = 31 - wave;
    const int nsmax = 2 * mtq3 + 2;
    bf16x8 gfb[2][8];
    for (int s = 0; s < nsmax; s += 2) {
        const bf16x8 bb0 = *(const LAS bf16x8*)(lds + bbase + s * 32), bb1 = *(const LAS bf16x8*)(lds + bbase + s * 32 + 32);
        const bool c0 = s < 2 * mtq0 + 2, c1 = s < 2 * mtq1 + 2, c2 = s < 2 * mtq2 + 2;
        bf16x8 a00, a01, a10, a11, a20, a21;
        if (c0) { a00 = *(const LAS bf16x8*)(lds + kb0 + mtq0 * 1024 - s * 512); a01 = *(const LAS bf16x8*)(lds + kb0 + mtq0 * 1024 - s * 512 - 512); }
        if (c1) { a10 = *(const LAS bf16x8*)(lds + kb0 + mtq1 * 1024 - s * 512); a11 = *(const LAS bf16x8*)(lds + kb0 + mtq1 * 1024 - s * 512 - 512); }
        if (c2) { a20 = *(const LAS bf16x8*)(lds + kb0 + mtq2 * 1024 - s * 512); a21 = *(const LAS bf16x8*)(lds + kb0 + mtq2 * 1024 - s * 512 - 512); }
        const bf16x8 a30 = *(const LAS bf16x8*)(lds + kb0 + mtq3 * 1024 - s * 512), a31 = *(const LAS bf16x8*)(lds + kb0 + mtq3 * 1024 - s * 512 - 512);
        acc4[3] = __builtin_amdgcn_mfma_f32_32x32x16_bf16(a30, bb0, acc4[3], 0, 0, 0);
        if (c2) acc4[2] = __builtin_amdgcn_mfma_f32_32x32x16_bf16(a20, bb0, acc4[2], 0, 0, 0);
        if (c1) acc4[1] = __builtin_amdgcn_mfma_f32_32x32x16_bf16(a10, bb0, acc4[1], 0, 0, 0);
        if (c0) acc4[0] = __builtin_amdgcn_mfma_f32_32x32x16_bf16(a00, bb0, acc4[0], 0, 0, 0);
        acc4[3] = __builtin_amdgcn_mfma_f32_32x32x16_bf16(a31, bb1, acc4[3], 0, 0, 0);
        if (c2) acc4[2] = __builtin_amdgcn_mfma_f32_32x32x16_bf16(a21, bb1, acc4[2], 0, 0, 0);
        if (c1) acc4[1] = __builtin_amdgcn_mfma_f32_32x32x16_bf16(a11, bb1, acc4[1], 0, 0, 0);
        if (c0) acc4[0] = __builtin_amdgcn_mfma_f32_32x32x16_bf16(a01, bb1, acc4[0], 0, 0, 0); }
#pragma unroll
    for (int q = 0; q < 2; ++q) { const bf16* gp = gtab + (((size_t)(g * 32 + (q == 0 ? mtq0 : mtq1)) * 8) * 64 + lane) * 8;
#pragma unroll
        for (int ks = 0; ks < 8; ++ks) gfb[q][ks] = *(const GAS bf16x8*)(gp + (size_t)ks * 512); }
    asm volatile("" ::: "memory");
    SSTAMP(26); __syncthreads(); SSTAMP(27);
#pragma unroll
    for (int q = 0; q < 2; ++q) {
#pragma unroll
        for (int ks = 0; ks < 8; ++ks) { const bf16x8 bb = *(const LAS bf16x8*)(lds + SS_C + n * SS_CST + (16 * ks + 8 * h) * 2);
            acc4[q] = __builtin_amdgcn_mfma_f32_32x32x16_bf16(gfb[q][ks], bb, acc4[q], 0, 0, 0); } }
#pragma unroll
    for (int q = 2; q < 4; ++q) { const bf16* gp = gtab + (((size_t)(g * 32 + (q == 2 ? mtq2 : mtq3)) * 8) * 64 + lane) * 8;
        bf16x8 gf[8];
#pragma unroll
        for (int ks = 0; ks < 8; ++ks) gf[ks] = *(const GAS bf16x8*)(gp + (size_t)ks * 512);
#pragma unroll
        for (int ks = 0; ks < 8; ++ks) { const bf16x8 bb = *(const LAS bf16x8*)(lds + SS_C + n * SS_CST + (16 * ks + 8 * h) * 2);
            acc4[q] = __builtin_amdgcn_mfma_f32_32x32x16_bf16(gf[ks], bb, acc4[q], 0, 0, 0); } }
    SSTAMP(28);
#pragma unroll
    for (int q = 0; q < 4; ++q) { const int mt = (q == 0) ? mtq0 : (q == 1) ? mtq1 : (q == 2) ? mtq2 : mtq3;
#pragma unroll
        for (int q4 = 0; q4 < 4; ++q4) { const int t = 2 * mt + (q4 >> 1), c0 = 8 * (q4 & 1) + 4 * h;
            const v2u uu = *(const LAS v2u*)(lds + SS_U + n * SS_UST + t * 32 + c0 * 2);
            const f32x4 dv = *(const f32x4*)(dskip + 16 * g + c0);
            const float y0 = acc4[q][4 * q4 + 0] + dv[0] * bf_lo(uu.x), y1 = acc4[q][4 * q4 + 1] + dv[1] * bf_hi(uu.x), y2 = acc4[q][4 * q4 + 2] + dv[2] * bf_lo(uu.y), y3 = acc4[q][4 * q4 + 3] + dv[3] * bf_hi(uu.y);
            *(GAS v2u*)(vg + (size_t)(b * SEQ + 64 * n + t) * SSMW + 16 * g + c0) = (v2u){pk2(gelu_tanh(y0), gelu_tanh(y1)), pk2(gelu_tanh(y2), gelu_tanh(y3))}; } }
    __syncthreads();
}

constexpr int AT_K = 0, AT_V = 272 * 256, AT_END = 2 * 272 * 256;
static_assert(AT_END <= 147456 - 1024, "attn LDS");
__device__ __forceinline__ unsigned off_b(unsigned row, unsigned ch) { return 256u * row + 16u * (ch ^ (((row & 3) << 2) | ((row >> 2) & 3))); }
typedef short v4i16_t __attribute__((ext_vector_type(4)));
__device__ __forceinline__ s16x4 tr_read(LAS unsigned char* p) { return __builtin_bit_cast(s16x4, __builtin_amdgcn_ds_read_tr16_b64_v4i16((LAS v4i16_t*)p)); }
struct AttnDesc { int b, hd, di, dil, res, blk; };
__device__ __forceinline__ AttnDesc attn_decode(int u) { AttnDesc d; const int bh = u / 48, w = u % 48; d.b = bh / NHEAD; d.hd = bh % NHEAD;
    if (w < 16) { d.di = 0; d.dil = 1; d.res = 0; d.blk = w; } else if (w < 32) { d.di = 1; d.dil = 4; d.res = (w - 16) >> 2; d.blk = (w - 16) & 3; } else { d.di = 2; d.dil = 16; d.res = w - 32; d.blk = 0; }
    return d; }
__device__ __forceinline__ void attn_run(LAS unsigned char* lds, int u0, int ustride, int uend, const bf16* proj, bf16* obr, float* lse, int tid, int lane, int wave) {
    if (u0 >= uend) return;
    if (tid < 256) { const int row = 256 + (tid >> 4), ch = tid & 15; *(LAS v4u*)(lds + AT_K + off_b(row, ch)) = (v4u){0u, 0u, 0u, 0u}; *(LAS v4u*)(lds + AT_V + off_b(row, ch)) = (v4u){0u, 0u, 0u, 0u}; }
    const int qn = lane & 15, g = lane >> 4, q4 = (lane & 15) >> 2, p4 = lane & 3;
    const int r0s = tid >> 4, chs = tid & 15; const unsigned soff = off_b(r0s, chs);
    v4u kr[8], vr[8]; bf16x8 qnx[4];
    int u = u0; AttnDesc nd = attn_decode(u);
#define AT_ISSUE(D) do { const size_t rowb_ = (size_t)(D).b * SEQ; \
        _Pragma("unroll") for (int it = 0; it < 8; ++it) { const int sub = 128 * (D).blk - 128 + r0s + 32 * it; kr[it] = (v4u){0u, 0u, 0u, 0u}; vr[it] = kr[it]; \
            if (sub >= 0) { const bf16* src = proj + (rowb_ + (D).res + (D).dil * sub) * PROJW + 2048 + (D).hd * HDIM + chs * 8; kr[it] = *(const GAS v4u*)src; vr[it] = *(const GAS v4u*)(src + 1024); } } \
        const int qt_ = (D).res + (D).dil * (128 * (D).blk + 16 * wave + qn); \
        _Pragma("unroll") for (int s_ = 0; s_ < 4; ++s_) qnx[s_] = *(const GAS bf16x8*)(proj + (rowb_ + qt_) * PROJW + 1024 + (D).hd * HDIM + 32 * s_ + 8 * g); } while (0)
    AT_ISSUE(nd);
    for (;;) {
        const AttnDesc d = nd;
#pragma unroll
        for (int it = 0; it < 8; ++it) { *(LAS v4u*)(lds + AT_K + soff + 8192 * it) = kr[it]; *(LAS v4u*)(lds + AT_V + soff + 8192 * it) = vr[it]; }
        bf16x8 qf[4];
#pragma unroll
        for (int s = 0; s < 4; ++s) qf[s] = qnx[s];
        __syncthreads();
        const int un = u + ustride; const bool has = un < uend;
        if (has) { nd = attn_decode(un); AT_ISSUE(nd); }
        const bool first = (d.blk == 0); const int tskip = first ? 8 - wave : 0;
        f32x4 sc[10];
#pragma unroll
        for (int kt = 0; kt < 10; ++kt) { f32x4 a = {0.f, 0.f, 0.f, 0.f};
            if (kt < 9 && kt >= tskip) {
#pragma unroll
                for (int s = 0; s < 4; ++s) { const bf16x8 kf = *(const LAS bf16x8*)(lds + AT_K + off_b(16 * (wave + kt) + qn, 4 * s + g));
                    a = __builtin_amdgcn_mfma_f32_16x16x32_bf16(kf, qf[s], a, 0, 0, 0); } }
            sc[kt] = a; }
        float mx = -1e30f;
#pragma unroll
        for (int kt = 0; kt < 10; ++kt)
#pragma unroll
            for (int r = 0; r < 4; ++r) { const int rel = 16 * kt + 4 * g + r; bool ok = (rel >= qn) && (rel <= qn + 128) && (kt >= tskip);
                sc[kt][r] = ok ? sc[kt][r] : -1e30f; mx = fmaxf(mx, sc[kt][r]); }
        mx = fmaxf(mx, __shfl_xor(mx, 16)); mx = fmaxf(mx, __shfl_xor(mx, 32));
        float ls = 0.f;
#pragma unroll
        for (int kt = 0; kt < 10; ++kt)
#pragma unroll
            for (int r = 0; r < 4; ++r) { const float p = (sc[kt][r] > -1e29f) ? __builtin_amdgcn_exp2f(sc[kt][r] - mx) : 0.f; sc[kt][r] = p; ls += p; }
        ls += __shfl_xor(ls, 16); ls += __shfl_xor(ls, 32);
        f32x4 o[8];
#pragma unroll
        for (int c = 0; c < 8; ++c) o[c] = (f32x4){0.f, 0.f, 0.f, 0.f};
#pragma unroll
        for (int ks = 0; ks < 5; ++ks) {
            if (2 * ks + 1 >= tskip) {
                union { unsigned uu[4]; bf16x8 v; } pb;
                pb.uu[0] = pk2(sc[2 * ks][0], sc[2 * ks][1]); pb.uu[1] = pk2(sc[2 * ks][2], sc[2 * ks][3]); pb.uu[2] = pk2(sc[2 * ks + 1][0], sc[2 * ks + 1][1]); pb.uu[3] = pk2(sc[2 * ks + 1][2], sc[2 * ks + 1][3]);
                const unsigned r0 = 16 * wave + 32 * ks + 4 * g + q4;
#pragma unroll
                for (int c = 0; c < 8; ++c) {
                    const s16x4 v0 = tr_read(lds + AT_V + off_b(r0, 2 * c + (p4 >> 1)) + 8 * (p4 & 1));
                    const s16x4 v1 = tr_read(lds + AT_V + off_b(r0 + 16, 2 * c + (p4 >> 1)) + 8 * (p4 & 1));
                    bf16x8 va; va[0] = v0[0]; va[1] = v0[1]; va[2] = v0[2]; va[3] = v0[3]; va[4] = v1[0]; va[5] = v1[1]; va[6] = v1[2]; va[7] = v1[3];
                    o[c] = __builtin_amdgcn_mfma_f32_16x16x32_bf16(va, pb.v, o[c], 0, 0, 0); } } }
        const float inv = 1.0f / ls;
        const size_t qrow = (size_t)d.b * SEQ + d.res + d.dil * (128 * d.blk + 16 * wave + qn);
        bf16* op = obr + (size_t)d.di * MTOK * ATTW + qrow * ATTW + d.hd * HDIM + 4 * g;
#pragma unroll
        for (int c = 0; c < 8; ++c) *(GAS v2u*)(op + 16 * c) = (v2u){pk2(o[c][0] * inv, o[c][1] * inv), pk2(o[c][2] * inv, o[c][3] * inv)};
        if (g == 0) lse[(size_t)d.di * MTOK * NHEAD + qrow * NHEAD + d.hd] = mx + __builtin_amdgcn_logf(ls);
        __syncthreads();
        if (!has) break;
        u = un;
    }
#undef AT_ISSUE
}

__device__ __forceinline__ void ynorm_phase(bf16* ycat, const bf16* obr, const float* lse, int lane, int wave) {
    for (int r = 0; r < 4; ++r) { const int row = blockIdx.x * 32 + wave * 4 + r;
        { const int hd = lane >> 3;
          const float l0 = lse[(size_t)row * NHEAD + hd], l1 = lse[(size_t)MTOK * NHEAD + (size_t)row * NHEAD + hd], l2 = lse[(size_t)2 * MTOK * NHEAD + (size_t)row * NHEAD + hd];
          const float lm = fmaxf(l0, fmaxf(l1, l2)); float w0 = __builtin_amdgcn_exp2f(l0 - lm), w1 = __builtin_amdgcn_exp2f(l1 - lm), w2 = __builtin_amdgcn_exp2f(l2 - lm);
          const float wi = 1.0f / (w0 + w1 + w2); w0 *= wi; w1 *= wi; w2 *= wi;
          float v[16];
#pragma unroll
          for (int i = 0; i < 16; ++i) v[i] = 0.f;
#pragma unroll
          for (int d = 0; d < 3; ++d) { const bf16* p = obr + (size_t)d * MTOK * ATTW + (size_t)row * ATTW + lane * 16; const v4u a = *(const GAS v4u*)p, c = *(const GAS v4u*)(p + 8); const float w = d == 0 ? w0 : d == 1 ? w1 : w2;
              v[0] += w * bf_lo(a.x); v[1] += w * bf_hi(a.x); v[2] += w * bf_lo(a.y); v[3] += w * bf_hi(a.y); v[4] += w * bf_lo(a.z); v[5] += w * bf_hi(a.z); v[6] += w * bf_lo(a.w); v[7] += w * bf_hi(a.w);
              v[8] += w * bf_lo(c.x); v[9] += w * bf_hi(c.x); v[10] += w * bf_lo(c.y); v[11] += w * bf_hi(c.y); v[12] += w * bf_lo(c.z); v[13] += w * bf_hi(c.z); v[14] += w * bf_lo(c.w); v[15] += w * bf_hi(c.w); }
          float s = 0.f;
#pragma unroll
          for (int i = 0; i < 16; ++i) s += v[i] * v[i];
          const float rstd = 1.0f / sqrtf(wave_sum(s) * (1.0f / ATTW) + 1e-6f);
          bf16* p = ycat + (size_t)row * DM + SSMW + lane * 16;
          *(GAS v4u*)p = (v4u){pk2(v[0] * rstd, v[1] * rstd), pk2(v[2] * rstd, v[3] * rstd), pk2(v[4] * rstd, v[5] * rstd), pk2(v[6] * rstd, v[7] * rstd)};
          *(GAS v4u*)(p + 8) = (v4u){pk2(v[8] * rstd, v[9] * rstd), pk2(v[10] * rstd, v[11] * rstd), pk2(v[12] * rstd, v[13] * rstd), pk2(v[14] * rstd, v[15] * rstd)}; } }
}
__device__ __forceinline__ void final_norm_phase(float* out, const float* gfin, int lane, int wave) {
    for (int r = 0; r < 4; ++r) { const int row = blockIdx.x * 32 + wave * 4 + r;
        f32x4* xr = (f32x4*)(out + (size_t)row * DM) + lane; f32x4 v[8]; float s = 0.f;
#pragma unroll
        for (int j = 0; j < 8; ++j) { v[j] = xr[64 * j]; s += (v[j].x * v[j].x + v[j].y * v[j].y) + (v[j].z * v[j].z + v[j].w * v[j].w); }
        const float rstd = 1.0f / sqrtf(wave_sum(s) * (1.0f / DM) + 1e-6f);
#pragma unroll
        for (int j = 0; j < 8; ++j) { const f32x4 gq = *((const f32x4*)gfin + lane + 64 * j); xr[64 * j] = v[j] * rstd * gq; } }
}

constexpr int NPH = 11;
constexpr int ATT_P3_UNITS = 512;
constexpr int IT_GEMV = KSPLIT * 48, IT_SSM = NGRP * 25, IT_FIN = 48 * 4, IT_ROPE = MTOK, IT_WIN = (DM / 64) * (PROJW / 64), IT_WGLU = (SSMW / 64) * (SSMW / 64), IT_WOUT = (DM / 64) * (DM / 64),
              IT_WG = (DM / 64) * (DFF / 64), IT_WD = (DFF / 64) * (DM / 64), IT_TOTAL = IT_GEMV + IT_SSM + IT_FIN + IT_ROPE + IT_WIN + IT_WGLU + IT_WOUT + 2 * IT_WG;
__global__ void __launch_bounds__(NWAVES * 64, 2) hymba_fwd(Args args) {
    extern __shared__ __attribute__((aligned(16))) unsigned char lds_raw[];
    LAS unsigned char* lds = (LAS unsigned char*)lds_raw;
    cg::grid_group grid = cg::this_grid();
    const int tid = threadIdx.x, lane = tid & 63, wave = __builtin_amdgcn_readfirstlane(tid >> 6);
    const int G = gridDim.x, bx = blockIdx.x;
    unsigned char* ws = args.ws;
    const float* const* in = args.in;
    float* modp = (float*)(ws + WS_MODP); float* modf = (float*)(ws + WS_MODF); float* cosT = (float*)(ws + WS_ROPE); float* sinT = cosT + (size_t)MTOK * 64;
    bf16* ktab = (bf16*)(ws + WS_KTAB); bf16* gtab = (bf16*)(ws + WS_GTAB); bf16* htab = (bf16*)(ws + WS_HTAB); float* a64 = (float*)(ws + WS_A64);
    bf16* Win = (bf16*)(ws + WS_WIN); bf16* Wglu = (bf16*)(ws + WS_WGLU); bf16* Wout = (bf16*)(ws + WS_WOUT); bf16* Wgu = (bf16*)(ws + WS_WGU); bf16* Wdn = (bf16*)(ws + WS_WDN);
    bf16* Hb = (bf16*)(ws + WS_H); bf16* proj = (bf16*)(ws + WS_PROJ); bf16* vg = (bf16*)(ws + WS_VG); bf16* ycat = (bf16*)(ws + WS_YCAT); bf16* obr = (bf16*)(ws + WS_OBR); float* lse = (float*)(ws + WS_LSE);
    bf16* ff = (bf16*)(ws + WS_FF); bf16* ut = (bf16*)(ws + WS_UT);
    const int lo = args.ph_lo, hi = args.ph_hi;
#ifndef PHMASK
#define PHMASK 0x7ff
#endif
#define IN(k) (((PHMASK >> (k)) & 1) && lo <= (k) && (k) < hi)
    volatile LAS unsigned* MISC = (volatile LAS unsigned*)(lds + MISC_OFF);
    if (tid < 2) MISC[tid] = 0u;
    __syncthreads();
    if (args.ph_lo < 0) grid.sync();
    const XcdBarrier xbar = xcd_barrier_post((unsigned*)(ws + WS_CTL), MISC);
    STAMP(0);
#define SEAM(k) do { if (IN(k) && IN((k) + 1)) xcd_barrier(xbar); } while (0)
#ifndef DOUBLE_MASK
#define DOUBLE_MASK 0
#endif
#define P0SUB 8
#define P3SUB 1
#define REPS(k) for (int rep_ = 0; rep_ < 1 + ((DOUBLE_MASK >> (k)) & 1); ++rep_)
#define RSYNC(k) do { if ((DOUBLE_MASK >> (k)) & 1) xcd_barrier(xbar); } while (0)

    REPS(0) if (IN(0)) {
        RSYNC(0);
        LAS float* scr = (LAS float*)(lds + wave * 16640);
        const int gw = wave * G + bx, NGW = G * NWAVES;
        const int nmine = (IT_TOTAL - gw + NGW - 1) / NGW;
        for (int kk = 0; kk < nmine; ++kk) {
            const bool gfirst = (gw < IT_GEMV);
            const int it = gw + ((wave & 1) ? ((gfirst && kk == 0) ? 0 : (gfirst ? nmine - kk : nmine - 1 - kk)) : kk) * NGW;
            int r = it;
#if DOUBLE_MASK & 1
            if (rep_ == 1) { const int ty = (it < IT_GEMV) ? 1 : (it < IT_GEMV + IT_SSM) ? 2 : (it < IT_GEMV + IT_SSM + IT_ROPE) ? 4 : 8; if (!(P0SUB & ty)) continue; }
#endif
            if (r < IT_GEMV) { p0_gemv_item(in[1], in[3], modp, modf, in[4], (unsigned*)(ws + WS_CNT), scr, r, lane); continue; } r -= IT_GEMV;
            if (r < IT_SSM) { const int g = r / 25, sub = r % 25;
                if (sub < 9) p0_ktab_item(in, ktab, a64, scr, g, sub, lane); else if (sub < 17) p0_gtab_item(in, gtab, g, sub - 9, lane); else p0_htab_item(in, htab, g, sub - 17, lane);
                continue; } r -= IT_SSM;
            if (r < IT_FIN) { p0_fin_item(modp, modf, in[4], (unsigned*)(ws + WS_CNT), r, lane); continue; } r -= IT_FIN;
            if (r < IT_ROPE) { p0_rope_item((const int*)in[2], cosT, sinT, r, lane); continue; } r -= IT_ROPE;
            if (r < IT_WIN) { p0_transpose_item<1>(in[6], DM, PROJW, Win, scr, r, lane, nullptr, nullptr); continue; } r -= IT_WIN;
            if (r < IT_WGLU) { p0_transpose_item<0>(in[15], SSMW, SSMW, Wglu, scr, r, lane, nullptr, nullptr); continue; } r -= IT_WGLU;
            if (r < IT_WOUT) { p0_transpose_item<4>(in[19], DM, DM, Wout, scr, r, lane, in[17], in[18]); continue; } r -= IT_WOUT;
            if (r < IT_WG) { p0_transpose_item<2>(in[21], DM, DFF, Wgu, scr, r, lane, nullptr, nullptr); continue; } r -= IT_WG;
            p0_transpose_item<3>(in[22], DM, DFF, Wgu, scr, r, lane, nullptr, nullptr);
        }
        __syncthreads();
    }
    STAMP(1); STAMP(2);
    REPS(1) if (IN(1)) {
        RSYNC(1);
        unsigned* gcnt = (unsigned*)(ws + WS_CNT);
        if (wave == 0) { unsigned sp = 0u; unsigned* dn = gcnt + 64 * 48;
            while ((unsigned)__builtin_amdgcn_readfirstlane((int)__hip_atomic_load(dn, __ATOMIC_RELAXED, __HIP_MEMORY_SCOPE_AGENT)) < 192u) { __builtin_amdgcn_s_sleep(4); if (++sp > (1u << 22)) break; }
            __builtin_amdgcn_fence(__ATOMIC_ACQUIRE, "agent"); asm volatile("s_waitcnt vmcnt(0)" ::: "memory"); }
        __syncthreads();
        modnorm_phase<false>(lds, in[0], Hb, in[5], modp, in[4], modf, 0, 1, tid, lane, wave);
    }
    STAMP(3); SEAM(1); STAMP(4);
    if (IN(2)) {
        pg8::Gemm g{Hb, Win, MTOK, PROJW, DM}; pg8::StaticOrder S; S.init(MTOK, PROJW, G, bx);
        pg8::EpiProj E{proj, ut, cosT, sinT, 0.08838834764831845f * 1.4426950408889634f};
        pg8::gemm_phase<pg8::EpiProj, pg8::StaticOrder, true, true>(lds, g, S, E);
    }
    STAMP(5); SEAM(2); STAMP(6);
    REPS(3) if (IN(3)) {
        RSYNC(3);
        int tid = threadIdx.x; asm volatile("" : "+v"(tid)); const int lane = tid & 63, wave = __builtin_amdgcn_readfirstlane(tid >> 6);
#if DOUBLE_MASK & 8
        if (rep_ == 0 || (P3SUB & 1))
#endif
        for (int u0 = bx; u0 < BATCH * NGRP; u0 += G) { const int x = u0 & 7, j = (u0 >> 3) & 31;
            ssm_unit(lds, j >> 3, 8 * x + (j & 7), ut, ktab, gtab, htab, a64, in[14], vg, tid, lane, wave); }
        STAMP(7);
#if DOUBLE_MASK & 8
        if (rep_ == 0 || (P3SUB & 2))
#endif
        { const int ax = 192 * (bx & 7), aj = bx >> 3;
          attn_run(lds, ax + aj, 32, ax + 64, proj, obr, lse, tid, lane, wave); }
    }
    STAMP(8); SEAM(3); STAMP(9);
    if (IN(4)) {
        pg8::Gemm g{vg, Wglu, MTOK, SSMW, SSMW}; pg8::StaticOrder S; S.init(MTOK, SSMW, G, bx);
        pg8::EpiGluNorm E{ycat, vg, in[16], (float*)(ws + WS_SLOTS) + 2 * 65536, (unsigned*)(ws + WS_GCNT)};
        pg8::gemm_phase<pg8::EpiGluNorm, pg8::StaticOrder, false, true>(lds, g, S, E);
        __syncthreads();
        STAMP(10);
        { int tid = threadIdx.x; asm volatile("" : "+v"(tid)); const int lane = tid & 63, wave = __builtin_amdgcn_readfirstlane(tid >> 6);
          const bool glu = bx < 128; const int ax = 192 * (bx & 7), aj = bx >> 3;
          attn_run(lds, glu ? ax + 64 + aj : ax + 80 + (aj - 16), 16, glu ? ax + 80 : ax + 192, proj, obr, lse, tid, lane, wave); }
    }
    STAMP(11); SEAM(4); STAMP(12);
    REPS(5) if (IN(5)) ynorm_phase(ycat, obr, lse, lane, wave);
    STAMP(13); SEAM(5); STAMP(14);
    if (IN(6)) {
        pg8::Gemm g{ycat, Wout, MTOK, DM, DM}; pg8::StaticOrder S; S.init(MTOK, DM, G, bx);
        pg8::EpiNormX<0> E{in[0], args.out, Hb, modf + 2 * DM, in[20], modf + 4 * DM, modf + 3 * DM, (float*)(ws + WS_SLOTS), (unsigned*)(ws + WS_PCNT), (bf16*)(ws + WS_OBR)};
        pg8::gemm_phase<pg8::EpiNormX<0>, pg8::StaticOrder, false, true>(lds, g, S, E);
    }
    STAMP(15); SEAM(6); STAMP(16);
    if (IN(8)) {
        pg8::Gemm g{Hb, Wgu, MTOK, 2 * DFF, DM}; pg8::StaticOrder S; S.init(MTOK, 2 * DFF, G, bx);
        pg8::EpiSwiglu E{ff};
        pg8::gemm_phase<pg8::EpiSwiglu, pg8::StaticOrder, true, true>(lds, g, S, E);
        if (bx >= 128) { int tid2 = threadIdx.x; asm volatile("" : "+v"(tid2)); const int lane2 = tid2 & 63, wave2 = __builtin_amdgcn_readfirstlane(tid2 >> 6);
            LAS float* scr = (LAS float*)(lds + wave2 * 16640);
            for (int it = (bx - 128) * NWAVES + wave2; it < IT_WD; it += 128 * NWAVES) p0_transpose_item<0>(in[23], DFF, DM, Wdn, scr, it, lane2, nullptr, nullptr); }
    }
    STAMP(19); SEAM(8); STAMP(20);
    if (IN(9)) {
        pg8::Gemm g{ff, Wdn, MTOK, DM, DFF}; pg8::StaticOrder S; S.init(MTOK, DM, G, bx);
        pg8::EpiNormX<1> E{args.out, args.out, nullptr, modf + 5 * DM, in[24], nullptr, nullptr, (float*)(ws + WS_SLOTS) + 65536, (unsigned*)(ws + WS_PCNT) + 32 * 64, (bf16*)(ws + WS_OBR)};
        pg8::gemm_phase<pg8::EpiNormX<1>, pg8::StaticOrder, false, true>(lds, g, S, E);
    }
    STAMP(21); STAMP(22);
    if (TS_A >= 0 && bx == 0) { STAMP(23); __syncthreads();
        const volatile LAS unsigned long long* ts = (const volatile LAS unsigned long long*)(lds + MISC_OFF + 16);
        unsigned long long tot = 0ull;
        for (int i = 0; i < 23; ++i) if ((TS_MASK >> i) & 1) tot += ts[i + 1] - ts[i];
        if (TS_X >= 0) tot = ts[TS_Y < 0 ? 0 : TS_Y] - ts[TS_X < 0 ? 0 : TS_X];
        const float dl = (float)tot * TS_SCALE;
        for (int i = threadIdx.x; i < 4096; i += NWAVES * 64) args.out[i] += dl; }
#undef IN
#undef SEAM
}

#ifndef MK_PER_PHASE
#define MK_PER_PHASE 0
#endif
extern "C" void kernel_launch(void* const* d_in, const int* in_sizes, int n_in, void* d_out, int out_size, void* d_ws, size_t ws_size, hipStream_t stream) {
    static int ready = 0;
    if (ready == 0) {
        ready = 1;
        if (n_in != 25 || out_size != MTOK * DM || ws_size < WS_END) { fprintf(stderr, "kernel_launch: unexpected shapes (n_in %d out %d ws %zu)\n", n_in, out_size, ws_size); ready = -1; }
        else if (hipFuncSetAttribute((const void*)hymba_fwd, hipFuncAttributeMaxDynamicSharedMemorySize, LDS_BYTES) != hipSuccess) { fprintf(stderr, "kernel_launch: hipFuncSetAttribute failed\n"); ready = -1; }
        else { int per_cu = 0; (void)hipOccupancyMaxActiveBlocksPerMultiprocessor(&per_cu, (const void*)hymba_fwd, NWAVES * 64, LDS_BYTES); (void)hipGetLastError();
               if (per_cu < 1) fprintf(stderr, "kernel_launch: occupancy query reports %d blocks per CU\n", per_cu); }
    }
    if (ready < 0) return;
    if (hipMemsetAsync((char*)d_ws + WS_CTL, 0, CTL_ZERO_BYTES, stream) != hipSuccess) { fprintf(stderr, "kernel_launch: memset failed\n"); return; }
    Args a{};
    for (int i = 0; i < 25; ++i) a.in[i] = (const float*)d_in[i];
    a.out = (float*)d_out; a.ws = (unsigned char*)d_ws;
#if MK_PER_PHASE
    for (int p = 0; p < NPH; ++p) { a.ph_lo = p; a.ph_hi = p + 1; hipLaunchKernelGGL(hymba_fwd, dim3(256), dim3(NWAVES * 64), LDS_BYTES, stream, a); }
#else
    a.ph_lo = 0; a.ph_hi = NPH;
    void* kargs[] = {&a};
    hipError_t e = hipLaunchCooperativeKernel((const void*)hymba_fwd, dim3(256), dim3(NWAVES * 64), kargs, LDS_BYTES, stream);
    if (e != hipSuccess) fprintf(stderr, "kernel_launch: cooperative launch failed: %s\n", hipGetErrorString(e));
#endif
}
```

```cpp
#include <hip/hip_runtime.h>
#include <hip/hip_cooperative_groups.h>
#include <cstdio>
#include <cstdint>
namespace cg = cooperative_groups;
namespace pg8 {
#define PG8_LAS __attribute__((address_space(3)))
typedef unsigned short bf16_t;
typedef short bf16x8 __attribute__((ext_vector_type(8)));
typedef float f32x4 __attribute__((ext_vector_type(4)));
typedef unsigned u32x4 __attribute__((ext_vector_type(4)));
constexpr int BM = 256, BK = 64, HALF = 128, HTB = HALF * BK * 2  , STAGE_BYTES = 8 * HTB, NXCD = 8, WGM = 8;

__host__ __device__ __forceinline__ int lds_byte(int r, int c) { const int st = (r >> 4) * 2 + (c >> 5), rr = r & 15, cc = c & 31, ob = rr * 64 + cc * 2; return st * 1024 + (ob ^ (((ob >> 9) & 1) << 5)); }
__host__ __device__ __forceinline__ void stage_rc(int b, int& R, int& C) { const int st = b / 1024, sb = b % 1024, swz = sb ^ (((sb >> 9) & 1) << 5); R = (st >> 1) * 16 + swz / 64; C = (st & 1) * 32 + (swz % 64) / 2; }
__host__ __device__ __forceinline__ int perm32(int rho) { const int n = rho >> 4, i = rho & 15; return 8 * (i >> 2) + 4 * n + (i & 3); }

struct Unit { int pm, pn; };
struct Gemm { const bf16_t* A; const bf16_t* Bt; int M, N, K; };

struct StaticOrder {
    int nM, nN, nwg, G, c;
    __host__ __device__ void init(int M, int N, int G_, int c_) { nM = M / BM; nN = N / BM; nwg = nM * nN; G = G_; c = c_; }
    __host__ __device__ bool next(int i, Unit& u) const {
        const long L = (long)i * G + c; if (L >= nwg) return false;
        int wgid = (int)L; { const int q = nwg / NXCD, r = nwg % NXCD, xcd = wgid % NXCD, off = wgid / NXCD; wgid = (xcd < r ? xcd * (q + 1) : r * (q + 1) + (xcd - r) * q) + off; }
        const int nig = WGM * nN, gid = wgid / nig, fm = gid * WGM, gsz = (nM - fm) < WGM ? (nM - fm) : WGM;
        u.pm = fm + ((wgid % nig) % gsz); u.pn = (wgid % nig) / gsz; return true;
    }
    __device__ __forceinline__ void a_ready(const Unit&) const {}
    __device__ __forceinline__ void done(const Unit&) const {}
};

__device__ __forceinline__ unsigned cvt_pk_bf16(float lo, float hi) { unsigned r; asm volatile("v_cvt_pk_bf16_f32 %0, %1, %2" : "=v"(r) : "v"(lo), "v"(hi)); return r; }
typedef float f32x2 __attribute__((ext_vector_type(2)));
__device__ __forceinline__ f32x2 gelu_pk(f32x2 v) {
    const f32x2 av = __builtin_elementwise_abs(v), d = av * 0.2316418882f + 1.0f;
    f32x2 t; t.x = __builtin_amdgcn_rcpf(d.x); t.y = __builtin_amdgcn_rcpf(d.y);
    f32x2 q = t * 0.5307027145f + (-0.7265760135f); q = q * t + 0.7107068705f; q = q * t + (-0.142248368f); q = q * t + 0.127414796f; q = q * t;
    const f32x2 s = (v * v) * (-0.72134752044f);
    f32x2 e; e.x = __builtin_amdgcn_exp2f(s.x); e.y = __builtin_amdgcn_exp2f(s.y);
    const f32x2 m = v * (q * e), r = v - m;
    f32x2 o; o.x = v.x < 0.f ? m.x : r.x; o.y = v.y < 0.f ? m.y : r.y; return o;
}

__device__ __forceinline__ float bflo(unsigned w) { return __uint_as_float(w << 16); }
__device__ __forceinline__ float bfhi(unsigned w) { return __uint_as_float(w & 0xffff0000u); }
__device__ __forceinline__ float fast_sigmoid(float v) { return __builtin_amdgcn_rcpf(1.0f + __builtin_amdgcn_exp2f(-1.4426950408889634f * v)); }
struct EpiProj {
    static constexpr bool PERM = true, AFTER_DRAIN = false;
    bf16_t* O; bf16_t* UT; const float* cosT; const float* sinT; float qscale;
    __device__ __forceinline__ void operator()(const f32x4 (&acc)[2][2][4][2], const Unit& u, int wr, int wc, int fr, int fq) const {
        const int row0 = u.pm * BM + wr * 64 + fr; const int col0 = u.pn * BM + wc * 32 + 8 * fq;
        const int sect = u.pn >> 2;
        const int j0 = 4 * (4 * wc + fq);
        const float sc = (sect == 1) ? qscale : 1.f;
#pragma unroll
        for (int ai = 0; ai < 2; ++ai)
#pragma unroll
            for (int m = 0; m < 4; ++m) { const int row = row0 + ai * HALF + m * 16; bf16_t* rowp = O + (size_t)row * 4096 + col0;
                f32x4 cs = (f32x4){1.f, 1.f, 1.f, 1.f}, sn = (f32x4){0.f, 0.f, 0.f, 0.f};
                if (sect == 1 || sect == 2) { cs = *(const f32x4*)(cosT + (size_t)row * 64 + j0); sn = *(const f32x4*)(sinT + (size_t)row * 64 + j0); }
#pragma unroll
                for (int bj = 0; bj < 2; ++bj) { const f32x4 t1 = acc[ai][bj][m][0], t2 = acc[ai][bj][m][1];
                    f32x4 v0 = (t1 * cs - t2 * sn) * sc, v1 = (t1 * sn + t2 * cs) * sc;
                    u32x4 w; w.x = cvt_pk_bf16(v0[0], v0[1]); w.y = cvt_pk_bf16(v0[2], v0[3]); w.z = cvt_pk_bf16(v1[0], v1[1]); w.w = cvt_pk_bf16(v1[2], v1[3]);
                    if (sect == 0) { const int col = col0 + bj * HALF; *(u32x4*)(UT + ((size_t)((row >> 11) * 64 + (col >> 4)) * 2048 + (row & 2047)) * 16 + (col & 15)) = w; }
                    else *(u32x4*)(rowp + bj * HALF) = w; } }
    }
};
struct EpiGlu {
    static constexpr bool PERM = true, AFTER_DRAIN = false;
    bf16_t* O; const bf16_t* VG; const float* bias;
    __device__ __forceinline__ void operator()(const f32x4 (&acc)[2][2][4][2], const Unit& u, int wr, int wc, int fr, int fq) const {
        const int row0 = u.pm * BM + wr * 64 + fr; const int col0 = u.pn * BM + wc * 32 + 8 * fq;
        f32x4 bv[2][2];
#pragma unroll
        for (int bj = 0; bj < 2; ++bj)
#pragma unroll
            for (int n = 0; n < 2; ++n) bv[bj][n] = *(const f32x4*)(bias + col0 + bj * HALF + 4 * n);
#pragma unroll
        for (int ai = 0; ai < 2; ++ai)
#pragma unroll
            for (int m = 0; m < 4; ++m) { const int row = row0 + ai * HALF + m * 16;
#pragma unroll
                for (int bj = 0; bj < 2; ++bj) { const u32x4 g = *(const u32x4*)(VG + (size_t)row * 1024 + col0 + bj * HALF);
                    const f32x4 a0 = acc[ai][bj][m][0] + bv[bj][0], a1 = acc[ai][bj][m][1] + bv[bj][1];
                    u32x4 w; w.x = cvt_pk_bf16(bflo(g.x) * fast_sigmoid(a0[0]), bfhi(g.x) * fast_sigmoid(a0[1])); w.y = cvt_pk_bf16(bflo(g.y) * fast_sigmoid(a0[2]), bfhi(g.y) * fast_sigmoid(a0[3]));
                    w.z = cvt_pk_bf16(bflo(g.z) * fast_sigmoid(a1[0]), bfhi(g.z) * fast_sigmoid(a1[1])); w.w = cvt_pk_bf16(bflo(g.w) * fast_sigmoid(a1[2]), bfhi(g.w) * fast_sigmoid(a1[3]));
                    *(u32x4*)(O + (size_t)row * 2048 + col0 + bj * HALF) = w; } }
    }
};
struct EpiResid {
    static constexpr bool PERM = false, AFTER_DRAIN = false;
    const float* base; float* out; const float* gate;
    __device__ __forceinline__ void operator()(const f32x4 (&acc)[2][2][4][2], const Unit& u, int wr, int wc, int fr, int fq) const {
        const int col0 = u.pn * BM + wc * 32 + 4 * fq; const int b = u.pm >> 3;
        f32x4 gv[2][2];
#pragma unroll
        for (int bj = 0; bj < 2; ++bj)
#pragma unroll
            for (int n = 0; n < 2; ++n) gv[bj][n] = *(const f32x4*)(gate + (size_t)b * 12288 + col0 + bj * HALF + n * 16);
#pragma unroll
        for (int ai = 0; ai < 2; ++ai)
#pragma unroll
            for (int m = 0; m < 4; ++m) { const size_t off = (size_t)(u.pm * BM + ai * HALF + wr * 64 + m * 16 + fr) * 2048 + col0;
#pragma unroll
                for (int bj = 0; bj < 2; ++bj)
#pragma unroll
                    for (int n = 0; n < 2; ++n) { const f32x4 bs = *(const f32x4*)(base + off + bj * HALF + n * 16);
                        *(f32x4*)(out + off + bj * HALF + n * 16) = bs + gv[bj][n] * acc[ai][bj][m][n]; } }
    }
};
template <int MODE> struct EpiNormX {
    static constexpr bool PERM = true, AFTER_DRAIN = true;
    const float* base; float* xout; bf16_t* hout; const float* gate; const float* gvec; const float* scv; const float* shv; float* slots; unsigned* cnt; bf16_t* xb;
    __device__ __forceinline__ void fused(f32x4 (&acc)[2][2][4][2], const Unit& u, int wr, int wc, int fr, int fq, PG8_LAS unsigned char* lds, int wid, int lane) const {
        PG8_LAS float* P = (PG8_LAS float*)lds; PG8_LAS float* S = (PG8_LAS float*)(lds + 8192); PG8_LAS unsigned* flag = (PG8_LAS unsigned*)(lds + 8192 + 2048);
        const int col0 = u.pn * BM + wc * 32 + 8 * fq; const int b = u.pm >> 3; const int tid = wid * 64 + lane;
        { f32x4 gv[2][2];
#pragma unroll
          for (int bj = 0; bj < 2; ++bj)
#pragma unroll
              for (int n = 0; n < 2; ++n) gv[bj][n] = *(const f32x4*)(gate + (size_t)b * 12288 + col0 + bj * HALF + 4 * n);
#pragma unroll
          for (int ai = 0; ai < 2; ++ai)
#pragma unroll
              for (int m = 0; m < 4; ++m) { const int r = ai * HALF + wr * 64 + m * 16 + fr; const size_t off = (size_t)(u.pm * BM + r) * 2048 + col0; float sq = 0.f;
#pragma unroll
                  for (int bj = 0; bj < 2; ++bj) { u32x4 xw; if (MODE == 1) xw = __builtin_nontemporal_load((const u32x4*)(xb + off + bj * HALF));
#pragma unroll
                      for (int n = 0; n < 2; ++n) { f32x4 bs;
                          if (MODE == 1) { const unsigned w0 = n ? xw.z : xw.x, w1 = n ? xw.w : xw.y; bs = (f32x4){bflo(w0), bfhi(w0), bflo(w1), bfhi(w1)}; }
                          else bs = __builtin_nontemporal_load((const f32x4*)(base + off + bj * HALF + 4 * n));
                          const f32x4 v = bs + gv[bj][n] * acc[ai][bj][m][n]; acc[ai][bj][m][n] = v;
                          sq += (v[0] * v[0] + v[1] * v[1]) + (v[2] * v[2] + v[3] * v[3]); } }
                  sq += __shfl_xor(sq, 16); sq += __shfl_xor(sq, 32);
                  if (fq == 0) P[r * 4 + wc] = sq;
                  if (m & 1) asm volatile("" ::: "memory"); } }
        asm volatile("s_waitcnt lgkmcnt(0)" ::: "memory"); __builtin_amdgcn_s_barrier(); asm volatile("" ::: "memory");
        if (tid < 256) { const float tot = (P[tid * 4 + 0] + P[tid * 4 + 1]) + (P[tid * 4 + 2] + P[tid * 4 + 3]);
            unsigned* sl = (unsigned*)slots + ((size_t)(u.pm * 8 + u.pn) * 256 + tid);
            __hip_atomic_store(sl, __float_as_uint(tot), __ATOMIC_RELAXED, __HIP_MEMORY_SCOPE_AGENT);
            asm volatile("s_waitcnt vmcnt(0)" ::: "memory");
            const unsigned rb = __hip_atomic_load(sl, __ATOMIC_RELAXED, __HIP_MEMORY_SCOPE_AGENT);
            asm volatile("s_waitcnt vmcnt(0)" :: "v"(rb) : "memory"); }
        asm volatile("s_waitcnt vmcnt(0)" ::: "memory");
        if (wid < 4 && lane == 0) __hip_atomic_fetch_add(cnt + 64 * u.pm, 1u, __ATOMIC_RELAXED, __HIP_MEMORY_SCOPE_AGENT);
        if (wid == 0) { unsigned sp = 0u;
            while ((unsigned)__builtin_amdgcn_readfirstlane((int)__hip_atomic_load(cnt + 64 * u.pm, __ATOMIC_RELAXED, __HIP_MEMORY_SCOPE_AGENT)) < 32u) { __builtin_amdgcn_s_sleep(2); if (++sp > (1u << 22)) break; }
            if (lane == 0) flag[0] = sp; }
        asm volatile("s_waitcnt vmcnt(0) lgkmcnt(0)" ::: "memory"); __builtin_amdgcn_s_barrier(); asm volatile("" ::: "memory");
        if (tid < 256) { float tot = 0.f;
#pragma unroll
            for (int t = 0; t < 8; ++t) tot += __uint_as_float(__hip_atomic_load((unsigned*)slots + ((size_t)(u.pm * 8 + t) * 256 + tid), __ATOMIC_RELAXED, __HIP_MEMORY_SCOPE_AGENT));
            S[tid] = 1.0f / sqrtf(tot * (1.0f / 2048.0f) + 1e-6f); }
        asm volatile("s_waitcnt vmcnt(0) lgkmcnt(0)" ::: "memory"); __builtin_amdgcn_s_barrier(); asm volatile("" ::: "memory");
        f32x4 ga[2][2], sh[2][2];
#pragma unroll
        for (int bj = 0; bj < 2; ++bj)
#pragma unroll
            for (int n = 0; n < 2; ++n) { const int c = col0 + bj * HALF + 4 * n; ga[bj][n] = *(const f32x4*)(gvec + c);
                if (MODE == 0) { ga[bj][n] = ga[bj][n] * (*(const f32x4*)(scv + (size_t)b * 12288 + c) + 1.0f); sh[bj][n] = *(const f32x4*)(shv + (size_t)b * 12288 + c); } }
#pragma unroll
        for (int ai = 0; ai < 2; ++ai)
#pragma unroll
            for (int m = 0; m < 4; ++m) { const int r = ai * HALF + wr * 64 + m * 16 + fr; const size_t off = (size_t)(u.pm * BM + r) * 2048 + col0; const float rstd = S[r];
#pragma unroll
                for (int bj = 0; bj < 2; ++bj) { const f32x4 v0 = acc[ai][bj][m][0], v1 = acc[ai][bj][m][1];
                    if (MODE == 0) { { u32x4 xw; xw.x = cvt_pk_bf16(v0[0], v0[1]); xw.y = cvt_pk_bf16(v0[2], v0[3]); xw.z = cvt_pk_bf16(v1[0], v1[1]); xw.w = cvt_pk_bf16(v1[2], v1[3]); *(u32x4*)(xb + off + bj * HALF) = xw; }
                        const f32x4 h0 = v0 * rstd * ga[bj][0] + sh[bj][0], h1 = v1 * rstd * ga[bj][1] + sh[bj][1];
                        u32x4 w; w.x = cvt_pk_bf16(h0[0], h0[1]); w.y = cvt_pk_bf16(h0[2], h0[3]); w.z = cvt_pk_bf16(h1[0], h1[1]); w.w = cvt_pk_bf16(h1[2], h1[3]);
                        *(u32x4*)(hout + off + bj * HALF) = w; }
                    else { *(f32x4*)(xout + off + bj * HALF) = v0 * rstd * ga[bj][0]; *(f32x4*)(xout + off + bj * HALF + 4) = v1 * rstd * ga[bj][1]; } }
                asm volatile("" ::: "memory"); }
    }
};
struct EpiGluNorm {
    static constexpr bool PERM = true, AFTER_DRAIN = true;
    bf16_t* O; const bf16_t* VG; const float* bias; float* slots; unsigned* cnt;
    __device__ __forceinline__ void fused(f32x4 (&acc)[2][2][4][2], const Unit& u, int wr, int wc, int fr, int fq, PG8_LAS unsigned char* lds, int wid, int lane) const {
        PG8_LAS float* P = (PG8_LAS float*)lds; PG8_LAS float* S = (PG8_LAS float*)(lds + 8192); PG8_LAS unsigned* flag = (PG8_LAS unsigned*)(lds + 8192 + 2048);
        const int col0 = u.pn * BM + wc * 32 + 8 * fq; const int tid = wid * 64 + lane;
        { f32x4 bv[2][2];
#pragma unroll
          for (int bj = 0; bj < 2; ++bj)
#pragma unroll
              for (int n = 0; n < 2; ++n) bv[bj][n] = *(const f32x4*)(bias + col0 + bj * HALF + 4 * n);
#pragma unroll
          for (int ai = 0; ai < 2; ++ai)
#pragma unroll
              for (int m = 0; m < 4; ++m) { const int r = ai * HALF + wr * 64 + m * 16 + fr; const size_t row = (size_t)(u.pm * BM + r); float sq = 0.f;
#pragma unroll
                  for (int bj = 0; bj < 2; ++bj) { const u32x4 g = *(const u32x4*)(VG + row * 1024 + col0 + bj * HALF);
                      const f32x4 a0 = acc[ai][bj][m][0] + bv[bj][0], a1 = acc[ai][bj][m][1] + bv[bj][1];
                      const f32x4 v0 = {bflo(g.x) * fast_sigmoid(a0[0]), bfhi(g.x) * fast_sigmoid(a0[1]), bflo(g.y) * fast_sigmoid(a0[2]), bfhi(g.y) * fast_sigmoid(a0[3])};
                      const f32x4 v1 = {bflo(g.z) * fast_sigmoid(a1[0]), bfhi(g.z) * fast_sigmoid(a1[1]), bflo(g.w) * fast_sigmoid(a1[2]), bfhi(g.w) * fast_sigmoid(a1[3])};
                      acc[ai][bj][m][0] = v0; acc[ai][bj][m][1] = v1;
                      sq += ((v0[0] * v0[0] + v0[1] * v0[1]) + (v0[2] * v0[2] + v0[3] * v0[3])) + ((v1[0] * v1[0] + v1[1] * v1[1]) + (v1[2] * v1[2] + v1[3] * v1[3])); }
                  sq += __shfl_xor(sq, 16); sq += __shfl_xor(sq, 32);
                  if (fq == 0) P[r * 4 + wc] = sq;
                  if (m & 1) asm volatile("" ::: "memory"); } }
        asm volatile("s_waitcnt lgkmcnt(0)" ::: "memory"); __builtin_amdgcn_s_barrier(); asm volatile("" ::: "memory");
        if (tid < 256) { const float tot = (P[tid * 4 + 0] + P[tid * 4 + 1]) + (P[tid * 4 + 2] + P[tid * 4 + 3]);
            unsigned* sl = (unsigned*)slots + ((size_t)(u.pm * 4 + u.pn) * 256 + tid);
            __hip_atomic_store(sl, __float_as_uint(tot), __ATOMIC_RELAXED, __HIP_MEMORY_SCOPE_AGENT);
            asm volatile("s_waitcnt vmcnt(0)" ::: "memory");
            const unsigned rb = __hip_atomic_load(sl, __ATOMIC_RELAXED, __HIP_MEMORY_SCOPE_AGENT);
            asm volatile("s_waitcnt vmcnt(0)" :: "v"(rb) : "memory"); }
        asm volatile("s_waitcnt vmcnt(0)" ::: "memory");
        if (wid < 4 && lane == 0) __hip_atomic_fetch_add(cnt + 64 * u.pm, 1u, __ATOMIC_RELAXED, __HIP_MEMORY_SCOPE_AGENT);
        if (wid == 0) { unsigned sp = 0u;
            while ((unsigned)__builtin_amdgcn_readfirstlane((int)__hip_atomic_load(cnt + 64 * u.pm, __ATOMIC_RELAXED, __HIP_MEMORY_SCOPE_AGENT)) < 16u) { __builtin_amdgcn_s_sleep(2); if (++sp > (1u << 22)) break; }
            __builtin_amdgcn_fence(__ATOMIC_ACQUIRE, "agent");
            if (lane == 0) flag[0] = sp; }
        asm volatile("s_waitcnt vmcnt(0) lgkmcnt(0)" ::: "memory"); __builtin_amdgcn_s_barrier(); asm volatile("" ::: "memory");
        if (tid < 256) { float tot = 0.f;
#pragma unroll
            for (int t = 0; t < 4; ++t) tot += __uint_as_float(__hip_atomic_load((unsigned*)slots + ((size_t)(u.pm * 4 + t) * 256 + tid), __ATOMIC_RELAXED, __HIP_MEMORY_SCOPE_AGENT));
            S[tid] = 1.0f / sqrtf(tot * (1.0f / 1024.0f) + 1e-6f); }
        asm volatile("s_waitcnt vmcnt(0) lgkmcnt(0)" ::: "memory"); __builtin_amdgcn_s_barrier(); asm volatile("" ::: "memory");
#pragma unroll
        for (int ai = 0; ai < 2; ++ai)
#pragma unroll
            for (int m = 0; m < 4; ++m) { const int r = ai * HALF + wr * 64 + m * 16 + fr; const size_t row = (size_t)(u.pm * BM + r); const float rstd = S[r];
#pragma unroll
                for (int bj = 0; bj < 2; ++bj) { const f32x4 v0 = acc[ai][bj][m][0] * rstd, v1 = acc[ai][bj][m][1] * rstd;
                    u32x4 w; w.x = cvt_pk_bf16(v0[0], v0[1]); w.y = cvt_pk_bf16(v0[2], v0[3]); w.z = cvt_pk_bf16(v1[0], v1[1]); w.w = cvt_pk_bf16(v1[2], v1[3]);
                    *(u32x4*)(O + row * 2048 + col0 + bj * HALF) = w; } }
    }
};
struct EpiSwiglu {
    static constexpr bool PERM = true, AFTER_DRAIN = false;
    bf16_t* O;
    __device__ __forceinline__ void operator()(const f32x4 (&acc)[2][2][4][2], const Unit& u, int wr, int wc, int fr, int fq) const {
        const int row0 = u.pm * BM + wr * 64 + fr; const int col0 = u.pn * HALF + wc * 32 + 8 * fq;
#pragma unroll
        for (int ai = 0; ai < 2; ++ai)
#pragma unroll
            for (int m = 0; m < 4; ++m) { const int row = row0 + ai * HALF + m * 16;
                const f32x4 g0 = acc[ai][0][m][0], g1 = acc[ai][0][m][1], u0 = acc[ai][1][m][0], u1 = acc[ai][1][m][1];
                f32x4 v0, v1;
#pragma unroll
                for (int i = 0; i < 4; ++i) { v0[i] = g0[i] * fast_sigmoid(g0[i]) * u0[i]; v1[i] = g1[i] * fast_sigmoid(g1[i]) * u1[i]; }
                u32x4 w; w.x = cvt_pk_bf16(v0[0], v0[1]); w.y = cvt_pk_bf16(v0[2], v0[3]); w.z = cvt_pk_bf16(v1[0], v1[1]); w.w = cvt_pk_bf16(v1[2], v1[3]);
                *(u32x4*)(O + (size_t)row * 5632 + col0) = w; }
    }
};

template <class Epi, class Sched, bool ALIGN_EPI = false, bool SP2 = false>
__device__ __forceinline__ void gemm_phase(PG8_LAS unsigned char* lds, const Gemm g, const Sched& S, const Epi& E) {
    const int tid = threadIdx.x, wid = __builtin_amdgcn_readfirstlane(tid >> 6), lane = tid & 63, wr = wid >> 2, wc = wid & 3, fr = lane & 15, fq = lane >> 4;
    const int K = g.K, nt = K / BK;
    unsigned voffA[2], voffB[2];
#pragma unroll
    for (int i = 0; i < 2; ++i) { int R, C; stage_rc(tid * 16 + i * 8192, R, C); const int Rb = Epi::PERM ? ((R & ~31) + perm32(R & 31)) : R;
        voffA[i] = (unsigned)(R * K + C) * 2u; voffB[i] = (unsigned)(Rb * K + C) * 2u; }
    const size_t kstep = (size_t)(BK * 2);
    const size_t hstep = (size_t)HALF * K * 2;
    const size_t tstep = 2 * hstep;
    const unsigned ldsw = (unsigned)wid * 1024u;
    const int aoff = lds_byte(wr * 64 + fr, fq * 8), boff = lds_byte(wc * 32 + fr, fq * 8);
#define PG8_SA(b, h) (((b) * 2 + (h)) * HTB)
#define PG8_SB(b, h) ((4 + (b) * 2 + (h)) * HTB)
#define PG8_STAGE(bufoff, gbase, voff) do { _Pragma("unroll") for (int _i = 0; _i < 2; ++_i) \
        __builtin_amdgcn_global_load_lds((const unsigned*)((const char*)(gbase) + (voff)[_i]), (PG8_LAS unsigned*)(lds + (bufoff) + ldsw + _i * 8192), 16, 0, 0); } while (0)
#define PG8_LDA(dst, b, h) do { _Pragma("unroll") for (int m = 0; m < 4; ++m) _Pragma("unroll") for (int k = 0; k < 2; ++k) dst[m][k] = *(const PG8_LAS bf16x8*)(lds + PG8_SA(b, h) + aoff + m * 2048 + k * 1024); } while (0)
#define PG8_LDB(dst, b, h) do { _Pragma("unroll") for (int n = 0; n < 2; ++n) _Pragma("unroll") for (int k = 0; k < 2; ++k) dst[n][k] = *(const PG8_LAS bf16x8*)(lds + PG8_SB(b, h) + boff + n * 2048 + k * 1024); } while (0)
#define PG8_MMA(ai, bj, At, Bt) do { __builtin_amdgcn_s_setprio(1); _Pragma("unroll") for (int m = 0; m < 4; ++m) _Pragma("unroll") for (int n = 0; n < 2; ++n) _Pragma("unroll") for (int k = 0; k < 2; ++k) \
        acc[ai][bj][m][n] = __builtin_amdgcn_mfma_f32_16x16x32_bf16(Bt[n][k], At[m][k], acc[ai][bj][m][n], 0, 0, 0); __builtin_amdgcn_s_setprio(0); } while (0)
#define PG8_WAIT_V(n) asm volatile("s_waitcnt vmcnt(" #n ")" ::: "memory")
#define PG8_WAIT_L(n) asm volatile("s_waitcnt lgkmcnt(" #n ")" ::: "memory")
#define PG8_BAR __builtin_amdgcn_s_barrier()
#define PG8_SCHED __builtin_amdgcn_sched_barrier(0)
    Unit cur, nxt; int ui = 0;
    if (!S.next(0, cur)) return;
    f32x4 acc[2][2][4][2];
#pragma unroll
    for (int a = 0; a < 2; ++a)
#pragma unroll
        for (int b = 0; b < 2; ++b)
#pragma unroll
            for (int m = 0; m < 4; ++m)
#pragma unroll
                for (int n = 0; n < 2; ++n) acc[a][b][m][n] = (f32x4){0.f, 0.f, 0.f, 0.f};
    bf16x8 At[4][2], B0[2][2], B1[2][2];
    const char* cA = (const char*)g.A + (size_t)cur.pm * tstep; const char* cB = (const char*)g.Bt + (size_t)cur.pn * tstep;
    S.a_ready(cur);
    if constexpr (SP2) {
        PG8_STAGE(PG8_SB(0, 0), cB, voffB); PG8_STAGE(PG8_SB(0, 1), cB + hstep, voffB); PG8_STAGE(PG8_SA(0, 0), cA, voffA); PG8_STAGE(PG8_SA(0, 1), cA + hstep, voffA);
        if (wr == 1) PG8_BAR;
        PG8_WAIT_V(2); PG8_BAR;
        PG8_STAGE(PG8_SB(1, 0), cB + kstep, voffB); PG8_STAGE(PG8_SA(1, 0), cA + kstep, voffA); PG8_STAGE(PG8_SB(1, 1), cB + hstep + kstep, voffB);
        PG8_WAIT_V(6); PG8_BAR;
    } else {
        PG8_STAGE(PG8_SB(0, 0), cB, voffB); PG8_STAGE(PG8_SA(0, 0), cA, voffA); PG8_STAGE(PG8_SB(0, 1), cB + hstep, voffB); PG8_STAGE(PG8_SA(0, 1), cA + hstep, voffA);
        if (wr == 1) PG8_BAR;
        PG8_WAIT_V(4); PG8_BAR;
        PG8_STAGE(PG8_SB(1, 0), cB + kstep, voffB); PG8_STAGE(PG8_SA(1, 0), cA + kstep, voffA); PG8_STAGE(PG8_SB(1, 1), cB + hstep + kstep, voffB);
        PG8_WAIT_V(6); PG8_BAR;
    }
    for (;;) {
        const bool has_next = S.next(ui + 1, nxt);
        const char* nA = has_next ? (const char*)g.A + (size_t)nxt.pm * tstep : cA; const char* nB = has_next ? (const char*)g.Bt + (size_t)nxt.pn * tstep : cB;
        for (int t = 0; t < nt; t += 2) {
            const bool last = (t == nt - 2);
            const char* a1 = cA + (size_t)(t + 1) * kstep;
            const char* a2 = last ? nA : cA + (size_t)(t + 2) * kstep; const char* b2 = last ? nB : cB + (size_t)(t + 2) * kstep;
            const char* a3 = a2 + kstep; const char* b3 = b2 + kstep;
            if (last && has_next) S.a_ready(nxt);
            if constexpr (SP2) {
            PG8_LDB(B0, 0, 0); PG8_LDB(B1, 0, 1); PG8_SCHED; PG8_LDA(At, 0, 0); PG8_STAGE(PG8_SA(1, 1), a1 + hstep, voffA);
            PG8_WAIT_V(8); PG8_WAIT_L(0); PG8_BAR; PG8_MMA(0, 0, At, B0); PG8_MMA(0, 1, At, B1); PG8_BAR; PG8_SCHED;
            PG8_LDA(At, 0, 1); PG8_STAGE(PG8_SB(0, 0), b2, voffB); PG8_STAGE(PG8_SB(0, 1), b2 + hstep, voffB); PG8_STAGE(PG8_SA(0, 0), a2, voffA);
            PG8_WAIT_V(8); PG8_WAIT_L(0); PG8_BAR; PG8_MMA(1, 0, At, B0); PG8_MMA(1, 1, At, B1); PG8_BAR; PG8_SCHED;
            PG8_LDB(B0, 1, 0); PG8_LDB(B1, 1, 1); PG8_SCHED; PG8_LDA(At, 1, 0); PG8_STAGE(PG8_SA(0, 1), a2 + hstep, voffA);
            PG8_WAIT_V(8); PG8_WAIT_L(0); PG8_BAR; PG8_MMA(0, 0, At, B0); PG8_MMA(0, 1, At, B1); PG8_BAR; PG8_SCHED;
            PG8_LDA(At, 1, 1); PG8_STAGE(PG8_SB(1, 0), b3, voffB); PG8_STAGE(PG8_SB(1, 1), b3 + hstep, voffB); PG8_STAGE(PG8_SA(1, 0), a3, voffA);
            PG8_WAIT_V(8); PG8_WAIT_L(0); PG8_BAR; PG8_MMA(1, 0, At, B0); PG8_MMA(1, 1, At, B1); PG8_BAR; PG8_SCHED;
            } else {
            PG8_LDB(B0, 0, 0); PG8_SCHED; PG8_LDA(At, 0, 0); PG8_STAGE(PG8_SA(1, 1), a1 + hstep, voffA);
            PG8_WAIT_L(8); PG8_BAR; PG8_WAIT_L(0); PG8_MMA(0, 0, At, B0); PG8_BAR; PG8_SCHED;
            PG8_LDB(B1, 0, 1); PG8_STAGE(PG8_SB(0, 0), b2, voffB);
            PG8_BAR; PG8_WAIT_L(0); PG8_MMA(0, 1, At, B1); PG8_BAR;
            PG8_LDA(At, 0, 1); PG8_STAGE(PG8_SA(0, 0), a2, voffA);
            PG8_BAR; PG8_WAIT_L(0); PG8_MMA(1, 0, At, B0); PG8_BAR; PG8_SCHED;
            PG8_STAGE(PG8_SB(0, 1), b2 + hstep, voffB);
            PG8_WAIT_V(6); PG8_BAR; PG8_MMA(1, 1, At, B1); PG8_BAR;
            PG8_LDB(B0, 1, 0); PG8_SCHED; PG8_LDA(At, 1, 0); PG8_STAGE(PG8_SA(0, 1), a2 + hstep, voffA);
            PG8_WAIT_L(8); PG8_BAR; PG8_WAIT_L(0); PG8_MMA(0, 0, At, B0); PG8_BAR; PG8_SCHED;
            PG8_LDB(B1, 1, 1); PG8_STAGE(PG8_SB(1, 0), b3, voffB);
            PG8_BAR; PG8_WAIT_L(0); PG8_MMA(0, 1, At, B1); PG8_BAR;
            PG8_LDA(At, 1, 1); PG8_STAGE(PG8_SA(1, 0), a3, voffA);
            PG8_BAR; PG8_WAIT_L(0); PG8_MMA(1, 0, At, B0); PG8_BAR; PG8_SCHED;
            PG8_STAGE(PG8_SB(1, 1), b3 + hstep, voffB);
            PG8_WAIT_V(6); PG8_BAR; PG8_MMA(1, 1, At, B1); PG8_BAR;
            }
        }
        if constexpr (ALIGN_EPI) { if (wr == 0) PG8_BAR; }
        if constexpr (!Epi::AFTER_DRAIN) { E(acc, cur, wr, wc, fr, fq); S.done(cur); }
        if (!has_next) break;
#pragma unroll
        for (int a = 0; a < 2; ++a)
#pragma unroll
            for (int b = 0; b < 2; ++b)
#pragma unroll
                for (int m = 0; m < 4; ++m)
#pragma unroll
                    for (int n = 0; n < 2; ++n) acc[a][b][m][n] = (f32x4){0.f, 0.f, 0.f, 0.f};
        cur = nxt; cA = nA; cB = nB; ++ui;
        if constexpr (ALIGN_EPI) { if (wr == 1) PG8_BAR; }
    }
    PG8_WAIT_V(0);
    if constexpr (!ALIGN_EPI) { if (wr == 0) PG8_BAR; }
    PG8_BAR;
    if constexpr (Epi::AFTER_DRAIN) { E.fused(acc, cur, wr, wc, fr, fq, lds, wid, lane); S.done(cur); }
#undef PG8_SA
#undef PG8_SB
#undef PG8_STAGE
#undef PG8_LDA
#undef PG8_LDB
#undef PG8_MMA
#undef PG8_WAIT_V
#undef PG8_WAIT_L
#undef PG8_BAR
#undef PG8_SCHED
}
}

constexpr int NWAVES = 8;
constexpr int BATCH = 4, SEQ = 2048, DM = 2048, MTOK = BATCH * SEQ, SSMW = 1024, ATTW = 1024, NGRP = 64, NST = 64, NHEAD = 8, HDIM = 128, DFF = 5632, PROJW = 4096, NMODW = 6 * DM;
constexpr int KSPLIT = 32;
constexpr size_t MiB = 1u << 20;
constexpr size_t WS_MODP = 2 * MiB, WS_MODF = 8 * MiB, WS_ROPE = 9 * MiB, WS_KTAB = 13 * MiB, WS_GTAB = 16 * MiB, WS_HTAB = 32 * MiB, WS_A64 = 48 * MiB;
constexpr size_t WS_WIN = 49 * MiB, WS_WGLU = 65 * MiB, WS_WOUT = 67 * MiB, WS_WGU = 75 * MiB, WS_WDN = 119 * MiB, WS_H = 141 * MiB, WS_PROJ = 173 * MiB, WS_VG = 237 * MiB;
constexpr size_t WS_YCAT = 253 * MiB, WS_OBR = 285 * MiB, WS_LSE = 333 * MiB, WS_FF = 173 * MiB, WS_UT = 334 * MiB, WS_END = 350 * MiB;
static_assert(WS_FF + (size_t)MTOK * DFF * 2 <= WS_OBR, "ff overlay");
constexpr int LDS_BYTES = 147456, MISC_OFF = 147456 - 256;
constexpr size_t WS_CTL = 0, CTL_ZERO_BYTES = 57344, WS_CNT = 16384, WS_PCNT = 32768, WS_GCNT = 49152  , WS_SLOTS = 1u << 20;

#define GAS __attribute__((address_space(1)))
#define LAS __attribute__((address_space(3)))
typedef unsigned short bf16;
typedef unsigned v4u __attribute__((ext_vector_type(4)));
typedef unsigned v2u __attribute__((ext_vector_type(2)));
typedef float f32x4 __attribute__((ext_vector_type(4)));
typedef float f32x16 __attribute__((ext_vector_type(16)));
typedef short bf16x8 __attribute__((ext_vector_type(8)));
typedef short s16x4 __attribute__((ext_vector_type(4)));
#define LDS_WAIT() asm volatile("s_waitcnt lgkmcnt(0)" ::: "memory")
__device__ __forceinline__ unsigned f2bf(float f) { unsigned u = __builtin_bit_cast(unsigned, f); return (u + 0x7fffu + ((u >> 16) & 1u)) >> 16; }
__device__ __forceinline__ unsigned pk2(float lo, float hi) { return f2bf(lo) | (f2bf(hi) << 16); }
__device__ __forceinline__ float bf_lo(unsigned w) { return __uint_as_float(w << 16); }
__device__ __forceinline__ float bf_hi(unsigned w) { return __uint_as_float(w & 0xffff0000u); }
__device__ __forceinline__ float wave_sum(float v) {
#pragma unroll
    for (int o = 1; o < 64; o <<= 1) v += __shfl_xor(v, o);
    return v;
}

struct Args { const float* in[25]; float* out; unsigned char* ws; int ph_lo, ph_hi; };

template <int MODE>
__device__ __forceinline__ void p0_transpose_item(const float* __restrict__ W, int K, int N, bf16* WT, LAS float* scr, int item, int lane, const float* gs, const float* ga) {
    const int nblk = N / 64, kb = item / nblk, nb = item % nblk, k0 = 64 * kb, n0 = 64 * nb;
    const int lr = lane >> 4, lc = lane & 15;
    f32x4 v[16];
#pragma unroll
    for (int i = 0; i < 16; ++i) v[i] = __builtin_nontemporal_load((const f32x4*)(W + (size_t)(k0 + 4 * i + lr) * N + n0 + 4 * lc));
#pragma unroll
    for (int i = 0; i < 16; ++i) { const int kk = 4 * i + lr; f32x4 t = v[i];
        if (MODE == 4) { const int k = k0 + kk; t = t * ((k < SSMW) ? gs[k] : ga[k - SSMW]); }
        LAS float* d = scr + kk * 65 + 4 * lc; d[0] = t.x; d[1] = t.y; d[2] = t.z; d[3] = t.w; }
    LDS_WAIT(); asm volatile("" ::: "memory");
    const int c = lane & 7;
#pragma unroll
    for (int j = 0; j < 8; ++j) { const int n = (lane >> 3) + 8 * j; const LAS float* s = scr + (8 * c) * 65 + n;
        v4u o; o.x = pk2(s[0 * 65], s[1 * 65]); o.y = pk2(s[2 * 65], s[3 * 65]); o.z = pk2(s[4 * 65], s[5 * 65]); o.w = pk2(s[6 * 65], s[7 * 65]);
        int col = n0 + n, row = col;
        if (MODE == 1) { if (col >= 1024 && col < 3072) { const int e = col & 127, half = e >> 6, ep = e & 63; row = (col - e) + ((ep >> 2) << 3) + (half << 2) + (ep & 3); } }
        if (MODE == 2) row = (col >> 7) * 256 + (col & 127);
        if (MODE == 3) row = (col >> 7) * 256 + 128 + (col & 127);
        *(GAS v4u*)(WT + (size_t)row * K + k0 + 8 * c) = o; }
    LDS_WAIT(); asm volatile("" ::: "memory");
}
__device__ __forceinline__ void wt_readback(const unsigned long long* p0, const unsigned long long* p1) {
    const unsigned long long a = __hip_atomic_load(p0, __ATOMIC_RELAXED, __HIP_MEMORY_SCOPE_AGENT), b = __hip_atomic_load(p1, __ATOMIC_RELAXED, __HIP_MEMORY_SCOPE_AGENT);
    asm volatile("s_waitcnt vmcnt(0)" :: "v"(a), "v"(b) : "memory");
}
__device__ __forceinline__ void p0_gemv_item(const float* __restrict__ cvec, const float* __restrict__ wmod, float* modp, float* modf, const float* __restrict__ bmod, unsigned* cnt, LAS float* scr, int item, int lane) {
    const int ks = item / 48, cb = item % 48, k0 = ks * 64, col = cb * 256 + lane * 4;
#pragma unroll
    for (int b = 0; b < 4; ++b) { const float v = cvec[b * DM + k0 + lane]; scr[lane * 4 + b] = v / (1.0f + __expf(-v)); }
    LDS_WAIT(); asm volatile("" ::: "memory");
    f32x4 a0 = {0, 0, 0, 0}, a1 = a0, a2 = a0, a3 = a0;
#pragma unroll 16
    for (int k = 0; k < 64; ++k) { const f32x4 w = __builtin_nontemporal_load((const f32x4*)(wmod + (size_t)(k0 + k) * NMODW + col)); const f32x4 s = *(const LAS f32x4*)(scr + 4 * k);
        a0 += w * s[0]; a1 += w * s[1]; a2 += w * s[2]; a3 += w * s[3]; }
    unsigned long long* o = (unsigned long long*)(modp + (size_t)(ks * 4) * NMODW + col);
#define GV_ST(p, v) do { __hip_atomic_store((p), ((unsigned long long)__float_as_uint((v).y) << 32) | __float_as_uint((v).x), __ATOMIC_RELAXED, __HIP_MEMORY_SCOPE_AGENT); \
                         __hip_atomic_store((p) + 1, ((unsigned long long)__float_as_uint((v).w) << 32) | __float_as_uint((v).z), __ATOMIC_RELAXED, __HIP_MEMORY_SCOPE_AGENT); } while (0)
    GV_ST(o, a0); GV_ST(o + NMODW / 2, a1); GV_ST(o + NMODW, a2); GV_ST(o + 3 * (NMODW / 2), a3);
#undef GV_ST
    LDS_WAIT(); asm volatile("s_waitcnt vmcnt(0)" ::: "memory");
    wt_readback(o, o + 1); wt_readback(o + NMODW / 2, o + NMODW / 2 + 1); wt_readback(o + NMODW, o + NMODW + 1); wt_readback(o + 3 * (NMODW / 2), o + 3 * (NMODW / 2) + 1);
    if (lane == 0) __hip_atomic_fetch_add(cnt + 64 * cb, 1u, __ATOMIC_RELAXED, __HIP_MEMORY_SCOPE_AGENT);
}
__device__ __forceinline__ void p0_fin_item(const float* modp, float* modf, const float* __restrict__ bmod, unsigned* cnt, int item, int lane) {
    const int cb = item >> 2, b = item & 3, col = cb * 256 + lane * 4;
    { unsigned sp = 0u;
      while ((unsigned)__builtin_amdgcn_readfirstlane((int)__hip_atomic_load(cnt + 64 * cb, __ATOMIC_RELAXED, __HIP_MEMORY_SCOPE_AGENT)) < (unsigned)KSPLIT) { __builtin_amdgcn_s_sleep(2); if (++sp > (1u << 22)) break; }
      __builtin_amdgcn_fence(__ATOMIC_ACQUIRE, "agent"); }
    f32x4 t = *(const f32x4*)(bmod + col);
#pragma unroll 8
    for (int k2 = 0; k2 < KSPLIT; ++k2) { const unsigned long long* pp = (const unsigned long long*)(modp + (size_t)(k2 * 4 + b) * NMODW + col);
        const unsigned long long w0 = __hip_atomic_load(pp, __ATOMIC_RELAXED, __HIP_MEMORY_SCOPE_AGENT), w1 = __hip_atomic_load(pp + 1, __ATOMIC_RELAXED, __HIP_MEMORY_SCOPE_AGENT);
        t += (f32x4){__uint_as_float((unsigned)w0), __uint_as_float((unsigned)(w0 >> 32)), __uint_as_float((unsigned)w1), __uint_as_float((unsigned)(w1 >> 32))}; }
    unsigned long long* mo = (unsigned long long*)(modf + (size_t)b * NMODW + col);
    __hip_atomic_store(mo, ((unsigned long long)__float_as_uint(t.y) << 32) | __float_as_uint(t.x), __ATOMIC_RELAXED, __HIP_MEMORY_SCOPE_AGENT);
    __hip_atomic_store(mo + 1, ((unsigned long long)__float_as_uint(t.w) << 32) | __float_as_uint(t.z), __ATOMIC_RELAXED, __HIP_MEMORY_SCOPE_AGENT);
    asm volatile("s_waitcnt vmcnt(0)" ::: "memory");
    wt_readback(mo, mo + 1);
    if (lane == 0) __hip_atomic_fetch_add(cnt + 64 * 48, 1u, __ATOMIC_RELAXED, __HIP_MEMORY_SCOPE_AGENT);
}
__device__ __forceinline__ void p0_rope_item(const int* __restrict__ pos, float* cosT, float* sinT, int item, int lane) {
    const double inv = exp(-(double)lane * (9.210340371976184 / 64.0));
    const double rev = (double)pos[item] * inv * 0.15915494309189535;
    const float x = (float)((rev - rint(rev)) * 6.283185307179586);
    cosT[(size_t)item * 64 + lane] = cosf(x); sinT[(size_t)item * 64 + lane] = sinf(x);
}
struct SsmLane { double lr, li, dt, ar, ai; };
__device__ __forceinline__ SsmLane ssm_lane(const float* are, const float* aim, const float* ldt, int g, int p) {
    SsmLane L; L.dt = exp((double)ldt[g]); L.lr = (double)are[g * 64 + p]; L.li = (double)aim[g * 64 + p];
    const double m = exp(L.lr * L.dt); L.ar = m * cos(L.li * L.dt); L.ai = m * sin(L.li * L.dt); return L; }
__device__ __forceinline__ void ssm_pow(const SsmLane& L, int n, double& zr, double& zi) { const double m = exp(L.lr * L.dt * n), th = L.li * L.dt * n; zr = m * cos(th); zi = m * sin(th); }
__device__ __forceinline__ void ssm_step(const SsmLane& L, double& zr, double& zi) { const double nr = zr * L.ar - zi * L.ai, ni = zr * L.ai + zi * L.ar; zr = nr; zi = ni; }
__device__ __forceinline__ void ssm_bbar(const SsmLane& L, const float* bre, const float* bim, int g, int p, float (&br)[16], float (&bi)[16]) {
    const double nr = L.ar - 1.0, ni = L.ai, den = L.lr * L.lr + L.li * L.li;
    const float fr = (float)((nr * L.lr + ni * L.li) / den), fi = (float)((ni * L.lr - nr * L.li) / den);
    const f32x4* pr = (const f32x4*)(bre + (size_t)(g * 64 + p) * 16); const f32x4* pi = (const f32x4*)(bim + (size_t)(g * 64 + p) * 16);
#pragma unroll
    for (int q = 0; q < 4; ++q) { const f32x4 r = pr[q], i = pi[q];
#pragma unroll
        for (int e = 0; e < 4; ++e) { br[4 * q + e] = fr * r[e] - fi * i[e]; bi[4 * q + e] = fr * i[e] + fi * r[e]; } }
}
__device__ __forceinline__ void p0_ktab_item(const float* const* in, bf16* ktab, float* a64, LAS float* scr, int g, int ch, int lane) {
    const SsmLane L = ssm_lane(in[7], in[8], in[9], g, lane);
    float br[16], bi[16]; ssm_bbar(L, in[10], in[11], g, lane, br, bi);
    double zr, zi; ssm_pow(L, ch == 0 ? 0 : 8 * ch - 1, zr, zi);
    const int c = lane >> 2, q = lane & 3; const float* cr = in[12] + (size_t)(g * 16 + c) * 64; const float* ci = in[13] + (size_t)(g * 16 + c) * 64;
    for (int e = 0; e < 8; ++e) { const int ti = 8 * ch + e; if (ti > 64) break;
        if (ti == 0) { double wr, wi; ssm_pow(L, 64, wr, wi); a64[(g * 64 + lane) * 2] = (float)wr; a64[(g * 64 + lane) * 2 + 1] = (float)wi;
            *(GAS v2u*)(ktab + (size_t)(g * 65) * 256 + lane * 4) = (v2u){0u, 0u}; continue; }
        const float fzr = (float)zr, fzi = (float)zi;
#pragma unroll
        for (int k = 0; k < 16; ++k) { scr[lane * 16 + k] = fzr * br[k] - fzi * bi[k]; scr[1024 + lane * 16 + k] = fzr * bi[k] + fzi * br[k]; }
        LDS_WAIT(); asm volatile("" ::: "memory");
        f32x4 acc = {0, 0, 0, 0};
#pragma unroll 8
        for (int p = 0; p < 64; ++p) { const f32x4 wr = *(const LAS f32x4*)(scr + p * 16 + 4 * q), wi = *(const LAS f32x4*)(scr + 1024 + p * 16 + 4 * q); acc += wr * cr[p] - wi * ci[p]; }
        *(GAS v2u*)(ktab + ((size_t)(g * 65 + ti) * 16 + c) * 16 + 4 * q) = (v2u){pk2(acc[0], acc[1]), pk2(acc[2], acc[3])};
        LDS_WAIT(); asm volatile("" ::: "memory");
        ssm_step(L, zr, zi); }
}
__device__ __forceinline__ void p0_gtab_item(const float* const* in, bf16* gtab, int g, int ch, int lane) {
    const SsmLane L = ssm_lane(in[7], in[8], in[9], g, lane); double dzr, dzi; ssm_pow(L, 8 * ch + 1, dzr, dzi);
    const int p = lane;
    float cr[16], ci[16];
#pragma unroll
    for (int c = 0; c < 16; ++c) { cr[c] = in[12][(size_t)(g * 16 + c) * 64 + p]; ci[c] = in[13][(size_t)(g * 16 + c) * 64 + p]; }
    for (int e = 0; e < 8; ++e) { const int t = 8 * ch + e; const float zr = (float)dzr, zi = (float)dzi;
        const size_t base = ((size_t)(g * 32 + (t >> 1)) * 8) * 512;
#pragma unroll
        for (int c = 0; c < 16; ++c) { const float gre = cr[c] * zr - ci[c] * zi, gni = -(cr[c] * zi + ci[c] * zr);
            { const int pp = p;      gtab[base + (size_t)(pp >> 4) * 512 + ((16 * (t & 1) + c) + 32 * ((pp >> 3) & 1)) * 8 + (pp & 7)] = (bf16)f2bf(gre); }
            { const int pp = p + 64; gtab[base + (size_t)(pp >> 4) * 512 + ((16 * (t & 1) + c) + 32 * ((pp >> 3) & 1)) * 8 + (pp & 7)] = (bf16)f2bf(gni); } }
        ssm_step(L, dzr, dzi); }
}
__device__ __forceinline__ void p0_htab_item(const float* const* in, bf16* htab, int g, int ch, int lane) {
    const SsmLane L = ssm_lane(in[7], in[8], in[9], g, lane); double dzr, dzi; ssm_pow(L, 56 - 8 * ch, dzr, dzi);
    float br[16], bi[16]; ssm_bbar(L, in[10], in[11], g, lane, br, bi);
    for (int e = 7; e >= 0; --e) { const int s = 8 * ch + e; const float zr = (float)dzr, zi = (float)dzi;
#pragma unroll
        for (int hh = 0; hh < 2; ++hh) { v4u o, o2;
            o.x = pk2(zr * br[8 * hh] - zi * bi[8 * hh], zr * br[8 * hh + 1] - zi * bi[8 * hh + 1]); o.y = pk2(zr * br[8 * hh + 2] - zi * bi[8 * hh + 2], zr * br[8 * hh + 3] - zi * bi[8 * hh + 3]);
            o.z = pk2(zr * br[8 * hh + 4] - zi * bi[8 * hh + 4], zr * br[8 * hh + 5] - zi * bi[8 * hh + 5]); o.w = pk2(zr * br[8 * hh + 6] - zi * bi[8 * hh + 6], zr * br[8 * hh + 7] - zi * bi[8 * hh + 7]);
            o2.x = pk2(zr * bi[8 * hh] + zi * br[8 * hh], zr * bi[8 * hh + 1] + zi * br[8 * hh + 1]); o2.y = pk2(zr * bi[8 * hh + 2] + zi * br[8 * hh + 2], zr * bi[8 * hh + 3] + zi * br[8 * hh + 3]);
            o2.z = pk2(zr * bi[8 * hh + 4] + zi * br[8 * hh + 4], zr * bi[8 * hh + 5] + zi * br[8 * hh + 5]); o2.w = pk2(zr * bi[8 * hh + 6] + zi * br[8 * hh + 6], zr * bi[8 * hh + 7] + zi * br[8 * hh + 7]);
            { const int pp = lane;      *(GAS v4u*)(htab + ((((size_t)(g * 4 + (pp >> 5)) * 64 + s) * 64) + (pp & 31) + 32 * hh) * 8) = o; }
            { const int pp = lane + 64; *(GAS v4u*)(htab + ((((size_t)(g * 4 + (pp >> 5)) * 64 + s) * 64) + (pp & 31) + 32 * hh) * 8) = o2; } }
        ssm_step(L, dzr, dzi); }
}
#define XB_TMO      128
#define XB_XCNT(j)  (256  + 64 * (j))
#define XB_XSUB(j)  (1280 + 64 * (j))
#define XB_XGEN(j)  (2304 + 64 * (j))
#define XB_TOP      3328
#define XB_TOPGEN   3392
#define XCD_BAR_WORDS 3456
#define XB_SPIN_CAP (1u << 18)

__device__ __forceinline__ unsigned xb_ld(unsigned* p)              { return __hip_atomic_load(p, __ATOMIC_RELAXED, __HIP_MEMORY_SCOPE_AGENT); }
__device__ __forceinline__ unsigned xb_add(unsigned* p, unsigned v) { return __hip_atomic_fetch_add(p, v, __ATOMIC_RELAXED, __HIP_MEMORY_SCOPE_AGENT); }
__device__ __forceinline__ unsigned xb_xcc_id() { return (unsigned)__builtin_amdgcn_s_getreg((3 << 11) | 20) & 0xFu; }
#define XB_SPIN(cond, bar) do { unsigned _sp = 0; while (cond) { __builtin_amdgcn_s_sleep(1); \
    if ((++_sp & 255u) == 0u) { if (xb_ld(&(bar)[XB_TMO])) break; if (_sp > XB_SPIN_CAP) { atomicAdd(&(bar)[XB_TMO], 1u); break; } } } } while (0)

struct XcdBarrier {
    unsigned* bar; unsigned x;
    volatile LAS unsigned* st;
};

__device__ __forceinline__ XcdBarrier xcd_barrier_post(unsigned* bar, volatile LAS unsigned* st) {
    XcdBarrier b; b.bar = bar; b.x = xb_xcc_id(); b.st = st;
    if (threadIdx.x == 0) (void)xb_add(&bar[XB_XCNT(b.x)], 1u);
    return b;
}
__device__ __forceinline__ void xcd_barrier_complete(unsigned* bar, unsigned x, unsigned& nloc, unsigned& nx) {
    const unsigned G = gridDim.x * gridDim.y * gridDim.z;
    unsigned sum, cnt, mine, sp = 0u;
    for (;;) {
        sum = 0u; cnt = 0u; mine = 0u;
#pragma unroll
        for (unsigned j = 0; j < 16; ++j) { const unsigned c = xb_ld(&bar[XB_XCNT(j)]); sum += c; cnt += (c > 0u) ? 1u : 0u; mine = (j == x) ? c : mine; }
        if (sum == G) break;
        __builtin_amdgcn_s_sleep(1);
        if ((++sp & 255u) == 0u) { if (xb_ld(&bar[XB_TMO])) break; if (sp > XB_SPIN_CAP) { atomicAdd(&bar[XB_TMO], 1u); break; } }
    }
    nloc = mine > 0u ? mine : 1u; nx = cnt > 0u ? cnt : 1u;
}

__device__ __forceinline__ void xcd_barrier(const XcdBarrier& b) {
    asm volatile("s_waitcnt vmcnt(0)" ::: "memory");
    __syncthreads();
    if (threadIdx.x == 0) {
        unsigned* bar = b.bar;
        __builtin_amdgcn_s_waitcnt(0);
        unsigned nloc = b.st[0], nx = b.st[1];
        if (nloc == 0u) { xcd_barrier_complete(bar, b.x, nloc, nx); b.st[0] = nloc; b.st[1] = nx; }
        const unsigned old = xb_add(&bar[XB_XSUB(b.x)], 1u);
        const unsigned gen = old / nloc;
        if (old + 1u == (gen + 1u) * nloc) {
            __builtin_amdgcn_fence(__ATOMIC_RELEASE, "agent");
            asm volatile("s_waitcnt vmcnt(0)" ::: "memory");
            const unsigned og = xb_add(&bar[XB_TOP], 1u);
            const unsigned tg = og / nx;
            if (og + 1u == (tg + 1u) * nx) xb_add(&bar[XB_TOPGEN], 1u);
            else XB_SPIN(xb_ld(&bar[XB_TOPGEN]) == tg, bar);
            __builtin_amdgcn_fence(__ATOMIC_ACQUIRE, "agent");
            xb_add(&bar[XB_XGEN(b.x)], 1u);
            asm volatile("s_waitcnt vmcnt(0)" ::: "memory");
        } else {
            XB_SPIN(xb_ld(&bar[XB_XGEN(b.x)]) == gen, bar);
            __builtin_amdgcn_fence(__ATOMIC_ACQUIRE, "agent");
            asm volatile("s_waitcnt vmcnt(0)" ::: "memory");
        }
    }
    __syncthreads();
}

template <bool FROMP>
__device__ __forceinline__ void modnorm_phase(LAS unsigned char* lds, const float* xin, bf16* hout, const float* gvec, const float* modp, const float* bmod, const float* modf, int jsh, int jsc, int tid, int lane, int wave) {
    LAS float* TA = (LAS float*)lds; LAS float* TS = TA + DM;
    const int b = (blockIdx.x * 32) / SEQ;
    for (int k = tid; k < DM; k += NWAVES * 64) {
        float sh, sc;
        if (FROMP) { sh = bmod[jsh * DM + k]; sc = bmod[jsc * DM + k];
            for (int ks = 0; ks < KSPLIT; ++ks) { sh += modp[(size_t)(ks * 4 + b) * NMODW + jsh * DM + k]; sc += modp[(size_t)(ks * 4 + b) * NMODW + jsc * DM + k]; } }
        else { sh = modf[(size_t)b * NMODW + jsh * DM + k]; sc = modf[(size_t)b * NMODW + jsc * DM + k]; }
        TA[k] = gvec[k] * (1.0f + sc); TS[k] = sh; }
    __syncthreads();
    for (int r = 0; r < 4; ++r) { const int row = blockIdx.x * 32 + wave * 4 + r;
        const f32x4* xr = (const f32x4*)(xin + (size_t)row * DM) + lane;
        f32x4 v[8]; float s = 0.f;
#pragma unroll
        for (int j = 0; j < 8; ++j) { v[j] = __builtin_nontemporal_load(xr + 64 * j); s += (v[j].x * v[j].x + v[j].y * v[j].y) + (v[j].z * v[j].z + v[j].w * v[j].w); }
        const float rstd = 1.0f / sqrtf(wave_sum(s) * (1.0f / DM) + 1e-6f);
        GAS v2u* o8 = (GAS v2u*)(hout + (size_t)row * DM) + lane;
#pragma unroll
        for (int j = 0; j < 8; ++j) { const f32x4 a = *(const LAS f32x4*)(TA + 4 * (lane + 64 * j)), sft = *(const LAS f32x4*)(TS + 4 * (lane + 64 * j));
            const f32x4 o = v[j] * rstd * a + sft; o8[64 * j] = (v2u){pk2(o.x, o.y), pk2(o.z, o.w)}; } }
    __syncthreads();
}

#define TS_A (-1)
#define TS_MASK 0
#define TS_SCALE 1e-5f
#define TS_X (-1)
#define TS_Y (-1)
#define STAMP(k) do { if (TS_A >= 0 && bx == 0 && threadIdx.x == 0) ((volatile LAS unsigned long long*)(lds + MISC_OFF + 16))[k] = __builtin_amdgcn_s_memrealtime(); } while (0)
#define SSTAMP(k) do { if (TS_A >= 0 && blockIdx.x == 0 && threadIdx.x == 0) ((volatile LAS unsigned long long*)(lds + MISC_OFF + 16))[k] = __builtin_amdgcn_s_memrealtime(); } while (0)
constexpr int SS_UST = 2064;
constexpr int SS_U = 0, SS_K = 32 * SS_UST, SS_E = SS_K + 65 * 512, SS_C = SS_E + 2 * 128 * 33 * 4, SS_CST = 272, SS_END = SS_C + 32 * SS_CST;
static_assert(SS_END <= 147456 - 1024, "ssm LDS");
__device__ __forceinline__ float gelu_tanh(float v) { const float t = 0.7978845608028654f * (v + 0.044715f * v * v * v); const float e = __builtin_amdgcn_exp2f(-2.885390081777927f * t); return v * __builtin_amdgcn_rcpf(1.0f + e); }
__device__ __forceinline__ void ssm_unit(LAS unsigned char* lds, int b, int g, const bf16* proj, const bf16* ktab, const bf16* gtab, const bf16* htab, const float* a64, const float* dskip, bf16* vg, int tid, int lane, int wave) {
    const int n = lane & 31, h = lane >> 5;
    const int mt1 = wave & 3, kh = wave >> 2;
    bf16x8 hf[32];
    { const bf16* hp = htab + (((size_t)(g * 4 + mt1) * 64 + kh * 32) * 64 + lane) * 8;
#pragma unroll
      for (int s = 0; s < 32; ++s) hf[s] = *(const GAS bf16x8*)(hp + (size_t)s * 512); }
    { v4u ur[8];
#pragma unroll
      for (int it = 0; it < 8; ++it) { const int i = tid + 512 * it; ur[it] = *(const GAS v4u*)(proj + ((size_t)(b * NGRP + g) * SEQ * 16 + (size_t)i * 8)); }
      v4u kr[5];
#pragma unroll
      for (int it = 0; it < 5; ++it) { const int i = tid + 512 * it; kr[it] = (v4u){0u, 0u, 0u, 0u}; if (i < 2080) kr[it] = *(const GAS v4u*)(ktab + (size_t)g * 65 * 256 + i * 8); }
#pragma unroll
      for (int it = 0; it < 8; ++it) { const int i = tid + 512 * it, t = i >> 1, hf2 = i & 1; *(LAS v4u*)(lds + SS_U + (t >> 6) * SS_UST + (t & 63) * 32 + hf2 * 16) = ur[it]; }
#pragma unroll
      for (int it = 0; it < 5; ++it) { const int i = tid + 512 * it; if (i < 2080) *(LAS v4u*)(lds + SS_K + i * 16) = kr[it]; } }
    __syncthreads(); SSTAMP(24);
    { f32x16 acc;
#pragma unroll
      for (int i = 0; i < 16; ++i) acc[i] = 0.f;
#pragma unroll
      for (int s = 0; s < 32; ++s) { const bf16x8 bb = *(const LAS bf16x8*)(lds + SS_U + n * SS_UST + (kh * 32 + s) * 32 + h * 16);
          acc = __builtin_amdgcn_mfma_f32_32x32x16_bf16(hf[s], bb, acc, 0, 0, 0); }
      LAS float* E = (LAS float*)(lds + SS_E) + kh * 128 * 33;
#pragma unroll
      for (int r = 0; r < 16; ++r) E[(32 * mt1 + (r & 3) + 8 * (r >> 2) + 4 * h) * 33 + n] = acc[r]; }
    __syncthreads(); SSTAMP(25);
    if (wave == 0) { const int p = lane; const float ar = a64[(g * 64 + p) * 2], ai = a64[(g * 64 + p) * 2 + 1]; float cr = 0.f, ci = 0.f;
        const LAS float* E0 = (const LAS float*)(lds + SS_E); const LAS float* E1 = E0 + 128 * 33;
#pragma unroll 8
        for (int j = 0; j < 32; ++j) { *(LAS bf16*)(lds + SS_C + j * SS_CST + p * 2) = (bf16)f2bf(cr); *(LAS bf16*)(lds + SS_C + j * SS_CST + (64 + p) * 2) = (bf16)f2bf(ci);
            const float er = E0[p * 33 + j] + E1[p * 33 + j], ei = E0[(64 + p) * 33 + j] + E1[(64 + p) * 33 + j];
            const float nr = ar * cr - ai * ci + er, ni = ar * ci + ai * cr + ei; cr = nr; ci = ni; } }
    f32x16 acc4[4];
#pragma unroll
    for (int q = 0; q < 4; ++q)
#pragma unroll
        for (int i = 0; i < 16; ++i) acc4[q][i] = 0.f;
    const int c_l = n & 15, tl = n >> 4;
    const int bbase = SS_U + n * SS_UST + h * 16;
    const int kb0 = SS_K + ((tl + 1) * 16 + c_l) * 32 + h * 16;
    const int mtq0 = wave, mtq1 = 15 - wave, mtq2 = 16 + wave, mtq3 = 31 - wave;
    const int nsmax = 2 * mtq3 + 2;
    bf16x8 gfb[2][8];
    for (int s = 0; s < nsmax; s += 2) {
        const bf16x8 bb0 = *(const LAS bf16x8*)(lds + bbase + s * 32), bb1 = *(const LAS bf16x8*)(lds + bbase + s * 32 + 32);
        const bool c0 = s < 2 * mtq0 + 2, c1 = s < 2 * mtq1 + 2, c2 = s < 2 * mtq2 + 2;
        bf16x8 a00, a01, a10, a11, a20, a21;
        if (c0) { a00 = *(const LAS bf16x8*)(lds + kb0 + mtq0 * 1024 - s * 512); a01 = *(const LAS bf16x8*)(lds + kb0 + mtq0 * 1024 - s * 512 - 512); }
        if (c1) { a10 = *(const LAS bf16x8*)(lds + kb0 + mtq1 * 1024 - s * 512); a11 = *(const LAS bf16x8*)(lds + kb0 + mtq1 * 1024 - s * 512 - 512); }
        if (c2) { a20 = *(const LAS bf16x8*)(lds + kb0 + mtq2 * 1024 - s * 512); a21 = *(const LAS bf16x8*)(lds + kb0 + mtq2 * 1024 - s * 512 - 512); }
        const bf16x8 a30 = *(const LAS bf16x8*)(lds + kb0 + mtq3 * 1024 - s * 512), a31 = *(const LAS bf16x8*)(lds + kb0 + mtq3 * 1024 - s * 512 - 512);
        acc4[3] = __builtin_amdgcn_mfma_f32_32x32x16_bf16(a30, bb0, acc4[3], 0, 0, 0);
        if (c2) acc4[2] = __builtin_amdgcn_mfma_f32_32x32x16_bf16(a20, bb0, acc4[2], 0, 0, 0);
        if (c1) acc4[1] = __builtin_amdgcn_mfma_f32_32x32x16_bf16(a10, bb0, acc4[1], 0, 0, 0);
        if (c0) acc4[0] = __builtin_amdgcn_mfma_f32_32x32x16_bf16(a00, bb0, acc4[0], 0, 0, 0);
        acc4[3] = __builtin_amdgcn_mfma_f32_32x32x16_bf16(a31, bb1, acc4[3], 0, 0, 0);
        if (c2) acc4[2] = __builtin_amdgcn_mfma_f32_32x32x16_bf16(a21, bb1, acc4[2], 0, 0, 0);
        if (c1) acc4[1] = __builtin_amdgcn_mfma_f32_32x32x16_bf16(a11, bb1, acc4[1], 0, 0, 0);
        if (c0) acc4[0] = __builtin_amdgcn_mfma_f32_32x32x16_bf16(a01, bb1, acc4[0], 0, 0, 0); }
#pragma unroll
    for (int q = 0; q < 2; ++q) { const bf16* gp = gtab + (((size_t)(g * 32 + (q == 0 ? mtq0 : mtq1)) * 8) * 64 + lane) * 8;
#pragma unroll
        for (int ks = 0; ks < 8; ++ks) gfb[q][ks] = *(const GAS bf16x8*)(gp + (size_t)ks * 512); }
    asm volatile("" ::: "memory");
    SSTAMP(26); __syncthreads(); SSTAMP(27);
#pragma unroll
    for (int q = 0; q < 2; ++q) {
#pragma unroll
        for (int ks = 0; ks < 8; ++ks) { const bf16x8 bb = *(const LAS bf16x8*)(lds + SS_C + n * SS_CST + (16 * ks + 8 * h) * 2);
            acc4[q] = __builtin_amdgcn_mfma_f32_32x32x16_bf16(gfb[q][ks], bb, acc4[q], 0, 0, 0); } }
#pragma unroll
    for (int q = 2; q < 4; ++q) { const bf16* gp = gtab + (((size_t)(g * 32 + (q == 2 ? mtq2 : mtq3)) * 8) * 64 + lane) * 8;
        bf16x8 gf[8];
#pragma unroll
        for (int ks = 0; ks < 8; ++ks) gf[ks] = *(const GAS bf16x8*)(gp + (size_t)ks * 512);
#pragma unroll
        for (int ks = 0; ks < 8; ++ks) { const bf16x8 bb = *(const LAS bf16x8*)(lds + SS_C + n * SS_CST + (16 * ks + 8 * h) * 2);
            acc4[q] = __builtin_amdgcn_mfma_f32_32x32x16_bf16(gf[ks], bb, acc4[q], 0, 0, 0); } }
    SSTAMP(28);
#pragma unroll
    for (int q = 0; q < 4; ++q) { const int mt = (q == 0) ? mtq0 : (q == 1) ? mtq1 : (q == 2) ? mtq2 : mtq3;
#pragma unroll
        for (int q4 = 0; q4 < 4; ++q4) { const int t = 2 * mt + (q4 >> 1), c0 = 8 * (q4 & 1) + 4 * h;
            const v2u uu = *(const LAS v2u*)(lds + SS_U + n * SS_UST + t * 32 + c0 * 2);
            const f32x4 dv = *(const f32x4*)(dskip + 16 * g + c0);
            const float y0 = acc4[q][4 * q4 + 0] + dv[0] * bf_lo(uu.x), y1 = acc4[q][4 * q4 + 1] + dv[1] * bf_hi(uu.x), y2 = acc4[q][4 * q4 + 2] + dv[2] * bf_lo(uu.y), y3 = acc4[q][4 * q4 + 3] + dv[3] * bf_hi(uu.y);
            *(GAS v2u*)(vg + (size_t)(b * SEQ + 64 * n + t) * SSMW + 16 * g + c0) = (v2u){pk2(gelu_tanh(y0), gelu_tanh(y1)), pk2(gelu_tanh(y2), gelu_tanh(y3))}; } }
    __syncthreads();
}

constexpr int AT_K = 0, AT_V = 272 * 256, AT_END = 2 * 272 * 256;
static_assert(AT_END <= 147456 - 1024, "attn LDS");
__device__ __forceinline__ unsigned off_b(unsigned row, unsigned ch) { return 256u * row + 16u * (ch ^ (((row & 3) << 2) | ((row >> 2) & 3))); }
typedef short v4i16_t __attribute__((ext_vector_type(4)));
__device__ __forceinline__ s16x4 tr_read(LAS unsigned char* p) { return __builtin_bit_cast(s16x4, __builtin_amdgcn_ds_read_tr16_b64_v4i16((LAS v4i16_t*)p)); }
struct AttnDesc { int b, hd, di, dil, res, blk; };
__device__ __forceinline__ AttnDesc attn_decode(int u) { AttnDesc d; const int bh = u / 48, w = u % 48; d.b = bh / NHEAD; d.hd = bh % NHEAD;
    if (w < 16) { d.di = 0; d.dil = 1; d.res = 0; d.blk = w; } else if (w < 32) { d.di = 1; d.dil = 4; d.res = (w - 16) >> 2; d.blk = (w - 16) & 3; } else { d.di = 2; d.dil = 16; d.res = w - 32; d.blk = 0; }
    return d; }
__device__ __forceinline__ void attn_run(LAS unsigned char* lds, int u0, int ustride, int uend, const bf16* proj, bf16* obr, float* lse, int tid, int lane, int wave) {
    if (u0 >= uend) return;
    if (tid < 256) { const int row = 256 + (tid >> 4), ch = tid & 15; *(LAS v4u*)(lds + AT_K + off_b(row, ch)) = (v4u){0u, 0u, 0u, 0u}; *(LAS v4u*)(lds + AT_V + off_b(row, ch)) = (v4u){0u, 0u, 0u, 0u}; }
    const int qn = lane & 15, g = lane >> 4, q4 = (lane & 15) >> 2, p4 = lane & 3;
    const int r0s = tid >> 4, chs = tid & 15; const unsigned soff = off_b(r0s, chs);
    v4u kr[8], vr[8]; bf16x8 qnx[4];
    int u = u0; AttnDesc nd = attn_decode(u);
#define AT_ISSUE(D) do { const size_t rowb_ = (size_t)(D).b * SEQ; \
        _Pragma("unroll") for (int it = 0; it < 8; ++it) { const int sub = 128 * (D).blk - 128 + r0s + 32 * it; kr[it] = (v4u){0u, 0u, 0u, 0u}; vr[it] = kr[it]; \
            if (sub >= 0) { const bf16* src = proj + (rowb_ + (D).res + (D).dil * sub) * PROJW + 2048 + (D).hd * HDIM + chs * 8; kr[it] = *(const GAS v4u*)src; vr[it] = *(const GAS v4u*)(src + 1024); } } \
        const int qt_ = (D).res + (D).dil * (128 * (D).blk + 16 * wave + qn); \
        _Pragma("unroll") for (int s_ = 0; s_ < 4; ++s_) qnx[s_] = *(const GAS bf16x8*)(proj + (rowb_ + qt_) * PROJW + 1024 + (D).hd * HDIM + 32 * s_ + 8 * g); } while (0)
    AT_ISSUE(nd);
    for (;;) {
        const AttnDesc d = nd;
#pragma unroll
        for (int it = 0; it < 8; ++it) { *(LAS v4u*)(lds + AT_K + soff + 8192 * it) = kr[it]; *(LAS v4u*)(lds + AT_V + soff + 8192 * it) = vr[it]; }
        bf16x8 qf[4];
#pragma unroll
        for (int s = 0; s < 4; ++s) qf[s] = qnx[s];
        __syncthreads();
        const int un = u + ustride; const bool has = un < uend;
        if (has) { nd = attn_decode(un); AT_ISSUE(nd); }
        const bool first = (d.blk == 0); const int tskip = first ? 8 - wave : 0;
        f32x4 sc[10];
#pragma unroll
        for (int kt = 0; kt < 10; ++kt) { f32x4 a = {0.f, 0.f, 0.f, 0.f};
            if (kt < 9 && kt >= tskip) {
#pragma unroll
                for (int s = 0; s < 4; ++s) { const bf16x8 kf = *(const LAS bf16x8*)(lds + AT_K + off_b(16 * (wave + kt) + qn, 4 * s + g));
                    a = __builtin_amdgcn_mfma_f32_16x16x32_bf16(kf, qf[s], a, 0, 0, 0); } }
            sc[kt] = a; }
        float mx = -1e30f;
#pragma unroll
        for (int kt = 0; kt < 10; ++kt)
#pragma unroll
            for (int r = 0; r < 4; ++r) { const int rel = 16 * kt + 4 * g + r; bool ok = (rel >= qn) && (rel <= qn + 128) && (kt >= tskip);
                sc[kt][r] = ok ? sc[kt][r] : -1e30f; mx = fmaxf(mx, sc[kt][r]); }
        mx = fmaxf(mx, __shfl_xor(mx, 16)); mx = fmaxf(mx, __shfl_xor(mx, 32));
        float ls = 0.f;
#pragma unroll
        for (int kt = 0; kt < 10; ++kt)
#pragma unroll
            for (int r = 0; r < 4; ++r) { const float p = (sc[kt][r] > -1e29f) ? __builtin_amdgcn_exp2f(sc[kt][r] - mx) : 0.f; sc[kt][r] = p; ls += p; }
        ls += __shfl_xor(ls, 16); ls += __shfl_xor(ls, 32);
        f32x4 o[8];
#pragma unroll
        for (int c = 0; c < 8; ++c) o[c] = (f32x4){0.f, 0.f, 0.f, 0.f};
#pragma unroll
        for (int ks = 0; ks < 5; ++ks) {
            if (2 * ks + 1 >= tskip) {
                union { unsigned uu[4]; bf16x8 v; } pb;
                pb.uu[0] = pk2(sc[2 * ks][0], sc[2 * ks][1]); pb.uu[1] = pk2(sc[2 * ks][2], sc[2 * ks][3]); pb.uu[2] = pk2(sc[2 * ks + 1][0], sc[2 * ks + 1][1]); pb.uu[3] = pk2(sc[2 * ks + 1][2], sc[2 * ks + 1][3]);
                const unsigned r0 = 16 * wave + 32 * ks + 4 * g + q4;
#pragma unroll
                for (int c = 0; c < 8; ++c) {
                    const s16x4 v0 = tr_read(lds + AT_V + off_b(r0, 2 * c + (p4 >> 1)) + 8 * (p4 & 1));
                    const s16x4 v1 = tr_read(lds + AT_V + off_b(r0 + 16, 2 * c + (p4 >> 1)) + 8 * (p4 & 1));
                    bf16x8 va; va[0] = v0[0]; va[1] = v0[1]; va[2] = v0[2]; va[3] = v0[3]; va[4] = v1[0]; va[5] = v1[1]; va[6] = v1[2]; va[7] = v1[3];
                    o[c] = __builtin_amdgcn_mfma_f32_16x16x32_bf16(va, pb.v, o[c], 0, 0, 0); } } }
        const float inv = 1.0f / ls;
        const size_t qrow = (size_t)d.b * SEQ + d.res + d.dil * (128 * d.blk + 16 * wave + qn);
        bf16* op = obr + (size_t)d.di * MTOK * ATTW + qrow * ATTW + d.hd * HDIM + 4 * g;
#pragma unroll
        for (int c = 0; c < 8; ++c) *(GAS v2u*)(op + 16 * c) = (v2u){pk2(o[c][0] * inv, o[c][1] * inv), pk2(o[c][2] * inv, o[c][3] * inv)};
        if (g == 0) lse[(size_t)d.di * MTOK * NHEAD + qrow * NHEAD + d.hd] = mx + __builtin_amdgcn_logf(ls);
        __syncthreads();
        if (!has) break;
        u = un;
    }
#undef AT_ISSUE
}

__device__ __forceinline__ void ynorm_phase(bf16* ycat, const bf16* obr, const float* lse, int lane, int wave) {
    for (int r = 0; r < 4; ++r) { const int row = blockIdx.x * 32 + wave * 4 + r;
        { const int hd = lane >> 3;
          const float l0 = lse[(size_t)row * NHEAD + hd], l1 = lse[(size_t)MTOK * NHEAD + (size_t)row * NHEAD + hd], l2 = lse[(size_t)2 * MTOK * NHEAD + (size_t)row * NHEAD + hd];
          const float lm = fmaxf(l0, fmaxf(l1, l2)); float w0 = __builtin_amdgcn_exp2f(l0 - lm), w1 = __builtin_amdgcn_exp2f(l1 - lm), w2 = __builtin_amdgcn_exp2f(l2 - lm);
          const float wi = 1.0f / (w0 + w1 + w2); w0 *= wi; w1 *= wi; w2 *= wi;
          float v[16];
#pragma unroll
          for (int i = 0; i < 16; ++i) v[i] = 0.f;
#pragma unroll
          for (int d = 0; d < 3; ++d) { const bf16* p = obr + (size_t)d * MTOK * ATTW + (size_t)row * ATTW + lane * 16; const v4u a = *(const GAS v4u*)p, c = *(const GAS v4u*)(p + 8); const float w = d == 0 ? w0 : d == 1 ? w1 : w2;
              v[0] += w * bf_lo(a.x); v[1] += w * bf_hi(a.x); v[2] += w * bf_lo(a.y); v[3] += w * bf_hi(a.y); v[4] += w * bf_lo(a.z); v[5] += w * bf_hi(a.z); v[6] += w * bf_lo(a.w); v[7] += w * bf_hi(a.w);
              v[8] += w * bf_lo(c.x); v[9] += w * bf_hi(c.x); v[10] += w * bf_lo(c.y); v[11] += w * bf_hi(c.y); v[12] += w * bf_lo(c.z); v[13] += w * bf_hi(c.z); v[14] += w * bf_lo(c.w); v[15] += w * bf_hi(c.w); }
          float s = 0.f;
#pragma unroll
          for (int i = 0; i < 16; ++i) s += v[i] * v[i];
          const float rstd = 1.0f / sqrtf(wave_sum(s) * (1.0f / ATTW) + 1e-6f);
          bf16* p = ycat + (size_t)row * DM + SSMW + lane * 16;
          *(GAS v4u*)p = (v4u){pk2(v[0] * rstd, v[1] * rstd), pk2(v[2] * rstd, v[3] * rstd), pk2(v[4] * rstd, v[5] * rstd), pk2(v[6] * rstd, v[7] * rstd)};
          *(GAS v4u*)(p + 8) = (v4u){pk2(v[8] * rstd, v[9] * rstd), pk2(v[10] * rstd, v[11] * rstd), pk2(v[12] * rstd, v[13] * rstd), pk2(v[14] * rstd, v[15] * rstd)}; } }
}
__device__ __forceinline__ void final_norm_phase(float* out, const float* gfin, int lane, int wave) {
    for (int r = 0; r < 4; ++r) { const int row = blockIdx.x * 32 + wave * 4 + r;
        f32x4* xr = (f32x4*)(out + (size_t)row * DM) + lane; f32x4 v[8]; float s = 0.f;
#pragma unroll
        for (int j = 0; j < 8; ++j) { v[j] = xr[64 * j]; s += (v[j].x * v[j].x + v[j].y * v[j].y) + (v[j].z * v[j].z + v[j].w * v[j].w); }
        const float rstd = 1.0f / sqrtf(wave_sum(s) * (1.0f / DM) + 1e-6f);
#pragma unroll
        for (int j = 0; j < 8; ++j) { const f32x4 gq = *((const f32x4*)gfin + lane + 64 * j); xr[64 * j] = v[j] * rstd * gq; } }
}

constexpr int NPH = 11;
constexpr int ATT_P3_UNITS = 512;
constexpr int IT_GEMV = KSPLIT * 48, IT_SSM = NGRP * 25, IT_FIN = 48 * 4, IT_ROPE = MTOK, IT_WIN = (DM / 64) * (PROJW / 64), IT_WGLU = (SSMW / 64) * (SSMW / 64), IT_WOUT = (DM / 64) * (DM / 64),
              IT_WG = (DM / 64) * (DFF / 64), IT_WD = (DFF / 64) * (DM / 64), IT_TOTAL = IT_GEMV + IT_SSM + IT_FIN + IT_ROPE + IT_WIN + IT_WGLU + IT_WOUT + 2 * IT_WG;
__global__ void __launch_bounds__(NWAVES * 64, 2) hymba_fwd(Args args) {
    extern __shared__ __attribute__((aligned(16))) unsigned char lds_raw[];
    LAS unsigned char* lds = (LAS unsigned char*)lds_raw;
    cg::grid_group grid = cg::this_grid();
    const int tid = threadIdx.x, lane = tid & 63, wave = __builtin_amdgcn_readfirstlane(tid >> 6);
    const int G = gridDim.x, bx = blockIdx.x;
    unsigned char* ws = args.ws;
    const float* const* in = args.in;
    float* modp = (float*)(ws + WS_MODP); float* modf = (float*)(ws + WS_MODF); float* cosT = (float*)(ws + WS_ROPE); float* sinT = cosT + (size_t)MTOK * 64;
    bf16* ktab = (bf16*)(ws + WS_KTAB); bf16* gtab = (bf16*)(ws + WS_GTAB); bf16* htab = (bf16*)(ws + WS_HTAB); float* a64 = (float*)(ws + WS_A64);
    bf16* Win = (bf16*)(ws + WS_WIN); bf16* Wglu = (bf16*)(ws + WS_WGLU); bf16* Wout = (bf16*)(ws + WS_WOUT); bf16* Wgu = (bf16*)(ws + WS_WGU); bf16* Wdn = (bf16*)(ws + WS_WDN);
    bf16* Hb = (bf16*)(ws + WS_H); bf16* proj = (bf16*)(ws + WS_PROJ); bf16* vg = (bf16*)(ws + WS_VG); bf16* ycat = (bf16*)(ws + WS_YCAT); bf16* obr = (bf16*)(ws + WS_OBR); float* lse = (float*)(ws + WS_LSE);
    bf16* ff = (bf16*)(ws + WS_FF); bf16* ut = (bf16*)(ws + WS_UT);
    const int lo = args.ph_lo, hi = args.ph_hi;
#ifndef PHMASK
#define PHMASK 0x7ff
#endif
#define IN(k) (((PHMASK >> (k)) & 1) && lo <= (k) && (k) < hi)
    volatile LAS unsigned* MISC = (volatile LAS unsigned*)(lds + MISC_OFF);
    if (tid < 2) MISC[tid] = 0u;
    __syncthreads();
    if (args.ph_lo < 0) grid.sync();
    const XcdBarrier xbar = xcd_barrier_post((unsigned*)(ws + WS_CTL), MISC);
    STAMP(0);
#define SEAM(k) do { if (IN(k) && IN((k) + 1)) xcd_barrier(xbar); } while (0)
#ifndef DOUBLE_MASK
#define DOUBLE_MASK 0
#endif
#define P0SUB 8
#define P3SUB 1
#define REPS(k) for (int rep_ = 0; rep_ < 1 + ((DOUBLE_MASK >> (k)) & 1); ++rep_)
#define RSYNC(k) do { if ((DOUBLE_MASK >> (k)) & 1) xcd_barrier(xbar); } while (0)

    REPS(0) if (IN(0)) {
        RSYNC(0);
        LAS float* scr = (LAS float*)(lds + wave * 16640);
        const int gw = wave * G + bx, NGW = G * NWAVES;
        const int nmine = (IT_TOTAL - gw + NGW - 1) / NGW;
        for (int kk = 0; kk < nmine; ++kk) {
            const bool gfirst = (gw < IT_GEMV);
            const int it = gw + ((wave & 1) ? ((gfirst && kk == 0) ? 0 : (gfirst ? nmine - kk : nmine - 1 - kk)) : kk) * NGW;
            int r = it;
#if DOUBLE_MASK & 1
            if (rep_ == 1) { const int ty = (it < IT_GEMV) ? 1 : (it < IT_GEMV + IT_SSM) ? 2 : (it < IT_GEMV + IT_SSM + IT_ROPE) ? 4 : 8; if (!(P0SUB & ty)) continue; }
#endif
            if (r < IT_GEMV) { p0_gemv_item(in[1], in[3], modp, modf, in[4], (unsigned*)(ws + WS_CNT), scr, r, lane); continue; } r -= IT_GEMV;
            if (r < IT_SSM) { const int g = r / 25, sub = r % 25;
                if (sub < 9) p0_ktab_item(in, ktab, a64, scr, g, sub, lane); else if (sub < 17) p0_gtab_item(in, gtab, g, sub - 9, lane); else p0_htab_item(in, htab, g, sub - 17, lane);
                continue; } r -= IT_SSM;
            if (r < IT_FIN) { p0_fin_item(modp, modf, in[4], (unsigned*)(ws + WS_CNT), r, lane); continue; } r -= IT_FIN;
            if (r < IT_ROPE) { p0_rope_item((const int*)in[2], cosT, sinT, r, lane); continue; } r -= IT_ROPE;
            if (r < IT_WIN) { p0_transpose_item<1>(in[6], DM, PROJW, Win, scr, r, lane, nullptr, nullptr); continue; } r -= IT_WIN;
            if (r < IT_WGLU) { p0_transpose_item<0>(in[15], SSMW, SSMW, Wglu, scr, r, lane, nullptr, nullptr); continue; } r -= IT_WGLU;
            if (r < IT_WOUT) { p0_transpose_item<4>(in[19], DM, DM, Wout, scr, r, lane, in[17], in[18]); continue; } r -= IT_WOUT;
            if (r < IT_WG) { p0_transpose_item<2>(in[21], DM, DFF, Wgu, scr, r, lane, nullptr, nullptr); continue; } r -= IT_WG;
            p0_transpose_item<3>(in[22], DM, DFF, Wgu, scr, r, lane, nullptr, nullptr);
        }
        __syncthreads();
    }
    STAMP(1); STAMP(2);
    REPS(1) if (IN(1)) {
        RSYNC(1);
        unsigned* gcnt = (unsigned*)(ws + WS_CNT);
        if (wave == 0) { unsigned sp = 0u; unsigned* dn = gcnt + 64 * 48;
            while ((unsigned)__builtin_amdgcn_readfirstlane((int)__hip_atomic_load(dn, __ATOMIC_RELAXED, __HIP_MEMORY_SCOPE_AGENT)) < 192u) { __builtin_amdgcn_s_sleep(4); if (++sp > (1u << 22)) break; }
            __builtin_amdgcn_fence(__ATOMIC_ACQUIRE, "agent"); asm volatile("s_waitcnt vmcnt(0)" ::: "memory"); }
        __syncthreads();
        modnorm_phase<false>(lds, in[0], Hb, in[5], modp, in[4], modf, 0, 1, tid, lane, wave);
    }
    STAMP(3); SEAM(1); STAMP(4);
    if (IN(2)) {
        pg8::Gemm g{Hb, Win, MTOK, PROJW, DM}; pg8::StaticOrder S; S.init(MTOK, PROJW, G, bx);
        pg8::EpiProj E{proj, ut, cosT, sinT, 0.08838834764831845f * 1.4426950408889634f};
        pg8::gemm_phase<pg8::EpiProj, pg8::StaticOrder, true, true>(lds, g, S, E);
    }
    STAMP(5); SEAM(2); STAMP(6);
    REPS(3) if (IN(3)) {
        RSYNC(3);
        int tid = threadIdx.x; asm volatile("" : "+v"(tid)); const int lane = tid & 63, wave = __builtin_amdgcn_readfirstlane(tid >> 6);
        { const int x = bx & 7, j = (bx >> 3) & 31, ax = 192 * (bx & 7), aj = bx >> 3;
          if ((bx & 1) == 0) { ssm_unit(lds, j >> 3, 8 * x + (j & 7), ut, ktab, gtab, htab, a64, in[14], vg, tid, lane, wave); attn_run(lds, ax + aj, 32, ax + 64, proj, obr, lse, tid, lane, wave); }
          else { attn_run(lds, ax + aj, 32, ax + 64, proj, obr, lse, tid, lane, wave); ssm_unit(lds, j >> 3, 8 * x + (j & 7), ut, ktab, gtab, htab, a64, in[14], vg, tid, lane, wave); } }
    }
    STAMP(8); SEAM(3); STAMP(9);
    if (IN(4)) {
        pg8::Gemm g{vg, Wglu, MTOK, SSMW, SSMW}; pg8::StaticOrder S; S.init(MTOK, SSMW, G, bx);
        pg8::EpiGluNorm E{ycat, vg, in[16], (float*)(ws + WS_SLOTS) + 2 * 65536, (unsigned*)(ws + WS_GCNT)};
        pg8::gemm_phase<pg8::EpiGluNorm, pg8::StaticOrder, false, true>(lds, g, S, E);
        __syncthreads();
        STAMP(10);
        { int tid = threadIdx.x; asm volatile("" : "+v"(tid)); const int lane = tid & 63, wave = __builtin_amdgcn_readfirstlane(tid >> 6);
          const bool glu = bx < 128; const int ax = 192 * (bx & 7), aj = bx >> 3;
          attn_run(lds, glu ? ax + 64 + aj : ax + 80 + (aj - 16), 16, glu ? ax + 80 : ax + 192, proj, obr, lse, tid, lane, wave); }
    }
    STAMP(11); SEAM(4); STAMP(12);
    REPS(5) if (IN(5)) ynorm_phase(ycat, obr, lse, lane, wave);
    STAMP(13); SEAM(5); STAMP(14);
    if (IN(6)) {
        pg8::Gemm g{ycat, Wout, MTOK, DM, DM}; pg8::StaticOrder S; S.init(MTOK, DM, G, bx);
        pg8::EpiNormX<0> E{in[0], args.out, Hb, modf + 2 * DM, in[20], modf + 4 * DM, modf + 3 * DM, (float*)(ws + WS_SLOTS), (unsigned*)(ws + WS_PCNT), (bf16*)(ws + WS_OBR)};
        pg8::gemm_phase<pg8::EpiNormX<0>, pg8::StaticOrder, false, true>(lds, g, S, E);
    }
    STAMP(15); SEAM(6); STAMP(16);
    if (IN(8)) {
        pg8::Gemm g{Hb, Wgu, MTOK, 2 * DFF, DM}; pg8::StaticOrder S; S.init(MTOK, 2 * DFF, G, bx);
        pg8::EpiSwiglu E{ff};
        pg8::gemm_phase<pg8::EpiSwiglu, pg8::StaticOrder, true, true>(lds, g, S, E);
        if (bx >= 128) { int tid2 = threadIdx.x; asm volatile("" : "+v"(tid2)); const int lane2 = tid2 & 63, wave2 = __builtin_amdgcn_readfirstlane(tid2 >> 6);
            LAS float* scr = (LAS float*)(lds + wave2 * 16640);
            for (int it = (bx - 128) * NWAVES + wave2; it < IT_WD; it += 128 * NWAVES) p0_transpose_item<0>(in[23], DFF, DM, Wdn, scr, it, lane2, nullptr, nullptr); }
    }
    STAMP(19); SEAM(8); STAMP(20);
    if (IN(9)) {
        pg8::Gemm g{ff, Wdn, MTOK, DM, DFF}; pg8::StaticOrder S; S.init(MTOK, DM, G, bx);
        pg8::EpiNormX<1> E{args.out, args.out, nullptr, modf + 5 * DM, in[24], nullptr, nullptr, (float*)(ws + WS_SLOTS) + 65536, (unsigned*)(ws + WS_PCNT) + 32 * 64, (bf16*)(ws + WS_OBR)};
        pg8::gemm_phase<pg8::EpiNormX<1>, pg8::StaticOrder, false, true>(lds, g, S, E);
    }
    STAMP(21); STAMP(22);
    if (TS_A >= 0 && bx == 0) { STAMP(23); __syncthreads();
        const volatile LAS unsigned long long* ts = (const volatile LAS unsigned long long*)(lds + MISC_OFF + 16);
        unsigned long long tot = 0ull;
        for (int i = 0; i < 23; ++i) if ((TS_MASK >> i) & 1) tot += ts[i + 1] - ts[i];
        if (TS_X >= 0) tot = ts[TS_Y < 0 ? 0 : TS_Y] - ts[TS_X < 0 ? 0 : TS_X];
        const float dl = (float)tot * TS_SCALE;
        for (int i = threadIdx.x; i < 4096; i += NWAVES * 64) args.out[i] += dl; }
#undef IN
#undef SEAM
}

#ifndef MK_PER_PHASE
#define MK_PER_PHASE 0
#endif
extern "C" void kernel_launch(void* const* d_in, const int* in_sizes, int n_in, void* d_out, int out_size, void* d_ws, size_t ws_size, hipStream_t stream) {
    static int ready = 0;
    if (ready == 0) {
        ready = 1;
        if (n_in != 25 || out_size != MTOK * DM || ws_size < WS_END) { fprintf(stderr, "kernel_launch: unexpected shapes (n_in %d out %d ws %zu)\n", n_in, out_size, ws_size); ready = -1; }
        else if (hipFuncSetAttribute((const void*)hymba_fwd, hipFuncAttributeMaxDynamicSharedMemorySize, LDS_BYTES) != hipSuccess) { fprintf(stderr, "kernel_launch: hipFuncSetAttribute failed\n"); ready = -1; }
        else { int per_cu = 0; (void)hipOccupancyMaxActiveBlocksPerMultiprocessor(&per_cu, (const void*)hymba_fwd, NWAVES * 64, LDS_BYTES); (void)hipGetLastError();
               if (per_cu < 1) fprintf(stderr, "kernel_launch: occupancy query reports %d blocks per CU\n", per_cu); }
    }
    if (ready < 0) return;
    if (hipMemsetAsync((char*)d_ws + WS_CTL, 0, CTL_ZERO_BYTES, stream) != hipSuccess) { fprintf(stderr, "kernel_launch: memset failed\n"); return; }
    Args a{};
    for (int i = 0; i < 25; ++i) a.in[i] = (const float*)d_in[i];
    a.out = (float*)d_out; a.ws = (unsigned char*)d_ws;
#if MK_PER_PHASE
    for (int p = 0; p < NPH; ++p) { a.ph_lo = p; a.ph_hi = p + 1; hipLaunchKernelGGL(hymba_fwd, dim3(256), dim3(NWAVES * 64), LDS_BYTES, stream, a); }
#else
    a.ph_lo = 0; a.ph_hi = NPH;
    void* kargs[] = {&a};
    hipError_t e = hipLaunchCooperativeKernel((const void*)hymba_fwd, dim3(256), dim3(NWAVES * 64), kargs, LDS_BYTES, stream);
    if (e != hipSuccess) fprintf(stderr, "kernel_launch: cooperative launch failed: %s\n", hipGetErrorString(e));
#endif
}
```
